# Optimizing an MI355X kernel written in HIP

```python
import math
import jax, jax.numpy as jnp
from jax import lax
import numpy as np

D_MODEL = 1024
BATCH = 8
SEQ = 2048
DEPTH = 1

N_DIFF_HEADS = 8
DIFF_HEAD_DIM = 64
DIFF_V_DIM = 2 * DIFF_HEAD_DIM
DIFF_WIDTH = N_DIFF_HEADS * DIFF_V_DIM
POOL_WINDOWS = (2, 4, 8, 16)
N_POOL_GROUPS = len(POOL_WINDOWS)
POOL_GROUP_DIM = 128
POOL_WIDTH = N_POOL_GROUPS * POOL_GROUP_DIM
N_BRANCHES = 2
IN_COLS = 3 * DIFF_WIDTH + POOL_WIDTH + N_BRANCHES * D_MODEL
ROPE_THETA = 500000.0
ROT_DIM = DIFF_HEAD_DIM // 4
Q_BLOCK = 128
N_EXPERTS = 32
TOP_K = 4
D_FF_EXPERT = D_MODEL
SWIGLU_ALPHA = 1.702
SWIGLU_LIMIT = 7.0
NORM_EPS = 1e-6
SUBLN_EPS = 1e-5
N_MOD = 6
NEG_BIG = -1e30

kernel_name = "hybrid_diffattn_pool_moe_block"


def _lambda_init(layer):
    return 0.8 - 0.6 * math.exp(-0.3 * layer)


def _rmsnorm(x, g, eps=NORM_EPS):
    xf = x.astype(jnp.float32)
    y = xf * lax.rsqrt(jnp.mean(xf * xf, axis=-1, keepdims=True) + eps)
    return (y * g.astype(jnp.float32)).astype(x.dtype)


def _partial_rope(t, positions):
    half = ROT_DIM // 2
    inv_freq = ROPE_THETA ** (-jnp.arange(half, dtype=jnp.float32) * 2.0 / ROT_DIM)
    ang = positions.astype(jnp.float32)[:, :, None] * inv_freq
    cos = jnp.cos(ang)[:, :, None, None, :]
    sin = jnp.sin(ang)[:, :, None, None, :]
    tf = t.astype(jnp.float32)
    t1, t2, rest = tf[..., :half], tf[..., half:ROT_DIM], tf[..., ROT_DIM:]
    out = jnp.concatenate([t1 * cos - t2 * sin, t2 * cos + t1 * sin, rest], axis=-1)
    return out.astype(t.dtype)


def _diff_attention(q, k, v, lam):
    B, S, H = q.shape[:3]
    nb = S // Q_BLOCK
    scale = DIFF_HEAD_DIM ** -0.5
    qt = q.transpose(3, 0, 2, 1, 4)
    kt = k.transpose(3, 0, 2, 1, 4)
    vt = v.transpose(0, 2, 1, 3)
    qb = qt.reshape(2, B, H, nb, Q_BLOCK, DIFF_HEAD_DIM).transpose(3, 0, 1, 2, 4, 5)
    kpos = jnp.arange(S)

    def block(args):
        qi, i = args
        qpos = i * Q_BLOCK + jnp.arange(Q_BLOCK)
        mask = kpos[None, :] <= qpos[:, None]
        s = jnp.einsum('cbhqd,cbhkd->cbhqk', qi, kt, preferred_element_type=jnp.float32) * scale
        s = jnp.where(mask, s, NEG_BIG)
        p = jax.nn.softmax(s, axis=-1)
        a = p[0] - lam * p[1]
        return jnp.einsum('bhqk,bhkd->bhqd', a.astype(vt.dtype), vt)

    o = lax.map(block, (qb, jnp.arange(nb)))
    return o.transpose(1, 0, 3, 2, 4).reshape(B, S, H, DIFF_V_DIM)


def _multiscale_pool(u, w_pool, pool_scale):
    B, S, _ = u.shape
    uf = u.astype(jnp.float32)
    cs = jnp.cumsum(uf, axis=1)
    t = jnp.arange(S)
    outs = []
    for g, w in enumerate(POOL_WINDOWS):
        sl = slice(g * POOL_GROUP_DIM, (g + 1) * POOL_GROUP_DIM)
        csg = cs[:, :, sl]
        lower = jnp.pad(csg[:, :S - w], ((0, 0), (w, 0), (0, 0)))
        count = jnp.minimum(t + 1, w).astype(jnp.float32)[None, :, None]
        outs.append((csg - lower) / count - uf[:, :, sl])
    d = jnp.stack(outs, axis=2)
    y = jnp.einsum('bsgc,gcd->bsgd', d, w_pool.astype(jnp.float32)).reshape(B, S, POOL_WIDTH)
    return (y * pool_scale.astype(jnp.float32)).astype(u.dtype)


def _clamped_swiglu(z):
    gate, up = z[..., ::2], z[..., 1::2]
    gate = jnp.minimum(gate, SWIGLU_LIMIT)
    up = jnp.clip(up, -SWIGLU_LIMIT, SWIGLU_LIMIT)
    return gate * jax.nn.sigmoid(SWIGLU_ALPHA * gate) * (up + 1.0)


def _moe(h, w_router, b_router, w1, b1, w2, b2):
    B, S, D = h.shape
    ht = h.reshape(B * S, D)
    logits = (ht @ w_router + b_router).astype(jnp.float32)
    top_v, top_i = lax.top_k(logits, TOP_K)
    top_w = jax.nn.softmax(top_v, axis=-1)
    comb = jnp.einsum('tk,tke->te', top_w, jax.nn.one_hot(top_i, N_EXPERTS, dtype=jnp.float32)).astype(h.dtype)
    y = jnp.zeros_like(ht)
    for e in range(N_EXPERTS):
        a = _clamped_swiglu(ht @ w1[e] + b1[e])
        y = y + comb[:, e:e + 1] * (a @ w2[e] + b2[e])
    return y.reshape(B, S, D)


def setup_inputs(seed: int = 0) -> dict:
    key = jax.random.key(seed)
    ks = jax.random.split(key, 26)
    L, D, E, F = DEPTH, D_MODEL, N_EXPERTS, D_FF_EXPERT

    def nrm(k, shape, s):
        return jax.random.normal(k, shape, jnp.float32) * s

    x = nrm(ks[0], (BATCH, SEQ, D), 1.0)
    c = nrm(ks[1], (BATCH, D), 1.0)
    positions = (jax.random.randint(ks[2], (BATCH, 1), 0, 1024) + jnp.arange(SEQ)[None, :]).astype(jnp.int32)
    return {
        "x": x,
        "c": c,
        "positions": positions,
        "w_ada": nrm(ks[3], (L, D, N_MOD * D), D ** -0.5),
        "b_ada": nrm(ks[4], (L, N_MOD * D), 0.01),
        "g_pre_mix": 1.0 + nrm(ks[5], (L, D), 0.05),
        "w_in": nrm(ks[6], (L, D, IN_COLS), D ** -0.5),
        "lambda_q1": nrm(ks[7], (L, DIFF_HEAD_DIM), 0.1),
        "lambda_k1": nrm(ks[8], (L, DIFF_HEAD_DIM), 0.1),
        "lambda_q2": nrm(ks[9], (L, DIFF_HEAD_DIM), 0.1),
        "lambda_k2": nrm(ks[10], (L, DIFF_HEAD_DIM), 0.1),
        "g_subln": 1.0 + nrm(ks[11], (L, DIFF_V_DIM), 0.05),
        "w_pool": nrm(ks[12], (L, N_POOL_GROUPS, POOL_GROUP_DIM, POOL_GROUP_DIM), POOL_GROUP_DIM ** -0.5),
        "pool_scale": 1.0 + nrm(ks[13], (L, POOL_WIDTH), 0.1),
        "w_proj_a": nrm(ks[14], (L, DIFF_WIDTH, D), DIFF_WIDTH ** -0.5),
        "w_proj_b": nrm(ks[15], (L, POOL_WIDTH, D), POOL_WIDTH ** -0.5),
        "w_out": nrm(ks[16], (L, D, D), D ** -0.5),
        "g_post_mix": 1.0 + nrm(ks[17], (L, D), 0.05),
        "g_pre_ffn": 1.0 + nrm(ks[18], (L, D), 0.05),
        "w_router": nrm(ks[19], (L, D, E), D ** -0.5),
        "b_router": nrm(ks[20], (L, E), 0.01),
        "w_exp1": nrm(ks[21], (L, E, D, 2 * F), D ** -0.5),
        "b_exp1": nrm(ks[22], (L, E, 2 * F), 0.01),
        "w_exp2": nrm(ks[23], (L, E, F, D), F ** -0.5),
        "b_exp2": nrm(ks[24], (L, E, D), 0.01),
        "g_post_ffn": 1.0 + nrm(ks[25], (L, D), 0.05),
    }


def reference(x, c, positions, w_ada, b_ada, g_pre_mix, w_in, lambda_q1, lambda_k1, lambda_q2, lambda_k2,
              g_subln, w_pool, pool_scale, w_proj_a, w_proj_b, w_out, g_post_mix, g_pre_ffn,
              w_router, b_router, w_exp1, b_exp1, w_exp2, b_exp2, g_post_ffn):
    B, S, D = x.shape
    H = N_DIFF_HEADS
    o_k = DIFF_WIDTH
    o_v = 2 * DIFF_WIDTH
    o_u = 3 * DIFF_WIDTH
    o_g = 3 * DIFF_WIDTH + POOL_WIDTH
    for l in range(DEPTH):
        mod = jax.nn.silu(c) @ w_ada[l] + b_ada[l]
        sh1, sc1, gt1, sh2, sc2, gt2 = [m[:, None, :] for m in jnp.split(mod, N_MOD, axis=-1)]

        h = _rmsnorm(x, g_pre_mix[l]) * (1.0 + sc1) + sh1
        z = h @ w_in[l]
        q = z[..., :o_k].reshape(B, S, H, 2, DIFF_HEAD_DIM)
        k = z[..., o_k:o_v].reshape(B, S, H, 2, DIFF_HEAD_DIM)
        v = z[..., o_v:o_u].reshape(B, S, H, DIFF_V_DIM)
        u = z[..., o_u:o_g]
        gates = jax.nn.sigmoid(z[..., o_g:].astype(jnp.float32)).astype(x.dtype)
        gate_a, gate_b = gates[..., :D], gates[..., D:]

        q = _partial_rope(q, positions)
        k = _partial_rope(k, positions)
        lam_init = _lambda_init(l)
        lam = (jnp.exp(jnp.sum(lambda_q1[l].astype(jnp.float32) * lambda_k1[l].astype(jnp.float32)))
               - jnp.exp(jnp.sum(lambda_q2[l].astype(jnp.float32) * lambda_k2[l].astype(jnp.float32)))
               + lam_init)
        o = _diff_attention(q, k, v, lam)
        o = _rmsnorm(o, g_subln[l], SUBLN_EPS) * (1.0 - lam_init)
        y_a = o.reshape(B, S, DIFF_WIDTH) @ w_proj_a[l]

        y_b = _multiscale_pool(u, w_pool[l], pool_scale[l]) @ w_proj_b[l]

        mixed = (gate_a * y_a + gate_b * y_b) @ w_out[l]
        x = x + gt1 * _rmsnorm(mixed, g_post_mix[l])

        h = _rmsnorm(x, g_pre_ffn[l]) * (1.0 + sc2) + sh2
        f = _moe(h, w_router[l], b_router[l], w_exp1[l], b_exp1[l], w_exp2[l], b_exp2[l])
        x = x + gt2 * _rmsnorm(f, g_post_ffn[l])
    return x
```

```cpp
#include <hip/hip_runtime.h>
#include <cstdio>
#include <cstdint>
#include <cmath>

constexpr int NB = 8, SEQ = 2048, D = 1024, T = NB * SEQ;
constexpr int NH = 8, HD = 64, VD = 128, DW = 1024, PW = 512, INC = 3 * DW + PW + 2 * D;
constexpr int NE = 32, TOPK = 4, FF = 1024, NMOD = 6;
constexpr int MPAD = TOPK * T + NE * 256, MT_MAX = MPAD / 256;
constexpr float NORM_EPS = 1e-6f, SUBLN_EPS = 1e-5f, LAM_INIT = 0.2f, SW_ALPHA = 1.702f, SW_LIMIT = 7.0f;
constexpr float QSCALE = 0.125f * 1.4426950408889634f;

constexpr size_t MiB = 1u << 20;
constexpr size_t WS_CTL = 0, CTL_ZERO_BYTES = 32768;
constexpr size_t WS_MOD = 1 * MiB;
constexpr size_t WS_ROPE = 2 * MiB;
constexpr size_t WS_LIST = 3 * MiB;
constexpr size_t WS_TOK = 5 * MiB;
constexpr size_t WS_WIN = 6 * MiB, WS_WA = 17 * MiB, WS_WB = 19 * MiB, WS_WPOOL = 20 * MiB, WS_WOUT = 21 * MiB, WS_W1 = 24 * MiB, WS_W2 = 152 * MiB;
constexpr size_t WS_H = 216 * MiB, WS_Q = 248 * MiB, WS_K = 280 * MiB, WS_V = 312 * MiB, WS_U = 344 * MiB, WS_GA = 360 * MiB, WS_GB = 392 * MiB, WS_DD = 424 * MiB;
constexpr size_t WS_O0 = 440 * MiB, WS_O1 = 472 * MiB, WS_OC = 504 * MiB, WS_PP = 536 * MiB, WS_Y = 552 * MiB, WS_MI = 616 * MiB, WS_MX = 648 * MiB, WS_X1 = 680 * MiB, WS_H2 = 712 * MiB, WS_H2F = 744 * MiB, WS_END = 760 * MiB;
constexpr size_t WS_A = 216 * MiB;
constexpr size_t WS_YE = 392 * MiB;
static_assert((size_t)MPAD * 1024 * 2 == 144 * MiB && WS_A + 144 * MiB <= WS_GA && WS_YE + 144 * MiB <= WS_PP, "overlay map");
constexpr int CW_TMO = 0, CW_CODE = 1;
constexpr int CW_CNT = 1024;
constexpr int CW_BAR = 4096;
static_assert((CW_BAR + 3456) * 4 <= (int)CTL_ZERO_BYTES && (CW_CNT + 64 * NE) * 4 <= (int)CTL_ZERO_BYTES, "control words inside the per-call memset");

__device__ __forceinline__ void rope_cs(int pos, int i, float& cs, float& sn) {
    const double invf = (i == 0) ? 1.0 : (i == 1) ? 0.19392274474868576 : (i == 2) ? 0.03760603093086393 : (i == 3) ? 0.007292664737217109 : (i == 4) ? 0.001414213562373095
                      : (i == 5) ? 0.0002742481756762073 : (i == 6) ? 5.318295896944988e-05 : 1.031338537721246e-05;
    const double ang = (double)pos * invf;
    const double qd = __builtin_rint(ang * 0.6366197723675814);
    const double r = ang - qd * 1.5707963267948966 - qd * 6.123233995736766e-17;
    const double r2 = r * r;
    const double s = r * (1.0 + r2 * (-1.0 / 6 + r2 * (1.0 / 120 + r2 * (-1.0 / 5040 + r2 * (1.0 / 362880 + r2 * (-1.0 / 39916800 + r2 * (1.0 / 6227020800.0)))))));
    const double c = 1.0 + r2 * (-0.5 + r2 * (1.0 / 24 + r2 * (-1.0 / 720 + r2 * (1.0 / 40320 + r2 * (-1.0 / 3628800 + r2 * (1.0 / 479001600.0 + r2 * (-1.0 / 87178291200.0)))))));
    const int n = (int)qd & 3;
    const double so = (n == 0) ? s : (n == 1) ? c : (n == 2) ? -s : -c;
    const double co = (n == 0) ? c : (n == 1) ? -s : (n == 2) ? -c : s;
    cs = (float)co; sn = (float)so;
}
#define MK_SINGLE 1
#define OPT_MASK 0x7ff
namespace pg8 {
#define PG8_LAS __attribute__((address_space(3)))
typedef unsigned short bf16_t;
typedef short bf16x8 __attribute__((ext_vector_type(8)));
typedef float f32x4 __attribute__((ext_vector_type(4)));
typedef unsigned u32x4 __attribute__((ext_vector_type(4)));
constexpr int BM = 256, BK = 64, HALF = 128, HTB = HALF * BK * 2  , STAGE_BYTES = 8 * HTB, NXCD = 8, WGM = 8;

__host__ __device__ __forceinline__ int lds_byte(int r, int c) { const int st = (r >> 4) * 2 + (c >> 5), rr = r & 15, cc = c & 31, ob = rr * 64 + cc * 2; return st * 1024 + (ob ^ (((ob >> 9) & 1) << 5)); }
__host__ __device__ __forceinline__ void stage_rc(int b, int& R, int& C) { const int st = b / 1024, sb = b % 1024, swz = sb ^ (((sb >> 9) & 1) << 5); R = (st >> 1) * 16 + swz / 64; C = (st & 1) * 32 + (swz % 64) / 2; }
__host__ __device__ __forceinline__ int perm32(int rho) { const int n = rho >> 4, i = rho & 15; return 8 * (i >> 2) + 4 * n + (i & 3); }

typedef int i32x8 __attribute__((ext_vector_type(8))); typedef int i32x4 __attribute__((ext_vector_type(4)));
__device__ __forceinline__ i32x8 cat8(const bf16x8 a, const bf16x8 b) { const i32x4 x = __builtin_bit_cast(i32x4, a), y = __builtin_bit_cast(i32x4, b); return __builtin_shufflevector(x, y, 0, 1, 2, 3, 4, 5, 6, 7); }
__device__ __forceinline__ void mfma_fp8(f32x4& acc, const i32x8 a, const i32x8 b) { asm volatile("v_mfma_f32_16x16x128_f8f6f4 %0, %1, %2, %0" : "+v"(acc) : "v"(a), "v"(b)); }
struct Unit { int pm, pn, e, half; };
struct Gemm { const bf16_t* A; const bf16_t* Bt; int K; int pad; size_t bstride; };

struct StaticOrder {
    int nM, nN, nwg, G, c;
    __device__ void init(int M, int N, int G_, int c_) { nM = M / BM; nN = N / BM; nwg = nM * nN; G = G_; c = c_; }
    __device__ bool next(int i, Unit& u) const {
        const long L = (long)i * G + c; if (L >= nwg) return false;
        int wgid = (int)L; { const int q = nwg / NXCD, r = nwg % NXCD, xcd = wgid % NXCD, off = wgid / NXCD; wgid = (xcd < r ? xcd * (q + 1) : r * (q + 1) + (xcd - r) * q) + off; }
        const int nig = WGM * nN, gid = wgid / nig, fm = gid * WGM, gsz = (nM - fm) < WGM ? (nM - fm) : WGM;
        u.pm = fm + ((wgid % nig) % gsz); u.pn = (wgid % nig) / gsz; u.e = 0; u.half = 0; return true;
    }
};
struct MoeOrder {
    int nM, nF, nN, nwgF, nwg, G, c, split; const PG8_LAS int* tile_e; const PG8_LAS int* tord;
    __device__ void init(int nM_, int nF_, int N, int G_, int c_, const PG8_LAS int* te, const PG8_LAS int* to, int split_) { nM = nM_; nF = nF_; nN = N / BM; nwgF = nF * nN; nwg = nM * nN; G = G_; c = c_; tile_e = te; tord = to;
        const int rem = nwg % G; split = (split_ && rem > 0 && 2 * rem <= G) ? 1 : 0; }
    __device__ bool next(int i, Unit& u) const {
        long L = (long)i * G + c; int part = 0;
        if (split && i == nwg / G) { const int rem = nwg % G; if (c >= 2 * rem) return false; L = (long)i * G + (c >> 1); part = 1 + (c & 1); }
        if (L >= nwg) return false;
        int wgid = (int)L;
        if (wgid < nwgF) {
            { const int q = nwgF / NXCD, r = nwgF % NXCD, xcd = wgid % NXCD, off = wgid / NXCD; wgid = (xcd < r ? xcd * (q + 1) : r * (q + 1) + (xcd - r) * q) + off; }
            const int nig = WGM * nN, gid = wgid / nig, fm = gid * WGM, gsz = (nF - fm) < WGM ? (nF - fm) : WGM;
            u.pm = tord[fm + ((wgid % nig) % gsz)]; u.pn = (wgid % nig) / gsz; u.half = part;
        } else { const int j = wgid - nwgF; if (part == 2) return false; u.pm = tord[nF + j / nN]; u.pn = j % nN; u.half = 1; }
        u.e = tile_e[u.pm]; return true;
    }
};

struct ListOrder {
    const PG8_LAS int* ul;
    __device__ bool next(int i, Unit& u) const { if (i >= ul[0]) return false; u.pm = ul[4 + 4 * i]; u.pn = ul[5 + 4 * i]; u.e = ul[6 + 4 * i]; u.half = ul[7 + 4 * i]; return true; }
};
__device__ __forceinline__ unsigned cvt_pk_bf16(float lo, float hi) { unsigned r; asm volatile("v_cvt_pk_bf16_f32 %0, %1, %2" : "=v"(r) : "v"(lo), "v"(hi)); return r; }
__device__ __forceinline__ float bflo(unsigned w) { return __uint_as_float(w << 16); }
__device__ __forceinline__ float bfhi(unsigned w) { return __uint_as_float(w & 0xffff0000u); }
__device__ __forceinline__ float sigm(float v) { return __builtin_amdgcn_rcpf(1.f + __builtin_amdgcn_exp2f(-1.4426950408889634f * v)); }
__device__ __forceinline__ u32x4 pack8(const f32x4 v0, const f32x4 v1) { u32x4 w; w.x = cvt_pk_bf16(v0[0], v0[1]); w.y = cvt_pk_bf16(v0[2], v0[3]); w.z = cvt_pk_bf16(v1[0], v1[1]); w.w = cvt_pk_bf16(v1[2], v1[3]); return w; }

typedef unsigned u32x2 __attribute__((ext_vector_type(2)));
__device__ __forceinline__ u32x2 pack8_fp8(const f32x4 v0, const f32x4 v1) { int a = 0, b = 0; a = __builtin_amdgcn_cvt_pk_fp8_f32(v0[0], v0[1], a, false); a = __builtin_amdgcn_cvt_pk_fp8_f32(v0[2], v0[3], a, true);
    b = __builtin_amdgcn_cvt_pk_fp8_f32(v1[0], v1[1], b, false); b = __builtin_amdgcn_cvt_pk_fp8_f32(v1[2], v1[3], b, true); return (u32x2){(unsigned)a, (unsigned)b}; }
constexpr float W8_SCALE = 32.f, W8_INV = 1.f / 32.f;
struct EpiZ {
    static constexpr bool PERM = true;
    bf16_t *q, *k, *v, *u, *ga, *gb; const float* rope;
    __device__ __forceinline__ void operator()(const f32x4 (&acc)[2][2][4][2], const Unit& un, int wr, int wc, int fr, int fq) const {
        const int pn = un.pn, row0 = un.pm * BM + wr * 64 + fr;
        int kind, ldc, colt; bf16_t* base;
        if (pn < 4) { kind = 0; base = q; ldc = 1024; colt = pn * 256; }
        else if (pn < 8) { kind = 1; base = k; ldc = 1024; colt = (pn - 4) * 256; }
        else if (pn < 12) { kind = 2; base = v; ldc = 1024; colt = (pn - 8) * 256; }
        else if (pn < 14) { kind = 2; base = u; ldc = 512; colt = (pn - 12) * 256; }
        else if (pn < 18) { kind = 3; base = ga; ldc = 1024; colt = (pn - 14) * 256; }
        else { kind = 3; base = gb; ldc = 1024; colt = (pn - 18) * 256; }
        const int col0 = colt + wc * 32 + 8 * fq;
        const bool ropew = (kind <= 1) && ((wc & 1) == 0);
        const bool rl = fq < 2;
#pragma unroll
        for (int ai = 0; ai < 2; ++ai)
#pragma unroll
            for (int m = 0; m < 4; ++m) {
                const int row = row0 + ai * HALF + m * 16; bf16_t* rowp = base + (size_t)row * ldc + col0;
                f32x4 cs = {1.f, 1.f, 1.f, 1.f}, sn = {0.f, 0.f, 0.f, 0.f};
                if (ropew && rl) { const f32x4* rp = (const f32x4*)(rope + (size_t)row * 16); cs = rp[fq]; sn = rp[2 + fq]; }
#pragma unroll
                for (int bj = 0; bj < 2; ++bj) {
                    f32x4 v0 = acc[ai][bj][m][0], v1 = acc[ai][bj][m][1];
                    if (ropew) {
                        const f32x4 r0 = {v0[0] * cs[0] - v0[1] * sn[0], v0[1] * cs[0] + v0[0] * sn[0], v0[2] * cs[1] - v0[3] * sn[1], v0[3] * cs[1] + v0[2] * sn[1]};
                        const f32x4 r1 = {v1[0] * cs[2] - v1[1] * sn[2], v1[1] * cs[2] + v1[0] * sn[2], v1[2] * cs[3] - v1[3] * sn[3], v1[3] * cs[3] + v1[2] * sn[3]};
                        v0 = r0; v1 = r1;
                    }
                    if (kind == 0) { v0 = v0 * QSCALE; v1 = v1 * QSCALE; }
                    if (kind == 3) {
#pragma unroll
                        for (int x = 0; x < 4; ++x) { v0[x] = sigm(v0[x]); v1[x] = sigm(v1[x]); } }
                    *(u32x4*)(rowp + bj * HALF) = pack8(v0, v1);
                }
            }
    }
};
struct EpiPool {
    static constexpr bool PERM = true;
    bf16_t* p; const float* scale;
    __device__ __forceinline__ void operator()(const f32x4 (&acc)[2][2][4][2], const Unit& un, int wr, int wc, int fr, int fq) const {
        const int row0 = un.pm * BM + wr * 64 + fr, col0 = un.pn * BM + wc * 32 + 8 * fq;
        f32x4 sv[2][2];
#pragma unroll
        for (int bj = 0; bj < 2; ++bj) { sv[bj][0] = *(const f32x4*)(scale + col0 + bj * HALF); sv[bj][1] = *(const f32x4*)(scale + col0 + bj * HALF + 4); }
#pragma unroll
        for (int ai = 0; ai < 2; ++ai)
#pragma unroll
            for (int m = 0; m < 4; ++m) { bf16_t* rowp = p + (size_t)(row0 + ai * HALF + m * 16) * PW + col0;
#pragma unroll
                for (int bj = 0; bj < 2; ++bj) *(u32x4*)(rowp + bj * HALF) = pack8(acc[ai][bj][m][0] * sv[bj][0], acc[ai][bj][m][1] * sv[bj][1]); }
    }
};
struct EpiGateY {
    static constexpr bool PERM = true;
    bf16_t* Y; const bf16_t* ga;
    __device__ __forceinline__ void operator()(const f32x4 (&acc)[2][2][4][2], const Unit& un, int wr, int wc, int fr, int fq) const {
        const int row0 = un.pm * BM + wr * 64 + fr, col0 = un.pn * BM + wc * 32 + 8 * fq;
#pragma unroll
        for (int ai = 0; ai < 2; ++ai)
#pragma unroll
            for (int m = 0; m < 4; ++m) { const size_t off = (size_t)(row0 + ai * HALF + m * 16) * D + col0;
#pragma unroll
                for (int bj = 0; bj < 2; ++bj) { const u32x4 g = *(const u32x4*)(ga + off + bj * HALF);
                    const f32x4 g0 = {bflo(g.x), bfhi(g.x), bflo(g.y), bfhi(g.y)}, g1 = {bflo(g.z), bfhi(g.z), bflo(g.w), bfhi(g.w)};
                    *(u32x4*)(Y + off + bj * HALF) = pack8(acc[ai][bj][m][0] * g0, acc[ai][bj][m][1] * g1); } }
    }
};
struct EpiGateAdd {
    static constexpr bool PERM = true;
    const bf16_t* Y; const bf16_t* gb; bf16_t* mi;
    __device__ __forceinline__ void operator()(const f32x4 (&acc)[2][2][4][2], const Unit& un, int wr, int wc, int fr, int fq) const {
        const int row0 = un.pm * BM + wr * 64 + fr, col0 = un.pn * BM + wc * 32 + 8 * fq;
#pragma unroll
        for (int ai = 0; ai < 2; ++ai)
#pragma unroll
            for (int m = 0; m < 4; ++m) { const size_t off = (size_t)(row0 + ai * HALF + m * 16) * D + col0;
#pragma unroll
                for (int bj = 0; bj < 2; ++bj) { const u32x4 g = *(const u32x4*)(gb + off + bj * HALF), y = *(const u32x4*)(Y + off + bj * HALF);
                    const f32x4 g0 = {bflo(g.x), bfhi(g.x), bflo(g.y), bfhi(g.y)}, g1 = {bflo(g.z), bfhi(g.z), bflo(g.w), bfhi(g.w)};
                    const f32x4 y0 = {bflo(y.x), bfhi(y.x), bflo(y.y), bfhi(y.y)}, y1 = {bflo(y.z), bfhi(y.z), bflo(y.w), bfhi(y.w)};
                    *(u32x4*)(mi + off + bj * HALF) = pack8(y0 + acc[ai][bj][m][0] * g0, y1 + acc[ai][bj][m][1] * g1); } }
    }
};
struct EpiChain {
    static constexpr bool PERM = true;
    const bf16_t* ga; const bf16_t* gb; bf16_t* mi;
    __device__ __forceinline__ void mid(f32x4 (&acc)[2][2][4][2], const Unit& un, int wr, int wc, int fr, int fq, const bool zero) const {
        const int row0 = un.pm * BM + wr * 64 + fr, col0 = un.pn * BM + wc * 32 + 8 * fq;
#pragma unroll
        for (int ai = 0; ai < 2; ++ai)
#pragma unroll
            for (int m = 0; m < 4; ++m) { const size_t off = (size_t)(row0 + ai * HALF + m * 16) * D + col0;
#pragma unroll
                for (int bj = 0; bj < 2; ++bj) { f32x4 f0 = {0.f, 0.f, 0.f, 0.f}, f1 = f0;
                    if (!zero) { const u32x4 a = *(const u32x4*)(ga + off + bj * HALF), b = *(const u32x4*)(gb + off + bj * HALF);
                        f32x4 a0 = {bflo(a.x), bfhi(a.x), bflo(a.y), bfhi(a.y)}, a1 = {bflo(a.z), bfhi(a.z), bflo(a.w), bfhi(a.w)};
                        const f32x4 b0 = {bflo(b.x), bfhi(b.x), bflo(b.y), bfhi(b.y)}, b1 = {bflo(b.z), bfhi(b.z), bflo(b.w), bfhi(b.w)};
#pragma unroll
                        for (int x = 0; x < 4; ++x) { a0[x] = __builtin_amdgcn_rcpf(fmaxf(a0[x], 1e-20f)); a1[x] = __builtin_amdgcn_rcpf(fmaxf(a1[x], 1e-20f)); }
                        f0 = b0 * a0; f1 = b1 * a1; }
                    acc[ai][bj][m][0] = acc[ai][bj][m][0] * f0; acc[ai][bj][m][1] = acc[ai][bj][m][1] * f1; }
                asm volatile("" : "+v"(acc[ai][0][m][0]), "+v"(acc[ai][0][m][1]), "+v"(acc[ai][1][m][0]), "+v"(acc[ai][1][m][1]) :: "memory"); }
    }
    __device__ __forceinline__ void operator()(const f32x4 (&acc)[2][2][4][2], const Unit& un, int wr, int wc, int fr, int fq) const {
        const int row0 = un.pm * BM + wr * 64 + fr, col0 = un.pn * BM + wc * 32 + 8 * fq;
#pragma unroll
        for (int ai = 0; ai < 2; ++ai)
#pragma unroll
            for (int m = 0; m < 4; ++m) { const size_t off = (size_t)(row0 + ai * HALF + m * 16) * D + col0;
#pragma unroll
                for (int bj = 0; bj < 2; ++bj) { const u32x4 a = *(const u32x4*)(ga + off + bj * HALF);
                    const f32x4 a0 = {bflo(a.x), bfhi(a.x), bflo(a.y), bfhi(a.y)}, a1 = {bflo(a.z), bfhi(a.z), bflo(a.w), bfhi(a.w)};
                    *(u32x4*)(mi + off + bj * HALF) = pack8(acc[ai][bj][m][0] * a0, acc[ai][bj][m][1] * a1); } }
    }
};
struct EpiBf16Plain {
    static constexpr bool PERM = true;
    bf16_t* O;
    __device__ __forceinline__ void operator()(const f32x4 (&acc)[2][2][4][2], const Unit& un, int wr, int wc, int fr, int fq) const {
        const int row0 = un.pm * BM + wr * 64 + fr, col0 = un.pn * BM + wc * 32 + 8 * fq;
#pragma unroll
        for (int ai = 0; ai < 2; ++ai)
#pragma unroll
            for (int m = 0; m < 4; ++m) { const size_t off = (size_t)(row0 + ai * HALF + m * 16) * D + col0;
#pragma unroll
                for (int bj = 0; bj < 2; ++bj) *(u32x4*)(O + off + bj * HALF) = pack8(acc[ai][bj][m][0], acc[ai][bj][m][1]); }
    }
};
struct EpiSwiglu {
    static constexpr bool PERM = true;
    unsigned char* a; const float* b1;
    __device__ __forceinline__ void operator()(const f32x4 (&acc)[2][2][4][2], const Unit& un, int wr, int wc, int fr, int fq) const {
        const int row0 = un.pm * BM + wr * 64 + fr, j0 = un.pn * HALF + wc * 32 + 8 * fq;
        const f32x4* bp = (const f32x4*)(b1 + (size_t)un.e * 2 * FF + 2 * j0);
        const f32x4 b0 = bp[0], b1v = bp[1], b2 = bp[2], b3 = bp[3];
        const f32x4 bg0 = {b0[0], b0[2], b1v[0], b1v[2]}, bu0 = {b0[1], b0[3], b1v[1], b1v[3]}, bg1 = {b2[0], b2[2], b3[0], b3[2]}, bu1 = {b2[1], b2[3], b3[1], b3[3]};
#pragma unroll
        for (int ai = 0; ai < 2; ++ai) { if (__builtin_amdgcn_readfirstlane(un.half) == 2 - ai) continue;
#pragma unroll
            for (int m = 0; m < 4; ++m) {
                f32x4 o[2];
#pragma unroll
                for (int n = 0; n < 2; ++n) {
                    f32x4 g = acc[ai][0][m][n] * W8_INV + (n ? bg1 : bg0), up = acc[ai][1][m][n] * W8_INV + (n ? bu1 : bu0), e, r;
#pragma unroll
                    for (int x = 0; x < 4; ++x) { g[x] = fminf(g[x], SW_LIMIT); up[x] = __builtin_amdgcn_fmed3f(up[x], -SW_LIMIT, SW_LIMIT); }
                    const f32x4 ex = g * (-SW_ALPHA * 1.4426950408889634f);
#pragma unroll
                    for (int x = 0; x < 4; ++x) e[x] = __builtin_amdgcn_exp2f(ex[x]);
                    e = e + 1.f;
#pragma unroll
                    for (int x = 0; x < 4; ++x) r[x] = __builtin_amdgcn_rcpf(e[x]);
                    const f32x4 gs = g * r; o[n] = gs * up + gs; }
                *(u32x2*)(a + (size_t)(row0 + ai * HALF + m * 16) * FF + j0) = pack8_fp8(o[0], o[1]);
            } }
    }
};
constexpr float YE_SCALE = 4.f, YE_INV = 0.25f;
struct EpiYe {
    static constexpr bool PERM = true;
    unsigned char* ye; const float* b2;
    __device__ __forceinline__ void operator()(const f32x4 (&acc)[2][2][4][2], const Unit& un, int wr, int wc, int fr, int fq) const {
        const int row0 = un.pm * BM + wr * 64 + fr, col0 = un.pn * BM + wc * 32 + 8 * fq;
        f32x4 bv[2][2];
#pragma unroll
        for (int bj = 0; bj < 2; ++bj) { bv[bj][0] = *(const f32x4*)(b2 + (size_t)un.e * D + col0 + bj * HALF); bv[bj][1] = *(const f32x4*)(b2 + (size_t)un.e * D + col0 + bj * HALF + 4); }
#pragma unroll
        for (int ai = 0; ai < 2; ++ai) { if (__builtin_amdgcn_readfirstlane(un.half) == 2 - ai) continue;
#pragma unroll
            for (int m = 0; m < 4; ++m) { unsigned char* rowp = ye + (size_t)(row0 + ai * HALF + m * 16) * D + col0;
#pragma unroll
                for (int bj = 0; bj < 2; ++bj) *(u32x2*)(rowp + bj * HALF) = pack8_fp8((acc[ai][bj][m][0] * W8_INV + bv[bj][0]) * YE_SCALE, (acc[ai][bj][m][1] * W8_INV + bv[bj][1]) * YE_SCALE); } }
    }
};

template <class Epi, class Sched, bool ALIGN_EPI, bool GATHER, bool FP8 = false>
__device__ __forceinline__ void gemm_phase(PG8_LAS unsigned char* lds, const Gemm g, const Sched& S, const Epi& E, const PG8_LAS int* gtab) {
    int tid_ = (int)threadIdx.x; asm volatile("" : "+v"(tid_));
    const int tid = tid_, wid = __builtin_amdgcn_readfirstlane(tid >> 6), lane = tid & 63, wr = wid >> 2, wc = wid & 3, fr = lane & 15, fq = lane >> 4;
    const int K = g.K, nt = K / BK;
    unsigned voffB[2];
#pragma unroll
    for (int i = 0; i < 2; ++i) { int R, C; stage_rc(tid * 16 + i * 8192, R, C); const int Rb = Epi::PERM ? ((R & ~31) + perm32(R & 31)) : R; voffB[i] = (unsigned)(Rb * K + C) * 2u; }
    const size_t kstep = (size_t)(BK * 2);
    const size_t hstep = (size_t)HALF * K * 2;
    const size_t tstep = 2 * hstep;
    const unsigned ldsw = (unsigned)wid * 1024u;
    const int aoff = lds_byte(wr * 64 + fr, fq * 8), boff = lds_byte(wc * 32 + fr, fq * 8);
#define PG8_SA(b, h) (((b) * 2 + (h)) * HTB)
#define PG8_SB(b, h) ((4 + (b) * 2 + (h)) * HTB)
#define PG8_STAGE(bufoff, gbase, voff) do { _Pragma("unroll") for (int _i = 0; _i < 2; ++_i) \
        __builtin_amdgcn_global_load_lds((const unsigned*)((const char*)(gbase) + (voff)[_i]), (PG8_LAS unsigned*)(lds + (bufoff) + ldsw + _i * 8192), 16, 0, 0); } while (0)
#define PG8_LDA(dst, b, h) do { _Pragma("unroll") for (int m = 0; m < 4; ++m) _Pragma("unroll") for (int k = 0; k < 2; ++k) dst[m][k] = *(const PG8_LAS bf16x8*)(lds + PG8_SA(b, h) + aoff + m * 2048 + k * 1024); } while (0)
#define PG8_LDB(dst, b, h) do { _Pragma("unroll") for (int n = 0; n < 2; ++n) _Pragma("unroll") for (int k = 0; k < 2; ++k) dst[n][k] = *(const PG8_LAS bf16x8*)(lds + PG8_SB(b, h) + boff + n * 2048 + k * 1024); } while (0)
#define PG8_MMA(ai, bj, At, Bt) do { __builtin_amdgcn_s_setprio(1); if constexpr (FP8) { _Pragma("unroll") for (int m = 0; m < 4; ++m) _Pragma("unroll") for (int n = 0; n < 2; ++n) \
        mfma_fp8(acc[ai][bj][m][n], cat8(Bt[n][0], Bt[n][1]), cat8(At[m][0], At[m][1])); } else { \
        _Pragma("unroll") for (int m = 0; m < 4; ++m) _Pragma("unroll") for (int n = 0; n < 2; ++n) _Pragma("unroll") for (int k = 0; k < 2; ++k) \
        acc[ai][bj][m][n] = __builtin_amdgcn_mfma_f32_16x16x32_bf16(Bt[n][k], At[m][k], acc[ai][bj][m][n], 0, 0, 0); } __builtin_amdgcn_s_setprio(0); } while (0)
#define PG8_WAIT_V(n) asm volatile("s_waitcnt vmcnt(" #n ")" ::: "memory")
#define PG8_WAIT_L(n) asm volatile("s_waitcnt lgkmcnt(" #n ")" ::: "memory")
#define PG8_BAR __builtin_amdgcn_s_barrier()
#define PG8_SCHED __builtin_amdgcn_sched_barrier(0)
#define PG8_AOFF(dst, u, uidx) do { _Pragma("unroll") for (int _i = 0; _i < 2; ++_i) { int _R, _C; stage_rc(tid * 16 + _i * 8192, _R, _C); _Pragma("unroll") for (int _h = 0; _h < 2; ++_h) { \
        const int _row = GATHER ? gtab[(uidx) * 256 + _h * HALF + _R] : ((u).pm * BM + _h * HALF + _R); dst[_h][_i] = (unsigned)(_row * K + _C) * 2u; } } } while (0)
    Unit cur, nxt; int ui = 0;
    if (!S.next(0, cur)) return;
    f32x4 acc[2][2][4][2];
#pragma unroll
    for (int a = 0; a < 2; ++a)
#pragma unroll
        for (int b = 0; b < 2; ++b)
#pragma unroll
            for (int m = 0; m < 4; ++m)
#pragma unroll
                for (int n = 0; n < 2; ++n) acc[a][b][m][n] = (f32x4){0.f, 0.f, 0.f, 0.f};
    bf16x8 At[4][2], B0[2][2], B1[2][2];
    unsigned vAc[2][2], vAn[2][2];
    const char* const Ab = (const char*)g.A;
    const char* cB = (const char*)g.Bt + (size_t)cur.e * g.bstride + (size_t)cur.pn * tstep;
    PG8_AOFF(vAc, cur, 0);
    PG8_STAGE(PG8_SB(0, 0), cB, voffB); PG8_STAGE(PG8_SB(0, 1), cB + hstep, voffB); PG8_STAGE(PG8_SA(0, 0), Ab, vAc[0]); PG8_STAGE(PG8_SA(0, 1), Ab, vAc[1]);
    if (wr == 1) PG8_BAR;
    PG8_WAIT_V(2); PG8_BAR;
    PG8_STAGE(PG8_SB(1, 0), cB + kstep, voffB); PG8_STAGE(PG8_SA(1, 0), Ab + kstep, vAc[0]); PG8_STAGE(PG8_SB(1, 1), cB + hstep + kstep, voffB);
    PG8_WAIT_V(6); PG8_BAR;
    for (;;) {
        const bool has_next = S.next(ui + 1, nxt);
        const char* nB = has_next ? (const char*)g.Bt + (size_t)nxt.e * g.bstride + (size_t)nxt.pn * tstep : cB;
        if (has_next) { PG8_AOFF(vAn, nxt, ui + 1); }
        else {
#pragma unroll
            for (int h = 0; h < 2; ++h)
#pragma unroll
                for (int i = 0; i < 2; ++i) vAn[h][i] = vAc[h][i]; }
        const int hf_ = FP8 ? __builtin_amdgcn_readfirstlane(cur.half) : 0; const bool dolo = hf_ != 2, dohi = hf_ != 1;
        _Pragma("nounroll") for (int t = 0; t < nt; t += 2) {
            const bool last = (t == nt - 2);
            const char* a1 = Ab + (size_t)(t + 1) * kstep;
            const char* a2 = last ? Ab : Ab + (size_t)(t + 2) * kstep; const char* b2 = last ? nB : cB + (size_t)(t + 2) * kstep;
            const char* a3 = a2 + kstep; const char* b3 = b2 + kstep;
            unsigned s0[2], s1[2];
#pragma unroll
            for (int i = 0; i < 2; ++i) { s0[i] = last ? vAn[0][i] : vAc[0][i]; s1[i] = last ? vAn[1][i] : vAc[1][i]; }
            PG8_LDB(B0, 0, 0); PG8_LDB(B1, 0, 1); PG8_SCHED; PG8_LDA(At, 0, 0); PG8_STAGE(PG8_SA(1, 1), a1, vAc[1]);
            PG8_WAIT_V(8); PG8_WAIT_L(0); PG8_BAR; if (dolo) { PG8_MMA(0, 0, At, B0); PG8_MMA(0, 1, At, B1); } PG8_BAR; PG8_SCHED;
            PG8_LDA(At, 0, 1); PG8_STAGE(PG8_SB(0, 0), b2, voffB); PG8_STAGE(PG8_SB(0, 1), b2 + hstep, voffB); PG8_STAGE(PG8_SA(0, 0), a2, s0);
            PG8_WAIT_V(8); PG8_WAIT_L(0); PG8_BAR; if (dohi) { PG8_MMA(1, 0, At, B0); PG8_MMA(1, 1, At, B1); } PG8_BAR; PG8_SCHED;
            PG8_LDB(B0, 1, 0); PG8_LDB(B1, 1, 1); PG8_SCHED; PG8_LDA(At, 1, 0); PG8_STAGE(PG8_SA(0, 1), a2, s1);
            PG8_WAIT_V(8); PG8_WAIT_L(0); PG8_BAR; if (dolo) { PG8_MMA(0, 0, At, B0); PG8_MMA(0, 1, At, B1); } PG8_BAR; PG8_SCHED;
            PG8_LDA(At, 1, 1); PG8_STAGE(PG8_SB(1, 0), b3, voffB); PG8_STAGE(PG8_SB(1, 1), b3 + hstep, voffB); PG8_STAGE(PG8_SA(1, 0), a3, s0);
            PG8_WAIT_V(8); PG8_WAIT_L(0); PG8_BAR; if (dohi) { PG8_MMA(1, 0, At, B0); PG8_MMA(1, 1, At, B1); } PG8_BAR; PG8_SCHED;
        }
        if constexpr (ALIGN_EPI) { if (wr == 0) PG8_BAR; }
        if constexpr (FP8) asm volatile("s_nop 15\n\ts_nop 15" ::: "memory");
        E(acc, cur, wr, wc, fr, fq);
        if (!has_next) break;
#pragma unroll
        for (int a = 0; a < 2; ++a)
#pragma unroll
            for (int b = 0; b < 2; ++b)
#pragma unroll
                for (int m = 0; m < 4; ++m)
#pragma unroll
                    for (int n = 0; n < 2; ++n) acc[a][b][m][n] = (f32x4){0.f, 0.f, 0.f, 0.f};
        cur = nxt; cB = nB; ++ui;
#pragma unroll
        for (int h = 0; h < 2; ++h)
#pragma unroll
            for (int i = 0; i < 2; ++i) vAc[h][i] = vAn[h][i];
        if constexpr (ALIGN_EPI) { if (wr == 1) PG8_BAR; }
    }
    PG8_WAIT_V(0);
    if constexpr (!ALIGN_EPI) { if (wr == 0) PG8_BAR; }
    PG8_BAR;
#undef PG8_SA
#undef PG8_SB
#undef PG8_STAGE
#undef PG8_LDA
#undef PG8_LDB
#undef PG8_MMA
#undef PG8_WAIT_V
#undef PG8_WAIT_L
#undef PG8_BAR
#undef PG8_SCHED
#undef PG8_AOFF
}
struct Gemm2 { const bf16_t* A0; const bf16_t* Bt0; const bf16_t* A1; const bf16_t* Bt1; int K0, K1; };
template <class Epi, class Sched>
__device__ __forceinline__ void gemm_chain2(PG8_LAS unsigned char* lds, const Gemm2 g, const Sched& S, const Epi& E) {
    constexpr bool ALIGN_EPI = true, GATHER = false, FP8 = false; const PG8_LAS int* gtab = nullptr; (void)gtab;
    int tid_ = (int)threadIdx.x; asm volatile("" : "+v"(tid_));
    const int tid = tid_, wid = __builtin_amdgcn_readfirstlane(tid >> 6), lane = tid & 63, wr = wid >> 2, wc = wid & 3, fr = lane & 15, fq = lane >> 4;
#define PG8_VOFFB(dst, Kx) do { _Pragma("unroll") for (int _i = 0; _i < 2; ++_i) { int _R, _C; stage_rc(tid * 16 + _i * 8192, _R, _C); const int _Rb = Epi::PERM ? ((_R & ~31) + perm32(_R & 31)) : _R; dst[_i] = (unsigned)(_Rb * (Kx) + _C) * 2u; } } while (0)
    int Kc = g.K0, Kn = g.K1, segc = 0;
    unsigned voffB[2], voffBn[2];
    PG8_VOFFB(voffB, Kc);
    const size_t kstep = (size_t)(BK * 2);
    size_t hstep = (size_t)HALF * Kc * 2, hstepn = hstep;
    const char* Ab = (const char*)g.A0; const char* Abn = Ab;
    const unsigned ldsw = (unsigned)wid * 1024u;
    const int aoff = lds_byte(wr * 64 + fr, fq * 8), boff = lds_byte(wc * 32 + fr, fq * 8);
#define PG8_SA(b, h) (((b) * 2 + (h)) * HTB)
#define PG8_SB(b, h) ((4 + (b) * 2 + (h)) * HTB)
#define PG8_STAGE(bufoff, gbase, voff) do { _Pragma("unroll") for (int _i = 0; _i < 2; ++_i) \
        __builtin_amdgcn_global_load_lds((const unsigned*)((const char*)(gbase) + (voff)[_i]), (PG8_LAS unsigned*)(lds + (bufoff) + ldsw + _i * 8192), 16, 0, 0); } while (0)
#define PG8_LDA(dst, b, h) do { _Pragma("unroll") for (int m = 0; m < 4; ++m) _Pragma("unroll") for (int k = 0; k < 2; ++k) dst[m][k] = *(const PG8_LAS bf16x8*)(lds + PG8_SA(b, h) + aoff + m * 2048 + k * 1024); } while (0)
#define PG8_LDB(dst, b, h) do { _Pragma("unroll") for (int n = 0; n < 2; ++n) _Pragma("unroll") for (int k = 0; k < 2; ++k) dst[n][k] = *(const PG8_LAS bf16x8*)(lds + PG8_SB(b, h) + boff + n * 2048 + k * 1024); } while (0)
#define PG8_MMA(ai, bj, At, Bt) do { __builtin_amdgcn_s_setprio(1); if constexpr (FP8) { _Pragma("unroll") for (int m = 0; m < 4; ++m) _Pragma("unroll") for (int n = 0; n < 2; ++n) \
        mfma_fp8(acc[ai][bj][m][n], cat8(Bt[n][0], Bt[n][1]), cat8(At[m][0], At[m][1])); } else { \
        _Pragma("unroll") for (int m = 0; m < 4; ++m) _Pragma("unroll") for (int n = 0; n < 2; ++n) _Pragma("unroll") for (int k = 0; k < 2; ++k) \
        acc[ai][bj][m][n] = __builtin_amdgcn_mfma_f32_16x16x32_bf16(Bt[n][k], At[m][k], acc[ai][bj][m][n], 0, 0, 0); } __builtin_amdgcn_s_setprio(0); } while (0)
#define PG8_WAIT_V(n) asm volatile("s_waitcnt vmcnt(" #n ")" ::: "memory")
#define PG8_WAIT_L(n) asm volatile("s_waitcnt lgkmcnt(" #n ")" ::: "memory")
#define PG8_BAR __builtin_amdgcn_s_barrier()
#define PG8_SCHED __builtin_amdgcn_sched_barrier(0)
#define PG8_AOFF(dst, u, uidx) do { _Pragma("unroll") for (int _i = 0; _i < 2; ++_i) { int _R, _C; stage_rc(tid * 16 + _i * 8192, _R, _C); _Pragma("unroll") for (int _h = 0; _h < 2; ++_h) { \
        const int _row = (u).pm * BM + _h * HALF + _R; dst[_h][_i] = (unsigned)(_row * (uidx) + _C) * 2u; } } } while (0)
    Unit cur, nxt; int ui = 0;
    if (!S.next(0, cur)) return;
    f32x4 acc[2][2][4][2];
#pragma unroll
    for (int a = 0; a < 2; ++a)
#pragma unroll
        for (int b = 0; b < 2; ++b)
#pragma unroll
            for (int m = 0; m < 4; ++m)
#pragma unroll
                for (int n = 0; n < 2; ++n) acc[a][b][m][n] = (f32x4){0.f, 0.f, 0.f, 0.f};
    bf16x8 At[4][2], B0[2][2], B1[2][2];
    unsigned vAc[2][2], vAn[2][2];
    const char* cB = (const char*)g.Bt0 + (size_t)cur.pn * 2 * hstep;
    PG8_AOFF(vAc, cur, Kc);
    PG8_STAGE(PG8_SB(0, 0), cB, voffB); PG8_STAGE(PG8_SB(0, 1), cB + hstep, voffB); PG8_STAGE(PG8_SA(0, 0), Ab, vAc[0]); PG8_STAGE(PG8_SA(0, 1), Ab, vAc[1]);
    if (wr == 1) PG8_BAR;
    PG8_WAIT_V(2); PG8_BAR;
    PG8_STAGE(PG8_SB(1, 0), cB + kstep, voffB); PG8_STAGE(PG8_SA(1, 0), Ab + kstep, vAc[0]); PG8_STAGE(PG8_SB(1, 1), cB + hstep + kstep, voffB);
    PG8_WAIT_V(6); PG8_BAR;
    for (;;) {
        bool has_next; const char* nB;
        if (segc == 0) { has_next = true; nxt = cur; Kn = g.K1; Abn = (const char*)g.A1; hstepn = (size_t)HALF * Kn * 2; nB = (const char*)g.Bt1 + (size_t)cur.pn * 2 * hstepn; PG8_VOFFB(voffBn, Kn); PG8_AOFF(vAn, cur, Kn); }
        else { has_next = S.next(ui + 1, nxt);
            if (has_next) { Kn = g.K0; Abn = (const char*)g.A0; hstepn = (size_t)HALF * Kn * 2; nB = (const char*)g.Bt0 + (size_t)nxt.pn * 2 * hstepn; PG8_VOFFB(voffBn, Kn); PG8_AOFF(vAn, nxt, Kn); }
            else { Kn = Kc; Abn = Ab; hstepn = hstep; nB = cB;
#pragma unroll
                for (int h = 0; h < 2; ++h)
#pragma unroll
                    for (int i = 0; i < 2; ++i) vAn[h][i] = vAc[h][i];
#pragma unroll
                for (int i = 0; i < 2; ++i) voffBn[i] = voffB[i]; } }
        const int nt = Kc / BK;
        _Pragma("nounroll") for (int t = 0; t < nt; t += 2) {
            const bool last = (t == nt - 2);
            const char* a1 = Ab + (size_t)(t + 1) * kstep;
            const char* a2 = last ? Abn : Ab + (size_t)(t + 2) * kstep; const char* b2 = last ? nB : cB + (size_t)(t + 2) * kstep;
            const size_t h2 = last ? hstepn : hstep; unsigned vB2[2];
#pragma unroll
            for (int i = 0; i < 2; ++i) vB2[i] = last ? voffBn[i] : voffB[i];
            const char* a3 = a2 + kstep; const char* b3 = b2 + kstep;
            unsigned s0[2], s1[2];
#pragma unroll
            for (int i = 0; i < 2; ++i) { s0[i] = last ? vAn[0][i] : vAc[0][i]; s1[i] = last ? vAn[1][i] : vAc[1][i]; }
            PG8_LDB(B0, 0, 0); PG8_LDB(B1, 0, 1); PG8_SCHED; PG8_LDA(At, 0, 0); PG8_STAGE(PG8_SA(1, 1), a1, vAc[1]);
            PG8_WAIT_V(8); PG8_WAIT_L(0); PG8_BAR; PG8_MMA(0, 0, At, B0); PG8_MMA(0, 1, At, B1); PG8_BAR; PG8_SCHED;
            PG8_LDA(At, 0, 1); PG8_STAGE(PG8_SB(0, 0), b2, vB2); PG8_STAGE(PG8_SB(0, 1), b2 + h2, vB2); PG8_STAGE(PG8_SA(0, 0), a2, s0);
            PG8_WAIT_V(8); PG8_WAIT_L(0); PG8_BAR; PG8_MMA(1, 0, At, B0); PG8_MMA(1, 1, At, B1); PG8_BAR; PG8_SCHED;
            PG8_LDB(B0, 1, 0); PG8_LDB(B1, 1, 1); PG8_SCHED; PG8_LDA(At, 1, 0); PG8_STAGE(PG8_SA(0, 1), a2, s1);
            PG8_WAIT_V(8); PG8_WAIT_L(0); PG8_BAR; PG8_MMA(0, 0, At, B0); PG8_MMA(0, 1, At, B1); PG8_BAR; PG8_SCHED;
            PG8_LDA(At, 1, 1); PG8_STAGE(PG8_SB(1, 0), b3, vB2); PG8_STAGE(PG8_SB(1, 1), b3 + h2, vB2); PG8_STAGE(PG8_SA(1, 0), a3, s0);
            PG8_WAIT_V(8); PG8_WAIT_L(0); PG8_BAR; PG8_MMA(1, 0, At, B0); PG8_MMA(1, 1, At, B1); PG8_BAR; PG8_SCHED;
        }
        if constexpr (ALIGN_EPI) { if (wr == 0) PG8_BAR; }
        if (segc == 1) { E(acc, cur, wr, wc, fr, fq); if (!has_next) break; }
        E.mid(acc, cur, wr, wc, fr, fq, segc == 1);
        if (segc == 1) { cur = nxt; ++ui; }
        segc ^= 1; Kc = Kn; Ab = Abn; hstep = hstepn; cB = nB;
#pragma unroll
        for (int i = 0; i < 2; ++i) voffB[i] = voffBn[i];
#pragma unroll
        for (int h = 0; h < 2; ++h)
#pragma unroll
            for (int i = 0; i < 2; ++i) vAc[h][i] = vAn[h][i];
        if constexpr (ALIGN_EPI) { if (wr == 1) PG8_BAR; }
    }
    PG8_WAIT_V(0);
    if constexpr (!ALIGN_EPI) { if (wr == 0) PG8_BAR; }
    PG8_BAR;
#undef PG8_SA
#undef PG8_SB
#undef PG8_STAGE
#undef PG8_LDA
#undef PG8_LDB
#undef PG8_MMA
#undef PG8_WAIT_V
#undef PG8_WAIT_L
#undef PG8_BAR
#undef PG8_SCHED
#undef PG8_AOFF
#undef PG8_VOFFB
}
}
#include <hip/hip_bf16.h>
#include <cmath>
namespace attn_body {
using bf16=__hip_bfloat16;
using bf16x8=__attribute__((ext_vector_type(8)))short;
using s16x4=__attribute__((ext_vector_type(4)))short;
using f32x16=__attribute__((ext_vector_type(16)))float;
using u32x4=__attribute__((ext_vector_type(4)))unsigned;
constexpr int BATCH=8,NHEAD=16,SEQ=2048,D=64,DM=NHEAD*D;
constexpr int NW=8,QBLK=32,QB=QBLK*NW,KVBLK=64,NQB=SEQ/QB;
constexpr int ATTN_PITCH=DM, ATTN_UNIT_ROWS=QB;
__device__ __forceinline__ int crow(int r,int hi){return (r&3)+8*(r>>2)+4*hi;}
#define SBAR() __builtin_amdgcn_sched_barrier(0)
__device__ __forceinline__ void cmask(f32x16&p0,f32x16&p1,int jb,int qrel,int hi){
  const float NEG=-INFINITY; int kb=64*jb+4*hi;
  #pragma unroll
  for(int r=0;r<16;++r){int kv=kb+(r&3)+8*(r>>2); if(kv>qrel)p0[r]=NEG; if(kv+32>qrel)p1[r]=NEG;}
}

constexpr int NSLOT=3, SLOTB=8192;
constexpr int LDS_K=0, LDS_V=NSLOT*SLOTB, LDS_WS=2*NSLOT*SLOTB, LDS_OST=LDS_WS+NW*64*4, LDS_BYTES=LDS_OST+NW*4096;
constexpr float C2=0.125f*1.4426950408889634f;
__device__ __forceinline__ void glds16(const void*gsrc,unsigned lds_dst){unsigned keep;
  asm volatile("s_mov_b32 %0, m0\n\ts_mov_b32 m0, %2\n\ts_nop 0\n\tglobal_load_lds_dwordx4 %1, off\n\ts_mov_b32 m0, %0":"=&s"(keep):"v"(gsrc),"s"(lds_dst):"memory");}
__device__ __forceinline__ float max3f(float a,float b,float c){float r;asm("v_max3_f32 %0, %1, %2, %3":"=v"(r):"v"(a),"v"(b),"v"(c));return r;}
__device__ __forceinline__ float max2f(float a,float b){float r;asm("v_max_f32_e32 %0, %1, %2":"=v"(r):"v"(a),"v"(b));return r;}
__device__ __forceinline__ float fadd_s(float a,float b){float r;asm("v_add_f32_e32 %0, %1, %2":"=v"(r):"v"(a),"v"(b));return r;}
__device__ __forceinline__ float fsub_s(float a,float b){float r;asm("v_sub_f32_e32 %0, %1, %2":"=v"(r):"v"(a),"v"(b));return r;}
typedef float f32x2_t __attribute__((ext_vector_type(2))); typedef __bf16 bf16x2_t __attribute__((ext_vector_type(2)));
__device__ __forceinline__ unsigned cvtpk_s(float lo,float hi){f32x2_t v={lo,hi};bf16x2_t b=__builtin_convertvector(v,bf16x2_t);return __builtin_bit_cast(unsigned,b);}
#define WAIT_BAR(N) asm volatile("s_waitcnt vmcnt(" #N ") lgkmcnt(0)\n\ts_barrier":::"memory")

__device__ __forceinline__ void qkt(f32x16&p0,f32x16&p1,const char*Kslot,const bf16x8*qr,const f32x16&negm,int r32,int hi){
  const char*kb=Kslot+hi*1024+r32*16;
  #pragma unroll
  for(int d0=0;d0<4;++d0){
    const bf16x8 b0=*reinterpret_cast<const bf16x8*>(kb+d0*2048);
    const bf16x8 b1=*reinterpret_cast<const bf16x8*>(kb+d0*2048+512);
    if(d0==0){p0=__builtin_amdgcn_mfma_f32_32x32x16_bf16(b0,qr[0],negm,0,0,0);p1=__builtin_amdgcn_mfma_f32_32x32x16_bf16(b1,qr[0],negm,0,0,0);}
    else{p0=__builtin_amdgcn_mfma_f32_32x32x16_bf16(b0,qr[d0],p0,0,0,0);p1=__builtin_amdgcn_mfma_f32_32x32x16_bf16(b1,qr[d0],p1,0,0,0);}}
}
typedef __attribute__((address_space(3))) const char* lds_cptr;
typedef short v4i16_t __attribute__((ext_vector_type(4)));
__device__ __forceinline__ void kload8(bf16x8*kf,lds_cptr kp){
  kf[0]=*(const __attribute__((address_space(3))) bf16x8*)(kp);      kf[1]=*(const __attribute__((address_space(3))) bf16x8*)(kp+512);
  kf[2]=*(const __attribute__((address_space(3))) bf16x8*)(kp+2048); kf[3]=*(const __attribute__((address_space(3))) bf16x8*)(kp+2560);
  kf[4]=*(const __attribute__((address_space(3))) bf16x8*)(kp+4096); kf[5]=*(const __attribute__((address_space(3))) bf16x8*)(kp+4608);
  kf[6]=*(const __attribute__((address_space(3))) bf16x8*)(kp+6144); kf[7]=*(const __attribute__((address_space(3))) bf16x8*)(kp+6656);
}
__device__ __forceinline__ void kload2(bf16x8*kf,lds_cptr kp,int j){ kf[2*j]=*(const __attribute__((address_space(3))) bf16x8*)(kp+j*2048); kf[2*j+1]=*(const __attribute__((address_space(3))) bf16x8*)(kp+j*2048+512); }
__device__ __forceinline__ s16x4 vtr(lds_cptr p){ return __builtin_bit_cast(s16x4,__builtin_amdgcn_ds_read_tr16_b64_v4i16((__attribute__((address_space(3))) v4i16_t*)p)); }
__device__ __forceinline__ float rowmax(const f32x16&p0,const f32x16&p1){
  float a=max3f(p0[0],p0[1],p1[0]),b=max3f(p0[2],p0[3],p1[1]);a=max3f(a,p1[2],p1[3]);
  #pragma unroll
  for(int r=4;r<16;r+=4){a=max3f(a,p0[r],p0[r+1]);b=max3f(b,p0[r+2],p0[r+3]);a=max3f(a,p1[r],p1[r+1]);b=max3f(b,p1[r+2],p1[r+3]);}
  const float m=max2f(a,b);
  auto rr=__builtin_amdgcn_permlane32_swap(__float_as_uint(m),__float_as_uint(m),false,false);
  return max2f(__uint_as_float(rr[0]),__uint_as_float(rr[1]));
}
__device__ __forceinline__ void pv(f32x16*o,int vb,bf16x8 pa0,bf16x8 pa1,bf16x8 pa2,bf16x8 pa3){
  #pragma unroll
  for(int d0=0;d0<2;++d0){s16x4 lo[4],hi[4];
    #pragma unroll
    for(int ks=0;ks<4;++ks){
      asm volatile("ds_read_b64_tr_b16 %0,%1 offset:%c2":"=&v"(lo[ks]):"v"(vb),"i"(d0*4096+ks*1024):"memory");
      asm volatile("ds_read_b64_tr_b16 %0,%1 offset:%c2":"=&v"(hi[ks]):"v"(vb),"i"(d0*4096+ks*1024+512):"memory");}
    asm volatile("s_waitcnt lgkmcnt(0)":::"memory");SBAR();
    #define PK(k) (bf16x8){lo[k][0],lo[k][1],lo[k][2],lo[k][3],hi[k][0],hi[k][1],hi[k][2],hi[k][3]}
    o[d0]=__builtin_amdgcn_mfma_f32_32x32x16_bf16(pa0,PK(0),o[d0],0,0,0);
    o[d0]=__builtin_amdgcn_mfma_f32_32x32x16_bf16(pa1,PK(1),o[d0],0,0,0);
    o[d0]=__builtin_amdgcn_mfma_f32_32x32x16_bf16(pa2,PK(2),o[d0],0,0,0);
    o[d0]=__builtin_amdgcn_mfma_f32_32x32x16_bf16(pa3,PK(3),o[d0],0,0,0);
    #undef PK
  }
}

#ifndef ATTN_STORE16
#define ATTN_STORE16(p,v) (*(u32x4*)(p)=(v))
#endif
template<int THRL> __device__ __forceinline__ void attn_unit(int b,int h,int hv,int qb,const bf16*Q,const bf16*__restrict__ K,const bf16*__restrict__ V,bf16*O,char*shm){
  int tid_=threadIdx.x; asm volatile("":"+v"(tid_));
  const int tid=tid_,lane=tid&63,r32=lane&31,hi=lane>>5; const int wid=__builtin_amdgcn_readfirstlane(tid>>6);
  const long rowbase=(long)b*SEQ; const int q0=qb*QB;
  const bf16*Qw=Q+(rowbase+q0+wid*QBLK)*DM+h*D;
  const bf16*Kh=K+rowbase*DM+h*D,*Vh=V+rowbase*DM+hv*D;
  const unsigned lds0=(unsigned)(uintptr_t)shm;
  float*wsf=(float*)(shm+LDS_WS)+wid*64;
  const bf16*ksrc=Kh+(long)lane*DM+wid*8;
  const bf16*vsrc=Vh+(long)(16*(wid&3)+(lane>>2))*DM+(wid>>2)*32+(lane&3)*8;
  const unsigned kdst=lds0+LDS_K+wid*1024, vdst=lds0+LDS_V+wid*1024;
  #define DMA_K(t,slot) glds16(ksrc+(long)(t)*KVBLK*DM,(unsigned)__builtin_amdgcn_readfirstlane(kdst+(slot)))
  #define DMA_V(t,slot) glds16(vsrc+(long)(t)*KVBLK*DM,(unsigned)__builtin_amdgcn_readfirstlane(vdst+(slot)))
  const int vb0=(int)(lds0+LDS_V)+((lane>>4)&1)*32+(lane&3)*8+(4*hi+((lane&15)>>2))*64;
  const char*Kbase=shm+LDS_K; bf16x8 kf[8];
  const lds_cptr shm3=(lds_cptr)shm; const lds_cptr kp0=shm3+LDS_K+hi*1024+r32*16; const lds_cptr vp0=shm3+LDS_V+((lane>>4)&1)*32+(lane&3)*8+(4*hi+((lane&15)>>2))*64;
  const int NT=(q0+QB)/KVBLK;
  DMA_K(0,0);DMA_V(0,0);DMA_K(1,SLOTB);
  bf16x8 qr[4];
  #pragma unroll
  for(int d0=0;d0<4;++d0)qr[d0]=*reinterpret_cast<const bf16x8*>(&Qw[(long)r32*DM+d0*16+hi*8]);
  float zz_=0.f; asm volatile("":"+v"(zz_));
  float mhat=0.f,l_reg=0.f;f32x16 o[2];
  #pragma unroll
  for(int r=0;r<16;++r){o[0][r]=zz_;o[1][r]=zz_;}
  f32x16 negm;
  #pragma unroll
  for(int r=0;r<16;++r)negm[r]=zz_;
  asm volatile("":"+v"(negm));
  const int qrel=wid*QBLK+r32;
  #define CMASK(P0,P1,t) do{int jb_=(t)-(NT-4); if(jb_>=0)cmask(P0,P1,jb_,qrel,hi);}while(0)
  bool resc=false;
  #define START(P0,P1) do{ const float rm=rowmax(P0,P1); resc=false; \
    { const float dl=rm; mhat=fadd_s(mhat,dl); \
      _Pragma("unroll") for(int r=0;r<16;++r){P0[r]=fsub_s(P0[r],dl);P1[r]=fsub_s(P1[r],dl);} \
      _Pragma("unroll") for(int r=0;r<16;++r)negm[r]=-mhat; asm volatile("":"+v"(negm)); } \
    _Pragma("unroll") for(int r=0;r<16;++r)P0[r]=__builtin_amdgcn_exp2f(P0[r]); }while(0)
  #define RESC() do{ if(resc){ asm volatile("s_waitcnt lgkmcnt(0)":::"memory"); \
      _Pragma("unroll") for(int d_=0;d_<2;++d_) _Pragma("unroll") for(int r=0;r<16;++r)o[d_][r]*=wsf[crow(r,hi)]; } }while(0)
  f32x16 pA0,pA1,pB0,pB1;
  int sl_prev=0,sl_cur=0,sl_next=SLOTB;
  #define ROT() do{sl_prev=sl_cur;sl_cur=sl_next;sl_next=(sl_next==(NSLOT-1)*SLOTB)?0:sl_next+SLOTB;}while(0)
  DMA_K(2,2*SLOTB);
  WAIT_BAR(3);
  qkt(pA0,pA1,Kbase,qr,negm,r32,hi);asm volatile("s_nop 15\n\ts_nop 7":"+v"(pA0),"+v"(pA1));CMASK(pA0,pA1,0);
  START(pA0,pA1);
  _Pragma("unroll") for(int r=0;r<16;++r)pA1[r]=__builtin_amdgcn_exp2f(pA1[r]);
  WAIT_BAR(0);
  DMA_K(3,0);DMA_V(1,SLOTB);
  ROT();
  kload8(kf,kp0+sl_cur);
  WAIT_BAR(2);
  s16x4 vlo[8],vhi[8]; u32x4 pw0,pw1,pw2,pw3;
  #define PKW(P,B) cvtpk_s(P[B],P[B+1])
  #define PAF(k) __builtin_bit_cast(bf16x8,pw##k)
  #define VFR(i) (bf16x8){vlo[i][0],vlo[i][1],vlo[i][2],vlo[i][3],vhi[i][0],vhi[i][1],vhi[i][2],vhi[i][3]}
  #define PIN(x) asm volatile("":"+v"(x))
  #define MX3(a,b,c) __builtin_fmaxf(__builtin_fmaxf((a),(b)),(c))
  #define GAPA(MF,A0,A1,A2,A3,W0,W1,PW) do{ MF; sacc+=A0; sacc+=A1; sacc+=A2; sacc+=A3; PIN(sacc); W0; W1; PIN(PW); SBAR(); }while(0)
  #define EX(v) __builtin_amdgcn_exp2f(v)
  #define GAPB(MF,X,B) do{ MF; X[B]=EX(X[B]); X[B+1]=EX(X[B+1]); X[B+2]=EX(X[B+2]); X[B+3]=EX(X[B+3]); PIN(X); SBAR(); }while(0)
  #define VRD(i) do{ vlo[i]=vtr(vp_+(((i)>>2)*4096+((i)&3)*1024)); vhi[i]=vtr(vp_+(((i)>>2)*4096+((i)&3)*1024+512)); }while(0)
  #define KRD(G,j) do{ if(G){ kload2(kf,kp0+sl_next,j); SBAR(); } }while(0)
  #define STEP(C0,C1,P0,P1,t,GK,GV,GL) do{ SBAR(); \
    const lds_cptr vp_=vp0+sl_prev; \
    VRD(0); SBAR(); float sacc=(P0[0]+P0[1]); \
    GAPA(C0=__builtin_amdgcn_mfma_f32_32x32x16_bf16(kf[0],qr[0],negm,0,0,0), P0[2],P0[3],P0[4],P0[5],     pw0[0]=PKW(P0,0), pw0[1]=PKW(P0,2), pw0); \
    VRD(4); SBAR(); GAPA(C1=__builtin_amdgcn_mfma_f32_32x32x16_bf16(kf[1],qr[0],negm,0,0,0), P0[6],P0[7],P0[8],P0[9],     pw0[2]=PKW(P0,4), pw0[3]=PKW(P0,6), pw0); \
    VRD(1); SBAR(); GAPA(C0=__builtin_amdgcn_mfma_f32_32x32x16_bf16(kf[2],qr[1],C0,0,0,0),   P0[10],P0[11],P0[12],P0[13], pw1[0]=PKW(P0,8), pw1[1]=PKW(P0,10), pw1); \
    VRD(5); SBAR(); GAPA(C1=__builtin_amdgcn_mfma_f32_32x32x16_bf16(kf[3],qr[1],C1,0,0,0),   P0[14],P0[15],P1[0],P1[1],   pw1[2]=PKW(P0,12),pw1[3]=PKW(P0,14), pw1); \
    VRD(2); SBAR(); GAPA(C0=__builtin_amdgcn_mfma_f32_32x32x16_bf16(kf[4],qr[2],C0,0,0,0),   P1[2],P1[3],P1[4],P1[5],     pw2[0]=PKW(P1,0), pw2[1]=PKW(P1,2), pw2); \
    VRD(6); SBAR(); GAPA(C1=__builtin_amdgcn_mfma_f32_32x32x16_bf16(kf[5],qr[2],C1,0,0,0),   P1[6],P1[7],P1[8],P1[9],     pw2[2]=PKW(P1,4), pw2[3]=PKW(P1,6), pw2); \
    VRD(3); SBAR(); GAPA(C0=__builtin_amdgcn_mfma_f32_32x32x16_bf16(kf[6],qr[3],C0,0,0,0),   P1[10],P1[11],P1[12],P1[13], pw3[0]=PKW(P1,8), pw3[1]=PKW(P1,10), pw3); \
    VRD(7); SBAR(); GAPA(C1=__builtin_amdgcn_mfma_f32_32x32x16_bf16(kf[7],qr[3],C1,0,0,0),   P1[14],P1[15],0.f,0.f,       pw3[2]=PKW(P1,12),pw3[3]=PKW(P1,14), pw3); \
    l_reg+=sacc; \
    if(GK){DMA_K((t)+3,sl_cur);} if(GV){DMA_V((t)+1,sl_next);} \
    CMASK(C0,C1,t); \
    { float a=MX3(C0[0],C0[1],C1[0]),b=MX3(C0[2],C0[3],C1[1]); a=MX3(a,C1[2],C1[3]); \
      _Pragma("unroll") for(int r=4;r<16;r+=4){a=MX3(a,C0[r],C0[r+1]);b=MX3(b,C0[r+2],C0[r+3]);a=MX3(a,C1[r],C1[r+1]);b=MX3(b,C1[r+2],C1[r+3]);} \
      float rm=__builtin_fmaxf(a,b); { auto rr=__builtin_amdgcn_permlane32_swap(__float_as_uint(rm),__float_as_uint(rm),false,false); rm=__builtin_fmaxf(__uint_as_float(rr[0]),__uint_as_float(rr[1])); } \
      resc=false; \
      if(__builtin_expect(__any(rm>(float)THRL),0)){ const float dl=__builtin_fmaxf(rm,0.f); mhat+=dl; \
        _Pragma("unroll") for(int r=0;r<16;++r){C0[r]-=dl;C1[r]-=dl;} \
        _Pragma("unroll") for(int r=0;r<16;++r)negm[r]=-mhat; asm volatile("":"+v"(negm)); \
        const float f=__builtin_amdgcn_exp2f(-dl); l_reg*=f; if(hi==0)wsf[r32]=f; resc=true; } } \
    SBAR(); \
    GAPB(o[0]=__builtin_amdgcn_mfma_f32_32x32x16_bf16(PAF(0),VFR(0),o[0],0,0,0), C0,0); \
    GAPB(o[1]=__builtin_amdgcn_mfma_f32_32x32x16_bf16(PAF(0),VFR(4),o[1],0,0,0), C0,4); \
    KRD(GL,0); GAPB(o[0]=__builtin_amdgcn_mfma_f32_32x32x16_bf16(PAF(1),VFR(1),o[0],0,0,0), C0,8); \
    KRD(GL,1); GAPB(o[1]=__builtin_amdgcn_mfma_f32_32x32x16_bf16(PAF(1),VFR(5),o[1],0,0,0), C0,12); \
    KRD(GL,2); GAPB(o[0]=__builtin_amdgcn_mfma_f32_32x32x16_bf16(PAF(2),VFR(2),o[0],0,0,0), C1,0); \
    KRD(GL,3); GAPB(o[1]=__builtin_amdgcn_mfma_f32_32x32x16_bf16(PAF(2),VFR(6),o[1],0,0,0), C1,4); \
    GAPB(o[0]=__builtin_amdgcn_mfma_f32_32x32x16_bf16(PAF(3),VFR(3),o[0],0,0,0), C1,8); \
    GAPB(o[1]=__builtin_amdgcn_mfma_f32_32x32x16_bf16(PAF(3),VFR(7),o[1],0,0,0), C1,12); \
    }while(0)
  int t=1;
  #undef CMASK
  #define CMASK(P0,P1,t) do{}while(0)
  for(;t+5<NT;t+=2){
    STEP(pB0,pB1,pA0,pA1,t,true,true,true);     WAIT_BAR(2); RESC(); ROT();
    STEP(pA0,pA1,pB0,pB1,t+1,true,true,true);   WAIT_BAR(2); RESC(); ROT();
  }
  #undef CMASK
  #define CMASK(P0,P1,t) do{int jb_=(t)-(NT-4); if(jb_>=0)cmask(P0,P1,jb_,qrel,hi);}while(0)
  #define ENDW(tt) do{ if((tt)+3<NT){WAIT_BAR(2);} else if((tt)+2<NT){WAIT_BAR(1);} else {WAIT_BAR(0);} }while(0)
  for(;t+1<NT;t+=2){
    STEP(pB0,pB1,pA0,pA1,t,(t+3<NT),(t+1<NT),(t+1<NT));       ENDW(t);   RESC(); ROT();
    STEP(pA0,pA1,pB0,pB1,t+1,(t+4<NT),(t+2<NT),(t+2<NT));     ENDW(t+1); RESC(); ROT();
  }
  STEP(pB0,pB1,pA0,pA1,NT-1,false,false,false); RESC();
  { float sacc=pB0[0]+pB0[1]; _Pragma("unroll") for(int r=2;r<16;++r)sacc+=pB0[r]; _Pragma("unroll") for(int r=0;r<16;++r)sacc+=pB1[r]; l_reg+=sacc;
    pw0=(u32x4){PKW(pB0,0),PKW(pB0,2),PKW(pB0,4),PKW(pB0,6)};pw1=(u32x4){PKW(pB0,8),PKW(pB0,10),PKW(pB0,12),PKW(pB0,14)};pw2=(u32x4){PKW(pB1,0),PKW(pB1,2),PKW(pB1,4),PKW(pB1,6)};pw3=(u32x4){PKW(pB1,8),PKW(pB1,10),PKW(pB1,12),PKW(pB1,14)};
    SBAR(); pv(o,vb0+sl_cur,PAF(0),PAF(1),PAF(2),PAF(3)); }
  #undef PKW
  #undef PAF
  #undef VFR
  #undef PIN
  #undef MX3
  #undef GAPA
  #undef GAPB
  #undef EX
  #undef VRD
  #undef KRD
  #undef STEP
  #undef ENDW
  {auto rr=__builtin_amdgcn_permlane32_swap(__float_as_uint(l_reg),__float_as_uint(l_reg),false,false);l_reg=__uint_as_float(rr[0])+__uint_as_float(rr[1]);}
  if(hi==0)wsf[32+r32]=l_reg;asm volatile("s_waitcnt lgkmcnt(0)":::"memory");
  float rli[16];
  #pragma unroll
  for(int r=0;r<16;++r)rli[r]=__builtin_amdgcn_rcpf(wsf[32+crow(r,hi)]);
  bf16*Ow=O+(rowbase+q0+wid*QBLK)*DM+hv*D;
  { bf16*stg=(bf16*)(shm+LDS_OST)+wid*2048;
    #pragma unroll
    for(int r=0;r<16;++r){const int orow=crow(r,hi);
      #pragma unroll
      for(int d0=0;d0<2;++d0)stg[orow*64+d0*32+r32]=__float2bfloat16(o[d0][r]*rli[r]);}
    asm volatile("s_waitcnt lgkmcnt(0)":::"memory");
    #pragma unroll
    for(int i=0;i<4;++i){const int row=i*8+(lane>>3),ch=lane&7; const u32x4 v=*(const u32x4*)(stg+row*64+ch*8); ATTN_STORE16(Ow+(long)row*DM+ch*8,v);} }
  asm volatile("s_waitcnt lgkmcnt(0)\n\ts_barrier":::"memory");
  #undef DMA_K
  #undef DMA_V
  #undef CMASK
  #undef START
  #undef RESC
  #undef ROT
}
constexpr int LDSW_K=0, LDSW_V=NSLOT*SLOTB, LDSW_WS=LDSW_V+NSLOT*2*SLOTB, LDSW_OST=LDSW_WS+NW*64*4, LDSW_BYTES=LDSW_OST+NW*4096;
struct Combine { bool on; const bf16* O0; bf16* oc; const float* g; float lam, eps, post; };
template<int THRL> __device__ __forceinline__ void attn_unit_w(int b,int h,int hh,int qb,const bf16*Q,const bf16*__restrict__ K,const bf16*__restrict__ V,bf16*O,char*shm,const Combine CB){
  int tid_=threadIdx.x; asm volatile("":"+v"(tid_));
  const int tid=tid_,lane=tid&63,r32=lane&31,hi=lane>>5; const int wid=__builtin_amdgcn_readfirstlane(tid>>6);
  const long rowbase=(long)b*SEQ; const int q0=qb*QB;
  const bf16*Qw=Q+(rowbase+q0+wid*QBLK)*DM+h*D;
  const bf16*Kh=K+rowbase*DM+h*D,*Vh=V+rowbase*DM+hh*128;
  const unsigned lds0=(unsigned)(uintptr_t)shm;
  float*wsf=(float*)(shm+LDSW_WS)+wid*64;
  const bf16*ksrc=Kh+(long)lane*DM+wid*8;
  const bf16*vsrc=Vh+(long)(16*(wid&3)+(lane>>2))*DM+(wid>>2)*32+(lane&3)*8;
  const unsigned kdst=lds0+LDSW_K+wid*1024, vdst=lds0+LDSW_V+wid*1024;
  #define DMA_K(t,slot) glds16(ksrc+(long)(t)*KVBLK*DM,(unsigned)__builtin_amdgcn_readfirstlane(kdst+(slot)))
  #define DMA_V(t,slot) do{ glds16(vsrc+(long)(t)*KVBLK*DM,(unsigned)__builtin_amdgcn_readfirstlane(vdst+2*(slot))); glds16(vsrc+(long)(t)*KVBLK*DM+64,(unsigned)__builtin_amdgcn_readfirstlane(vdst+2*(slot)+8192)); }while(0)
  const int vb0=(int)(lds0+LDSW_V)+((lane>>4)&1)*32+(lane&3)*8+(4*hi+((lane&15)>>2))*64;
  const char*Kbase=shm+LDSW_K; bf16x8 kf[8];
  const lds_cptr shm3=(lds_cptr)shm; const lds_cptr kp0=shm3+LDSW_K+hi*1024+r32*16; const lds_cptr vp0=shm3+LDSW_V+((lane>>4)&1)*32+(lane&3)*8+(4*hi+((lane&15)>>2))*64;
  const int NT=(q0+QB)/KVBLK;
  DMA_K(0,0);DMA_V(0,0);DMA_K(1,SLOTB);
  bf16x8 qr[4];
  #pragma unroll
  for(int d0=0;d0<4;++d0)qr[d0]=*reinterpret_cast<const bf16x8*>(&Qw[(long)r32*DM+d0*16+hi*8]);
  float zz_=0.f; asm volatile("":"+v"(zz_));
  float mhat=0.f,l_reg=0.f;f32x16 o[4];
  #pragma unroll
  for(int r=0;r<16;++r){o[0][r]=zz_;o[1][r]=zz_;o[2][r]=zz_;o[3][r]=zz_;}
  const f32x16 zero16={};
  const int qrel=wid*QBLK+r32;
  #define CMASK(P0,P1,t) do{int jb_=(t)-(NT-4); if(jb_>=0)cmask(P0,P1,jb_,qrel,hi);}while(0)
  bool resc=false;
  #define START(P0,P1) do{ const float rm=rowmax(P0,P1); resc=false; \
    { const float dl=(__builtin_fabsf(rm)>(float)THRL)?rm:0.f; mhat=fadd_s(mhat,dl);     \
      _Pragma("unroll") for(int r=0;r<16;++r){P0[r]=fsub_s(P0[r],dl);P1[r]=fsub_s(P1[r],dl);} } \
    _Pragma("unroll") for(int r=0;r<16;++r)P0[r]=__builtin_amdgcn_exp2f(P0[r]); }while(0)
  #define RESC() do{ if(resc){ asm volatile("s_waitcnt lgkmcnt(0)":::"memory"); \
      _Pragma("unroll") for(int d_=0;d_<4;++d_) _Pragma("unroll") for(int r=0;r<16;++r)o[d_][r]*=wsf[crow(r,hi)]; } }while(0)
  f32x16 pA0,pA1,pB0,pB1;
  int sl_prev=0,sl_cur=0,sl_next=SLOTB;
  #define ROT() do{sl_prev=sl_cur;sl_cur=sl_next;sl_next=(sl_next==(NSLOT-1)*SLOTB)?0:sl_next+SLOTB;}while(0)
  DMA_K(2,2*SLOTB);
  WAIT_BAR(4);
  qkt(pA0,pA1,Kbase,qr,zero16,r32,hi);asm volatile("s_nop 15\n\ts_nop 7":"+v"(pA0),"+v"(pA1));CMASK(pA0,pA1,0);
  START(pA0,pA1);
  _Pragma("unroll") for(int r=0;r<16;++r)pA1[r]=__builtin_amdgcn_exp2f(pA1[r]);
  WAIT_BAR(0);
  DMA_K(3,0);DMA_V(1,SLOTB);
  ROT();
  kload8(kf,kp0+sl_cur);
  WAIT_BAR(3);
  s16x4 vlo[4],vhi[4]; u32x4 pw0,pw1,pw2,pw3;
  #define GAPB2(MF,X,B) do{ MF; X[B]=EX(X[B]); X[B+1]=EX(X[B+1]); PIN(X); SBAR(); }while(0)
  #define PKW(P,B) cvtpk_s(P[B],P[B+1])
  #define PAF(k) __builtin_bit_cast(bf16x8,pw##k)
  #define VFR(i) (bf16x8){vlo[i][0],vlo[i][1],vlo[i][2],vlo[i][3],vhi[i][0],vhi[i][1],vhi[i][2],vhi[i][3]}
  #define PIN(x) asm volatile("":"+v"(x))
  #define MX3(a,b,c) __builtin_fmaxf(__builtin_fmaxf((a),(b)),(c))
  #define GAPA(MF,A0,A1,A2,A3,W0,W1,PW) do{ MF; sacc+=A0; sacc+=A1; sacc+=A2; sacc+=A3; PIN(sacc); W0; W1; PIN(PW); SBAR(); }while(0)
  #define EX(v) __builtin_amdgcn_exp2f(v)
  #define GAPB(MF,X,B) do{ MF; X[B]=EX(X[B]); X[B+1]=EX(X[B+1]); X[B+2]=EX(X[B+2]); X[B+3]=EX(X[B+3]); PIN(X); SBAR(); }while(0)
  #define VLD(sl,hf,i) do{ vlo[sl]=vtr(vp_+((hf)*8192+((i)>>2)*4096+((i)&3)*1024)); vhi[sl]=vtr(vp_+((hf)*8192+((i)>>2)*4096+((i)&3)*1024+512)); }while(0)
  #define KRD(G,j) do{ if(G){ kload2(kf,kp0+sl_next,j); SBAR(); } }while(0)
  #define STEP(C0,C1,P0,P1,t,GK,GV,GL) do{ SBAR(); \
    const lds_cptr vp_=vp0+2*sl_prev; \
    float sacc=(P0[0]+P0[1]); \
    GAPA(C0=__builtin_amdgcn_mfma_f32_32x32x16_bf16(kf[0],qr[0],zero16,0,0,0), P0[2],P0[3],P0[4],P0[5],     pw0[0]=PKW(P0,0), pw0[1]=PKW(P0,2), pw0); \
    GAPA(C1=__builtin_amdgcn_mfma_f32_32x32x16_bf16(kf[1],qr[0],zero16,0,0,0), P0[6],P0[7],P0[8],P0[9],     pw0[2]=PKW(P0,4), pw0[3]=PKW(P0,6), pw0); \
    GAPA(C0=__builtin_amdgcn_mfma_f32_32x32x16_bf16(kf[2],qr[1],C0,0,0,0),   P0[10],P0[11],P0[12],P0[13], pw1[0]=PKW(P0,8), pw1[1]=PKW(P0,10), pw1); \
    GAPA(C1=__builtin_amdgcn_mfma_f32_32x32x16_bf16(kf[3],qr[1],C1,0,0,0),   P0[14],P0[15],P1[0],P1[1],   pw1[2]=PKW(P0,12),pw1[3]=PKW(P0,14), pw1); \
    VLD(0,0,0); SBAR(); GAPA(C0=__builtin_amdgcn_mfma_f32_32x32x16_bf16(kf[4],qr[2],C0,0,0,0),   P1[2],P1[3],P1[4],P1[5],     pw2[0]=PKW(P1,0), pw2[1]=PKW(P1,2), pw2); \
    VLD(1,0,4); SBAR(); GAPA(C1=__builtin_amdgcn_mfma_f32_32x32x16_bf16(kf[5],qr[2],C1,0,0,0),   P1[6],P1[7],P1[8],P1[9],     pw2[2]=PKW(P1,4), pw2[3]=PKW(P1,6), pw2); \
    VLD(2,0,1); SBAR(); GAPA(C0=__builtin_amdgcn_mfma_f32_32x32x16_bf16(kf[6],qr[3],C0,0,0,0),   P1[10],P1[11],P1[12],P1[13], pw3[0]=PKW(P1,8), pw3[1]=PKW(P1,10), pw3); \
    VLD(3,0,5); SBAR(); GAPA(C1=__builtin_amdgcn_mfma_f32_32x32x16_bf16(kf[7],qr[3],C1,0,0,0),   P1[14],P1[15],0.f,0.f,       pw3[2]=PKW(P1,12),pw3[3]=PKW(P1,14), pw3); \
    l_reg+=sacc; \
    if(__any(mhat!=0.f)){ _Pragma("unroll") for(int r=0;r<16;++r){C0[r]-=mhat;C1[r]-=mhat;} } \
    if(GK){DMA_K((t)+3,sl_cur);} if(GV){DMA_V((t)+1,sl_next);} \
    CMASK(C0,C1,t); \
    { float a=MX3(C0[0],C0[1],C1[0]),b=MX3(C0[2],C0[3],C1[1]); a=MX3(a,C1[2],C1[3]); \
      _Pragma("unroll") for(int r=4;r<16;r+=4){a=MX3(a,C0[r],C0[r+1]);b=MX3(b,C0[r+2],C0[r+3]);a=MX3(a,C1[r],C1[r+1]);b=MX3(b,C1[r+2],C1[r+3]);} \
      float rm=__builtin_fmaxf(a,b); { auto rr=__builtin_amdgcn_permlane32_swap(__float_as_uint(rm),__float_as_uint(rm),false,false); rm=__builtin_fmaxf(__uint_as_float(rr[0]),__uint_as_float(rr[1])); } \
      resc=false; \
      if(__builtin_expect(__any(rm>(float)THRL),0)){ const float dl=__builtin_fmaxf(rm,0.f); mhat+=dl; \
        _Pragma("unroll") for(int r=0;r<16;++r){C0[r]-=dl;C1[r]-=dl;} \
        const float f=__builtin_amdgcn_exp2f(-dl); l_reg*=f; if(hi==0)wsf[r32]=f; resc=true; } } \
    SBAR(); \
    GAPB2(o[0]=__builtin_amdgcn_mfma_f32_32x32x16_bf16(PAF(0),VFR(0),o[0],0,0,0), C0,0); VLD(0,0,2); SBAR(); \
    GAPB2(o[1]=__builtin_amdgcn_mfma_f32_32x32x16_bf16(PAF(0),VFR(1),o[1],0,0,0), C0,2); VLD(1,0,6); SBAR(); \
    GAPB2(o[0]=__builtin_amdgcn_mfma_f32_32x32x16_bf16(PAF(1),VFR(2),o[0],0,0,0), C0,4); VLD(2,0,3); SBAR(); \
    GAPB2(o[1]=__builtin_amdgcn_mfma_f32_32x32x16_bf16(PAF(1),VFR(3),o[1],0,0,0), C0,6); VLD(3,0,7); SBAR(); \
    GAPB2(o[0]=__builtin_amdgcn_mfma_f32_32x32x16_bf16(PAF(2),VFR(0),o[0],0,0,0), C0,8); VLD(0,1,0); SBAR(); \
    GAPB2(o[1]=__builtin_amdgcn_mfma_f32_32x32x16_bf16(PAF(2),VFR(1),o[1],0,0,0), C0,10); VLD(1,1,4); SBAR(); \
    GAPB2(o[0]=__builtin_amdgcn_mfma_f32_32x32x16_bf16(PAF(3),VFR(2),o[0],0,0,0), C0,12); VLD(2,1,1); SBAR(); \
    GAPB2(o[1]=__builtin_amdgcn_mfma_f32_32x32x16_bf16(PAF(3),VFR(3),o[1],0,0,0), C0,14); VLD(3,1,5); SBAR(); \
    GAPB2(o[2]=__builtin_amdgcn_mfma_f32_32x32x16_bf16(PAF(0),VFR(0),o[2],0,0,0), C1,0); VLD(0,1,2); SBAR(); \
    GAPB2(o[3]=__builtin_amdgcn_mfma_f32_32x32x16_bf16(PAF(0),VFR(1),o[3],0,0,0), C1,2); VLD(1,1,6); SBAR(); \
    KRD(GL,0); GAPB2(o[2]=__builtin_amdgcn_mfma_f32_32x32x16_bf16(PAF(1),VFR(2),o[2],0,0,0), C1,4); VLD(2,1,3); SBAR(); \
    KRD(GL,1); GAPB2(o[3]=__builtin_amdgcn_mfma_f32_32x32x16_bf16(PAF(1),VFR(3),o[3],0,0,0), C1,6); VLD(3,1,7); SBAR(); \
    KRD(GL,2); GAPB2(o[2]=__builtin_amdgcn_mfma_f32_32x32x16_bf16(PAF(2),VFR(0),o[2],0,0,0), C1,8); \
    KRD(GL,3); GAPB2(o[3]=__builtin_amdgcn_mfma_f32_32x32x16_bf16(PAF(2),VFR(1),o[3],0,0,0), C1,10); \
    GAPB2(o[2]=__builtin_amdgcn_mfma_f32_32x32x16_bf16(PAF(3),VFR(2),o[2],0,0,0), C1,12); \
    GAPB2(o[3]=__builtin_amdgcn_mfma_f32_32x32x16_bf16(PAF(3),VFR(3),o[3],0,0,0), C1,14); \
    }while(0)
  int t=1;
  #undef CMASK
  #define CMASK(P0,P1,t) do{}while(0)
  for(;t+5<NT;t+=2){
    STEP(pB0,pB1,pA0,pA1,t,true,true,true);     WAIT_BAR(3); RESC(); ROT();
    STEP(pA0,pA1,pB0,pB1,t+1,true,true,true);   WAIT_BAR(3); RESC(); ROT();
  }
  #undef CMASK
  #define CMASK(P0,P1,t) do{int jb_=(t)-(NT-4); if(jb_>=0)cmask(P0,P1,jb_,qrel,hi);}while(0)
  #define ENDW(tt) do{ if((tt)+3<NT){WAIT_BAR(3);} else if((tt)+2<NT){WAIT_BAR(2);} else {WAIT_BAR(0);} }while(0)
  for(;t+1<NT;t+=2){
    STEP(pB0,pB1,pA0,pA1,t,(t+3<NT),(t+1<NT),(t+1<NT));       ENDW(t);   RESC(); ROT();
    STEP(pA0,pA1,pB0,pB1,t+1,(t+4<NT),(t+2<NT),(t+2<NT));     ENDW(t+1); RESC(); ROT();
  }
  STEP(pB0,pB1,pA0,pA1,NT-1,false,false,false); RESC();
  { float sacc=pB0[0]+pB0[1]; _Pragma("unroll") for(int r=2;r<16;++r)sacc+=pB0[r]; _Pragma("unroll") for(int r=0;r<16;++r)sacc+=pB1[r]; l_reg+=sacc;
    pw0=(u32x4){PKW(pB0,0),PKW(pB0,2),PKW(pB0,4),PKW(pB0,6)};pw1=(u32x4){PKW(pB0,8),PKW(pB0,10),PKW(pB0,12),PKW(pB0,14)};pw2=(u32x4){PKW(pB1,0),PKW(pB1,2),PKW(pB1,4),PKW(pB1,6)};pw3=(u32x4){PKW(pB1,8),PKW(pB1,10),PKW(pB1,12),PKW(pB1,14)};
    SBAR(); pv(o,vb0+2*sl_cur,PAF(0),PAF(1),PAF(2),PAF(3)); pv(o+2,vb0+2*sl_cur+8192,PAF(0),PAF(1),PAF(2),PAF(3)); }
  #undef PKW
  #undef PAF
  #undef VFR
  #undef PIN
  #undef MX3
  #undef GAPA
  #undef GAPB
  #undef GAPB2
  #undef EX
  #undef VLD
  #undef KRD
  #undef STEP
  #undef ENDW
  {auto rr=__builtin_amdgcn_permlane32_swap(__float_as_uint(l_reg),__float_as_uint(l_reg),false,false);l_reg=__uint_as_float(rr[0])+__uint_as_float(rr[1]);}
  if(hi==0)wsf[32+r32]=l_reg;asm volatile("s_waitcnt lgkmcnt(0)":::"memory");
  float rli[16];
  #pragma unroll
  for(int r=0;r<16;++r)rli[r]=__builtin_amdgcn_rcpf(wsf[32+crow(r,hi)]);
  bf16*Ow=O+(rowbase+q0+wid*QBLK)*DM+hh*128;
  bf16*stg=(bf16*)(shm+LDSW_OST)+wid*2048;
  if(!CB.on){
    #pragma unroll
    for(int hf=0;hf<2;++hf){
      #pragma unroll
      for(int r=0;r<16;++r){const int orow=crow(r,hi);
        #pragma unroll
        for(int d0=0;d0<2;++d0)stg[orow*64+d0*32+r32]=__float2bfloat16(o[2*hf+d0][r]*rli[r]);}
      asm volatile("s_waitcnt lgkmcnt(0)":::"memory");
      #pragma unroll
      for(int i=0;i<4;++i){const int row=i*8+(lane>>3),ch=lane&7; const u32x4 v=*(const u32x4*)(stg+row*64+ch*8); ATTN_STORE16(Ow+(long)row*DM+hf*64+ch*8,v);}
      asm volatile("s_waitcnt lgkmcnt(0)":::"memory"); }
  } else {
    const bf16*O0w=CB.O0+(rowbase+q0+wid*QBLK)*DM+hh*128; bf16*Cw=CB.oc+(rowbase+q0+wid*QBLK)*DM+hh*128;
    float av[2][4][8]; float ss[4]={0.f,0.f,0.f,0.f};
    #pragma unroll
    for(int hf=0;hf<2;++hf){
      #pragma unroll
      for(int r=0;r<16;++r){const int orow=crow(r,hi);
        #pragma unroll
        for(int d0=0;d0<2;++d0)stg[orow*64+d0*32+r32]=__float2bfloat16(o[2*hf+d0][r]*rli[r]);}
      asm volatile("s_waitcnt lgkmcnt(0)":::"memory");
      #pragma unroll
      for(int i=0;i<4;++i){const int row=i*8+(lane>>3),ch=lane&7; const u32x4 v1=*(const u32x4*)(stg+row*64+ch*8); const u32x4 v0=*(const u32x4*)(O0w+(long)row*DM+hf*64+ch*8);
        #pragma unroll
        for(int x=0;x<4;++x){ const float a0=__uint_as_float(v0[x]<<16)-CB.lam*__uint_as_float(v1[x]<<16), a1=__uint_as_float(v0[x]&0xffff0000u)-CB.lam*__uint_as_float(v1[x]&0xffff0000u);
          av[hf][i][2*x]=a0; av[hf][i][2*x+1]=a1; ss[i]+=a0*a0+a1*a1; } }
      asm volatile("s_waitcnt lgkmcnt(0)":::"memory"); }
    #pragma unroll
    for(int i=0;i<4;++i){ float t=ss[i];
      t+=__builtin_bit_cast(float,__builtin_amdgcn_update_dpp(0,__builtin_bit_cast(int,t),0xB1,0xf,0xf,false)); t+=__builtin_bit_cast(float,__builtin_amdgcn_update_dpp(0,__builtin_bit_cast(int,t),0x4E,0xf,0xf,false));
      t+=__builtin_bit_cast(float,__builtin_amdgcn_update_dpp(0,__builtin_bit_cast(int,t),0x141,0xf,0xf,false));
      const float rn=__builtin_amdgcn_rsqf(t*(1.f/128.f)+CB.eps)*CB.post; const int row=i*8+(lane>>3),ch=lane&7;
      #pragma unroll
      for(int hf=0;hf<2;++hf){ const float*gp=CB.g+hf*64+ch*8; u32x4 w;
        #pragma unroll
        for(int x=0;x<4;++x)w[x]=cvtpk_s(av[hf][i][2*x]*rn*gp[2*x],av[hf][i][2*x+1]*rn*gp[2*x+1]);
        ATTN_STORE16(Cw+(long)row*DM+hf*64+ch*8,w); } }
  }
  asm volatile("s_waitcnt lgkmcnt(0)\n\ts_barrier":::"memory");
  #undef DMA_K
  #undef DMA_V
  #undef CMASK
  #undef START
  #undef RESC
  #undef ROT
}
constexpr int ATTN_LDS_BYTES=LDS_BYTES;
struct AttnTensors { const bf16* Q; const bf16* K; const bf16* V; bf16* O0; Combine cb; };
template<int THRL=8,class Gap> __device__ __forceinline__ void attn_phase(char*lds,const AttnTensors&T,int vcu,int G,Gap gap){
  const int nbig=(512-vcu+G-1)/G; int i=0;
  if(__builtin_amdgcn_readfirstlane((int)threadIdx.x)>=256) __builtin_amdgcn_s_setprio(1);
  for(int L=vcu;L<512;L+=G){ const int rnd=L>>8,v=L&255,r=v&7,qb=rnd?r:(NQB-1-r); const int b=v>>5,h=rnd*4+((v&31)>>3);
    #pragma unroll 1
    for(int c=0;c<2;++c){ Combine cb=T.cb; cb.on=(c==1); attn_unit_w<THRL>(b,2*h+c,h,qb,T.Q,T.K,T.V,T.O0,lds,cb); gap(i,2*nbig); ++i; } }
}
#undef SBAR
#undef WAIT_BAR
}
#ifndef PROBE_DUP
#define PROBE_DUP (-1)
#endif
constexpr int NWAVES = 8;
constexpr int NPHASE = 11;
constexpr int RING_OFF = 0, RING_BYTES = 131072;
constexpr int LDSCTL_OFF = RING_BYTES, MISC_OFF = LDSCTL_OFF + 320;
constexpr int L_PTRS = LDSCTL_OFF;
constexpr int L_TSTART = 131584;
constexpr int L_CNT = 131744;
constexpr int L_TILEE = 131872;
constexpr int L_GTAB = 133120, MAXU = 12;
constexpr int L_ULIST = L_GTAB + MAXU * 1024;
constexpr int L_TORD = 145664;
constexpr int LDS_BYTES = 147456;
static_assert(MISC_OFF + 128 <= L_TSTART && L_TILEE + MT_MAX * 4 <= L_GTAB && L_ULIST + 16 + 16 * MAXU <= L_TORD && L_TORD + MT_MAX * 4 <= LDS_BYTES, "LDS map");

#define GAS __attribute__((address_space(1)))
#define LAS __attribute__((address_space(3)))
typedef unsigned short bf16;
typedef unsigned v4u __attribute__((ext_vector_type(4)));
typedef unsigned v2u __attribute__((ext_vector_type(2)));
typedef float f32x4 __attribute__((ext_vector_type(4)));
typedef GAS unsigned gu32;
#define RLX_AGENT __ATOMIC_RELAXED, __HIP_MEMORY_SCOPE_AGENT
#define LDS_WAIT() asm volatile("s_waitcnt lgkmcnt(0)" ::: "memory")
#define VM_WAIT() asm volatile("s_waitcnt vmcnt(0)" ::: "memory")
__device__ __forceinline__ unsigned pk2(float lo, float hi) { return pg8::cvt_pk_bf16(lo, hi); }
__device__ __forceinline__ float bflo(unsigned w) { return __uint_as_float(w << 16); }
__device__ __forceinline__ float bfhi(unsigned w) { return __uint_as_float(w & 0xffff0000u); }

#define XB_TMO      128
#define XB_XCNT(j)  (256  + 64 * (j))
#define XB_XSUB(j)  (1280 + 64 * (j))
#define XB_XGEN(j)  (2304 + 64 * (j))
#define XB_TOP      3328
#define XB_TOPGEN   3392
#define XCD_BAR_WORDS 3456
#define XB_LSUB(j)  (-1024 + 64 * (j))
#define XB_LGEN(j)  (-512 + 64 * (j))
#define XB_SPIN_CAP (1u << 18)
__device__ __forceinline__ unsigned xb_ld(unsigned* p)              { return __hip_atomic_load(p, __ATOMIC_RELAXED, __HIP_MEMORY_SCOPE_AGENT); }
__device__ __forceinline__ unsigned xb_add(unsigned* p, unsigned v) { return __hip_atomic_fetch_add(p, v, __ATOMIC_RELAXED, __HIP_MEMORY_SCOPE_AGENT); }
__device__ __forceinline__ unsigned xb_xcc_id() { return (unsigned)__builtin_amdgcn_s_getreg((3 << 11) | 20) & 0xFu; }
#define XB_SPIN(cond, bar) do { unsigned _sp = 0; while (cond) { __builtin_amdgcn_s_sleep(1); \
    if ((++_sp & 255u) == 0u) { if (xb_ld(&(bar)[XB_TMO])) break; if (_sp > XB_SPIN_CAP) { atomicAdd(&(bar)[XB_TMO], 1u); break; } } } } while (0)
struct XcdBarrier { unsigned* bar; unsigned x; volatile LAS unsigned* st; };
__device__ __forceinline__ XcdBarrier xcd_barrier_post(unsigned* bar, volatile LAS unsigned* st) {
    XcdBarrier b; b.bar = bar; b.x = xb_xcc_id(); b.st = st;
    if (threadIdx.x == 0) st[3] = xb_add(&bar[XB_XCNT(b.x)], 1u);
    return b;
}
__device__ __forceinline__ void xcd_barrier_complete(unsigned* bar, unsigned x, unsigned& nloc, unsigned& nx, unsigned& even) {
    const unsigned G = gridDim.x * gridDim.y * gridDim.z;
    unsigned sum, cnt, mine, sp = 0u;
    for (;;) {
        sum = 0u; cnt = 0u; mine = 0u; even = (G == 256u) ? 1u : 0u;
#pragma unroll
        for (unsigned j = 0; j < 16; ++j) { const unsigned c = xb_ld(&bar[XB_XCNT(j)]); sum += c; cnt += (c > 0u) ? 1u : 0u; mine = (j == x) ? c : mine; even = (c == (j < 8u ? 32u : 0u)) ? even : 0u; }
        if (sum == G) break;
        __builtin_amdgcn_s_sleep(1);
        if ((++sp & 255u) == 0u) { if (xb_ld(&bar[XB_TMO])) break; if (sp > XB_SPIN_CAP) { atomicAdd(&bar[XB_TMO], 1u); break; } }
    }
    nloc = mine > 0u ? mine : 1u; nx = cnt > 0u ? cnt : 1u;
}
__device__ __forceinline__ void xcd_barrier(const XcdBarrier& b) {
    asm volatile("s_waitcnt vmcnt(0)" ::: "memory");
    __syncthreads();
    if (threadIdx.x == 0) {
        unsigned* bar = b.bar;
        __builtin_amdgcn_s_waitcnt(0);
        unsigned nloc = b.st[0], nx = b.st[1];
        if (nloc == 0u) { unsigned even; xcd_barrier_complete(bar, b.x, nloc, nx, even); b.st[0] = nloc; b.st[1] = nx; b.st[2] = 1u + even; }
        const unsigned old = xb_add(&bar[XB_XSUB(b.x)], 1u);
        const unsigned gen = old / nloc;
        if (old + 1u == (gen + 1u) * nloc) {
            __builtin_amdgcn_fence(__ATOMIC_RELEASE, "agent");
            asm volatile("s_waitcnt vmcnt(0)" ::: "memory");
            const unsigned og = xb_add(&bar[XB_TOP], 1u);
            const unsigned tg = og / nx;
            if (og + 1u == (tg + 1u) * nx) xb_add(&bar[XB_TOPGEN], 1u);
            else XB_SPIN(xb_ld(&bar[XB_TOPGEN]) == tg, bar);
            __builtin_amdgcn_fence(__ATOMIC_ACQUIRE, "agent");
            xb_add(&bar[XB_XGEN(b.x)], 1u);
            asm volatile("s_waitcnt vmcnt(0)" ::: "memory");
        } else {
            XB_SPIN(xb_ld(&bar[XB_XGEN(b.x)]) == gen, bar);
            __builtin_amdgcn_fence(__ATOMIC_ACQUIRE, "agent");
            asm volatile("s_waitcnt vmcnt(0)" ::: "memory");
        }
    }
    __syncthreads();
}

__device__ __forceinline__ void xcc_local_barrier(const XcdBarrier& b) {
    asm volatile("s_waitcnt vmcnt(0)" ::: "memory");
    __syncthreads();
    if (threadIdx.x == 0) {
        unsigned* bar = b.bar;
        __builtin_amdgcn_s_waitcnt(0);
        const unsigned old = xb_add(&bar[XB_LSUB((int)b.x)], 1u);
        const unsigned gen = old >> 5;
        if (old + 1u == (gen + 1u) << 5) xb_add(&bar[XB_LGEN((int)b.x)], 1u);
        else XB_SPIN(xb_ld(&bar[XB_LGEN((int)b.x)]) == gen, bar);
        __builtin_amdgcn_fence(__ATOMIC_ACQUIRE, "agent");
        asm volatile("s_waitcnt vmcnt(0)" ::: "memory");
    }
    __syncthreads();
}

struct Frame {
    LAS unsigned char* lds;
    volatile LAS unsigned* MISC;
    gu32* ctl;
    int tid, lane, wave;
    int vcu, G, vb;
    unsigned char* ws;
};
__device__ __forceinline__ const void* inp(const Frame& F, int i) {
    const LAS unsigned* p = (const LAS unsigned*)(F.lds + L_PTRS) + 2 * i;
    const unsigned lo = __builtin_amdgcn_readfirstlane(p[0]), hi = __builtin_amdgcn_readfirstlane(p[1]);
    return (const void*)(const GAS char*)(((unsigned long long)hi << 32) | lo);
}
template <int CTRL> __device__ __forceinline__ float dpp_f(float v) { return __builtin_bit_cast(float, __builtin_amdgcn_update_dpp(0, __builtin_bit_cast(int, v), CTRL, 0xf, 0xf, false)); }
#define XSUM16(v) do { const auto r_ = __builtin_amdgcn_permlane16_swap(__float_as_uint(v), __float_as_uint(v), false, false); v = __uint_as_float(r_[0]) + __uint_as_float(r_[1]); } while (0)
#define XSUM32(v) do { const auto r_ = __builtin_amdgcn_permlane32_swap(__float_as_uint(v), __float_as_uint(v), false, false); v = __uint_as_float(r_[0]) + __uint_as_float(r_[1]); } while (0)
#define XMAX16(v) do { const auto r_ = __builtin_amdgcn_permlane16_swap(__float_as_uint(v), __float_as_uint(v), false, false); v = fmaxf(__uint_as_float(r_[0]), __uint_as_float(r_[1])); } while (0)
__device__ __forceinline__ float sum8(float v) { v += dpp_f<0xB1>(v); v += dpp_f<0x4E>(v); v += dpp_f<0x141>(v); return v; }
__device__ __forceinline__ float wave_sum(float v) {
    v = sum8(v); v += dpp_f<0x140>(v);
    XSUM16(v); XSUM32(v);
    return v;
}
__device__ __forceinline__ float max32(float v) {
    v = fmaxf(v, dpp_f<0xB1>(v)); v = fmaxf(v, dpp_f<0x4E>(v)); v = fmaxf(v, dpp_f<0x141>(v)); v = fmaxf(v, dpp_f<0x140>(v));
    XMAX16(v); return v;
}

template <class RowFn>
__device__ __forceinline__ void tr_item(const float* W, int ldw, int k0, int n0, bf16* dst, int ldk, int kd0, RowFn drow, LAS bf16* scr, int lane, bool zero) {
    const int c4 = lane & 15, kr = lane >> 4;
    if (!zero) {
        f32x4 v[16];
#pragma unroll
        for (int s = 0; s < 16; ++s) v[s] = *(const GAS f32x4*)(W + (size_t)(k0 + kr + 4 * s) * ldw + n0 + 4 * c4);
#pragma unroll
        for (int s = 0; s < 16; ++s) { const int kk = kr + 4 * s; const unsigned lo = pk2(v[s][0], v[s][1]), hi = pk2(v[s][2], v[s][3]);
            scr[(4 * c4 + 0) * 66 + kk] = (bf16)(lo & 0xffff); scr[(4 * c4 + 1) * 66 + kk] = (bf16)(lo >> 16); scr[(4 * c4 + 2) * 66 + kk] = (bf16)(hi & 0xffff); scr[(4 * c4 + 3) * 66 + kk] = (bf16)(hi >> 16); }
        LDS_WAIT(); asm volatile("" ::: "memory");
    }
    const int ch = lane & 7;
#pragma unroll
    for (int j = 0; j < 8; ++j) { const int nn = (lane >> 3) + 8 * j; v4u o = {0u, 0u, 0u, 0u};
        if (!zero) { const LAS unsigned* sp = (const LAS unsigned*)(scr + nn * 66 + 8 * ch); o.x = sp[0]; o.y = sp[1]; o.z = sp[2]; o.w = sp[3]; }
        *(GAS v4u*)(dst + (size_t)drow(nn) * ldk + kd0 + 8 * ch) = o; }
    LDS_WAIT(); asm volatile("" ::: "memory");
}

template <class RowFn>
__device__ __forceinline__ void tr_item_fp8(const float* W, int ldw, int k0, int n0, unsigned char* dst, int ldk, int kd0, RowFn drow, LAS unsigned char* scr, int lane) {
    const int c4 = lane & 15, kr = lane >> 4;
    f32x4 v[4][4];
#pragma unroll
    for (int s = 0; s < 4; ++s)
#pragma unroll
        for (int j = 0; j < 4; ++j) v[s][j] = *(const GAS f32x4*)(W + (size_t)(k0 + 16 * s + 4 * kr + j) * ldw + n0 + 4 * c4);
#pragma unroll
    for (int s = 0; s < 4; ++s)
#pragma unroll
        for (int x = 0; x < 4; ++x) { int w = 0; w = __builtin_amdgcn_cvt_pk_fp8_f32(v[s][0][x] * pg8::W8_SCALE, v[s][1][x] * pg8::W8_SCALE, w, false); w = __builtin_amdgcn_cvt_pk_fp8_f32(v[s][2][x] * pg8::W8_SCALE, v[s][3][x] * pg8::W8_SCALE, w, true);
            *(LAS unsigned*)(scr + (4 * c4 + x) * 68 + 16 * s + 4 * kr) = (unsigned)w; }
    LDS_WAIT(); asm volatile("" ::: "memory");
    const int ch = lane & 3;
#pragma unroll
    for (int j = 0; j < 4; ++j) { const int nn = (lane >> 2) + 16 * j; const LAS unsigned* sp = (const LAS unsigned*)(scr + nn * 68 + 16 * ch); v4u o; o.x = sp[0]; o.y = sp[1]; o.z = sp[2]; o.w = sp[3];
        *(GAS v4u*)(dst + (size_t)drow(nn) * ldk + kd0 + 16 * ch) = o; }
    LDS_WAIT(); asm volatile("" ::: "memory");
}

struct CItem { const float* src; unsigned char* dst; int ldw, ldk, base, mode; };
__device__ __forceinline__ CItem conv_item(const float* w_exp1, const float* w_exp2, unsigned char* ws, int r) {
    constexpr int I_2 = NE * 16 * 16;
    CItem it;
    if (r >= I_2) { r -= I_2; const int e = r / 512, rr = r % 512, kb = rr / 32, nb = rr % 32, n0 = nb * 64, j2 = n0 >> 1, pn = j2 >> 7, j = j2 & 127;
        it.src = w_exp1 + (size_t)e * D * 2 * FF + (size_t)(kb * 64) * (2 * FF) + n0; it.ldw = 2 * FF; it.dst = ws + WS_W1 + (size_t)e * 2 * FF * D + kb * 64; it.ldk = D; it.base = 256 * pn + j; it.mode = 1; }
    else { const int e = r / 256, rr = r % 256, kb = rr / 16, nb = rr % 16;
        it.src = w_exp2 + (size_t)e * FF * D + (size_t)(kb * 64) * D + nb * 64; it.ldw = D; it.dst = ws + WS_W2 + (size_t)e * D * FF + kb * 64; it.ldk = FF; it.base = nb * 64; it.mode = 0; }
    return it;
}
__device__ __forceinline__ void conv_load(const CItem& it, f32x4 (&v)[4][4], int lane) {
    const int c4 = lane & 15, kr = lane >> 4;
#pragma unroll
    for (int s = 0; s < 4; ++s)
#pragma unroll
        for (int j = 0; j < 4; ++j) v[s][j] = __builtin_nontemporal_load((const GAS f32x4*)(it.src + (size_t)(16 * s + 4 * kr + j) * it.ldw + 4 * c4));
}
__device__ __forceinline__ void conv_store(const CItem& it, const f32x4 (&v)[4][4], LAS unsigned char* scr, int lane) {
    const int c4 = lane & 15, kr = lane >> 4;
#pragma unroll
    for (int s = 0; s < 4; ++s)
#pragma unroll
        for (int x = 0; x < 4; ++x) { int w = 0; w = __builtin_amdgcn_cvt_pk_fp8_f32(v[s][0][x] * pg8::W8_SCALE, v[s][1][x] * pg8::W8_SCALE, w, false); w = __builtin_amdgcn_cvt_pk_fp8_f32(v[s][2][x] * pg8::W8_SCALE, v[s][3][x] * pg8::W8_SCALE, w, true);
            *(LAS unsigned*)(scr + (4 * c4 + x) * 68 + 16 * s + 4 * kr) = (unsigned)w; }
    LDS_WAIT(); asm volatile("" ::: "memory");
    const int ch = lane & 3;
#pragma unroll
    for (int j = 0; j < 4; ++j) { const int nn = (lane >> 2) + 16 * j; const LAS unsigned* sp = (const LAS unsigned*)(scr + nn * 68 + 16 * ch); v4u o; o.x = sp[0]; o.y = sp[1]; o.z = sp[2]; o.w = sp[3];
        const int row = it.mode ? it.base + 128 * (nn & 1) + (nn >> 1) : it.base + nn;
        *(GAS v4u*)(it.dst + (size_t)row * it.ldk + 16 * ch) = o; }
    LDS_WAIT(); asm volatile("" ::: "memory");
}
__device__ __forceinline__ void conv_expert_items(Frame& F, int first, int count, int k, int n, int part, int nparts, LAS unsigned char* scr) {
    const float* const w_exp1_ = (const float*)inp(F, 21); const float* const w_exp2_ = (const float*)inp(F, 23);
    const int ipw = (count + n - 1) / n, base = k * ipw, own = (ipw - F.wave + 7) / 8;
    const int j0 = own * part / nparts, j1 = own * (part + 1) / nparts;
    int lane = F.lane; asm volatile("" : "+v"(lane));
    int jj = j0;
    for (; jj + 1 < j1; jj += 2) {
        const int r0 = base + F.wave + 8 * jj, r1 = r0 + 8; if (r1 >= count) break;
        const CItem a = conv_item(w_exp1_, w_exp2_, F.ws, first + r0), b = conv_item(w_exp1_, w_exp2_, F.ws, first + r1);
        f32x4 va[4][4], vb[4][4]; conv_load(a, va, lane); conv_load(b, vb, lane); conv_store(a, va, scr, lane); conv_store(b, vb, scr, lane);
    }
    for (; jj < j1; ++jj) {
        const int r0 = base + F.wave + 8 * jj; if (r0 >= count) break;
        const CItem a = conv_item(w_exp1_, w_exp2_, F.ws, first + r0); f32x4 va[4][4]; conv_load(a, va, lane); conv_store(a, va, scr, lane);
    }
}
__device__ __forceinline__ void conv_in_idle_round(Frame& F, int nwg, int first, int count) {
    const int r = nwg % F.G, c = F.vb;
    if (r != 0 && c < r) return;
    conv_expert_items(F, first, count, r ? c - r : c, r ? F.G - r : F.G, 0, 1, F.lds + RING_OFF + F.wave * 4352);
}
constexpr int CONV_W2_IN_P2 = 5120, CONV_W2_ALL = NE * 16 * 16, CONV_ALL = NE * 16 * 16 + NE * 16 * 32;
__device__ __forceinline__ void p0_prologue(Frame& F) {
    const float* const c_ = (const float*)inp(F, 1); const float* const w_ada_ = (const float*)inp(F, 3); const float* const b_ada_ = (const float*)inp(F, 4); float* const mod_ = (float*)(F.ws + WS_MOD); const int* const positions_ = (const int*)inp(F, 2); float* const rope_ = (float*)(F.ws + WS_ROPE); const float* const lq1_ = (const float*)inp(F, 7); const float* const lk1_ = (const float*)inp(F, 8); const float* const lq2_ = (const float*)inp(F, 9); const float* const lk2_ = (const float*)inp(F, 10); float* const lam_ = (float*)(F.ws + WS_MOD + 256 * 1024); const float* const w_exp1_ = (const float*)inp(F, 21); bf16* const W1_t_ = (bf16*)(F.ws + WS_W1); const float* const w_exp2_ = (const float*)inp(F, 23); bf16* const W2_t_ = (bf16*)(F.ws + WS_W2); const float* const w_in_ = (const float*)inp(F, 6); bf16* const Win_t_ = (bf16*)(F.ws + WS_WIN); const float* const w_proj_a_ = (const float*)inp(F, 14); bf16* const Wa_t_ = (bf16*)(F.ws + WS_WA); const float* const w_proj_b_ = (const float*)inp(F, 15); bf16* const Wb_t_ = (bf16*)(F.ws + WS_WB); const float* const w_pool_ = (const float*)inp(F, 12); const float* const pool_scale_ = (const float*)inp(F, 13); bf16* const Wpool_t_ = (bf16*)(F.ws + WS_WPOOL); const float* const w_out_ = (const float*)inp(F, 16); bf16* const Wout_t_ = (bf16*)(F.ws + WS_WOUT);
    {
        LAS float* sc = (LAS float*)(F.lds + RING_OFF);
        LAS float* red = (LAS float*)(F.lds + RING_OFF + 32768);
        bool staged = false;
        for (int it = blockIdx.x; it < 96; it += F.G) {
            if (!staged) { for (int i = F.tid; i < NB * D; i += NWAVES * 64) { const int b = i >> 10, kk = i & 1023; const float v = c_[i]; sc[kk * 8 + b] = v / (1.f + __expf(-v)); } __syncthreads(); staged = true; }
            const int j0 = it * 64, cg = F.lane & 15, kq = F.lane >> 4;
            float acc[8][4];
#pragma unroll
            for (int b = 0; b < 8; ++b)
#pragma unroll
                for (int xx = 0; xx < 4; ++xx) acc[b][xx] = 0.f;
#pragma unroll 8
            for (int s = 0; s < 32; ++s) { const int kk = 32 * s + 4 * F.wave + kq;
                const f32x4 w = *(const GAS f32x4*)(w_ada_ + (size_t)kk * (NMOD * D) + j0 + 4 * cg);
                const f32x4 s0 = *(const LAS f32x4*)(sc + kk * 8), s1 = *(const LAS f32x4*)(sc + kk * 8 + 4);
#pragma unroll
                for (int xx = 0; xx < 4; ++xx) { acc[0][xx] += s0[0] * w[xx]; acc[1][xx] += s0[1] * w[xx]; acc[2][xx] += s0[2] * w[xx]; acc[3][xx] += s0[3] * w[xx];
                    acc[4][xx] += s1[0] * w[xx]; acc[5][xx] += s1[1] * w[xx]; acc[6][xx] += s1[2] * w[xx]; acc[7][xx] += s1[3] * w[xx]; } }
#pragma unroll
            for (int b = 0; b < 8; ++b)
#pragma unroll
                for (int xx = 0; xx < 4; ++xx) { float a = acc[b][xx]; a += __shfl_xor(a, 16); a += __shfl_xor(a, 32); if (kq == 0) red[(F.wave * 8 + b) * 64 + 4 * cg + xx] = a; }
            __syncthreads();
            { const int b = F.tid >> 6, col = F.tid & 63; float a = b_ada_[j0 + col];
#pragma unroll
              for (int w = 0; w < 8; ++w) a += red[(w * 8 + b) * 64 + col];
              mod_[b * (NMOD * D) + j0 + col] = a; }
            __syncthreads();
        }
        if (staged) __syncthreads();
    }
    for (int idx = F.vcu * (NWAVES * 64) + F.tid; idx < T * 8; idx += F.G * NWAVES * 64) { const int t = idx >> 3, i = idx & 7; float cs, sn; rope_cs(positions_[t], i, cs, sn); rope_[t * 16 + i] = cs; rope_[t * 16 + 8 + i] = sn; }
    if (blockIdx.x == 0 && F.wave == 0) { const float s1 = wave_sum(lq1_[F.lane] * lk1_[F.lane]), s2 = wave_sum(lq2_[F.lane] * lk2_[F.lane]); if (F.lane == 0) lam_[0] = expf(s1) - expf(s2) + LAM_INIT; }
    {
        LAS bf16* scr = (LAS bf16*)(F.lds + RING_OFF + F.wave * 8448);
        const int gw = F.vcu * NWAVES + F.wave, NGW = F.G * NWAVES;
        constexpr int I_IN = 16 * (INC / 64), I_A = 16 * 16, I_O = 16 * 16;
        constexpr int NITEMS = I_IN + I_A + I_O;
        for (int it = gw; it < NITEMS; it += NGW) {
            int r = it;
            if (r < I_IN) { const int kb = r / (INC / 64), nb = r % (INC / 64);
                tr_item(w_in_, INC, kb * 64, nb * 64, Win_t_, D, kb * 64, [=](int nn) { return nb * 64 + ((nb < 32 && nn < 16) ? ((nn & 7) * 2 + (nn >> 3)) : nn); }, scr, F.lane, false); continue; } r -= I_IN;
            if (r < I_A) { const int kb = r / 16, nb = r % 16;
                tr_item(w_proj_a_, D, kb * 64, nb * 64, Wa_t_, DW, kb * 64, [=](int nn) { return nb * 64 + nn; }, scr, F.lane, false); continue; } r -= I_A;
            { const int kb = r / 16, nb = r % 16;
                tr_item(w_out_, D, kb * 64, nb * 64, Wout_t_, D, kb * 64, [=](int nn) { return nb * 64 + nn; }, scr, F.lane, false); }
        }
        const int nfree = (F.G > 96) ? F.G - 96 : F.G, myfree = (F.G > 96) ? (int)blockIdx.x - 96 : (int)blockIdx.x;
        for (int it = myfree * NWAVES + F.wave; myfree >= 0 && it < 16 * 64; it += nfree * NWAVES) {
            const int n = (it & 15) * 64 + F.lane, kk0 = (it >> 4) * 8, g = kk0 >> 7, c0 = kk0 & 127;
            const float* wp = w_pool_ + (size_t)g * 128 * 128 + (size_t)c0 * 128; const float* sc = pool_scale_ + g * 128; const float* wb = w_proj_b_ + (size_t)(g * 128) * D + n;
            float wr0[8], wr1[8];
            { const float s0 = sc[F.lane], s1 = sc[64 + F.lane];
#pragma unroll
              for (int q = 0; q < 8; ++q) { wr0[q] = wp[q * 128 + F.lane] * s0; wr1[q] = wp[q * 128 + 64 + F.lane] * s1; } }
            float acc[8];
#pragma unroll
            for (int q = 0; q < 8; ++q) acc[q] = 0.f;
#pragma unroll 1
            for (int j0 = 0; j0 < 128; j0 += 32) {
                float b[32];
#pragma unroll
                for (int u = 0; u < 32; ++u) b[u] = wb[(size_t)(j0 + u) * D];
#pragma unroll
                for (int u = 0; u < 32; ++u) { const int jx = j0 + u;
#pragma unroll
                    for (int q = 0; q < 8; ++q) { const float w = __builtin_bit_cast(float, __builtin_amdgcn_readlane(__builtin_bit_cast(int, (j0 < 64) ? wr0[q] : wr1[q]), jx & 63)); acc[q] += w * b[u]; } }
            }
            *(GAS v4u*)(Wb_t_ + (size_t)n * PW + kk0) = (v4u){pk2(acc[0], acc[1]), pk2(acc[2], acc[3]), pk2(acc[4], acc[5]), pk2(acc[6], acc[7])};
        }
    }
}

__device__ __forceinline__ void p1_norm(Frame& F) {
    const float* const g_pre_mix_ = (const float*)inp(F, 5); const float* const x_ = (const float*)inp(F, 0); float* const mod_ = (float*)(F.ws + WS_MOD); bf16* const h_ = (bf16*)(F.ws + WS_H);
    const int gw = F.vcu * NWAVES + F.wave, NGW = F.G * NWAVES;
    f32x4 gv[4];
#pragma unroll
    for (int j = 0; j < 4; ++j) gv[j] = *((const GAS f32x4*)g_pre_mix_ + F.lane + 64 * j);
    for (int mi_ = gw; mi_ < T; mi_ += NGW) {
        const int m = ((mi_ & 2047) >> 8) * SEQ + (mi_ >> 11) * 256 + (mi_ & 255);
        const GAS f32x4* xr = (const GAS f32x4*)(x_ + (size_t)m * D) + F.lane; const float* mb = mod_ + (m / SEQ) * (NMOD * D);
        f32x4 v[4]; float s = 0.f;
#pragma unroll
        for (int j = 0; j < 4; ++j) { v[j] = xr[64 * j]; s += (v[j].x * v[j].x + v[j].y * v[j].y) + (v[j].z * v[j].z + v[j].w * v[j].w); }
        const float r = rsqrtf(wave_sum(s) * (1.f / D) + NORM_EPS);
        GAS v2u* o8 = (GAS v2u*)(h_ + (size_t)m * D) + F.lane;
#pragma unroll
        for (int j = 0; j < 4; ++j) { const f32x4 sh = *((const GAS f32x4*)mb + F.lane + 64 * j), sc = *((const GAS f32x4*)(mb + D) + F.lane + 64 * j);
            const f32x4 o = v[j] * r * gv[j] * (sc + 1.f) + sh; o8[64 * j] = (v2u){pk2(o.x, o.y), pk2(o.z, o.w)}; }
    }
}
__device__ __forceinline__ void p3_poold(Frame& F) {
    bf16* const u_ = (bf16*)(F.ws + WS_U); bf16* const dd_ = (bf16*)(F.ws + WS_DD);
    LAS unsigned* col = (LAS unsigned*)(F.lds + RING_OFF + F.wave * 16384);
    const int gw = F.vcu * NWAVES + F.wave, NGW = F.G * NWAVES;
    for (int it = gw; it < (T / 32) * 4; it += NGW) {
        const int g = it & 3, blk = it >> 2, t0 = blk * 32, tin0 = t0 % SEQ, w = 2 << g;
        const bf16* up = u_ + (size_t)t0 * PW + g * 128 + 2 * F.lane;
        unsigned vals[48];
#pragma unroll
        for (int r = 0; r < 48; ++r) { vals[r] = 0u; if (tin0 - 16 + r >= 0) vals[r] = *(const GAS unsigned*)(up + (ptrdiff_t)(r - 16) * PW); }
#pragma unroll
        for (int r = 0; r < 48; ++r) col[r * 64 + F.lane] = vals[r];
        LDS_WAIT(); asm volatile("" ::: "memory");
        float s0 = 0.f, s1 = 0.f;
        for (int j = 1; j <= w; ++j) { const unsigned val = col[(16 - j) * 64 + F.lane]; s0 += bflo(val); s1 += bfhi(val); }
        bf16* dp = dd_ + (size_t)t0 * PW + g * 128 + 2 * F.lane;
        for (int r = 0; r < 32; ++r) { const unsigned cur = col[(16 + r) * 64 + F.lane], old = col[(16 + r - w) * 64 + F.lane];
            s0 += bflo(cur) - bflo(old); s1 += bfhi(cur) - bfhi(old);
            const float inv = 1.f / (float)min(tin0 + r + 1, w);
            *(GAS unsigned*)(dp + (size_t)r * PW) = pk2(s0 * inv - bflo(cur), s1 * inv - bfhi(cur)); }
        LDS_WAIT(); asm volatile("" ::: "memory");
    }
}
__device__ __forceinline__ void p3_combine(Frame& F, int b, int h, int qb) {
    const float* const g_subln_ = (const float*)inp(F, 11); const float* const lam_ = (const float*)(F.ws + WS_MOD + 256 * 1024);
    const bf16* const O0_ = (const bf16*)(F.ws + WS_O0); const bf16* const O1_ = (const bf16*)(F.ws + WS_O1); bf16* const oc_ = (bf16*)(F.ws + WS_OC);
    asm volatile("s_waitcnt vmcnt(0)" ::: "memory"); __syncthreads();
    const __amdgpu_buffer_rsrc_t r0 = __builtin_amdgcn_make_buffer_rsrc((void*)O0_, 0, T * DW * 2, 0x00020000), r1 = __builtin_amdgcn_make_buffer_rsrc((void*)O1_, 0, T * DW * 2, 0x00020000);
    int lane = F.lane; asm volatile("" : "+v"(lane));
    const float lam = lam_[0];
    float gs[16];
#pragma unroll
    for (int i = 0; i < 16; ++i) gs[i] = g_subln_[16 * (lane & 7) + i] * (1.f - LAM_INIT);
#pragma unroll 2
    for (int st = 0; st < 4; ++st) {
        const int row = b * SEQ + qb * 256 + F.wave * 32 + st * 8 + (lane >> 3);
        const size_t off = (size_t)row * DW + h * 128 + 16 * (lane & 7);
        const unsigned ob = (unsigned)(off * 2);
        const v4u a0 = __builtin_amdgcn_raw_buffer_load_b128(r0, ob, 0, 16), a1 = __builtin_amdgcn_raw_buffer_load_b128(r0, ob + 16, 0, 16), b0 = __builtin_amdgcn_raw_buffer_load_b128(r1, ob, 0, 16), b1 = __builtin_amdgcn_raw_buffer_load_b128(r1, ob + 16, 0, 16);
        float v[16];
#pragma unroll
        for (int i = 0; i < 4; ++i) { v[2 * i] = bflo(a0[i]) - lam * bflo(b0[i]); v[2 * i + 1] = bfhi(a0[i]) - lam * bfhi(b0[i]); v[8 + 2 * i] = bflo(a1[i]) - lam * bflo(b1[i]); v[8 + 2 * i + 1] = bfhi(a1[i]) - lam * bfhi(b1[i]); }
        float ss = 0.f;
#pragma unroll
        for (int i = 0; i < 16; ++i) ss += v[i] * v[i];
        ss = sum8(ss);
        const float r = rsqrtf(ss * (1.f / 128.f) + SUBLN_EPS);
        v4u o0, o1;
#pragma unroll
        for (int i = 0; i < 4; ++i) { o0[i] = pk2(v[2 * i] * r * gs[2 * i], v[2 * i + 1] * r * gs[2 * i + 1]); o1[i] = pk2(v[8 + 2 * i] * r * gs[8 + 2 * i], v[9 + 2 * i] * r * gs[9 + 2 * i]); }
        *(GAS v4u*)(oc_ + off) = o0; *(GAS v4u*)(oc_ + off + 8) = o1;
    }
}
__device__ __forceinline__ void p7_router(Frame& F, const int npass) {
    const float* const w_router_ = (const float*)inp(F, 19); const float* const b_router_ = (const float*)inp(F, 20); float* const mod_ = (float*)(F.ws + WS_MOD); float* const mx_ = (float*)(F.ws + WS_MX); const float* const x_ = (const float*)inp(F, 0); const float* const g_post_mix_ = (const float*)inp(F, 17); float* const out_ = (float*)inp(F, 26); const float* const g_pre_ffn_ = (const float*)inp(F, 18); bf16* const h2_ = (bf16*)(F.ws + WS_H2); int* const list_ = (int*)(F.ws + WS_LIST); unsigned* const tokslot_ = (unsigned*)(F.ws + WS_TOK); float* const tokw_ = (float*)(F.ws + WS_TOK + 256 * 1024);
    constexpr int HP = 2064;
    LAS unsigned char* hhi = F.lds + RING_OFF; LAS unsigned char* hlo = F.lds + RING_OFF + 16 * HP;
    LAS float* part = (LAS float*)(F.lds + RING_OFF + 66048);
    LAS unsigned* sel = (LAS unsigned*)(F.lds + RING_OFF + 98304);
    LAS float* selw = (LAS float*)(F.lds + RING_OFF + 98304 + 2048);
    LAS int* selt = (LAS int*)(F.lds + RING_OFF + 98304 + 4096);
    LAS unsigned* lcnt = (LAS unsigned*)(F.lds + RING_OFF + 98304 + 4608);
    if (F.tid < 64) lcnt[F.tid] = 0u;
    const int e = F.lane & 31;
    pg8::bf16x8 bhi[4][2], blo[4][2];
#pragma unroll
    for (int ks = 0; ks < 4; ++ks)
#pragma unroll
        for (int nb2 = 0; nb2 < 2; ++nb2) { unsigned hh[4], ll[4];
#pragma unroll
            for (int jp = 0; jp < 4; ++jp) { const size_t k0 = (size_t)(128 * F.wave + 32 * ks + 8 * (F.lane >> 4) + 2 * jp); const float w0 = w_router_[k0 * NE + 16 * nb2 + (F.lane & 15)], w1 = w_router_[(k0 + 1) * NE + 16 * nb2 + (F.lane & 15)];
                hh[jp] = pk2(w0, w1); ll[jp] = pk2(w0 - bflo(hh[jp]), w1 - bfhi(hh[jp])); }
            bhi[ks][nb2] = __builtin_bit_cast(pg8::bf16x8, (v4u){hh[0], hh[1], hh[2], hh[3]}); blo[ks][nb2] = __builtin_bit_cast(pg8::bf16x8, (v4u){ll[0], ll[1], ll[2], ll[3]}); }
    const float bre = b_router_[e];
    __syncthreads();
    int nb = 0;
    for (int pass = 0; pass < npass; ++pass) {
    if (pass > 0) { __syncthreads(); if (F.tid < 64) lcnt[F.tid] = 0u; __syncthreads(); }
    nb = 0;
    for (int bi = F.vcu; bi < T / 16; bi += F.G, ++nb) {
        const int bt = ((bi & 255) >> 5) * (SEQ / 16) + (bi >> 8) * 32 + (bi & 31);
        {
            const int t0 = bt * 16 + 2 * F.wave; const float* mb = mod_ + (t0 / SEQ) * (NMOD * D);
            f32x4 mv[2][4], xv[2][4];
#pragma unroll
            for (int rr = 0; rr < 2; ++rr)
#pragma unroll
                for (int j = 0; j < 4; ++j) { { const v2u mw = *((const GAS v2u*)((const bf16*)mx_ + (size_t)(t0 + rr) * D) + F.lane + 64 * j); mv[rr][j] = (f32x4){bflo(mw.x), bfhi(mw.x), bflo(mw.y), bfhi(mw.y)}; } xv[rr][j] = *((const GAS f32x4*)(x_ + (size_t)(t0 + rr) * D) + F.lane + 64 * j); }
#pragma unroll
            for (int rr = 0; rr < 2; ++rr) {
                const int r = 2 * F.wave + rr, t = t0 + rr; float s = 0.f;
#pragma unroll
                for (int j = 0; j < 4; ++j) s += (mv[rr][j].x * mv[rr][j].x + mv[rr][j].y * mv[rr][j].y) + (mv[rr][j].z * mv[rr][j].z + mv[rr][j].w * mv[rr][j].w);
                float rs = rsqrtf(wave_sum(s) * (1.f / D) + NORM_EPS); s = 0.f;
#pragma unroll
                for (int j = 0; j < 4; ++j) { const f32x4 gp = *((const GAS f32x4*)g_post_mix_ + F.lane + 64 * j), gt = *((const GAS f32x4*)(mb + 2 * D) + F.lane + 64 * j);
                    xv[rr][j] = xv[rr][j] + gt * (mv[rr][j] * rs * gp); *((GAS v2u*)(F.ws + WS_X1 + (size_t)t * D * 2) + F.lane + 64 * j) = (v2u){pk2(xv[rr][j].x, xv[rr][j].y), pk2(xv[rr][j].z, xv[rr][j].w)};     s += (xv[rr][j].x * xv[rr][j].x + xv[rr][j].y * xv[rr][j].y) + (xv[rr][j].z * xv[rr][j].z + xv[rr][j].w * xv[rr][j].w); }
                rs = rsqrtf(wave_sum(s) * (1.f / D) + NORM_EPS);
#pragma unroll
                for (int j = 0; j < 4; ++j) { const f32x4 gq = *((const GAS f32x4*)g_pre_ffn_ + F.lane + 64 * j), sh = *((const GAS f32x4*)(mb + 3 * D) + F.lane + 64 * j), sc = *((const GAS f32x4*)(mb + 4 * D) + F.lane + 64 * j);
                    const f32x4 hv = xv[rr][j] * rs * gq * (sc + 1.f) + sh;
                    if (!MK_SINGLE) *((GAS v2u*)(h2_ + (size_t)t * D) + F.lane + 64 * j) = (v2u){pk2(hv.x, hv.y), pk2(hv.z, hv.w)};
                    { int w8 = 0; w8 = __builtin_amdgcn_cvt_pk_fp8_f32(hv.x, hv.y, w8, false); w8 = __builtin_amdgcn_cvt_pk_fp8_f32(hv.z, hv.w, w8, true); *((GAS unsigned*)(F.ws + WS_H2F + (size_t)t * D) + F.lane + 64 * j) = (unsigned)w8; }
                    { const unsigned h0 = pk2(hv.x, hv.y), h1 = pk2(hv.z, hv.w); *(LAS v2u*)(hhi + r * HP + 8 * (F.lane + 64 * j)) = (v2u){h0, h1};
                      *(LAS v2u*)(hlo + r * HP + 8 * (F.lane + 64 * j)) = (v2u){pk2(hv.x - bflo(h0), hv.y - bfhi(h0)), pk2(hv.z - bflo(h1), hv.w - bfhi(h1))}; } }
            }
        }
        __syncthreads();
        { pg8::f32x4 acc2[2] = {{0.f, 0.f, 0.f, 0.f}, {0.f, 0.f, 0.f, 0.f}};
#pragma unroll
          for (int ks = 0; ks < 4; ++ks) { const int ao = (F.lane & 15) * HP + 2 * (128 * F.wave + 32 * ks + 8 * (F.lane >> 4));
              const pg8::bf16x8 ahi = *(const LAS pg8::bf16x8*)(hhi + ao), alo = *(const LAS pg8::bf16x8*)(hlo + ao);
#pragma unroll
              for (int nb2 = 0; nb2 < 2; ++nb2) { acc2[nb2] = __builtin_amdgcn_mfma_f32_16x16x32_bf16(ahi, bhi[ks][nb2], acc2[nb2], 0, 0, 0); acc2[nb2] = __builtin_amdgcn_mfma_f32_16x16x32_bf16(ahi, blo[ks][nb2], acc2[nb2], 0, 0, 0);
                  acc2[nb2] = __builtin_amdgcn_mfma_f32_16x16x32_bf16(alo, bhi[ks][nb2], acc2[nb2], 0, 0, 0); } }
#pragma unroll
          for (int nb2 = 0; nb2 < 2; ++nb2)
#pragma unroll
              for (int i2 = 0; i2 < 4; ++i2) part[(F.wave * 16 + 4 * (F.lane >> 4) + i2) * 32 + 16 * nb2 + (F.lane & 15)] = acc2[nb2][i2]; }
        __syncthreads();
        {
            const int r = 2 * F.wave + (F.lane >> 5), t = bt * 16 + r; float lg = bre;
#pragma unroll
            for (int w = 0; w < 8; ++w) lg += part[(w * 16 + r) * 32 + e];
            float val = lg, tv[4]; int ti[4];
#pragma unroll
            for (int kk = 0; kk < 4; ++kk) { const float m = max32(val);
                const unsigned long long bal = __ballot(val == m); const unsigned hb = (F.lane >> 5) ? (unsigned)(bal >> 32) : (unsigned)bal; const int idx = __builtin_ctz(hb);
                tv[kk] = m; ti[kk] = idx; if (e == idx) val = -INFINITY; }
            if (e == 0) { float pw[4], den = 0.f;
#pragma unroll
                for (int kk = 0; kk < 4; ++kk) { pw[kk] = __expf(tv[kk] - tv[0]); den += pw[kk]; }
                const float inv = 1.f / den; const int lr = nb * 16 + r; selt[lr] = t;
#pragma unroll
                for (int kk = 0; kk < 4; ++kk) { const unsigned lp = __hip_atomic_fetch_add(lcnt + ti[kk], 1u, __ATOMIC_RELAXED, __HIP_MEMORY_SCOPE_WORKGROUP); sel[lr * 4 + kk] = ((unsigned)ti[kk] << 16) | lp; selw[lr * 4 + kk] = pw[kk] * inv; } }
        }
    }
    }
    __syncthreads();
    if (PROBE_DUP == 77) { if (F.tid < NE) lcnt[32 + F.tid] = __hip_atomic_fetch_add((unsigned*)(F.ctl + CW_CNT + 64 * F.tid), 0u, RLX_AGENT); __syncthreads(); }
    if (F.tid < NE) lcnt[32 + F.tid] = __hip_atomic_fetch_add((unsigned*)(F.ctl + CW_CNT + 64 * F.tid), lcnt[F.tid], RLX_AGENT);
    __syncthreads();
    for (int s = F.tid; s < nb * 64; s += NWAVES * 64) { const unsigned sv = sel[s]; const int ee = sv >> 16; const unsigned pos = lcnt[32 + ee] + (sv & 0xffffu); const int t = selt[s >> 2];
        list_[ee * T + pos] = t; tokslot_[t * 4 + (s & 3)] = ((unsigned)ee << 16) | pos; tokw_[t * 4 + (s & 3)] = selw[s]; }
    __syncthreads();
}
__device__ __forceinline__ void moe_tables(Frame& F) {

    LAS int* tstart = (LAS int*)(F.lds + L_TSTART); LAS int* cntl = (LAS int*)(F.lds + L_CNT); LAS int* tile_e = (LAS int*)(F.lds + L_TILEE);
    if (F.tid < NE) cntl[F.tid] = (int)__hip_atomic_load((unsigned*)(F.ctl + CW_CNT + 64 * F.tid), RLX_AGENT);
    __syncthreads();
    if (F.tid == 0) { int s = 0; for (int e = 0; e < NE; ++e) { tstart[e] = s; s += (cntl[e] + 255) >> 8; } tstart[NE] = s; }
    __syncthreads();
    for (int pm = F.tid; pm < MT_MAX; pm += NWAVES * 64) { int e = 0;
#pragma unroll
        for (int j = 1; j < NE; ++j) e += (pm >= tstart[j]) ? 1 : 0;
        tile_e[pm] = e; }
    { LAS int* tord = (LAS int*)(F.lds + L_TORD); const int nM = tstart[NE];
      int hall = 0;
#pragma unroll
      for (int j = 0; j < NE; ++j) { const int r = cntl[j] & 255; hall += (r >= 1 && r <= 128) ? 1 : 0; }
      const int nF = nM - hall; if (F.tid == 0) tstart[NE + 1] = nF;
      for (int pm = F.tid; pm < nM; pm += NWAVES * 64) { int e = 0, hb = 0;
#pragma unroll
        for (int j = 1; j < NE; ++j) { const bool ge = pm >= tstart[j]; const int r = cntl[j - 1] & 255; e += ge ? 1 : 0; hb += (ge && r >= 1 && r <= 128) ? 1 : 0; }
        const int re = cntl[e] & 255; const bool shortt = (pm == tstart[e + 1] - 1) && re >= 1 && re <= 128;
        tord[shortt ? nF + hb : pm - hb] = pm; } }
    __syncthreads();
}
__device__ __forceinline__ void p10_final(Frame& F, const bool dry) {
    const float* const g_post_ffn_ = (const float*)inp(F, 25); const unsigned* const tokslot_ = (const unsigned*)(F.ws + WS_TOK); const float* const tokw_ = (const float*)(F.ws + WS_TOK + 256 * 1024);
    const unsigned char* const ye_ = (const unsigned char*)(F.ws + WS_YE); const float* const mod_ = (const float*)(F.ws + WS_MOD); float* const out_ = (float*)inp(F, 26);
    const LAS int* tstart = (const LAS int*)(F.lds + L_TSTART);
    const int gw = F.vcu * NWAVES + F.wave, NGW = F.G * NWAVES;
    f32x4 gp[4];
#pragma unroll
    for (int j = 0; j < 4; ++j) gp[j] = *((const GAS f32x4*)g_post_ffn_ + F.lane + 64 * j);
    v4u tsA, tsB; f32x4 twA, twB;
    { const int t0 = gw, tb = (gw + NGW < T) ? gw + NGW : gw; if (t0 < T) { tsA = *(const GAS v4u*)(tokslot_ + t0 * 4); tsB = *(const GAS v4u*)(tokslot_ + tb * 4); twA = *(const GAS f32x4*)(tokw_ + t0 * 4); twB = *(const GAS f32x4*)(tokw_ + tb * 4); } }
    for (int t0 = gw; t0 < T; t0 += 2 * NGW) {
        const int t1 = t0 + NGW; const bool two = t1 < T; const int tb = two ? t1 : t0;
        unsigned ya[4][4], yb[4][4];
#pragma unroll
        for (int kk = 0; kk < 4; ++kk) { const GAS unsigned* ra = (const GAS unsigned*)(ye_ + (size_t)(256 * tstart[tsA[kk] >> 16] + (tsA[kk] & 0xffff)) * D); const GAS unsigned* rb = (const GAS unsigned*)(ye_ + (size_t)(256 * tstart[tsB[kk] >> 16] + (tsB[kk] & 0xffff)) * D);
#pragma unroll
            for (int j = 0; j < 4; ++j) { ya[kk][j] = ra[F.lane + 64 * j]; yb[kk][j] = rb[F.lane + 64 * j]; } }
        v2u xa[4], xb[4];
#pragma unroll
        for (int j = 0; j < 4; ++j) { xa[j] = *((const GAS v2u*)(F.ws + WS_X1 + (size_t)t0 * D * 2) + F.lane + 64 * j); xb[j] = *((const GAS v2u*)(F.ws + WS_X1 + (size_t)tb * D * 2) + F.lane + 64 * j); }
        const f32x4 twA0 = twA, twB0 = twB;
        { const int n0 = t0 + 2 * NGW, nb2 = (n0 + NGW < T) ? n0 + NGW : n0; if (n0 < T) { tsA = *(const GAS v4u*)(tokslot_ + n0 * 4); tsB = *(const GAS v4u*)(tokslot_ + nb2 * 4); twA = *(const GAS f32x4*)(tokw_ + n0 * 4); twB = *(const GAS f32x4*)(tokw_ + nb2 * 4); } }
#pragma unroll
        for (int rr = 0; rr < 2; ++rr) {
            if (rr == 1 && !two) break;
            const int t = rr ? t1 : t0;
            float f[16];
#pragma unroll
            for (int i = 0; i < 16; ++i) f[i] = 0.f;
#pragma unroll
            for (int kk = 0; kk < 4; ++kk) { const float ws = (rr ? twB0[kk] : twA0[kk]) * pg8::YE_INV;
#pragma unroll
                for (int j = 0; j < 4; ++j) { const int a = (int)(rr ? yb[kk][j] : ya[kk][j]); const auto lo = __builtin_amdgcn_cvt_pk_f32_fp8(a, false), hi = __builtin_amdgcn_cvt_pk_f32_fp8(a, true);
                    f[4 * j] += ws * lo[0]; f[4 * j + 1] += ws * lo[1]; f[4 * j + 2] += ws * hi[0]; f[4 * j + 3] += ws * hi[1]; } }
            float ss = 0.f;
#pragma unroll
            for (int i = 0; i < 16; ++i) ss += f[i] * f[i];
            const float r = rsqrtf(wave_sum(ss) * (1.f / D) + NORM_EPS);
            const GAS f32x4* gtp = (const GAS f32x4*)(mod_ + (t / SEQ) * (NMOD * D) + 5 * D) + F.lane; GAS f32x4* op = (GAS f32x4*)(out_ + (size_t)t * D) + F.lane;
#pragma unroll
            for (int j = 0; j < 4; ++j) { const f32x4 gt = gtp[64 * j]; const v2u xw = rr ? xb[j] : xa[j]; const f32x4 x1 = {bflo(xw.x), bfhi(xw.x), bflo(xw.y), bfhi(xw.y)};
                const f32x4 fv = {f[4 * j], f[4 * j + 1], f[4 * j + 2], f[4 * j + 3]}; if (!dry) op[64 * j] = x1 + gt * (fv * r * gp[j]); }
        }
    }
}

struct Args { const void* in[26]; float* out; unsigned char* ws; int ph_lo, ph_hi; };
__global__ void __launch_bounds__(NWAVES * 64, 2) mega_fwd(Args args) {
    extern __shared__ __attribute__((aligned(16))) unsigned char lds[];
    Frame F;
    F.lds = (LAS unsigned char*)lds;
    F.MISC = (volatile LAS unsigned*)(F.lds + MISC_OFF);
    F.tid = threadIdx.x; F.lane = F.tid & 63; F.wave = __builtin_amdgcn_readfirstlane(F.tid >> 6);
    F.G = gridDim.x; { const int bx = blockIdx.x; F.vcu = (F.G % 8 == 0) ? (bx % 8) * (F.G / 8) + bx / 8 : bx; F.vb = bx; }
    F.ws = args.ws; F.ctl = (gu32*)(args.ws + WS_CTL);
    for (int u = F.tid; u < (LDS_BYTES - LDSCTL_OFF) / 4; u += NWAVES * 64) ((LAS unsigned*)(F.lds + LDSCTL_OFF))[u] = 0u;
    __syncthreads();
    if (F.tid == 0) { LAS unsigned long long* pt = (LAS unsigned long long*)(F.lds + L_PTRS);
#define PT(i) pt[i] = (unsigned long long)args.in[i];
        PT(0) PT(1) PT(2) PT(3) PT(4) PT(5) PT(6) PT(7) PT(8) PT(9) PT(10) PT(11) PT(12) PT(13) PT(14) PT(15) PT(16) PT(17) PT(18) PT(19) PT(20) PT(21) PT(22) PT(23) PT(24) PT(25)
#undef PT
        pt[26] = (unsigned long long)args.out; }
    __syncthreads();
    const int lo = args.ph_lo, hi = args.ph_hi;
    const bool single = (hi - lo) > 1;
    XcdBarrier bar; bar.bar = (unsigned*)(F.ctl + CW_BAR); bar.x = 0; bar.st = nullptr;
    if (single) bar = xcd_barrier_post((unsigned*)(F.ctl + CW_BAR), F.MISC + 8);
#define IN(k) (lo <= (k) && (k) < hi)
#define NREP(k) ((PROBE_DUP == (k) || (PROBE_DUP == 35 && (k) == 3)) ? 2 : 1)
#define SEAM(k) do { if (IN(k) && IN((k) + 1)) { xcd_barrier(bar); if (PROBE_DUP == 100 && (k) < 5) xcd_barrier(bar); } } while (0)
#define SEAML(k) do { if (IN(k) && IN((k) + 1)) { if (grp) xcc_local_barrier(bar); else xcd_barrier(bar); } } while (0)
    bool grp = false;
    const LAS int* gtab = (const LAS int*)(F.lds + L_GTAB);
#define REFRESH() do { int t_ = (int)threadIdx.x; asm volatile("" : "+v"(t_)); F.tid = t_; F.lane = t_ & 63; } while (0)

    _Pragma("unroll") for (int allrep_ = 0; allrep_ < ((PROBE_DUP == 200) ? 2 : 1); ++allrep_) {
    if (allrep_ > 0) { xcd_barrier(bar); if (blockIdx.x == 0 && F.tid < NE) __hip_atomic_store((unsigned*)(F.ctl + CW_CNT + 64 * F.tid), 0u, RLX_AGENT); xcd_barrier(bar); }
    if (IN(0)) _Pragma("unroll") for (int rep_ = 0; rep_ < NREP(0); ++rep_) { REFRESH(); p0_prologue(F); if (NREP(0) > 1) __syncthreads(); } SEAM(0);
    if (single && allrep_ == 0) { const unsigned md = __builtin_amdgcn_readfirstlane(F.MISC[10]), rk = __builtin_amdgcn_readfirstlane(F.MISC[11]);
        if (md == 2u && PROBE_DUP != 101) { grp = true; F.vcu = (int)bar.x * 32 + (int)rk; F.vb = (int)rk * 8 + (int)bar.x; } }
    if (IN(1)) _Pragma("unroll") for (int rep_ = 0; rep_ < NREP(1); ++rep_) { REFRESH(); p1_norm(F); } SEAML(1);
    if (IN(2)) _Pragma("unroll") for (int rep_ = 0; rep_ < NREP(2); ++rep_) { REFRESH();
        pg8::Gemm g{((bf16*)(F.ws + WS_H)), ((bf16*)(F.ws + WS_WIN)), D, 0, 0}; pg8::StaticOrder S; S.init(T, INC, F.G, F.vb);
        pg8::EpiZ E{((bf16*)(F.ws + WS_Q)), ((bf16*)(F.ws + WS_K)), ((bf16*)(F.ws + WS_V)), ((bf16*)(F.ws + WS_U)), ((bf16*)(F.ws + WS_GA)), ((bf16*)(F.ws + WS_GB)), ((float*)(F.ws + WS_ROPE))};
        pg8::gemm_phase<pg8::EpiZ, pg8::StaticOrder, true, false>(F.lds + RING_OFF, g, S, E, gtab);
        if (rep_ == NREP(2) - 1) conv_in_idle_round(F, (T / 256) * (INC / 256), 0, CONV_W2_IN_P2);
    } SEAML(2);
    if (IN(3)) _Pragma("unroll") for (int rep_ = 0; rep_ < NREP(3); ++rep_) { REFRESH();
        p3_poold(F);
        __syncthreads();
        const attn_body::Combine CB{false, (const attn_body::bf16*)(F.ws + WS_O0), (attn_body::bf16*)(F.ws + WS_OC), (const float*)inp(F, 11), ((const float*)(F.ws + WS_MOD + 256 * 1024))[0], SUBLN_EPS, 1.f - LAM_INIT};
        const attn_body::AttnTensors AT{(const attn_body::bf16*)(F.ws + WS_Q), (const attn_body::bf16*)(F.ws + WS_K), (const attn_body::bf16*)(F.ws + WS_V), (attn_body::bf16*)(F.ws + WS_O0), CB};
        attn_body::attn_phase<16>((char*)lds + RING_OFF, AT, F.vcu, F.G,
            [&](int i, int nun) { if (!((PROBE_DUP == 3 || PROBE_DUP == 35) && rep_ > 0)) { conv_expert_items(F, CONV_W2_ALL, CONV_ALL - CONV_W2_ALL, F.vcu, F.G, i, nun, F.lds + RING_OFF + F.wave * 4352);
                if (PROBE_DUP == 36) { const float* w1 = (const float*)inp(F, 21); int lane = F.lane; asm volatile("" : "+v"(lane));
                    for (int q = 0; q < 2; ++q) { CItem a; a.src = w1 + (size_t)(F.wave * 64) * (2 * FF); a.ldw = 2 * FF; a.dst = F.ws + WS_Y + (size_t)(blockIdx.x * 8 + F.wave) * 65536; a.ldk = D; a.base = 0; a.mode = 0; f32x4 va[4][4]; conv_load(a, va, lane); conv_store(a, va, F.lds + RING_OFF + F.wave * 4352, lane); } }
                asm volatile("s_waitcnt lgkmcnt(0)\n\ts_barrier" ::: "memory"); } });
        __builtin_amdgcn_s_setprio(0);
    } SEAML(3);
    if (IN(5)) _Pragma("unroll") for (int rep_ = 0; rep_ < NREP(5); ++rep_) { REFRESH();
        pg8::Gemm2 g{((bf16*)(F.ws + WS_DD)), ((bf16*)(F.ws + WS_WB)), ((bf16*)(F.ws + WS_OC)), ((bf16*)(F.ws + WS_WA)), PW, DW};
        pg8::StaticOrder S; S.init(T, D, F.G, F.vb);
        pg8::EpiChain E{((const bf16*)(F.ws + WS_GA)), ((const bf16*)(F.ws + WS_GB)), ((bf16*)(F.ws + WS_MI))};
        pg8::gemm_chain2<pg8::EpiChain, pg8::StaticOrder>(F.lds + RING_OFF, g, S, E);
    } SEAML(5);
    if (IN(6)) _Pragma("unroll") for (int rep_ = 0; rep_ < NREP(6); ++rep_) { REFRESH();
        pg8::Gemm g{((bf16*)(F.ws + WS_MI)), ((bf16*)(F.ws + WS_WOUT)), D, 0, 0}; pg8::StaticOrder S; S.init(T, D, F.G, F.vb);
        pg8::EpiBf16Plain E{((bf16*)(F.ws + WS_MX))};
        pg8::gemm_phase<pg8::EpiBf16Plain, pg8::StaticOrder, true, false>(F.lds + RING_OFF, g, S, E, gtab);
    } SEAML(6);
    if (IN(7)) { REFRESH(); p7_router(F, NREP(7)); } SEAM(7);
    if (IN(8) || IN(9) || IN(10)) { REFRESH(); moe_tables(F); }
    if (IN(8)) _Pragma("unroll") for (int rep_ = 0; rep_ < NREP(8); ++rep_) { REFRESH();
        const LAS int* tstart = (const LAS int*)(F.lds + L_TSTART); const LAS int* cntl = (const LAS int*)(F.lds + L_CNT);
        { pg8::MoeOrder S0; S0.init(tstart[NE], tstart[NE + 1], 2 * FF, F.G, F.vb, (const LAS int*)(F.lds + L_TILEE), (const LAS int*)(F.lds + L_TORD), 0);
          pg8::Unit un; LAS int* gt = (LAS int*)(F.lds + L_GTAB); LAS int* ul = (LAS int*)(F.lds + L_ULIST); int n = 0;
          _Pragma("unroll 1") for (int i = 0; i < MAXU && S0.next(i, un); ++i, ++n) if (F.tid == 0) { ul[4 + 4 * i] = un.pm; ul[5 + 4 * i] = un.pn; ul[6 + 4 * i] = un.e; ul[7 + 4 * i] = un.half; }
          if (F.tid == 0) ul[0] = n;
          __syncthreads();
          int tokv[MAXU / 2];
#pragma unroll
          for (int j = 0; j < MAXU / 2; ++j) { const int x = F.tid + 512 * j, i = x >> 8, r = x & 255; tokv[j] = 0;
              if (i < n) { const int pm = ul[4 + 4 * i], e = ul[6 + 4 * i], pos = (pm - tstart[e]) * 256 + r; if (pos < cntl[e]) tokv[j] = ((const int*)(F.ws + WS_LIST))[e * T + pos]; } }
#pragma unroll
          for (int j = 0; j < MAXU / 2; ++j) { const int x = F.tid + 512 * j; if ((x >> 8) < n) gt[x] = tokv[j]; }
          __syncthreads(); }
        const pg8::ListOrder S{(const LAS int*)(F.lds + L_ULIST)};
        pg8::Gemm g{((bf16*)(F.ws + WS_H2F)), ((bf16*)(F.ws + WS_W1)), D / 2, 0, (size_t)2 * FF * D};
        pg8::EpiSwiglu E{(unsigned char*)(F.ws + WS_A), ((const float*)inp(F, 22))};
        pg8::gemm_phase<pg8::EpiSwiglu, pg8::ListOrder, true, true, true>(F.lds + RING_OFF, g, S, E, gtab);
        if (rep_ == NREP(8) - 1) conv_in_idle_round(F, tstart[NE] * (2 * FF / 256), CONV_W2_IN_P2, CONV_W2_ALL - CONV_W2_IN_P2);
    } SEAM(8);
    if (IN(9)) _Pragma("unroll") for (int rep_ = 0; rep_ < NREP(9); ++rep_) { REFRESH();
        const LAS int* tstart = (const LAS int*)(F.lds + L_TSTART);
        { pg8::MoeOrder S0; S0.init(tstart[NE], tstart[NE + 1], D, F.G, F.vb, (const LAS int*)(F.lds + L_TILEE), (const LAS int*)(F.lds + L_TORD), 1);
          pg8::Unit un; LAS int* ul = (LAS int*)(F.lds + L_ULIST); int n = 0;
          __syncthreads();
          _Pragma("unroll 1") for (int i = 0; i < MAXU && S0.next(i, un); ++i, ++n) if (F.tid == 0) { ul[4 + 4 * i] = un.pm; ul[5 + 4 * i] = un.pn; ul[6 + 4 * i] = un.e; ul[7 + 4 * i] = un.half; }
          if (F.tid == 0) ul[0] = n;
          __syncthreads(); }
        const pg8::ListOrder S{(const LAS int*)(F.lds + L_ULIST)};
        pg8::Gemm g{((bf16*)(F.ws + WS_A)), ((bf16*)(F.ws + WS_W2)), FF / 2, 0, (size_t)D * FF};
        pg8::EpiYe E{(unsigned char*)(F.ws + WS_YE), ((const float*)inp(F, 24))};
        pg8::gemm_phase<pg8::EpiYe, pg8::ListOrder, true, false, true>(F.lds + RING_OFF, g, S, E, gtab);
    } SEAM(9);
    if (IN(10)) { REFRESH(); if (NREP(10) > 1) p10_final(F, true); p10_final(F, false); }
    }
#undef IN
#undef SEAM
#undef SEAML
}
#ifndef MK_SINGLE
#define MK_SINGLE 1
#endif
#ifndef OPT_MASK
#define OPT_MASK 0x7ff
#endif
extern "C" void kernel_launch(void* const* d_in, const int* in_sizes, int n_in, void* d_out, int out_size, void* d_ws, size_t ws_size, hipStream_t stream) {
    static int grid = 0;
    if (grid == 0) {
        if (n_in != 26 || in_sizes[0] != T * D || out_size != T * D || ws_size < WS_END) { fprintf(stderr, "kernel_launch: unexpected shapes (n_in %d, in0 %d, out %d, ws %zu); nothing launched\n", n_in, n_in > 0 ? in_sizes[0] : -1, out_size, ws_size); grid = -1; return; }
        int dev = 0, cus = 0, per_cu = 0;
        if (hipGetDevice(&dev) != hipSuccess || hipDeviceGetAttribute(&cus, hipDeviceAttributeMultiprocessorCount, dev) != hipSuccess) { fprintf(stderr, "kernel_launch: device query failed\n"); grid = -1; return; }
        if (hipFuncSetAttribute((const void*)mega_fwd, hipFuncAttributeMaxDynamicSharedMemorySize, LDS_BYTES) != hipSuccess) { fprintf(stderr, "kernel_launch: hipFuncSetAttribute failed\n"); grid = -1; return; }
        if (hipOccupancyMaxActiveBlocksPerMultiprocessor(&per_cu, (const void*)mega_fwd, NWAVES * 64, LDS_BYTES) != hipSuccess || per_cu < 1) fprintf(stderr, "kernel_launch: note: occupancy query reports %d workgroups per CU\n", per_cu);
        (void)hipGetLastError();
        grid = cus;
    }
    if (grid < 0) return;
    unsigned char* ws = (unsigned char*)d_ws;
    (void)hipMemsetAsync(ws + WS_CTL, 0, CTL_ZERO_BYTES, stream);
    Args a{};
    for (int i = 0; i < 26; ++i) a.in[i] = d_in[i];
    a.out = (float*)d_out; a.ws = ws;
#if MK_SINGLE
    a.ph_lo = 0; a.ph_hi = NPHASE;
    hipLaunchKernelGGL(mega_fwd, dim3(grid), dim3(NWAVES * 64), LDS_BYTES, stream, a);
#else
    const float* x = (const float*)d_in[0]; const float* c = (const float*)d_in[1]; const int* positions = (const int*)d_in[2];
    const float* w_ada = (const float*)d_in[3]; const float* b_ada = (const float*)d_in[4]; const float* g_pre_mix = (const float*)d_in[5]; const float* w_in = (const float*)d_in[6];
    const float* lq1 = (const float*)d_in[7]; const float* lk1 = (const float*)d_in[8]; const float* lq2 = (const float*)d_in[9]; const float* lk2 = (const float*)d_in[10];
    const float* g_subln = (const float*)d_in[11]; const float* w_pool = (const float*)d_in[12]; const float* pool_scale = (const float*)d_in[13];
    const float* w_proj_a = (const float*)d_in[14]; const float* w_proj_b = (const float*)d_in[15]; const float* w_out = (const float*)d_in[16];
    const float* g_post_mix = (const float*)d_in[17]; const float* g_pre_ffn = (const float*)d_in[18]; const float* w_router = (const float*)d_in[19]; const float* b_router = (const float*)d_in[20];
    const float* w_exp1 = (const float*)d_in[21]; const float* b_exp1 = (const float*)d_in[22]; const float* w_exp2 = (const float*)d_in[23]; const float* b_exp2 = (const float*)d_in[24];
    const float* g_post_ffn = (const float*)d_in[25];
    float* out = (float*)d_out;
    using nv::bf;
    unsigned* ctl = (unsigned*)(ws + WS_CTL); unsigned* cnt = ctl + CW_CNT;
    float* mod = (float*)(ws + WS_MOD); float* lam = (float*)(ws + WS_MOD + 256 * 1024); int* tstart = (int*)(ws + WS_MOD + 260 * 1024);
    float* rope = (float*)(ws + WS_ROPE); int* list = (int*)(ws + WS_LIST); unsigned* tokslot = (unsigned*)(ws + WS_TOK); float* tokw = (float*)(ws + WS_TOK + 256 * 1024);
    bf* h = (bf*)(ws + WS_H); bf* q = (bf*)(ws + WS_Q); bf* k = (bf*)(ws + WS_K); bf* v = (bf*)(ws + WS_V); bf* u = (bf*)(ws + WS_U); bf* ga = (bf*)(ws + WS_GA); bf* gb = (bf*)(ws + WS_GB);
    bf* dd = (bf*)(ws + WS_DD); bf* O0 = (bf*)(ws + WS_O0); bf* O1 = (bf*)(ws + WS_O1); bf* oc = (bf*)(ws + WS_OC); bf* pp = (bf*)(ws + WS_PP); float* Y = (float*)(ws + WS_Y);
    bf* mi = (bf*)(ws + WS_MI); float* mx = (float*)(ws + WS_MX); bf* h2 = (bf*)(ws + WS_H2); bf* abuf = (bf*)(ws + WS_A); bf* ye = (bf*)(ws + WS_YE);
#define OPT(kk) ((OPT_MASK >> (kk)) & 1)
#define LAUNCH_OPT(kk) do { a.ph_lo = (kk); a.ph_hi = (kk) + 1; hipLaunchKernelGGL(mega_fwd, dim3(grid), dim3(NWAVES * 64), LDS_BYTES, stream, a); } while (0)
    if (OPT_MASK != 0) LAUNCH_OPT(0);
    if (!OPT(0)) { nv::k_mod<<<NB * NMOD * D / 256, 256, 0, stream>>>(c, w_ada, b_ada, lq1, lk1, lq2, lk2, mod, lam); nv::k_rope<<<T * 8 / 256, 256, 0, stream>>>(positions, rope); }
    if (OPT(1)) LAUNCH_OPT(1); else nv::k_norm1<<<T, 256, 0, stream>>>(x, g_pre_mix, mod, 0, D, h);
    if (OPT(2)) LAUNCH_OPT(2); else { nv::k_gemm<<<dim3(INC / 64, T / 64), 256, 0, stream>>>(nv::RmPlain{h, w_in, D, INC}, nv::EpZ{q, k, v, u, ga, gb}, D); nv::k_rope_apply<<<T * 1024 / 256, 256, 0, stream>>>(q, k, rope); }
    if (OPT(3)) LAUNCH_OPT(3); else { nv::k_attn<<<NB * 16 * SEQ / 4, 256, 0, stream>>>(q, k, v, O0, O1); nv::k_poold<<<T * PW / 256, 256, 0, stream>>>(u, dd); }
    if (OPT(4)) LAUNCH_OPT(4); else { nv::k_combine<<<T * NH / 4, 256, 0, stream>>>(O0, O1, lam, g_subln, oc);
        for (int g = 0; g < 4; ++g) nv::k_gemm<<<dim3(128 / 64, T / 64), 256, 0, stream>>>(nv::RmPlain{dd + g * 128, w_pool + g * 128 * 128, PW, 128}, nv::EpPool{pp, pool_scale, g, 0}, 128); }
    if (OPT(5)) LAUNCH_OPT(5); else { nv::k_gemm<<<dim3(D / 64, T / 64), 256, 0, stream>>>(nv::RmPlain{oc, w_proj_a, D, D}, nv::EpGateY{Y, ga}, DW);
        nv::k_gemm<<<dim3(D / 64, T / 64), 256, 0, stream>>>(nv::RmPlain{pp, w_proj_b, PW, D}, nv::EpGateAdd{Y, gb, mi}, PW); }
    if (OPT(6)) LAUNCH_OPT(6); else nv::k_gemm<<<dim3(D / 64, T / 64), 256, 0, stream>>>(nv::RmPlain{mi, w_out, D, D}, nv::EpF32{mx}, D);
    if (OPT(7)) LAUNCH_OPT(7); else nv::k_router<<<T / 4, 256, 0, stream>>>(x, mx, mod, g_post_mix, g_pre_ffn, w_router, b_router, out, h2, cnt, list, tokslot, tokw);
    nv::k_tstart<<<1, 64, 0, stream>>>(cnt, tstart);
    if (OPT(8)) LAUNCH_OPT(8); else nv::k_moe1<<<dim3(2 * FF / 64, MPAD / 64), 256, 0, stream>>>(nv::RmMoe{h2, tstart, cnt, list, w_exp1, (size_t)D * 2 * FF, 2 * FF, 1}, b_exp1, abuf);
    if (OPT(9)) LAUNCH_OPT(9); else nv::k_gemm<<<dim3(D / 64, MPAD / 64), 256, 0, stream>>>(nv::RmMoe{abuf, tstart, cnt, list, w_exp2, (size_t)FF * D, D, 0}, nv::EpYe{ye, b_exp2}, FF);
    if (OPT(10)) LAUNCH_OPT(10); else nv::k_final<<<T / 4, 256, 0, stream>>>(ye, tstart, tokslot, tokw, mod, g_post_ffn, out);
#endif
}
```

```cpp
#include <hip/hip_runtime.h>
#include <cstdio>
#include <cstdint>
#include <cmath>

constexpr int NB = 8, SEQ = 2048, D = 1024, T = NB * SEQ;
constexpr int NH = 8, HD = 64, VD = 128, DW = 1024, PW = 512, INC = 3 * DW + PW + 2 * D;
constexpr int NE = 32, TOPK = 4, FF = 1024, NMOD = 6;
constexpr int MPAD = TOPK * T + NE * 256, MT_MAX = MPAD / 256;
constexpr float NORM_EPS = 1e-6f, SUBLN_EPS = 1e-5f, LAM_INIT = 0.2f, SW_ALPHA = 1.702f, SW_LIMIT = 7.0f;
constexpr float QSCALE = 0.125f * 1.4426950408889634f;

constexpr size_t MiB = 1u << 20;
constexpr size_t WS_CTL = 0, CTL_ZERO_BYTES = 32768;
constexpr size_t WS_MOD = 1 * MiB;
constexpr size_t WS_ROPE = 2 * MiB;
constexpr size_t WS_LIST = 3 * MiB;
constexpr size_t WS_TOK = 5 * MiB;
constexpr size_t WS_WIN = 6 * MiB, WS_WA = 17 * MiB, WS_WB = 19 * MiB, WS_WPOOL = 20 * MiB, WS_WOUT = 21 * MiB, WS_W1 = 24 * MiB, WS_W2 = 152 * MiB;
constexpr size_t WS_H = 216 * MiB, WS_Q = 248 * MiB, WS_K = 280 * MiB, WS_V = 312 * MiB, WS_U = 344 * MiB, WS_GA = 360 * MiB, WS_GB = 392 * MiB, WS_DD = 424 * MiB;
constexpr size_t WS_O0 = 440 * MiB, WS_O1 = 472 * MiB, WS_OC = 504 * MiB, WS_PP = 536 * MiB, WS_Y = 552 * MiB, WS_MI = 616 * MiB, WS_MX = 648 * MiB, WS_X1 = 680 * MiB, WS_H2 = 712 * MiB, WS_H2F = 744 * MiB, WS_END = 760 * MiB;
constexpr size_t WS_A = 216 * MiB;
constexpr size_t WS_YE = 392 * MiB;
static_assert((size_t)MPAD * 1024 * 2 == 144 * MiB && WS_A + 144 * MiB <= WS_GA && WS_YE + 144 * MiB <= WS_PP, "overlay map");
constexpr int CW_TMO = 0, CW_CODE = 1;
constexpr int CW_CNT = 1024;
constexpr int CW_BAR = 4096;
static_assert((CW_BAR + 3456) * 4 <= (int)CTL_ZERO_BYTES && (CW_CNT + 64 * NE) * 4 <= (int)CTL_ZERO_BYTES, "control words inside the per-call memset");

__device__ __forceinline__ void rope_cs(int pos, int i, float& cs, float& sn) {
    const double invf = (i == 0) ? 1.0 : (i == 1) ? 0.19392274474868576 : (i == 2) ? 0.03760603093086393 : (i == 3) ? 0.007292664737217109 : (i == 4) ? 0.001414213562373095
                      : (i == 5) ? 0.0002742481756762073 : (i == 6) ? 5.318295896944988e-05 : 1.031338537721246e-05;
    const double ang = (double)pos * invf;
    const double qd = __builtin_rint(ang * 0.6366197723675814);
    const double r = ang - qd * 1.5707963267948966 - qd * 6.123233995736766e-17;
    const double r2 = r * r;
    const double s = r * (1.0 + r2 * (-1.0 / 6 + r2 * (1.0 / 120 + r2 * (-1.0 / 5040 + r2 * (1.0 / 362880 + r2 * (-1.0 / 39916800 + r2 * (1.0 / 6227020800.0)))))));
    const double c = 1.0 + r2 * (-0.5 + r2 * (1.0 / 24 + r2 * (-1.0 / 720 + r2 * (1.0 / 40320 + r2 * (-1.0 / 3628800 + r2 * (1.0 / 479001600.0 + r2 * (-1.0 / 87178291200.0)))))));
    const int n = (int)qd & 3;
    const double so = (n == 0) ? s : (n == 1) ? c : (n == 2) ? -s : -c;
    const double co = (n == 0) ? c : (n == 1) ? -s : (n == 2) ? -c : s;
    cs = (float)co; sn = (float)so;
}
#define MK_SINGLE 1
#define OPT_MASK 0x7ff
namespace pg8 {
#define PG8_LAS __attribute__((address_space(3)))
typedef unsigned short bf16_t;
typedef short bf16x8 __attribute__((ext_vector_type(8)));
typedef float f32x4 __attribute__((ext_vector_type(4)));
typedef unsigned u32x4 __attribute__((ext_vector_type(4)));
constexpr int BM = 256, BK = 64, HALF = 128, HTB = HALF * BK * 2  , STAGE_BYTES = 8 * HTB, NXCD = 8, WGM = 8;

__host__ __device__ __forceinline__ int lds_byte(int r, int c) { const int st = (r >> 4) * 2 + (c >> 5), rr = r & 15, cc = c & 31, ob = rr * 64 + cc * 2; return st * 1024 + (ob ^ (((ob >> 9) & 1) << 5)); }
__host__ __device__ __forceinline__ void stage_rc(int b, int& R, int& C) { const int st = b / 1024, sb = b % 1024, swz = sb ^ (((sb >> 9) & 1) << 5); R = (st >> 1) * 16 + swz / 64; C = (st & 1) * 32 + (swz % 64) / 2; }
__host__ __device__ __forceinline__ int perm32(int rho) { const int n = rho >> 4, i = rho & 15; return 8 * (i >> 2) + 4 * n + (i & 3); }

typedef int i32x8 __attribute__((ext_vector_type(8))); typedef int i32x4 __attribute__((ext_vector_type(4)));
__device__ __forceinline__ i32x8 cat8(const bf16x8 a, const bf16x8 b) { const i32x4 x = __builtin_bit_cast(i32x4, a), y = __builtin_bit_cast(i32x4, b); return __builtin_shufflevector(x, y, 0, 1, 2, 3, 4, 5, 6, 7); }
__device__ __forceinline__ void mfma_fp8(f32x4& acc, const i32x8 a, const i32x8 b) { asm volatile("v_mfma_f32_16x16x128_f8f6f4 %0, %1, %2, %0" : "+v"(acc) : "v"(a), "v"(b)); }
struct Unit { int pm, pn, e; };
struct Gemm { const bf16_t* A; const bf16_t* Bt; int K; int pad; size_t bstride; };

struct StaticOrder {
    int nM, nN, nwg, G, c;
    __device__ void init(int M, int N, int G_, int c_) { nM = M / BM; nN = N / BM; nwg = nM * nN; G = G_; c = c_; }
    __device__ bool next(int i, Unit& u) const {
        const long L = (long)i * G + c; if (L >= nwg) return false;
        int wgid = (int)L; { const int q = nwg / NXCD, r = nwg % NXCD, xcd = wgid % NXCD, off = wgid / NXCD; wgid = (xcd < r ? xcd * (q + 1) : r * (q + 1) + (xcd - r) * q) + off; }
        const int nig = WGM * nN, gid = wgid / nig, fm = gid * WGM, gsz = (nM - fm) < WGM ? (nM - fm) : WGM;
        u.pm = fm + ((wgid % nig) % gsz); u.pn = (wgid % nig) / gsz; u.e = 0; return true;
    }
};
struct MoeOrder {
    int nM, nN, nwg, G, c; const PG8_LAS int* tile_e;
    __device__ void init(int nM_, int N, int G_, int c_, const PG8_LAS int* te) { nM = nM_; nN = N / BM; nwg = nM * nN; G = G_; c = c_; tile_e = te; }
    __device__ bool next(int i, Unit& u) const {
        const long L = (long)i * G + c; if (L >= nwg) return false;
        int wgid = (int)L; { const int q = nwg / NXCD, r = nwg % NXCD, xcd = wgid % NXCD, off = wgid / NXCD; wgid = (xcd < r ? xcd * (q + 1) : r * (q + 1) + (xcd - r) * q) + off; }
        const int nig = WGM * nN, gid = wgid / nig, fm = gid * WGM, gsz = (nM - fm) < WGM ? (nM - fm) : WGM;
        u.pm = fm + ((wgid % nig) % gsz); u.pn = (wgid % nig) / gsz; u.e = tile_e[u.pm]; return true;
    }
};

struct ListOrder {
    const PG8_LAS int* ul;
    __device__ bool next(int i, Unit& u) const { if (i >= ul[0]) return false; u.pm = ul[4 + 4 * i]; u.pn = ul[5 + 4 * i]; u.e = ul[6 + 4 * i]; return true; }
};
__device__ __forceinline__ unsigned cvt_pk_bf16(float lo, float hi) { unsigned r; asm volatile("v_cvt_pk_bf16_f32 %0, %1, %2" : "=v"(r) : "v"(lo), "v"(hi)); return r; }
__device__ __forceinline__ float bflo(unsigned w) { return __uint_as_float(w << 16); }
__device__ __forceinline__ float bfhi(unsigned w) { return __uint_as_float(w & 0xffff0000u); }
__device__ __forceinline__ float sigm(float v) { return __builtin_amdgcn_rcpf(1.f + __builtin_amdgcn_exp2f(-1.4426950408889634f * v)); }
__device__ __forceinline__ u32x4 pack8(const f32x4 v0, const f32x4 v1) { u32x4 w; w.x = cvt_pk_bf16(v0[0], v0[1]); w.y = cvt_pk_bf16(v0[2], v0[3]); w.z = cvt_pk_bf16(v1[0], v1[1]); w.w = cvt_pk_bf16(v1[2], v1[3]); return w; }

typedef unsigned u32x2 __attribute__((ext_vector_type(2)));
__device__ __forceinline__ u32x2 pack8_fp8(const f32x4 v0, const f32x4 v1) { int a = 0, b = 0; a = __builtin_amdgcn_cvt_pk_fp8_f32(v0[0], v0[1], a, false); a = __builtin_amdgcn_cvt_pk_fp8_f32(v0[2], v0[3], a, true);
    b = __builtin_amdgcn_cvt_pk_fp8_f32(v1[0], v1[1], b, false); b = __builtin_amdgcn_cvt_pk_fp8_f32(v1[2], v1[3], b, true); return (u32x2){(unsigned)a, (unsigned)b}; }
constexpr float W8_SCALE = 32.f, W8_INV = 1.f / 32.f;
struct EpiZ {
    static constexpr bool PERM = true;
    bf16_t *q, *k, *v, *u, *ga, *gb; const float* rope;
    __device__ __forceinline__ void operator()(const f32x4 (&acc)[2][2][4][2], const Unit& un, int wr, int wc, int fr, int fq) const {
        const int pn = un.pn, row0 = un.pm * BM + wr * 64 + fr;
        int kind, ldc, colt; bf16_t* base;
        if (pn < 4) { kind = 0; base = q; ldc = 1024; colt = pn * 256; }
        else if (pn < 8) { kind = 1; base = k; ldc = 1024; colt = (pn - 4) * 256; }
        else if (pn < 12) { kind = 2; base = v; ldc = 1024; colt = (pn - 8) * 256; }
        else if (pn < 14) { kind = 2; base = u; ldc = 512; colt = (pn - 12) * 256; }
        else if (pn < 18) { kind = 3; base = ga; ldc = 1024; colt = (pn - 14) * 256; }
        else { kind = 3; base = gb; ldc = 1024; colt = (pn - 18) * 256; }
        const int col0 = colt + wc * 32 + 8 * fq;
        const bool ropew = (kind <= 1) && ((wc & 1) == 0);
        const bool rl = fq < 2;
#pragma unroll
        for (int ai = 0; ai < 2; ++ai)
#pragma unroll
            for (int m = 0; m < 4; ++m) {
                const int row = row0 + ai * HALF + m * 16; bf16_t* rowp = base + (size_t)row * ldc + col0;
                f32x4 cs = {1.f, 1.f, 1.f, 1.f}, sn = {0.f, 0.f, 0.f, 0.f};
                if (ropew && rl) { const f32x4* rp = (const f32x4*)(rope + (size_t)row * 16); cs = rp[fq]; sn = rp[2 + fq]; }
#pragma unroll
                for (int bj = 0; bj < 2; ++bj) {
                    f32x4 v0 = acc[ai][bj][m][0], v1 = acc[ai][bj][m][1];
                    if (ropew) {
                        const f32x4 r0 = {v0[0] * cs[0] - v0[1] * sn[0], v0[1] * cs[0] + v0[0] * sn[0], v0[2] * cs[1] - v0[3] * sn[1], v0[3] * cs[1] + v0[2] * sn[1]};
                        const f32x4 r1 = {v1[0] * cs[2] - v1[1] * sn[2], v1[1] * cs[2] + v1[0] * sn[2], v1[2] * cs[3] - v1[3] * sn[3], v1[3] * cs[3] + v1[2] * sn[3]};
                        v0 = r0; v1 = r1;
                    }
                    if (kind == 0) { v0 = v0 * QSCALE; v1 = v1 * QSCALE; }
                    if (kind == 3) {
#pragma unroll
                        for (int x = 0; x < 4; ++x) { v0[x] = sigm(v0[x]); v1[x] = sigm(v1[x]); } }
                    *(u32x4*)(rowp + bj * HALF) = pack8(v0, v1);
                }
            }
    }
};
struct EpiPool {
    static constexpr bool PERM = true;
    bf16_t* p; const float* scale;
    __device__ __forceinline__ void operator()(const f32x4 (&acc)[2][2][4][2], const Unit& un, int wr, int wc, int fr, int fq) const {
        const int row0 = un.pm * BM + wr * 64 + fr, col0 = un.pn * BM + wc * 32 + 8 * fq;
        f32x4 sv[2][2];
#pragma unroll
        for (int bj = 0; bj < 2; ++bj) { sv[bj][0] = *(const f32x4*)(scale + col0 + bj * HALF); sv[bj][1] = *(const f32x4*)(scale + col0 + bj * HALF + 4); }
#pragma unroll
        for (int ai = 0; ai < 2; ++ai)
#pragma unroll
            for (int m = 0; m < 4; ++m) { bf16_t* rowp = p + (size_t)(row0 + ai * HALF + m * 16) * PW + col0;
#pragma unroll
                for (int bj = 0; bj < 2; ++bj) *(u32x4*)(rowp + bj * HALF) = pack8(acc[ai][bj][m][0] * sv[bj][0], acc[ai][bj][m][1] * sv[bj][1]); }
    }
};
struct EpiGateY {
    static constexpr bool PERM = true;
    bf16_t* Y; const bf16_t* ga;
    __device__ __forceinline__ void operator()(const f32x4 (&acc)[2][2][4][2], const Unit& un, int wr, int wc, int fr, int fq) const {
        const int row0 = un.pm * BM + wr * 64 + fr, col0 = un.pn * BM + wc * 32 + 8 * fq;
#pragma unroll
        for (int ai = 0; ai < 2; ++ai)
#pragma unroll
            for (int m = 0; m < 4; ++m) { const size_t off = (size_t)(row0 + ai * HALF + m * 16) * D + col0;
#pragma unroll
                for (int bj = 0; bj < 2; ++bj) { const u32x4 g = *(const u32x4*)(ga + off + bj * HALF);
                    const f32x4 g0 = {bflo(g.x), bfhi(g.x), bflo(g.y), bfhi(g.y)}, g1 = {bflo(g.z), bfhi(g.z), bflo(g.w), bfhi(g.w)};
                    *(u32x4*)(Y + off + bj * HALF) = pack8(acc[ai][bj][m][0] * g0, acc[ai][bj][m][1] * g1); } }
    }
};
struct EpiGateAdd {
    static constexpr bool PERM = true;
    const bf16_t* Y; const bf16_t* gb; bf16_t* mi;
    __device__ __forceinline__ void operator()(const f32x4 (&acc)[2][2][4][2], const Unit& un, int wr, int wc, int fr, int fq) const {
        const int row0 = un.pm * BM + wr * 64 + fr, col0 = un.pn * BM + wc * 32 + 8 * fq;
#pragma unroll
        for (int ai = 0; ai < 2; ++ai)
#pragma unroll
            for (int m = 0; m < 4; ++m) { const size_t off = (size_t)(row0 + ai * HALF + m * 16) * D + col0;
#pragma unroll
                for (int bj = 0; bj < 2; ++bj) { const u32x4 g = *(const u32x4*)(gb + off + bj * HALF), y = *(const u32x4*)(Y + off + bj * HALF);
                    const f32x4 g0 = {bflo(g.x), bfhi(g.x), bflo(g.y), bfhi(g.y)}, g1 = {bflo(g.z), bfhi(g.z), bflo(g.w), bfhi(g.w)};
                    const f32x4 y0 = {bflo(y.x), bfhi(y.x), bflo(y.y), bfhi(y.y)}, y1 = {bflo(y.z), bfhi(y.z), bflo(y.w), bfhi(y.w)};
                    *(u32x4*)(mi + off + bj * HALF) = pack8(y0 + acc[ai][bj][m][0] * g0, y1 + acc[ai][bj][m][1] * g1); } }
    }
};
struct EpiChain {
    static constexpr bool PERM = true;
    const bf16_t* ga; const bf16_t* gb; bf16_t* mi;
    __device__ __forceinline__ void mid(f32x4 (&acc)[2][2][4][2], const Unit& un, int wr, int wc, int fr, int fq, const bool zero) const {
        const int row0 = un.pm * BM + wr * 64 + fr, col0 = un.pn * BM + wc * 32 + 8 * fq;
#pragma unroll
        for (int ai = 0; ai < 2; ++ai)
#pragma unroll
            for (int m = 0; m < 4; ++m) { const size_t off = (size_t)(row0 + ai * HALF + m * 16) * D + col0;
#pragma unroll
                for (int bj = 0; bj < 2; ++bj) { f32x4 f0 = {0.f, 0.f, 0.f, 0.f}, f1 = f0;
                    if (!zero) { const u32x4 a = *(const u32x4*)(ga + off + bj * HALF), b = *(const u32x4*)(gb + off + bj * HALF);
                        f32x4 a0 = {bflo(a.x), bfhi(a.x), bflo(a.y), bfhi(a.y)}, a1 = {bflo(a.z), bfhi(a.z), bflo(a.w), bfhi(a.w)};
                        const f32x4 b0 = {bflo(b.x), bfhi(b.x), bflo(b.y), bfhi(b.y)}, b1 = {bflo(b.z), bfhi(b.z), bflo(b.w), bfhi(b.w)};
#pragma unroll
                        for (int x = 0; x < 4; ++x) { a0[x] = __builtin_amdgcn_rcpf(fmaxf(a0[x], 1e-20f)); a1[x] = __builtin_amdgcn_rcpf(fmaxf(a1[x], 1e-20f)); }
                        f0 = b0 * a0; f1 = b1 * a1; }
                    acc[ai][bj][m][0] = acc[ai][bj][m][0] * f0; acc[ai][bj][m][1] = acc[ai][bj][m][1] * f1; }
                asm volatile("" : "+v"(acc[ai][0][m][0]), "+v"(acc[ai][0][m][1]), "+v"(acc[ai][1][m][0]), "+v"(acc[ai][1][m][1]) :: "memory"); }
    }
    __device__ __forceinline__ void operator()(const f32x4 (&acc)[2][2][4][2], const Unit& un, int wr, int wc, int fr, int fq) const {
        const int row0 = un.pm * BM + wr * 64 + fr, col0 = un.pn * BM + wc * 32 + 8 * fq;
#pragma unroll
        for (int ai = 0; ai < 2; ++ai)
#pragma unroll
            for (int m = 0; m < 4; ++m) { const size_t off = (size_t)(row0 + ai * HALF + m * 16) * D + col0;
#pragma unroll
                for (int bj = 0; bj < 2; ++bj) { const u32x4 a = *(const u32x4*)(ga + off + bj * HALF);
                    const f32x4 a0 = {bflo(a.x), bfhi(a.x), bflo(a.y), bfhi(a.y)}, a1 = {bflo(a.z), bfhi(a.z), bflo(a.w), bfhi(a.w)};
                    *(u32x4*)(mi + off + bj * HALF) = pack8(acc[ai][bj][m][0] * a0, acc[ai][bj][m][1] * a1); } }
    }
};
struct EpiBf16Plain {
    static constexpr bool PERM = true;
    bf16_t* O;
    __device__ __forceinline__ void operator()(const f32x4 (&acc)[2][2][4][2], const Unit& un, int wr, int wc, int fr, int fq) const {
        const int row0 = un.pm * BM + wr * 64 + fr, col0 = un.pn * BM + wc * 32 + 8 * fq;
#pragma unroll
        for (int ai = 0; ai < 2; ++ai)
#pragma unroll
            for (int m = 0; m < 4; ++m) { const size_t off = (size_t)(row0 + ai * HALF + m * 16) * D + col0;
#pragma unroll
                for (int bj = 0; bj < 2; ++bj) *(u32x4*)(O + off + bj * HALF) = pack8(acc[ai][bj][m][0], acc[ai][bj][m][1]); }
    }
};
struct EpiSwiglu {
    static constexpr bool PERM = true;
    unsigned char* a; const float* b1;
    __device__ __forceinline__ void operator()(const f32x4 (&acc)[2][2][4][2], const Unit& un, int wr, int wc, int fr, int fq) const {
        const int row0 = un.pm * BM + wr * 64 + fr, j0 = un.pn * HALF + wc * 32 + 8 * fq;
        const f32x4* bp = (const f32x4*)(b1 + (size_t)un.e * 2 * FF + 2 * j0);
        const f32x4 b0 = bp[0], b1v = bp[1], b2 = bp[2], b3 = bp[3];
        const f32x4 bg0 = {b0[0], b0[2], b1v[0], b1v[2]}, bu0 = {b0[1], b0[3], b1v[1], b1v[3]}, bg1 = {b2[0], b2[2], b3[0], b3[2]}, bu1 = {b2[1], b2[3], b3[1], b3[3]};
#pragma unroll
        for (int ai = 0; ai < 2; ++ai)
#pragma unroll
            for (int m = 0; m < 4; ++m) {
                f32x4 o[2];
#pragma unroll
                for (int n = 0; n < 2; ++n) {
                    f32x4 g = acc[ai][0][m][n] * W8_INV + (n ? bg1 : bg0), up = acc[ai][1][m][n] * W8_INV + (n ? bu1 : bu0), e, r;
#pragma unroll
                    for (int x = 0; x < 4; ++x) { g[x] = fminf(g[x], SW_LIMIT); up[x] = __builtin_amdgcn_fmed3f(up[x], -SW_LIMIT, SW_LIMIT); }
                    const f32x4 ex = g * (-SW_ALPHA * 1.4426950408889634f);
#pragma unroll
                    for (int x = 0; x < 4; ++x) e[x] = __builtin_amdgcn_exp2f(ex[x]);
                    e = e + 1.f;
#pragma unroll
                    for (int x = 0; x < 4; ++x) r[x] = __builtin_amdgcn_rcpf(e[x]);
                    const f32x4 gs = g * r; o[n] = gs * up + gs; }
                *(u32x2*)(a + (size_t)(row0 + ai * HALF + m * 16) * FF + j0) = pack8_fp8(o[0], o[1]);
            }
    }
};
constexpr float YE_SCALE = 4.f, YE_INV = 0.25f;
struct EpiYe {
    static constexpr bool PERM = true;
    unsigned char* ye; const float* b2;
    __device__ __forceinline__ void operator()(const f32x4 (&acc)[2][2][4][2], const Unit& un, int wr, int wc, int fr, int fq) const {
        const int row0 = un.pm * BM + wr * 64 + fr, col0 = un.pn * BM + wc * 32 + 8 * fq;
        f32x4 bv[2][2];
#pragma unroll
        for (int bj = 0; bj < 2; ++bj) { bv[bj][0] = *(const f32x4*)(b2 + (size_t)un.e * D + col0 + bj * HALF); bv[bj][1] = *(const f32x4*)(b2 + (size_t)un.e * D + col0 + bj * HALF + 4); }
#pragma unroll
        for (int ai = 0; ai < 2; ++ai)
#pragma unroll
            for (int m = 0; m < 4; ++m) { unsigned char* rowp = ye + (size_t)(row0 + ai * HALF + m * 16) * D + col0;
#pragma unroll
                for (int bj = 0; bj < 2; ++bj) *(u32x2*)(rowp + bj * HALF) = pack8_fp8((acc[ai][bj][m][0] * W8_INV + bv[bj][0]) * YE_SCALE, (acc[ai][bj][m][1] * W8_INV + bv[bj][1]) * YE_SCALE); }
    }
};

template <class Epi, class Sched, bool ALIGN_EPI, bool GATHER, bool FP8 = false>
__device__ __forceinline__ void gemm_phase(PG8_LAS unsigned char* lds, const Gemm g, const Sched& S, const Epi& E, const PG8_LAS int* gtab) {
    int tid_ = (int)threadIdx.x; asm volatile("" : "+v"(tid_));
    const int tid = tid_, wid = __builtin_amdgcn_readfirstlane(tid >> 6), lane = tid & 63, wr = wid >> 2, wc = wid & 3, fr = lane & 15, fq = lane >> 4;
    const int K = g.K, nt = K / BK;
    unsigned voffB[2];
#pragma unroll
    for (int i = 0; i < 2; ++i) { int R, C; stage_rc(tid * 16 + i * 8192, R, C); const int Rb = Epi::PERM ? ((R & ~31) + perm32(R & 31)) : R; voffB[i] = (unsigned)(Rb * K + C) * 2u; }
    const size_t kstep = (size_t)(BK * 2);
    const size_t hstep = (size_t)HALF * K * 2;
    const size_t tstep = 2 * hstep;
    const unsigned ldsw = (unsigned)wid * 1024u;
    const int aoff = lds_byte(wr * 64 + fr, fq * 8), boff = lds_byte(wc * 32 + fr, fq * 8);
#define PG8_SA(b, h) (((b) * 2 + (h)) * HTB)
#define PG8_SB(b, h) ((4 + (b) * 2 + (h)) * HTB)
#define PG8_STAGE(bufoff, gbase, voff) do { _Pragma("unroll") for (int _i = 0; _i < 2; ++_i) \
        __builtin_amdgcn_global_load_lds((const unsigned*)((const char*)(gbase) + (voff)[_i]), (PG8_LAS unsigned*)(lds + (bufoff) + ldsw + _i * 8192), 16, 0, 0); } while (0)
#define PG8_LDA(dst, b, h) do { _Pragma("unroll") for (int m = 0; m < 4; ++m) _Pragma("unroll") for (int k = 0; k < 2; ++k) dst[m][k] = *(const PG8_LAS bf16x8*)(lds + PG8_SA(b, h) + aoff + m * 2048 + k * 1024); } while (0)
#define PG8_LDB(dst, b, h) do { _Pragma("unroll") for (int n = 0; n < 2; ++n) _Pragma("unroll") for (int k = 0; k < 2; ++k) dst[n][k] = *(const PG8_LAS bf16x8*)(lds + PG8_SB(b, h) + boff + n * 2048 + k * 1024); } while (0)
#define PG8_MMA(ai, bj, At, Bt) do { __builtin_amdgcn_s_setprio(1); if constexpr (FP8) { _Pragma("unroll") for (int m = 0; m < 4; ++m) _Pragma("unroll") for (int n = 0; n < 2; ++n) \
        mfma_fp8(acc[ai][bj][m][n], cat8(Bt[n][0], Bt[n][1]), cat8(At[m][0], At[m][1])); } else { \
        _Pragma("unroll") for (int m = 0; m < 4; ++m) _Pragma("unroll") for (int n = 0; n < 2; ++n) _Pragma("unroll") for (int k = 0; k < 2; ++k) \
        acc[ai][bj][m][n] = __builtin_amdgcn_mfma_f32_16x16x32_bf16(Bt[n][k], At[m][k], acc[ai][bj][m][n], 0, 0, 0); } __builtin_amdgcn_s_setprio(0); } while (0)
#define PG8_WAIT_V(n) asm volatile("s_waitcnt vmcnt(" #n ")" ::: "memory")
#define PG8_WAIT_L(n) asm volatile("s_waitcnt lgkmcnt(" #n ")" ::: "memory")
#define PG8_BAR __builtin_amdgcn_s_barrier()
#define PG8_SCHED __builtin_amdgcn_sched_barrier(0)
#define PG8_AOFF(dst, u, uidx) do { _Pragma("unroll") for (int _i = 0; _i < 2; ++_i) { int _R, _C; stage_rc(tid * 16 + _i * 8192, _R, _C); _Pragma("unroll") for (int _h = 0; _h < 2; ++_h) { \
        const int _row = GATHER ? gtab[(uidx) * 256 + _h * HALF + _R] : ((u).pm * BM + _h * HALF + _R); dst[_h][_i] = (unsigned)(_row * K + _C) * 2u; } } } while (0)
    Unit cur, nxt; int ui = 0;
    if (!S.next(0, cur)) return;
    f32x4 acc[2][2][4][2];
#pragma unroll
    for (int a = 0; a < 2; ++a)
#pragma unroll
        for (int b = 0; b < 2; ++b)
#pragma unroll
            for (int m = 0; m < 4; ++m)
#pragma unroll
                for (int n = 0; n < 2; ++n) acc[a][b][m][n] = (f32x4){0.f, 0.f, 0.f, 0.f};
    bf16x8 At[4][2], B0[2][2], B1[2][2];
    unsigned vAc[2][2], vAn[2][2];
    const char* const Ab = (const char*)g.A;
    const char* cB = (const char*)g.Bt + (size_t)cur.e * g.bstride + (size_t)cur.pn * tstep;
    PG8_AOFF(vAc, cur, 0);
    PG8_STAGE(PG8_SB(0, 0), cB, voffB); PG8_STAGE(PG8_SB(0, 1), cB + hstep, voffB); PG8_STAGE(PG8_SA(0, 0), Ab, vAc[0]); PG8_STAGE(PG8_SA(0, 1), Ab, vAc[1]);
    if (wr == 1) PG8_BAR;
    PG8_WAIT_V(2); PG8_BAR;
    PG8_STAGE(PG8_SB(1, 0), cB + kstep, voffB); PG8_STAGE(PG8_SA(1, 0), Ab + kstep, vAc[0]); PG8_STAGE(PG8_SB(1, 1), cB + hstep + kstep, voffB);
    PG8_WAIT_V(6); PG8_BAR;
    for (;;) {
        const bool has_next = S.next(ui + 1, nxt);
        const char* nB = has_next ? (const char*)g.Bt + (size_t)nxt.e * g.bstride + (size_t)nxt.pn * tstep : cB;
        if (has_next) { PG8_AOFF(vAn, nxt, ui + 1); }
        else {
#pragma unroll
            for (int h = 0; h < 2; ++h)
#pragma unroll
                for (int i = 0; i < 2; ++i) vAn[h][i] = vAc[h][i]; }
        _Pragma("nounroll") for (int t = 0; t < nt; t += 2) {
            const bool last = (t == nt - 2);
            const char* a1 = Ab + (size_t)(t + 1) * kstep;
            const char* a2 = last ? Ab : Ab + (size_t)(t + 2) * kstep; const char* b2 = last ? nB : cB + (size_t)(t + 2) * kstep;
            const char* a3 = a2 + kstep; const char* b3 = b2 + kstep;
            unsigned s0[2], s1[2];
#pragma unroll
            for (int i = 0; i < 2; ++i) { s0[i] = last ? vAn[0][i] : vAc[0][i]; s1[i] = last ? vAn[1][i] : vAc[1][i]; }
            PG8_LDB(B0, 0, 0); PG8_LDB(B1, 0, 1); PG8_SCHED; PG8_LDA(At, 0, 0); PG8_STAGE(PG8_SA(1, 1), a1, vAc[1]);
            PG8_WAIT_V(8); PG8_WAIT_L(0); PG8_BAR; PG8_MMA(0, 0, At, B0); PG8_MMA(0, 1, At, B1); PG8_BAR; PG8_SCHED;
            PG8_LDA(At, 0, 1); PG8_STAGE(PG8_SB(0, 0), b2, voffB); PG8_STAGE(PG8_SB(0, 1), b2 + hstep, voffB); PG8_STAGE(PG8_SA(0, 0), a2, s0);
            PG8_WAIT_V(8); PG8_WAIT_L(0); PG8_BAR; PG8_MMA(1, 0, At, B0); PG8_MMA(1, 1, At, B1); PG8_BAR; PG8_SCHED;
            PG8_LDB(B0, 1, 0); PG8_LDB(B1, 1, 1); PG8_SCHED; PG8_LDA(At, 1, 0); PG8_STAGE(PG8_SA(0, 1), a2, s1);
            PG8_WAIT_V(8); PG8_WAIT_L(0); PG8_BAR; PG8_MMA(0, 0, At, B0); PG8_MMA(0, 1, At, B1); PG8_BAR; PG8_SCHED;
            PG8_LDA(At, 1, 1); PG8_STAGE(PG8_SB(1, 0), b3, voffB); PG8_STAGE(PG8_SB(1, 1), b3 + hstep, voffB); PG8_STAGE(PG8_SA(1, 0), a3, s0);
            PG8_WAIT_V(8); PG8_WAIT_L(0); PG8_BAR; PG8_MMA(1, 0, At, B0); PG8_MMA(1, 1, At, B1); PG8_BAR; PG8_SCHED;
        }
        if constexpr (ALIGN_EPI) { if (wr == 0) PG8_BAR; }
        if constexpr (FP8) asm volatile("s_nop 15\n\ts_nop 15" ::: "memory");
        E(acc, cur, wr, wc, fr, fq);
        if (!has_next) break;
#pragma unroll
        for (int a = 0; a < 2; ++a)
#pragma unroll
            for (int b = 0; b < 2; ++b)
#pragma unroll
                for (int m = 0; m < 4; ++m)
#pragma unroll
                    for (int n = 0; n < 2; ++n) acc[a][b][m][n] = (f32x4){0.f, 0.f, 0.f, 0.f};
        cur = nxt; cB = nB; ++ui;
#pragma unroll
        for (int h = 0; h < 2; ++h)
#pragma unroll
            for (int i = 0; i < 2; ++i) vAc[h][i] = vAn[h][i];
        if constexpr (ALIGN_EPI) { if (wr == 1) PG8_BAR; }
    }
    PG8_WAIT_V(0);
    if constexpr (!ALIGN_EPI) { if (wr == 0) PG8_BAR; }
    PG8_BAR;
#undef PG8_SA
#undef PG8_SB
#undef PG8_STAGE
#undef PG8_LDA
#undef PG8_LDB
#undef PG8_MMA
#undef PG8_WAIT_V
#undef PG8_WAIT_L
#undef PG8_BAR
#undef PG8_SCHED
#undef PG8_AOFF
}
struct Gemm2 { const bf16_t* A0; const bf16_t* Bt0; const bf16_t* A1; const bf16_t* Bt1; int K0, K1; };
template <class Epi, class Sched>
__device__ __forceinline__ void gemm_chain2(PG8_LAS unsigned char* lds, const Gemm2 g, const Sched& S, const Epi& E) {
    constexpr bool ALIGN_EPI = true, GATHER = false, FP8 = false; const PG8_LAS int* gtab = nullptr; (void)gtab;
    int tid_ = (int)threadIdx.x; asm volatile("" : "+v"(tid_));
    const int tid = tid_, wid = __builtin_amdgcn_readfirstlane(tid >> 6), lane = tid & 63, wr = wid >> 2, wc = wid & 3, fr = lane & 15, fq = lane >> 4;
#define PG8_VOFFB(dst, Kx) do { _Pragma("unroll") for (int _i = 0; _i < 2; ++_i) { int _R, _C; stage_rc(tid * 16 + _i * 8192, _R, _C); const int _Rb = Epi::PERM ? ((_R & ~31) + perm32(_R & 31)) : _R; dst[_i] = (unsigned)(_Rb * (Kx) + _C) * 2u; } } while (0)
    int Kc = g.K0, Kn = g.K1, segc = 0;
    unsigned voffB[2], voffBn[2];
    PG8_VOFFB(voffB, Kc);
    const size_t kstep = (size_t)(BK * 2);
    size_t hstep = (size_t)HALF * Kc * 2, hstepn = hstep;
    const char* Ab = (const char*)g.A0; const char* Abn = Ab;
    const unsigned ldsw = (unsigned)wid * 1024u;
    const int aoff = lds_byte(wr * 64 + fr, fq * 8), boff = lds_byte(wc * 32 + fr, fq * 8);
#define PG8_SA(b, h) (((b) * 2 + (h)) * HTB)
#define PG8_SB(b, h) ((4 + (b) * 2 + (h)) * HTB)
#define PG8_STAGE(bufoff, gbase, voff) do { _Pragma("unroll") for (int _i = 0; _i < 2; ++_i) \
        __builtin_amdgcn_global_load_lds((const unsigned*)((const char*)(gbase) + (voff)[_i]), (PG8_LAS unsigned*)(lds + (bufoff) + ldsw + _i * 8192), 16, 0, 0); } while (0)
#define PG8_LDA(dst, b, h) do { _Pragma("unroll") for (int m = 0; m < 4; ++m) _Pragma("unroll") for (int k = 0; k < 2; ++k) dst[m][k] = *(const PG8_LAS bf16x8*)(lds + PG8_SA(b, h) + aoff + m * 2048 + k * 1024); } while (0)
#define PG8_LDB(dst, b, h) do { _Pragma("unroll") for (int n = 0; n < 2; ++n) _Pragma("unroll") for (int k = 0; k < 2; ++k) dst[n][k] = *(const PG8_LAS bf16x8*)(lds + PG8_SB(b, h) + boff + n * 2048 + k * 1024); } while (0)
#define PG8_MMA(ai, bj, At, Bt) do { __builtin_amdgcn_s_setprio(1); if constexpr (FP8) { _Pragma("unroll") for (int m = 0; m < 4; ++m) _Pragma("unroll") for (int n = 0; n < 2; ++n) \
        mfma_fp8(acc[ai][bj][m][n], cat8(Bt[n][0], Bt[n][1]), cat8(At[m][0], At[m][1])); } else { \
        _Pragma("unroll") for (int m = 0; m < 4; ++m) _Pragma("unroll") for (int n = 0; n < 2; ++n) _Pragma("unroll") for (int k = 0; k < 2; ++k) \
        acc[ai][bj][m][n] = __builtin_amdgcn_mfma_f32_16x16x32_bf16(Bt[n][k], At[m][k], acc[ai][bj][m][n], 0, 0, 0); } __builtin_amdgcn_s_setprio(0); } while (0)
#define PG8_WAIT_V(n) asm volatile("s_waitcnt vmcnt(" #n ")" ::: "memory")
#define PG8_WAIT_L(n) asm volatile("s_waitcnt lgkmcnt(" #n ")" ::: "memory")
#define PG8_BAR __builtin_amdgcn_s_barrier()
#define PG8_SCHED __builtin_amdgcn_sched_barrier(0)
#define PG8_AOFF(dst, u, uidx) do { _Pragma("unroll") for (int _i = 0; _i < 2; ++_i) { int _R, _C; stage_rc(tid * 16 + _i * 8192, _R, _C); _Pragma("unroll") for (int _h = 0; _h < 2; ++_h) { \
        const int _row = (u).pm * BM + _h * HALF + _R; dst[_h][_i] = (unsigned)(_row * (uidx) + _C) * 2u; } } } while (0)
    Unit cur, nxt; int ui = 0;
    if (!S.next(0, cur)) return;
    f32x4 acc[2][2][4][2];
#pragma unroll
    for (int a = 0; a < 2; ++a)
#pragma unroll
        for (int b = 0; b < 2; ++b)
#pragma unroll
            for (int m = 0; m < 4; ++m)
#pragma unroll
                for (int n = 0; n < 2; ++n) acc[a][b][m][n] = (f32x4){0.f, 0.f, 0.f, 0.f};
    bf16x8 At[4][2], B0[2][2], B1[2][2];
    unsigned vAc[2][2], vAn[2][2];
    const char* cB = (const char*)g.Bt0 + (size_t)cur.pn * 2 * hstep;
    PG8_AOFF(vAc, cur, Kc);
    PG8_STAGE(PG8_SB(0, 0), cB, voffB); PG8_STAGE(PG8_SB(0, 1), cB + hstep, voffB); PG8_STAGE(PG8_SA(0, 0), Ab, vAc[0]); PG8_STAGE(PG8_SA(0, 1), Ab, vAc[1]);
    if (wr == 1) PG8_BAR;
    PG8_WAIT_V(2); PG8_BAR;
    PG8_STAGE(PG8_SB(1, 0), cB + kstep, voffB); PG8_STAGE(PG8_SA(1, 0), Ab + kstep, vAc[0]); PG8_STAGE(PG8_SB(1, 1), cB + hstep + kstep, voffB);
    PG8_WAIT_V(6); PG8_BAR;
    for (;;) {
        bool has_next; const char* nB;
        if (segc == 0) { has_next = true; nxt = cur; Kn = g.K1; Abn = (const char*)g.A1; hstepn = (size_t)HALF * Kn * 2; nB = (const char*)g.Bt1 + (size_t)cur.pn * 2 * hstepn; PG8_VOFFB(voffBn, Kn); PG8_AOFF(vAn, cur, Kn); }
        else { has_next = S.next(ui + 1, nxt);
            if (has_next) { Kn = g.K0; Abn = (const char*)g.A0; hstepn = (size_t)HALF * Kn * 2; nB = (const char*)g.Bt0 + (size_t)nxt.pn * 2 * hstepn; PG8_VOFFB(voffBn, Kn); PG8_AOFF(vAn, nxt, Kn); }
            else { Kn = Kc; Abn = Ab; hstepn = hstep; nB = cB;
#pragma unroll
                for (int h = 0; h < 2; ++h)
#pragma unroll
                    for (int i = 0; i < 2; ++i) vAn[h][i] = vAc[h][i];
#pragma unroll
                for (int i = 0; i < 2; ++i) voffBn[i] = voffB[i]; } }
        const int nt = Kc / BK;
        _Pragma("nounroll") for (int t = 0; t < nt; t += 2) {
            const bool last = (t == nt - 2);
            const char* a1 = Ab + (size_t)(t + 1) * kstep;
            const char* a2 = last ? Abn : Ab + (size_t)(t + 2) * kstep; const char* b2 = last ? nB : cB + (size_t)(t + 2) * kstep;
            const size_t h2 = last ? hstepn : hstep; unsigned vB2[2];
#pragma unroll
            for (int i = 0; i < 2; ++i) vB2[i] = last ? voffBn[i] : voffB[i];
            const char* a3 = a2 + kstep; const char* b3 = b2 + kstep;
            unsigned s0[2], s1[2];
#pragma unroll
            for (int i = 0; i < 2; ++i) { s0[i] = last ? vAn[0][i] : vAc[0][i]; s1[i] = last ? vAn[1][i] : vAc[1][i]; }
            PG8_LDB(B0, 0, 0); PG8_LDB(B1, 0, 1); PG8_SCHED; PG8_LDA(At, 0, 0); PG8_STAGE(PG8_SA(1, 1), a1, vAc[1]);
            PG8_WAIT_V(8); PG8_WAIT_L(0); PG8_BAR; PG8_MMA(0, 0, At, B0); PG8_MMA(0, 1, At, B1); PG8_BAR; PG8_SCHED;
            PG8_LDA(At, 0, 1); PG8_STAGE(PG8_SB(0, 0), b2, vB2); PG8_STAGE(PG8_SB(0, 1), b2 + h2, vB2); PG8_STAGE(PG8_SA(0, 0), a2, s0);
            PG8_WAIT_V(8); PG8_WAIT_L(0); PG8_BAR; PG8_MMA(1, 0, At, B0); PG8_MMA(1, 1, At, B1); PG8_BAR; PG8_SCHED;
            PG8_LDB(B0, 1, 0); PG8_LDB(B1, 1, 1); PG8_SCHED; PG8_LDA(At, 1, 0); PG8_STAGE(PG8_SA(0, 1), a2, s1);
            PG8_WAIT_V(8); PG8_WAIT_L(0); PG8_BAR; PG8_MMA(0, 0, At, B0); PG8_MMA(0, 1, At, B1); PG8_BAR; PG8_SCHED;
            PG8_LDA(At, 1, 1); PG8_STAGE(PG8_SB(1, 0), b3, vB2); PG8_STAGE(PG8_SB(1, 1), b3 + h2, vB2); PG8_STAGE(PG8_SA(1, 0), a3, s0);
            PG8_WAIT_V(8); PG8_WAIT_L(0); PG8_BAR; PG8_MMA(1, 0, At, B0); PG8_MMA(1, 1, At, B1); PG8_BAR; PG8_SCHED;
        }
        if constexpr (ALIGN_EPI) { if (wr == 0) PG8_BAR; }
        if (segc == 1) { E(acc, cur, wr, wc, fr, fq); if (!has_next) break; }
        E.mid(acc, cur, wr, wc, fr, fq, segc == 1);
        if (segc == 1) { cur = nxt; ++ui; }
        segc ^= 1; Kc = Kn; Ab = Abn; hstep = hstepn; cB = nB;
#pragma unroll
        for (int i = 0; i < 2; ++i) voffB[i] = voffBn[i];
#pragma unroll
        for (int h = 0; h < 2; ++h)
#pragma unroll
            for (int i = 0; i < 2; ++i) vAc[h][i] = vAn[h][i];
        if constexpr (ALIGN_EPI) { if (wr == 1) PG8_BAR; }
    }
    PG8_WAIT_V(0);
    if constexpr (!ALIGN_EPI) { if (wr == 0) PG8_BAR; }
    PG8_BAR;
#undef PG8_SA
#undef PG8_SB
#undef PG8_STAGE
#undef PG8_LDA
#undef PG8_LDB
#undef PG8_MMA
#undef PG8_WAIT_V
#undef PG8_WAIT_L
#undef PG8_BAR
#undef PG8_SCHED
#undef PG8_AOFF
#undef PG8_VOFFB
}
}
#include <hip/hip_bf16.h>
#include <cmath>
namespace attn_body {
using bf16=__hip_bfloat16;
using bf16x8=__attribute__((ext_vector_type(8)))short;
using s16x4=__attribute__((ext_vector_type(4)))short;
using f32x16=__attribute__((ext_vector_type(16)))float;
using u32x4=__attribute__((ext_vector_type(4)))unsigned;
constexpr int BATCH=8,NHEAD=16,SEQ=2048,D=64,DM=NHEAD*D;
constexpr int NW=8,QBLK=32,QB=QBLK*NW,KVBLK=64,NQB=SEQ/QB;
constexpr int ATTN_PITCH=DM, ATTN_UNIT_ROWS=QB;
__device__ __forceinline__ int crow(int r,int hi){return (r&3)+8*(r>>2)+4*hi;}
#define SBAR() __builtin_amdgcn_sched_barrier(0)
__device__ __forceinline__ void cmask(f32x16&p0,f32x16&p1,int jb,int qrel,int hi){
  const float NEG=-INFINITY; int kb=64*jb+4*hi;
  #pragma unroll
  for(int r=0;r<16;++r){int kv=kb+(r&3)+8*(r>>2); if(kv>qrel)p0[r]=NEG; if(kv+32>qrel)p1[r]=NEG;}
}

constexpr int NSLOT=3, SLOTB=8192;
constexpr int LDS_K=0, LDS_V=NSLOT*SLOTB, LDS_WS=2*NSLOT*SLOTB, LDS_OST=LDS_WS+NW*64*4, LDS_BYTES=LDS_OST+NW*4096;
constexpr float C2=0.125f*1.4426950408889634f;
__device__ __forceinline__ void glds16(const void*gsrc,unsigned lds_dst){unsigned keep;
  asm volatile("s_mov_b32 %0, m0\n\ts_mov_b32 m0, %2\n\ts_nop 0\n\tglobal_load_lds_dwordx4 %1, off\n\ts_mov_b32 m0, %0":"=&s"(keep):"v"(gsrc),"s"(lds_dst):"memory");}
__device__ __forceinline__ float max3f(float a,float b,float c){float r;asm("v_max3_f32 %0, %1, %2, %3":"=v"(r):"v"(a),"v"(b),"v"(c));return r;}
__device__ __forceinline__ float max2f(float a,float b){float r;asm("v_max_f32_e32 %0, %1, %2":"=v"(r):"v"(a),"v"(b));return r;}
__device__ __forceinline__ float fadd_s(float a,float b){float r;asm("v_add_f32_e32 %0, %1, %2":"=v"(r):"v"(a),"v"(b));return r;}
__device__ __forceinline__ float fsub_s(float a,float b){float r;asm("v_sub_f32_e32 %0, %1, %2":"=v"(r):"v"(a),"v"(b));return r;}
typedef float f32x2_t __attribute__((ext_vector_type(2))); typedef __bf16 bf16x2_t __attribute__((ext_vector_type(2)));
__device__ __forceinline__ unsigned cvtpk_s(float lo,float hi){f32x2_t v={lo,hi};bf16x2_t b=__builtin_convertvector(v,bf16x2_t);return __builtin_bit_cast(unsigned,b);}
#define WAIT_BAR(N) asm volatile("s_waitcnt vmcnt(" #N ") lgkmcnt(0)\n\ts_barrier":::"memory")

__device__ __forceinline__ void qkt(f32x16&p0,f32x16&p1,const char*Kslot,const bf16x8*qr,const f32x16&negm,int r32,int hi){
  const char*kb=Kslot+hi*1024+r32*16;
  #pragma unroll
  for(int d0=0;d0<4;++d0){
    const bf16x8 b0=*reinterpret_cast<const bf16x8*>(kb+d0*2048);
    const bf16x8 b1=*reinterpret_cast<const bf16x8*>(kb+d0*2048+512);
    if(d0==0){p0=__builtin_amdgcn_mfma_f32_32x32x16_bf16(b0,qr[0],negm,0,0,0);p1=__builtin_amdgcn_mfma_f32_32x32x16_bf16(b1,qr[0],negm,0,0,0);}
    else{p0=__builtin_amdgcn_mfma_f32_32x32x16_bf16(b0,qr[d0],p0,0,0,0);p1=__builtin_amdgcn_mfma_f32_32x32x16_bf16(b1,qr[d0],p1,0,0,0);}}
}
typedef __attribute__((address_space(3))) const char* lds_cptr;
typedef short v4i16_t __attribute__((ext_vector_type(4)));
__device__ __forceinline__ void kload8(bf16x8*kf,lds_cptr kp){
  kf[0]=*(const __attribute__((address_space(3))) bf16x8*)(kp);      kf[1]=*(const __attribute__((address_space(3))) bf16x8*)(kp+512);
  kf[2]=*(const __attribute__((address_space(3))) bf16x8*)(kp+2048); kf[3]=*(const __attribute__((address_space(3))) bf16x8*)(kp+2560);
  kf[4]=*(const __attribute__((address_space(3))) bf16x8*)(kp+4096); kf[5]=*(const __attribute__((address_space(3))) bf16x8*)(kp+4608);
  kf[6]=*(const __attribute__((address_space(3))) bf16x8*)(kp+6144); kf[7]=*(const __attribute__((address_space(3))) bf16x8*)(kp+6656);
}
__device__ __forceinline__ void kload2(bf16x8*kf,lds_cptr kp,int j){ kf[2*j]=*(const __attribute__((address_space(3))) bf16x8*)(kp+j*2048); kf[2*j+1]=*(const __attribute__((address_space(3))) bf16x8*)(kp+j*2048+512); }
__device__ __forceinline__ s16x4 vtr(lds_cptr p){ return __builtin_bit_cast(s16x4,__builtin_amdgcn_ds_read_tr16_b64_v4i16((__attribute__((address_space(3))) v4i16_t*)p)); }
__device__ __forceinline__ float rowmax(const f32x16&p0,const f32x16&p1){
  float a=max3f(p0[0],p0[1],p1[0]),b=max3f(p0[2],p0[3],p1[1]);a=max3f(a,p1[2],p1[3]);
  #pragma unroll
  for(int r=4;r<16;r+=4){a=max3f(a,p0[r],p0[r+1]);b=max3f(b,p0[r+2],p0[r+3]);a=max3f(a,p1[r],p1[r+1]);b=max3f(b,p1[r+2],p1[r+3]);}
  const float m=max2f(a,b);
  auto rr=__builtin_amdgcn_permlane32_swap(__float_as_uint(m),__float_as_uint(m),false,false);
  return max2f(__uint_as_float(rr[0]),__uint_as_float(rr[1]));
}
__device__ __forceinline__ void pv(f32x16*o,int vb,bf16x8 pa0,bf16x8 pa1,bf16x8 pa2,bf16x8 pa3){
  #pragma unroll
  for(int d0=0;d0<2;++d0){s16x4 lo[4],hi[4];
    #pragma unroll
    for(int ks=0;ks<4;++ks){
      asm volatile("ds_read_b64_tr_b16 %0,%1 offset:%c2":"=&v"(lo[ks]):"v"(vb),"i"(d0*4096+ks*1024):"memory");
      asm volatile("ds_read_b64_tr_b16 %0,%1 offset:%c2":"=&v"(hi[ks]):"v"(vb),"i"(d0*4096+ks*1024+512):"memory");}
    asm volatile("s_waitcnt lgkmcnt(0)":::"memory");SBAR();
    #define PK(k) (bf16x8){lo[k][0],lo[k][1],lo[k][2],lo[k][3],hi[k][0],hi[k][1],hi[k][2],hi[k][3]}
    o[d0]=__builtin_amdgcn_mfma_f32_32x32x16_bf16(pa0,PK(0),o[d0],0,0,0);
    o[d0]=__builtin_amdgcn_mfma_f32_32x32x16_bf16(pa1,PK(1),o[d0],0,0,0);
    o[d0]=__builtin_amdgcn_mfma_f32_32x32x16_bf16(pa2,PK(2),o[d0],0,0,0);
    o[d0]=__builtin_amdgcn_mfma_f32_32x32x16_bf16(pa3,PK(3),o[d0],0,0,0);
    #undef PK
  }
}

#ifndef ATTN_STORE16
#define ATTN_STORE16(p,v) (*(u32x4*)(p)=(v))
#endif
template<int THRL> __device__ __forceinline__ void attn_unit(int b,int h,int hv,int qb,const bf16*Q,const bf16*__restrict__ K,const bf16*__restrict__ V,bf16*O,char*shm){
  int tid_=threadIdx.x; asm volatile("":"+v"(tid_));
  const int tid=tid_,lane=tid&63,r32=lane&31,hi=lane>>5; const int wid=__builtin_amdgcn_readfirstlane(tid>>6);
  const long rowbase=(long)b*SEQ; const int q0=qb*QB;
  const bf16*Qw=Q+(rowbase+q0+wid*QBLK)*DM+h*D;
  const bf16*Kh=K+rowbase*DM+h*D,*Vh=V+rowbase*DM+hv*D;
  const unsigned lds0=(unsigned)(uintptr_t)shm;
  float*wsf=(float*)(shm+LDS_WS)+wid*64;
  const bf16*ksrc=Kh+(long)lane*DM+wid*8;
  const bf16*vsrc=Vh+(long)(16*(wid&3)+(lane>>2))*DM+(wid>>2)*32+(lane&3)*8;
  const unsigned kdst=lds0+LDS_K+wid*1024, vdst=lds0+LDS_V+wid*1024;
  #define DMA_K(t,slot) glds16(ksrc+(long)(t)*KVBLK*DM,(unsigned)__builtin_amdgcn_readfirstlane(kdst+(slot)))
  #define DMA_V(t,slot) glds16(vsrc+(long)(t)*KVBLK*DM,(unsigned)__builtin_amdgcn_readfirstlane(vdst+(slot)))
  const int vb0=(int)(lds0+LDS_V)+((lane>>4)&1)*32+(lane&3)*8+(4*hi+((lane&15)>>2))*64;
  const char*Kbase=shm+LDS_K; bf16x8 kf[8];
  const lds_cptr shm3=(lds_cptr)shm; const lds_cptr kp0=shm3+LDS_K+hi*1024+r32*16; const lds_cptr vp0=shm3+LDS_V+((lane>>4)&1)*32+(lane&3)*8+(4*hi+((lane&15)>>2))*64;
  const int NT=(q0+QB)/KVBLK;
  DMA_K(0,0);DMA_V(0,0);DMA_K(1,SLOTB);
  bf16x8 qr[4];
  #pragma unroll
  for(int d0=0;d0<4;++d0)qr[d0]=*reinterpret_cast<const bf16x8*>(&Qw[(long)r32*DM+d0*16+hi*8]);
  float zz_=0.f; asm volatile("":"+v"(zz_));
  float mhat=0.f,l_reg=0.f;f32x16 o[2];
  #pragma unroll
  for(int r=0;r<16;++r){o[0][r]=zz_;o[1][r]=zz_;}
  f32x16 negm;
  #pragma unroll
  for(int r=0;r<16;++r)negm[r]=zz_;
  asm volatile("":"+v"(negm));
  const int qrel=wid*QBLK+r32;
  #define CMASK(P0,P1,t) do{int jb_=(t)-(NT-4); if(jb_>=0)cmask(P0,P1,jb_,qrel,hi);}while(0)
  bool resc=false;
  #define START(P0,P1) do{ const float rm=rowmax(P0,P1); resc=false; \
    { const float dl=rm; mhat=fadd_s(mhat,dl); \
      _Pragma("unroll") for(int r=0;r<16;++r){P0[r]=fsub_s(P0[r],dl);P1[r]=fsub_s(P1[r],dl);} \
      _Pragma("unroll") for(int r=0;r<16;++r)negm[r]=-mhat; asm volatile("":"+v"(negm)); } \
    _Pragma("unroll") for(int r=0;r<16;++r)P0[r]=__builtin_amdgcn_exp2f(P0[r]); }while(0)
  #define RESC() do{ if(resc){ asm volatile("s_waitcnt lgkmcnt(0)":::"memory"); \
      _Pragma("unroll") for(int d_=0;d_<2;++d_) _Pragma("unroll") for(int r=0;r<16;++r)o[d_][r]*=wsf[crow(r,hi)]; } }while(0)
  f32x16 pA0,pA1,pB0,pB1;
  int sl_prev=0,sl_cur=0,sl_next=SLOTB;
  #define ROT() do{sl_prev=sl_cur;sl_cur=sl_next;sl_next=(sl_next==(NSLOT-1)*SLOTB)?0:sl_next+SLOTB;}while(0)
  DMA_K(2,2*SLOTB);
  WAIT_BAR(3);
  qkt(pA0,pA1,Kbase,qr,negm,r32,hi);asm volatile("s_nop 15\n\ts_nop 7":"+v"(pA0),"+v"(pA1));CMASK(pA0,pA1,0);
  START(pA0,pA1);
  _Pragma("unroll") for(int r=0;r<16;++r)pA1[r]=__builtin_amdgcn_exp2f(pA1[r]);
  WAIT_BAR(0);
  DMA_K(3,0);DMA_V(1,SLOTB);
  ROT();
  kload8(kf,kp0+sl_cur);
  WAIT_BAR(2);
  s16x4 vlo[8],vhi[8]; u32x4 pw0,pw1,pw2,pw3;
  #define PKW(P,B) cvtpk_s(P[B],P[B+1])
  #define PAF(k) __builtin_bit_cast(bf16x8,pw##k)
  #define VFR(i) (bf16x8){vlo[i][0],vlo[i][1],vlo[i][2],vlo[i][3],vhi[i][0],vhi[i][1],vhi[i][2],vhi[i][3]}
  #define PIN(x) asm volatile("":"+v"(x))
  #define MX3(a,b,c) __builtin_fmaxf(__builtin_fmaxf((a),(b)),(c))
  #define GAPA(MF,A0,A1,A2,A3,W0,W1,PW) do{ MF; sacc+=A0; sacc+=A1; sacc+=A2; sacc+=A3; PIN(sacc); W0; W1; PIN(PW); SBAR(); }while(0)
  #define EX(v) __builtin_amdgcn_exp2f(v)
  #define GAPB(MF,X,B) do{ MF; X[B]=EX(X[B]); X[B+1]=EX(X[B+1]); X[B+2]=EX(X[B+2]); X[B+3]=EX(X[B+3]); PIN(X); SBAR(); }while(0)
  #define VRD(i) do{ vlo[i]=vtr(vp_+(((i)>>2)*4096+((i)&3)*1024)); vhi[i]=vtr(vp_+(((i)>>2)*4096+((i)&3)*1024+512)); }while(0)
  #define KRD(G,j) do{ if(G){ kload2(kf,kp0+sl_next,j); SBAR(); } }while(0)
  #define STEP(C0,C1,P0,P1,t,GK,GV,GL) do{ SBAR(); \
    const lds_cptr vp_=vp0+sl_prev; \
    VRD(0); SBAR(); float sacc=(P0[0]+P0[1]); \
    GAPA(C0=__builtin_amdgcn_mfma_f32_32x32x16_bf16(kf[0],qr[0],negm,0,0,0), P0[2],P0[3],P0[4],P0[5],     pw0[0]=PKW(P0,0), pw0[1]=PKW(P0,2), pw0); \
    VRD(4); SBAR(); GAPA(C1=__builtin_amdgcn_mfma_f32_32x32x16_bf16(kf[1],qr[0],negm,0,0,0), P0[6],P0[7],P0[8],P0[9],     pw0[2]=PKW(P0,4), pw0[3]=PKW(P0,6), pw0); \
    VRD(1); SBAR(); GAPA(C0=__builtin_amdgcn_mfma_f32_32x32x16_bf16(kf[2],qr[1],C0,0,0,0),   P0[10],P0[11],P0[12],P0[13], pw1[0]=PKW(P0,8), pw1[1]=PKW(P0,10), pw1); \
    VRD(5); SBAR(); GAPA(C1=__builtin_amdgcn_mfma_f32_32x32x16_bf16(kf[3],qr[1],C1,0,0,0),   P0[14],P0[15],P1[0],P1[1],   pw1[2]=PKW(P0,12),pw1[3]=PKW(P0,14), pw1); \
    VRD(2); SBAR(); GAPA(C0=__builtin_amdgcn_mfma_f32_32x32x16_bf16(kf[4],qr[2],C0,0,0,0),   P1[2],P1[3],P1[4],P1[5],     pw2[0]=PKW(P1,0), pw2[1]=PKW(P1,2), pw2); \
    VRD(6); SBAR(); GAPA(C1=__builtin_amdgcn_mfma_f32_32x32x16_bf16(kf[5],qr[2],C1,0,0,0),   P1[6],P1[7],P1[8],P1[9],     pw2[2]=PKW(P1,4), pw2[3]=PKW(P1,6), pw2); \
    VRD(3); SBAR(); GAPA(C0=__builtin_amdgcn_mfma_f32_32x32x16_bf16(kf[6],qr[3],C0,0,0,0),   P1[10],P1[11],P1[12],P1[13], pw3[0]=PKW(P1,8), pw3[1]=PKW(P1,10), pw3); \
    VRD(7); SBAR(); GAPA(C1=__builtin_amdgcn_mfma_f32_32x32x16_bf16(kf[7],qr[3],C1,0,0,0),   P1[14],P1[15],0.f,0.f,       pw3[2]=PKW(P1,12),pw3[3]=PKW(P1,14), pw3); \
    l_reg+=sacc; \
    if(GK){DMA_K((t)+3,sl_cur);} if(GV){DMA_V((t)+1,sl_next);} \
    CMASK(C0,C1,t); \
    { float a=MX3(C0[0],C0[1],C1[0]),b=MX3(C0[2],C0[3],C1[1]); a=MX3(a,C1[2],C1[3]); \
      _Pragma("unroll") for(int r=4;r<16;r+=4){a=MX3(a,C0[r],C0[r+1]);b=MX3(b,C0[r+2],C0[r+3]);a=MX3(a,C1[r],C1[r+1]);b=MX3(b,C1[r+2],C1[r+3]);} \
      float rm=__builtin_fmaxf(a,b); { auto rr=__builtin_amdgcn_permlane32_swap(__float_as_uint(rm),__float_as_uint(rm),false,false); rm=__builtin_fmaxf(__uint_as_float(rr[0]),__uint_as_float(rr[1])); } \
      resc=false; \
      if(__builtin_expect(__any(rm>(float)THRL),0)){ const float dl=__builtin_fmaxf(rm,0.f); mhat+=dl; \
        _Pragma("unroll") for(int r=0;r<16;++r){C0[r]-=dl;C1[r]-=dl;} \
        _Pragma("unroll") for(int r=0;r<16;++r)negm[r]=-mhat; asm volatile("":"+v"(negm)); \
        const float f=__builtin_amdgcn_exp2f(-dl); l_reg*=f; if(hi==0)wsf[r32]=f; resc=true; } } \
    SBAR(); \
    GAPB(o[0]=__builtin_amdgcn_mfma_f32_32x32x16_bf16(PAF(0),VFR(0),o[0],0,0,0), C0,0); \
    GAPB(o[1]=__builtin_amdgcn_mfma_f32_32x32x16_bf16(PAF(0),VFR(4),o[1],0,0,0), C0,4); \
    KRD(GL,0); GAPB(o[0]=__builtin_amdgcn_mfma_f32_32x32x16_bf16(PAF(1),VFR(1),o[0],0,0,0), C0,8); \
    KRD(GL,1); GAPB(o[1]=__builtin_amdgcn_mfma_f32_32x32x16_bf16(PAF(1),VFR(5),o[1],0,0,0), C0,12); \
    KRD(GL,2); GAPB(o[0]=__builtin_amdgcn_mfma_f32_32x32x16_bf16(PAF(2),VFR(2),o[0],0,0,0), C1,0); \
    KRD(GL,3); GAPB(o[1]=__builtin_amdgcn_mfma_f32_32x32x16_bf16(PAF(2),VFR(6),o[1],0,0,0), C1,4); \
    GAPB(o[0]=__builtin_amdgcn_mfma_f32_32x32x16_bf16(PAF(3),VFR(3),o[0],0,0,0), C1,8); \
    GAPB(o[1]=__builtin_amdgcn_mfma_f32_32x32x16_bf16(PAF(3),VFR(7),o[1],0,0,0), C1,12); \
    }while(0)
  int t=1;
  #undef CMASK
  #define CMASK(P0,P1,t) do{}while(0)
  for(;t+5<NT;t+=2){
    STEP(pB0,pB1,pA0,pA1,t,true,true,true);     WAIT_BAR(2); RESC(); ROT();
    STEP(pA0,pA1,pB0,pB1,t+1,true,true,true);   WAIT_BAR(2); RESC(); ROT();
  }
  #undef CMASK
  #define CMASK(P0,P1,t) do{int jb_=(t)-(NT-4); if(jb_>=0)cmask(P0,P1,jb_,qrel,hi);}while(0)
  #define ENDW(tt) do{ if((tt)+3<NT){WAIT_BAR(2);} else if((tt)+2<NT){WAIT_BAR(1);} else {WAIT_BAR(0);} }while(0)
  for(;t+1<NT;t+=2){
    STEP(pB0,pB1,pA0,pA1,t,(t+3<NT),(t+1<NT),(t+1<NT));       ENDW(t);   RESC(); ROT();
    STEP(pA0,pA1,pB0,pB1,t+1,(t+4<NT),(t+2<NT),(t+2<NT));     ENDW(t+1); RESC(); ROT();
  }
  STEP(pB0,pB1,pA0,pA1,NT-1,false,false,false); RESC();
  { float sacc=pB0[0]+pB0[1]; _Pragma("unroll") for(int r=2;r<16;++r)sacc+=pB0[r]; _Pragma("unroll") for(int r=0;r<16;++r)sacc+=pB1[r]; l_reg+=sacc;
    pw0=(u32x4){PKW(pB0,0),PKW(pB0,2),PKW(pB0,4),PKW(pB0,6)};pw1=(u32x4){PKW(pB0,8),PKW(pB0,10),PKW(pB0,12),PKW(pB0,14)};pw2=(u32x4){PKW(pB1,0),PKW(pB1,2),PKW(pB1,4),PKW(pB1,6)};pw3=(u32x4){PKW(pB1,8),PKW(pB1,10),PKW(pB1,12),PKW(pB1,14)};
    SBAR(); pv(o,vb0+sl_cur,PAF(0),PAF(1),PAF(2),PAF(3)); }
  #undef PKW
  #undef PAF
  #undef VFR
  #undef PIN
  #undef MX3
  #undef GAPA
  #undef GAPB
  #undef EX
  #undef VRD
  #undef KRD
  #undef STEP
  #undef ENDW
  {auto rr=__builtin_amdgcn_permlane32_swap(__float_as_uint(l_reg),__float_as_uint(l_reg),false,false);l_reg=__uint_as_float(rr[0])+__uint_as_float(rr[1]);}
  if(hi==0)wsf[32+r32]=l_reg;asm volatile("s_waitcnt lgkmcnt(0)":::"memory");
  float rli[16];
  #pragma unroll
  for(int r=0;r<16;++r)rli[r]=__builtin_amdgcn_rcpf(wsf[32+crow(r,hi)]);
  bf16*Ow=O+(rowbase+q0+wid*QBLK)*DM+hv*D;
  { bf16*stg=(bf16*)(shm+LDS_OST)+wid*2048;
    #pragma unroll
    for(int r=0;r<16;++r){const int orow=crow(r,hi);
      #pragma unroll
      for(int d0=0;d0<2;++d0)stg[orow*64+d0*32+r32]=__float2bfloat16(o[d0][r]*rli[r]);}
    asm volatile("s_waitcnt lgkmcnt(0)":::"memory");
    #pragma unroll
    for(int i=0;i<4;++i){const int row=i*8+(lane>>3),ch=lane&7; const u32x4 v=*(const u32x4*)(stg+row*64+ch*8); ATTN_STORE16(Ow+(long)row*DM+ch*8,v);} }
  asm volatile("s_waitcnt lgkmcnt(0)\n\ts_barrier":::"memory");
  #undef DMA_K
  #undef DMA_V
  #undef CMASK
  #undef START
  #undef RESC
  #undef ROT
}
constexpr int LDSW_K=0, LDSW_V=NSLOT*SLOTB, LDSW_WS=LDSW_V+NSLOT*2*SLOTB, LDSW_OST=LDSW_WS+NW*64*4, LDSW_BYTES=LDSW_OST+NW*4096;
struct Combine { bool on; const bf16* O0; bf16* oc; const float* g; float lam, eps, post; };
template<int THRL> __device__ __forceinline__ void attn_unit_w(int b,int h,int hh,int qb,const bf16*Q,const bf16*__restrict__ K,const bf16*__restrict__ V,bf16*O,char*shm,const Combine CB){
  int tid_=threadIdx.x; asm volatile("":"+v"(tid_));
  const int tid=tid_,lane=tid&63,r32=lane&31,hi=lane>>5; const int wid=__builtin_amdgcn_readfirstlane(tid>>6);
  const long rowbase=(long)b*SEQ; const int q0=qb*QB;
  const bf16*Qw=Q+(rowbase+q0+wid*QBLK)*DM+h*D;
  const bf16*Kh=K+rowbase*DM+h*D,*Vh=V+rowbase*DM+hh*128;
  const unsigned lds0=(unsigned)(uintptr_t)shm;
  float*wsf=(float*)(shm+LDSW_WS)+wid*64;
  const bf16*ksrc=Kh+(long)lane*DM+wid*8;
  const bf16*vsrc=Vh+(long)(16*(wid&3)+(lane>>2))*DM+(wid>>2)*32+(lane&3)*8;
  const unsigned kdst=lds0+LDSW_K+wid*1024, vdst=lds0+LDSW_V+wid*1024;
  #define DMA_K(t,slot) glds16(ksrc+(long)(t)*KVBLK*DM,(unsigned)__builtin_amdgcn_readfirstlane(kdst+(slot)))
  #define DMA_V(t,slot) do{ glds16(vsrc+(long)(t)*KVBLK*DM,(unsigned)__builtin_amdgcn_readfirstlane(vdst+2*(slot))); glds16(vsrc+(long)(t)*KVBLK*DM+64,(unsigned)__builtin_amdgcn_readfirstlane(vdst+2*(slot)+8192)); }while(0)
  const int vb0=(int)(lds0+LDSW_V)+((lane>>4)&1)*32+(lane&3)*8+(4*hi+((lane&15)>>2))*64;
  const char*Kbase=shm+LDSW_K; bf16x8 kf[8];
  const lds_cptr shm3=(lds_cptr)shm; const lds_cptr kp0=shm3+LDSW_K+hi*1024+r32*16; const lds_cptr vp0=shm3+LDSW_V+((lane>>4)&1)*32+(lane&3)*8+(4*hi+((lane&15)>>2))*64;
  const int NT=(q0+QB)/KVBLK;
  DMA_K(0,0);DMA_V(0,0);DMA_K(1,SLOTB);
  bf16x8 qr[4];
  #pragma unroll
  for(int d0=0;d0<4;++d0)qr[d0]=*reinterpret_cast<const bf16x8*>(&Qw[(long)r32*DM+d0*16+hi*8]);
  float zz_=0.f; asm volatile("":"+v"(zz_));
  float mhat=0.f,l_reg=0.f;f32x16 o[4];
  #pragma unroll
  for(int r=0;r<16;++r){o[0][r]=zz_;o[1][r]=zz_;o[2][r]=zz_;o[3][r]=zz_;}
  const f32x16 zero16={};
  const int qrel=wid*QBLK+r32;
  #define CMASK(P0,P1,t) do{int jb_=(t)-(NT-4); if(jb_>=0)cmask(P0,P1,jb_,qrel,hi);}while(0)
  bool resc=false;
  #define START(P0,P1) do{ const float rm=rowmax(P0,P1); resc=false; \
    { const float dl=(__builtin_fabsf(rm)>(float)THRL)?rm:0.f; mhat=fadd_s(mhat,dl);     \
      _Pragma("unroll") for(int r=0;r<16;++r){P0[r]=fsub_s(P0[r],dl);P1[r]=fsub_s(P1[r],dl);} } \
    _Pragma("unroll") for(int r=0;r<16;++r)P0[r]=__builtin_amdgcn_exp2f(P0[r]); }while(0)
  #define RESC() do{ if(resc){ asm volatile("s_waitcnt lgkmcnt(0)":::"memory"); \
      _Pragma("unroll") for(int d_=0;d_<4;++d_) _Pragma("unroll") for(int r=0;r<16;++r)o[d_][r]*=wsf[crow(r,hi)]; } }while(0)
  f32x16 pA0,pA1,pB0,pB1;
  int sl_prev=0,sl_cur=0,sl_next=SLOTB;
  #define ROT() do{sl_prev=sl_cur;sl_cur=sl_next;sl_next=(sl_next==(NSLOT-1)*SLOTB)?0:sl_next+SLOTB;}while(0)
  DMA_K(2,2*SLOTB);
  WAIT_BAR(4);
  qkt(pA0,pA1,Kbase,qr,zero16,r32,hi);asm volatile("s_nop 15\n\ts_nop 7":"+v"(pA0),"+v"(pA1));CMASK(pA0,pA1,0);
  START(pA0,pA1);
  _Pragma("unroll") for(int r=0;r<16;++r)pA1[r]=__builtin_amdgcn_exp2f(pA1[r]);
  WAIT_BAR(0);
  DMA_K(3,0);DMA_V(1,SLOTB);
  ROT();
  kload8(kf,kp0+sl_cur);
  WAIT_BAR(3);
  s16x4 vlo[4],vhi[4]; u32x4 pw0,pw1,pw2,pw3;
  #define GAPB2(MF,X,B) do{ MF; X[B]=EX(X[B]); X[B+1]=EX(X[B+1]); PIN(X); SBAR(); }while(0)
  #define PKW(P,B) cvtpk_s(P[B],P[B+1])
  #define PAF(k) __builtin_bit_cast(bf16x8,pw##k)
  #define VFR(i) (bf16x8){vlo[i][0],vlo[i][1],vlo[i][2],vlo[i][3],vhi[i][0],vhi[i][1],vhi[i][2],vhi[i][3]}
  #define PIN(x) asm volatile("":"+v"(x))
  #define MX3(a,b,c) __builtin_fmaxf(__builtin_fmaxf((a),(b)),(c))
  #define GAPA(MF,A0,A1,A2,A3,W0,W1,PW) do{ MF; sacc+=A0; sacc+=A1; sacc+=A2; sacc+=A3; PIN(sacc); W0; W1; PIN(PW); SBAR(); }while(0)
  #define EX(v) __builtin_amdgcn_exp2f(v)
  #define GAPB(MF,X,B) do{ MF; X[B]=EX(X[B]); X[B+1]=EX(X[B+1]); X[B+2]=EX(X[B+2]); X[B+3]=EX(X[B+3]); PIN(X); SBAR(); }while(0)
  #define VLD(sl,hf,i) do{ vlo[sl]=vtr(vp_+((hf)*8192+((i)>>2)*4096+((i)&3)*1024)); vhi[sl]=vtr(vp_+((hf)*8192+((i)>>2)*4096+((i)&3)*1024+512)); }while(0)
  #define KRD(G,j) do{ if(G){ kload2(kf,kp0+sl_next,j); SBAR(); } }while(0)
  #define STEP(C0,C1,P0,P1,t,GK,GV,GL) do{ SBAR(); \
    const lds_cptr vp_=vp0+2*sl_prev; \
    float sacc=(P0[0]+P0[1]); \
    GAPA(C0=__builtin_amdgcn_mfma_f32_32x32x16_bf16(kf[0],qr[0],zero16,0,0,0), P0[2],P0[3],P0[4],P0[5],     pw0[0]=PKW(P0,0), pw0[1]=PKW(P0,2), pw0); \
    GAPA(C1=__builtin_amdgcn_mfma_f32_32x32x16_bf16(kf[1],qr[0],zero16,0,0,0), P0[6],P0[7],P0[8],P0[9],     pw0[2]=PKW(P0,4), pw0[3]=PKW(P0,6), pw0); \
    GAPA(C0=__builtin_amdgcn_mfma_f32_32x32x16_bf16(kf[2],qr[1],C0,0,0,0),   P0[10],P0[11],P0[12],P0[13], pw1[0]=PKW(P0,8), pw1[1]=PKW(P0,10), pw1); \
    GAPA(C1=__builtin_amdgcn_mfma_f32_32x32x16_bf16(kf[3],qr[1],C1,0,0,0),   P0[14],P0[15],P1[0],P1[1],   pw1[2]=PKW(P0,12),pw1[3]=PKW(P0,14), pw1); \
    VLD(0,0,0); SBAR(); GAPA(C0=__builtin_amdgcn_mfma_f32_32x32x16_bf16(kf[4],qr[2],C0,0,0,0),   P1[2],P1[3],P1[4],P1[5],     pw2[0]=PKW(P1,0), pw2[1]=PKW(P1,2), pw2); \
    VLD(1,0,4); SBAR(); GAPA(C1=__builtin_amdgcn_mfma_f32_32x32x16_bf16(kf[5],qr[2],C1,0,0,0),   P1[6],P1[7],P1[8],P1[9],     pw2[2]=PKW(P1,4), pw2[3]=PKW(P1,6), pw2); \
    VLD(2,0,1); SBAR(); GAPA(C0=__builtin_amdgcn_mfma_f32_32x32x16_bf16(kf[6],qr[3],C0,0,0,0),   P1[10],P1[11],P1[12],P1[13], pw3[0]=PKW(P1,8), pw3[1]=PKW(P1,10), pw3); \
    VLD(3,0,5); SBAR(); GAPA(C1=__builtin_amdgcn_mfma_f32_32x32x16_bf16(kf[7],qr[3],C1,0,0,0),   P1[14],P1[15],0.f,0.f,       pw3[2]=PKW(P1,12),pw3[3]=PKW(P1,14), pw3); \
    l_reg+=sacc; \
    if(__any(mhat!=0.f)){ _Pragma("unroll") for(int r=0;r<16;++r){C0[r]-=mhat;C1[r]-=mhat;} } \
    if(GK){DMA_K((t)+3,sl_cur);} if(GV){DMA_V((t)+1,sl_next);} \
    CMASK(C0,C1,t); \
    { float a=MX3(C0[0],C0[1],C1[0]),b=MX3(C0[2],C0[3],C1[1]); a=MX3(a,C1[2],C1[3]); \
      _Pragma("unroll") for(int r=4;r<16;r+=4){a=MX3(a,C0[r],C0[r+1]);b=MX3(b,C0[r+2],C0[r+3]);a=MX3(a,C1[r],C1[r+1]);b=MX3(b,C1[r+2],C1[r+3]);} \
      float rm=__builtin_fmaxf(a,b); { auto rr=__builtin_amdgcn_permlane32_swap(__float_as_uint(rm),__float_as_uint(rm),false,false); rm=__builtin_fmaxf(__uint_as_float(rr[0]),__uint_as_float(rr[1])); } \
      resc=false; \
      if(__builtin_expect(__any(rm>(float)THRL),0)){ const float dl=__builtin_fmaxf(rm,0.f); mhat+=dl; \
        _Pragma("unroll") for(int r=0;r<16;++r){C0[r]-=dl;C1[r]-=dl;} \
        const float f=__builtin_amdgcn_exp2f(-dl); l_reg*=f; if(hi==0)wsf[r32]=f; resc=true; } } \
    SBAR(); \
    GAPB2(o[0]=__builtin_amdgcn_mfma_f32_32x32x16_bf16(PAF(0),VFR(0),o[0],0,0,0), C0,0); VLD(0,0,2); SBAR(); \
    GAPB2(o[1]=__builtin_amdgcn_mfma_f32_32x32x16_bf16(PAF(0),VFR(1),o[1],0,0,0), C0,2); VLD(1,0,6); SBAR(); \
    GAPB2(o[0]=__builtin_amdgcn_mfma_f32_32x32x16_bf16(PAF(1),VFR(2),o[0],0,0,0), C0,4); VLD(2,0,3); SBAR(); \
    GAPB2(o[1]=__builtin_amdgcn_mfma_f32_32x32x16_bf16(PAF(1),VFR(3),o[1],0,0,0), C0,6); VLD(3,0,7); SBAR(); \
    GAPB2(o[0]=__builtin_amdgcn_mfma_f32_32x32x16_bf16(PAF(2),VFR(0),o[0],0,0,0), C0,8); VLD(0,1,0); SBAR(); \
    GAPB2(o[1]=__builtin_amdgcn_mfma_f32_32x32x16_bf16(PAF(2),VFR(1),o[1],0,0,0), C0,10); VLD(1,1,4); SBAR(); \
    GAPB2(o[0]=__builtin_amdgcn_mfma_f32_32x32x16_bf16(PAF(3),VFR(2),o[0],0,0,0), C0,12); VLD(2,1,1); SBAR(); \
    GAPB2(o[1]=__builtin_amdgcn_mfma_f32_32x32x16_bf16(PAF(3),VFR(3),o[1],0,0,0), C0,14); VLD(3,1,5); SBAR(); \
    GAPB2(o[2]=__builtin_amdgcn_mfma_f32_32x32x16_bf16(PAF(0),VFR(0),o[2],0,0,0), C1,0); VLD(0,1,2); SBAR(); \
    GAPB2(o[3]=__builtin_amdgcn_mfma_f32_32x32x16_bf16(PAF(0),VFR(1),o[3],0,0,0), C1,2); VLD(1,1,6); SBAR(); \
    KRD(GL,0); GAPB2(o[2]=__builtin_amdgcn_mfma_f32_32x32x16_bf16(PAF(1),VFR(2),o[2],0,0,0), C1,4); VLD(2,1,3); SBAR(); \
    KRD(GL,1); GAPB2(o[3]=__builtin_amdgcn_mfma_f32_32x32x16_bf16(PAF(1),VFR(3),o[3],0,0,0), C1,6); VLD(3,1,7); SBAR(); \
    KRD(GL,2); GAPB2(o[2]=__builtin_amdgcn_mfma_f32_32x32x16_bf16(PAF(2),VFR(0),o[2],0,0,0), C1,8); \
    KRD(GL,3); GAPB2(o[3]=__builtin_amdgcn_mfma_f32_32x32x16_bf16(PAF(2),VFR(1),o[3],0,0,0), C1,10); \
    GAPB2(o[2]=__builtin_amdgcn_mfma_f32_32x32x16_bf16(PAF(3),VFR(2),o[2],0,0,0), C1,12); \
    GAPB2(o[3]=__builtin_amdgcn_mfma_f32_32x32x16_bf16(PAF(3),VFR(3),o[3],0,0,0), C1,14); \
    }while(0)
  int t=1;
  #undef CMASK
  #define CMASK(P0,P1,t) do{}while(0)
  for(;t+5<NT;t+=2){
    STEP(pB0,pB1,pA0,pA1,t,true,true,true);     WAIT_BAR(3); RESC(); ROT();
    STEP(pA0,pA1,pB0,pB1,t+1,true,true,true);   WAIT_BAR(3); RESC(); ROT();
  }
  #undef CMASK
  #define CMASK(P0,P1,t) do{int jb_=(t)-(NT-4); if(jb_>=0)cmask(P0,P1,jb_,qrel,hi);}while(0)
  #define ENDW(tt) do{ if((tt)+3<NT){WAIT_BAR(3);} else if((tt)+2<NT){WAIT_BAR(2);} else {WAIT_BAR(0);} }while(0)
  for(;t+1<NT;t+=2){
    STEP(pB0,pB1,pA0,pA1,t,(t+3<NT),(t+1<NT),(t+1<NT));       ENDW(t);   RESC(); ROT();
    STEP(pA0,pA1,pB0,pB1,t+1,(t+4<NT),(t+2<NT),(t+2<NT));     ENDW(t+1); RESC(); ROT();
  }
  STEP(pB0,pB1,pA0,pA1,NT-1,false,false,false); RESC();
  { float sacc=pB0[0]+pB0[1]; _Pragma("unroll") for(int r=2;r<16;++r)sacc+=pB0[r]; _Pragma("unroll") for(int r=0;r<16;++r)sacc+=pB1[r]; l_reg+=sacc;
    pw0=(u32x4){PKW(pB0,0),PKW(pB0,2),PKW(pB0,4),PKW(pB0,6)};pw1=(u32x4){PKW(pB0,8),PKW(pB0,10),PKW(pB0,12),PKW(pB0,14)};pw2=(u32x4){PKW(pB1,0),PKW(pB1,2),PKW(pB1,4),PKW(pB1,6)};pw3=(u32x4){PKW(pB1,8),PKW(pB1,10),PKW(pB1,12),PKW(pB1,14)};
    SBAR(); pv(o,vb0+2*sl_cur,PAF(0),PAF(1),PAF(2),PAF(3)); pv(o+2,vb0+2*sl_cur+8192,PAF(0),PAF(1),PAF(2),PAF(3)); }
  #undef PKW
  #undef PAF
  #undef VFR
  #undef PIN
  #undef MX3
  #undef GAPA
  #undef GAPB
  #undef GAPB2
  #undef EX
  #undef VLD
  #undef KRD
  #undef STEP
  #undef ENDW
  {auto rr=__builtin_amdgcn_permlane32_swap(__float_as_uint(l_reg),__float_as_uint(l_reg),false,false);l_reg=__uint_as_float(rr[0])+__uint_as_float(rr[1]);}
  if(hi==0)wsf[32+r32]=l_reg;asm volatile("s_waitcnt lgkmcnt(0)":::"memory");
  float rli[16];
  #pragma unroll
  for(int r=0;r<16;++r)rli[r]=__builtin_amdgcn_rcpf(wsf[32+crow(r,hi)]);
  bf16*Ow=O+(rowbase+q0+wid*QBLK)*DM+hh*128;
  bf16*stg=(bf16*)(shm+LDSW_OST)+wid*2048;
  if(!CB.on){
    #pragma unroll
    for(int hf=0;hf<2;++hf){
      #pragma unroll
      for(int r=0;r<16;++r){const int orow=crow(r,hi);
        #pragma unroll
        for(int d0=0;d0<2;++d0)stg[orow*64+d0*32+r32]=__float2bfloat16(o[2*hf+d0][r]*rli[r]);}
      asm volatile("s_waitcnt lgkmcnt(0)":::"memory");
      #pragma unroll
      for(int i=0;i<4;++i){const int row=i*8+(lane>>3),ch=lane&7; const u32x4 v=*(const u32x4*)(stg+row*64+ch*8); ATTN_STORE16(Ow+(long)row*DM+hf*64+ch*8,v);}
      asm volatile("s_waitcnt lgkmcnt(0)":::"memory"); }
  } else {
    const bf16*O0w=CB.O0+(rowbase+q0+wid*QBLK)*DM+hh*128; bf16*Cw=CB.oc+(rowbase+q0+wid*QBLK)*DM+hh*128;
    float av[2][4][8]; float ss[4]={0.f,0.f,0.f,0.f};
    #pragma unroll
    for(int hf=0;hf<2;++hf){
      #pragma unroll
      for(int r=0;r<16;++r){const int orow=crow(r,hi);
        #pragma unroll
        for(int d0=0;d0<2;++d0)stg[orow*64+d0*32+r32]=__float2bfloat16(o[2*hf+d0][r]*rli[r]);}
      asm volatile("s_waitcnt lgkmcnt(0)":::"memory");
      #pragma unroll
      for(int i=0;i<4;++i){const int row=i*8+(lane>>3),ch=lane&7; const u32x4 v1=*(const u32x4*)(stg+row*64+ch*8); const u32x4 v0=*(const u32x4*)(O0w+(long)row*DM+hf*64+ch*8);
        #pragma unroll
        for(int x=0;x<4;++x){ const float a0=__uint_as_float(v0[x]<<16)-CB.lam*__uint_as_float(v1[x]<<16), a1=__uint_as_float(v0[x]&0xffff0000u)-CB.lam*__uint_as_float(v1[x]&0xffff0000u);
          av[hf][i][2*x]=a0; av[hf][i][2*x+1]=a1; ss[i]+=a0*a0+a1*a1; } }
      asm volatile("s_waitcnt lgkmcnt(0)":::"memory"); }
    #pragma unroll
    for(int i=0;i<4;++i){ float t=ss[i];
      t+=__builtin_bit_cast(float,__builtin_amdgcn_update_dpp(0,__builtin_bit_cast(int,t),0xB1,0xf,0xf,false)); t+=__builtin_bit_cast(float,__builtin_amdgcn_update_dpp(0,__builtin_bit_cast(int,t),0x4E,0xf,0xf,false));
      t+=__builtin_bit_cast(float,__builtin_amdgcn_update_dpp(0,__builtin_bit_cast(int,t),0x141,0xf,0xf,false));
      const float rn=__builtin_amdgcn_rsqf(t*(1.f/128.f)+CB.eps)*CB.post; const int row=i*8+(lane>>3),ch=lane&7;
      #pragma unroll
      for(int hf=0;hf<2;++hf){ const float*gp=CB.g+hf*64+ch*8; u32x4 w;
        #pragma unroll
        for(int x=0;x<4;++x)w[x]=cvtpk_s(av[hf][i][2*x]*rn*gp[2*x],av[hf][i][2*x+1]*rn*gp[2*x+1]);
        ATTN_STORE16(Cw+(long)row*DM+hf*64+ch*8,w); } }
  }
  asm volatile("s_waitcnt lgkmcnt(0)\n\ts_barrier":::"memory");
  #undef DMA_K
  #undef DMA_V
  #undef CMASK
  #undef START
  #undef RESC
  #undef ROT
}
constexpr int ATTN_LDS_BYTES=LDS_BYTES;
struct AttnTensors { const bf16* Q; const bf16* K; const bf16* V; bf16* O0; Combine cb; };
template<int THRL=8,class Gap> __device__ __forceinline__ void attn_phase(char*lds,const AttnTensors&T,int vcu,int G,Gap gap){
  const int nbig=(512-vcu+G-1)/G; int i=0;
  if(__builtin_amdgcn_readfirstlane((int)threadIdx.x)>=256) __builtin_amdgcn_s_setprio(1);
  for(int L=vcu;L<512;L+=G){ const int rnd=L>>8,v=L&255,r=v&7,qb=rnd?r:(NQB-1-r); const int b=v>>5,h=rnd*4+((v&31)>>3);
    #pragma unroll 1
    for(int c=0;c<2;++c){ Combine cb=T.cb; cb.on=(c==1); attn_unit_w<THRL>(b,2*h+c,h,qb,T.Q,T.K,T.V,T.O0,lds,cb); gap(i,2*nbig); ++i; } }
}
#undef SBAR
#undef WAIT_BAR
}
#ifndef PROBE_DUP
#define PROBE_DUP (-1)
#endif
constexpr int NWAVES = 8;
constexpr int NPHASE = 11;
constexpr int RING_OFF = 0, RING_BYTES = 131072;
constexpr int LDSCTL_OFF = RING_BYTES, MISC_OFF = LDSCTL_OFF + 320;
constexpr int L_PTRS = LDSCTL_OFF;
constexpr int L_TSTART = 131584;
constexpr int L_CNT = 131744;
constexpr int L_TILEE = 131872;
constexpr int L_GTAB = 133120, MAXU = 12;
constexpr int L_ULIST = L_GTAB + MAXU * 1024;
constexpr int LDS_BYTES = 147456;
static_assert(MISC_OFF + 128 <= L_TSTART && L_TILEE + MT_MAX * 4 <= L_GTAB && L_ULIST + 16 + 16 * MAXU <= LDS_BYTES, "LDS map");

#define GAS __attribute__((address_space(1)))
#define LAS __attribute__((address_space(3)))
typedef unsigned short bf16;
typedef unsigned v4u __attribute__((ext_vector_type(4)));
typedef unsigned v2u __attribute__((ext_vector_type(2)));
typedef float f32x4 __attribute__((ext_vector_type(4)));
typedef GAS unsigned gu32;
#define RLX_AGENT __ATOMIC_RELAXED, __HIP_MEMORY_SCOPE_AGENT
#define LDS_WAIT() asm volatile("s_waitcnt lgkmcnt(0)" ::: "memory")
#define VM_WAIT() asm volatile("s_waitcnt vmcnt(0)" ::: "memory")
__device__ __forceinline__ unsigned pk2(float lo, float hi) { return pg8::cvt_pk_bf16(lo, hi); }
__device__ __forceinline__ float bflo(unsigned w) { return __uint_as_float(w << 16); }
__device__ __forceinline__ float bfhi(unsigned w) { return __uint_as_float(w & 0xffff0000u); }

#define XB_TMO      128
#define XB_XCNT(j)  (256  + 64 * (j))
#define XB_XSUB(j)  (1280 + 64 * (j))
#define XB_XGEN(j)  (2304 + 64 * (j))
#define XB_TOP      3328
#define XB_TOPGEN   3392
#define XCD_BAR_WORDS 3456
#define XB_LSUB(j)  (-1024 + 64 * (j))
#define XB_LGEN(j)  (-512 + 64 * (j))
#define XB_SPIN_CAP (1u << 18)
__device__ __forceinline__ unsigned xb_ld(unsigned* p)              { return __hip_atomic_load(p, __ATOMIC_RELAXED, __HIP_MEMORY_SCOPE_AGENT); }
__device__ __forceinline__ unsigned xb_add(unsigned* p, unsigned v) { return __hip_atomic_fetch_add(p, v, __ATOMIC_RELAXED, __HIP_MEMORY_SCOPE_AGENT); }
__device__ __forceinline__ unsigned xb_xcc_id() { return (unsigned)__builtin_amdgcn_s_getreg((3 << 11) | 20) & 0xFu; }
#define XB_SPIN(cond, bar) do { unsigned _sp = 0; while (cond) { __builtin_amdgcn_s_sleep(1); \
    if ((++_sp & 255u) == 0u) { if (xb_ld(&(bar)[XB_TMO])) break; if (_sp > XB_SPIN_CAP) { atomicAdd(&(bar)[XB_TMO], 1u); break; } } } } while (0)
struct XcdBarrier { unsigned* bar; unsigned x; volatile LAS unsigned* st; };
__device__ __forceinline__ XcdBarrier xcd_barrier_post(unsigned* bar, volatile LAS unsigned* st) {
    XcdBarrier b; b.bar = bar; b.x = xb_xcc_id(); b.st = st;
    if (threadIdx.x == 0) st[3] = xb_add(&bar[XB_XCNT(b.x)], 1u);
    return b;
}
__device__ __forceinline__ void xcd_barrier_complete(unsigned* bar, unsigned x, unsigned& nloc, unsigned& nx, unsigned& even) {
    const unsigned G = gridDim.x * gridDim.y * gridDim.z;
    unsigned sum, cnt, mine, sp = 0u;
    for (;;) {
        sum = 0u; cnt = 0u; mine = 0u; even = (G == 256u) ? 1u : 0u;
#pragma unroll
        for (unsigned j = 0; j < 16; ++j) { const unsigned c = xb_ld(&bar[XB_XCNT(j)]); sum += c; cnt += (c > 0u) ? 1u : 0u; mine = (j == x) ? c : mine; even = (c == (j < 8u ? 32u : 0u)) ? even : 0u; }
        if (sum == G) break;
        __builtin_amdgcn_s_sleep(1);
        if ((++sp & 255u) == 0u) { if (xb_ld(&bar[XB_TMO])) break; if (sp > XB_SPIN_CAP) { atomicAdd(&bar[XB_TMO], 1u); break; } }
    }
    nloc = mine > 0u ? mine : 1u; nx = cnt > 0u ? cnt : 1u;
}
__device__ __forceinline__ void xcd_barrier(const XcdBarrier& b) {
    asm volatile("s_waitcnt vmcnt(0)" ::: "memory");
    __syncthreads();
    if (threadIdx.x == 0) {
        unsigned* bar = b.bar;
        __builtin_amdgcn_s_waitcnt(0);
        unsigned nloc = b.st[0], nx = b.st[1];
        if (nloc == 0u) { unsigned even; xcd_barrier_complete(bar, b.x, nloc, nx, even); b.st[0] = nloc; b.st[1] = nx; b.st[2] = 1u + even; }
        const unsigned old = xb_add(&bar[XB_XSUB(b.x)], 1u);
        const unsigned gen = old / nloc;
        if (old + 1u == (gen + 1u) * nloc) {
            __builtin_amdgcn_fence(__ATOMIC_RELEASE, "agent");
            asm volatile("s_waitcnt vmcnt(0)" ::: "memory");
            const unsigned og = xb_add(&bar[XB_TOP], 1u);
            const unsigned tg = og / nx;
            if (og + 1u == (tg + 1u) * nx) xb_add(&bar[XB_TOPGEN], 1u);
            else XB_SPIN(xb_ld(&bar[XB_TOPGEN]) == tg, bar);
            __builtin_amdgcn_fence(__ATOMIC_ACQUIRE, "agent");
            xb_add(&bar[XB_XGEN(b.x)], 1u);
            asm volatile("s_waitcnt vmcnt(0)" ::: "memory");
        } else {
            XB_SPIN(xb_ld(&bar[XB_XGEN(b.x)]) == gen, bar);
            __builtin_amdgcn_fence(__ATOMIC_ACQUIRE, "agent");
            asm volatile("s_waitcnt vmcnt(0)" ::: "memory");
        }
    }
    __syncthreads();
}

__device__ __forceinline__ void xcc_local_barrier(const XcdBarrier& b) {
    asm volatile("s_waitcnt vmcnt(0)" ::: "memory");
    __syncthreads();
    if (threadIdx.x == 0) {
        unsigned* bar = b.bar;
        __builtin_amdgcn_s_waitcnt(0);
        const unsigned old = xb_add(&bar[XB_LSUB((int)b.x)], 1u);
        const unsigned gen = old >> 5;
        if (old + 1u == (gen + 1u) << 5) xb_add(&bar[XB_LGEN((int)b.x)], 1u);
        else XB_SPIN(xb_ld(&bar[XB_LGEN((int)b.x)]) == gen, bar);
        __builtin_amdgcn_fence(__ATOMIC_ACQUIRE, "agent");
        asm volatile("s_waitcnt vmcnt(0)" ::: "memory");
    }
    __syncthreads();
}

struct Frame {
    LAS unsigned char* lds;
    volatile LAS unsigned* MISC;
    gu32* ctl;
    int tid, lane, wave;
    int vcu, G, vb;
    unsigned char* ws;
};
__device__ __forceinline__ const void* inp(const Frame& F, int i) {
    const LAS unsigned* p = (const LAS unsigned*)(F.lds + L_PTRS) + 2 * i;
    const unsigned lo = __builtin_amdgcn_readfirstlane(p[0]), hi = __builtin_amdgcn_readfirstlane(p[1]);
    return (const void*)(const GAS char*)(((unsigned long long)hi << 32) | lo);
}
template <int CTRL> __device__ __forceinline__ float dpp_f(float v) { return __builtin_bit_cast(float, __builtin_amdgcn_update_dpp(0, __builtin_bit_cast(int, v), CTRL, 0xf, 0xf, false)); }
#define XSUM16(v) do { const auto r_ = __builtin_amdgcn_permlane16_swap(__float_as_uint(v), __float_as_uint(v), false, false); v = __uint_as_float(r_[0]) + __uint_as_float(r_[1]); } while (0)
#define XSUM32(v) do { const auto r_ = __builtin_amdgcn_permlane32_swap(__float_as_uint(v), __float_as_uint(v), false, false); v = __uint_as_float(r_[0]) + __uint_as_float(r_[1]); } while (0)
#define XMAX16(v) do { const auto r_ = __builtin_amdgcn_permlane16_swap(__float_as_uint(v), __float_as_uint(v), false, false); v = fmaxf(__uint_as_float(r_[0]), __uint_as_float(r_[1])); } while (0)
__device__ __forceinline__ float sum8(float v) { v += dpp_f<0xB1>(v); v += dpp_f<0x4E>(v); v += dpp_f<0x141>(v); return v; }
__device__ __forceinline__ float wave_sum(float v) {
    v = sum8(v); v += dpp_f<0x140>(v);
    XSUM16(v); XSUM32(v);
    return v;
}
__device__ __forceinline__ float max32(float v) {
    v = fmaxf(v, dpp_f<0xB1>(v)); v = fmaxf(v, dpp_f<0x4E>(v)); v = fmaxf(v, dpp_f<0x141>(v)); v = fmaxf(v, dpp_f<0x140>(v));
    XMAX16(v); return v;
}

template <class RowFn>
__device__ __forceinline__ void tr_item(const float* W, int ldw, int k0, int n0, bf16* dst, int ldk, int kd0, RowFn drow, LAS bf16* scr, int lane, bool zero) {
    const int c4 = lane & 15, kr = lane >> 4;
    if (!zero) {
        f32x4 v[16];
#pragma unroll
        for (int s = 0; s < 16; ++s) v[s] = *(const GAS f32x4*)(W + (size_t)(k0 + kr + 4 * s) * ldw + n0 + 4 * c4);
#pragma unroll
        for (int s = 0; s < 16; ++s) { const int kk = kr + 4 * s; const unsigned lo = pk2(v[s][0], v[s][1]), hi = pk2(v[s][2], v[s][3]);
            scr[(4 * c4 + 0) * 66 + kk] = (bf16)(lo & 0xffff); scr[(4 * c4 + 1) * 66 + kk] = (bf16)(lo >> 16); scr[(4 * c4 + 2) * 66 + kk] = (bf16)(hi & 0xffff); scr[(4 * c4 + 3) * 66 + kk] = (bf16)(hi >> 16); }
        LDS_WAIT(); asm volatile("" ::: "memory");
    }
    const int ch = lane & 7;
#pragma unroll
    for (int j = 0; j < 8; ++j) { const int nn = (lane >> 3) + 8 * j; v4u o = {0u, 0u, 0u, 0u};
        if (!zero) { const LAS unsigned* sp = (const LAS unsigned*)(scr + nn * 66 + 8 * ch); o.x = sp[0]; o.y = sp[1]; o.z = sp[2]; o.w = sp[3]; }
        *(GAS v4u*)(dst + (size_t)drow(nn) * ldk + kd0 + 8 * ch) = o; }
    LDS_WAIT(); asm volatile("" ::: "memory");
}

template <class RowFn>
__device__ __forceinline__ void tr_item_fp8(const float* W, int ldw, int k0, int n0, unsigned char* dst, int ldk, int kd0, RowFn drow, LAS unsigned char* scr, int lane) {
    const int c4 = lane & 15, kr = lane >> 4;
    f32x4 v[4][4];
#pragma unroll
    for (int s = 0; s < 4; ++s)
#pragma unroll
        for (int j = 0; j < 4; ++j) v[s][j] = *(const GAS f32x4*)(W + (size_t)(k0 + 16 * s + 4 * kr + j) * ldw + n0 + 4 * c4);
#pragma unroll
    for (int s = 0; s < 4; ++s)
#pragma unroll
        for (int x = 0; x < 4; ++x) { int w = 0; w = __builtin_amdgcn_cvt_pk_fp8_f32(v[s][0][x] * pg8::W8_SCALE, v[s][1][x] * pg8::W8_SCALE, w, false); w = __builtin_amdgcn_cvt_pk_fp8_f32(v[s][2][x] * pg8::W8_SCALE, v[s][3][x] * pg8::W8_SCALE, w, true);
            *(LAS unsigned*)(scr + (4 * c4 + x) * 68 + 16 * s + 4 * kr) = (unsigned)w; }
    LDS_WAIT(); asm volatile("" ::: "memory");
    const int ch = lane & 3;
#pragma unroll
    for (int j = 0; j < 4; ++j) { const int nn = (lane >> 2) + 16 * j; const LAS unsigned* sp = (const LAS unsigned*)(scr + nn * 68 + 16 * ch); v4u o; o.x = sp[0]; o.y = sp[1]; o.z = sp[2]; o.w = sp[3];
        *(GAS v4u*)(dst + (size_t)drow(nn) * ldk + kd0 + 16 * ch) = o; }
    LDS_WAIT(); asm volatile("" ::: "memory");
}

struct CItem { const float* src; unsigned char* dst; int ldw, ldk, base, mode; };
__device__ __forceinline__ CItem conv_item(const float* w_exp1, const float* w_exp2, unsigned char* ws, int r) {
    constexpr int I_2 = NE * 16 * 16;
    CItem it;
    if (r >= I_2) { r -= I_2; const int e = r / 512, rr = r % 512, kb = rr / 32, nb = rr % 32, n0 = nb * 64, j2 = n0 >> 1, pn = j2 >> 7, j = j2 & 127;
        it.src = w_exp1 + (size_t)e * D * 2 * FF + (size_t)(kb * 64) * (2 * FF) + n0; it.ldw = 2 * FF; it.dst = ws + WS_W1 + (size_t)e * 2 * FF * D + kb * 64; it.ldk = D; it.base = 256 * pn + j; it.mode = 1; }
    else { const int e = r / 256, rr = r % 256, kb = rr / 16, nb = rr % 16;
        it.src = w_exp2 + (size_t)e * FF * D + (size_t)(kb * 64) * D + nb * 64; it.ldw = D; it.dst = ws + WS_W2 + (size_t)e * D * FF + kb * 64; it.ldk = FF; it.base = nb * 64; it.mode = 0; }
    return it;
}
__device__ __forceinline__ void conv_load(const CItem& it, f32x4 (&v)[4][4], int lane) {
    const int c4 = lane & 15, kr = lane >> 4;
#pragma unroll
    for (int s = 0; s < 4; ++s)
#pragma unroll
        for (int j = 0; j < 4; ++j) v[s][j] = __builtin_nontemporal_load((const GAS f32x4*)(it.src + (size_t)(16 * s + 4 * kr + j) * it.ldw + 4 * c4));
}
__device__ __forceinline__ void conv_store(const CItem& it, const f32x4 (&v)[4][4], LAS unsigned char* scr, int lane) {
    const int c4 = lane & 15, kr = lane >> 4;
#pragma unroll
    for (int s = 0; s < 4; ++s)
#pragma unroll
        for (int x = 0; x < 4; ++x) { int w = 0; w = __builtin_amdgcn_cvt_pk_fp8_f32(v[s][0][x] * pg8::W8_SCALE, v[s][1][x] * pg8::W8_SCALE, w, false); w = __builtin_amdgcn_cvt_pk_fp8_f32(v[s][2][x] * pg8::W8_SCALE, v[s][3][x] * pg8::W8_SCALE, w, true);
            *(LAS unsigned*)(scr + (4 * c4 + x) * 68 + 16 * s + 4 * kr) = (unsigned)w; }
    LDS_WAIT(); asm volatile("" ::: "memory");
    const int ch = lane & 3;
#pragma unroll
    for (int j = 0; j < 4; ++j) { const int nn = (lane >> 2) + 16 * j; const LAS unsigned* sp = (const LAS unsigned*)(scr + nn * 68 + 16 * ch); v4u o; o.x = sp[0]; o.y = sp[1]; o.z = sp[2]; o.w = sp[3];
        const int row = it.mode ? it.base + 128 * (nn & 1) + (nn >> 1) : it.base + nn;
        *(GAS v4u*)(it.dst + (size_t)row * it.ldk + 16 * ch) = o; }
    LDS_WAIT(); asm volatile("" ::: "memory");
}
__device__ __forceinline__ void conv_expert_items(Frame& F, int first, int count, int k, int n, int part, int nparts, LAS unsigned char* scr) {
    const float* const w_exp1_ = (const float*)inp(F, 21); const float* const w_exp2_ = (const float*)inp(F, 23);
    const int ipw = (count + n - 1) / n, base = k * ipw, own = (ipw - F.wave + 7) / 8;
    const int j0 = own * part / nparts, j1 = own * (part + 1) / nparts;
    int lane = F.lane; asm volatile("" : "+v"(lane));
    int jj = j0;
    for (; jj + 1 < j1; jj += 2) {
        const int r0 = base + F.wave + 8 * jj, r1 = r0 + 8; if (r1 >= count) break;
        const CItem a = conv_item(w_exp1_, w_exp2_, F.ws, first + r0), b = conv_item(w_exp1_, w_exp2_, F.ws, first + r1);
        f32x4 va[4][4], vb[4][4]; conv_load(a, va, lane); conv_load(b, vb, lane); conv_store(a, va, scr, lane); conv_store(b, vb, scr, lane);
    }
    for (; jj < j1; ++jj) {
        const int r0 = base + F.wave + 8 * jj; if (r0 >= count) break;
        const CItem a = conv_item(w_exp1_, w_exp2_, F.ws, first + r0); f32x4 va[4][4]; conv_load(a, va, lane); conv_store(a, va, scr, lane);
    }
}
__device__ __forceinline__ void conv_in_idle_round(Frame& F, int nwg, int first, int count) {
    const int r = nwg % F.G, c = F.vb;
    if (r != 0 && c < r) return;
    conv_expert_items(F, first, count, r ? c - r : c, r ? F.G - r : F.G, 0, 1, F.lds + RING_OFF + F.wave * 4352);
}
constexpr int CONV_W2_IN_P2 = 5120, CONV_W2_ALL = NE * 16 * 16, CONV_ALL = NE * 16 * 16 + NE * 16 * 32;
__device__ __forceinline__ void p0_prologue(Frame& F) {
    const float* const c_ = (const float*)inp(F, 1); const float* const w_ada_ = (const float*)inp(F, 3); const float* const b_ada_ = (const float*)inp(F, 4); float* const mod_ = (float*)(F.ws + WS_MOD); const int* const positions_ = (const int*)inp(F, 2); float* const rope_ = (float*)(F.ws + WS_ROPE); const float* const lq1_ = (const float*)inp(F, 7); const float* const lk1_ = (const float*)inp(F, 8); const float* const lq2_ = (const float*)inp(F, 9); const float* const lk2_ = (const float*)inp(F, 10); float* const lam_ = (float*)(F.ws + WS_MOD + 256 * 1024); const float* const w_exp1_ = (const float*)inp(F, 21); bf16* const W1_t_ = (bf16*)(F.ws + WS_W1); const float* const w_exp2_ = (const float*)inp(F, 23); bf16* const W2_t_ = (bf16*)(F.ws + WS_W2); const float* const w_in_ = (const float*)inp(F, 6); bf16* const Win_t_ = (bf16*)(F.ws + WS_WIN); const float* const w_proj_a_ = (const float*)inp(F, 14); bf16* const Wa_t_ = (bf16*)(F.ws + WS_WA); const float* const w_proj_b_ = (const float*)inp(F, 15); bf16* const Wb_t_ = (bf16*)(F.ws + WS_WB); const float* const w_pool_ = (const float*)inp(F, 12); const float* const pool_scale_ = (const float*)inp(F, 13); bf16* const Wpool_t_ = (bf16*)(F.ws + WS_WPOOL); const float* const w_out_ = (const float*)inp(F, 16); bf16* const Wout_t_ = (bf16*)(F.ws + WS_WOUT);
    {
        LAS float* sc = (LAS float*)(F.lds + RING_OFF);
        LAS float* red = (LAS float*)(F.lds + RING_OFF + 32768);
        bool staged = false;
        for (int it = blockIdx.x; it < 96; it += F.G) {
            if (!staged) { for (int i = F.tid; i < NB * D; i += NWAVES * 64) { const int b = i >> 10, kk = i & 1023; const float v = c_[i]; sc[kk * 8 + b] = v / (1.f + __expf(-v)); } __syncthreads(); staged = true; }
            const int j0 = it * 64, cg = F.lane & 15, kq = F.lane >> 4;
            float acc[8][4];
#pragma unroll
            for (int b = 0; b < 8; ++b)
#pragma unroll
                for (int xx = 0; xx < 4; ++xx) acc[b][xx] = 0.f;
#pragma unroll 8
            for (int s = 0; s < 32; ++s) { const int kk = 32 * s + 4 * F.wave + kq;
                const f32x4 w = *(const GAS f32x4*)(w_ada_ + (size_t)kk * (NMOD * D) + j0 + 4 * cg);
                const f32x4 s0 = *(const LAS f32x4*)(sc + kk * 8), s1 = *(const LAS f32x4*)(sc + kk * 8 + 4);
#pragma unroll
                for (int xx = 0; xx < 4; ++xx) { acc[0][xx] += s0[0] * w[xx]; acc[1][xx] += s0[1] * w[xx]; acc[2][xx] += s0[2] * w[xx]; acc[3][xx] += s0[3] * w[xx];
                    acc[4][xx] += s1[0] * w[xx]; acc[5][xx] += s1[1] * w[xx]; acc[6][xx] += s1[2] * w[xx]; acc[7][xx] += s1[3] * w[xx]; } }
#pragma unroll
            for (int b = 0; b < 8; ++b)
#pragma unroll
                for (int xx = 0; xx < 4; ++xx) { float a = acc[b][xx]; a += __shfl_xor(a, 16); a += __shfl_xor(a, 32); if (kq == 0) red[(F.wave * 8 + b) * 64 + 4 * cg + xx] = a; }
            __syncthreads();
            { const int b = F.tid >> 6, col = F.tid & 63; float a = b_ada_[j0 + col];
#pragma unroll
              for (int w = 0; w < 8; ++w) a += red[(w * 8 + b) * 64 + col];
              mod_[b * (NMOD * D) + j0 + col] = a; }
            __syncthreads();
        }
        if (staged) __syncthreads();
    }
    for (int idx = F.vcu * (NWAVES * 64) + F.tid; idx < T * 8; idx += F.G * NWAVES * 64) { const int t = idx >> 3, i = idx & 7; float cs, sn; rope_cs(positions_[t], i, cs, sn); rope_[t * 16 + i] = cs; rope_[t * 16 + 8 + i] = sn; }
    if (blockIdx.x == 0 && F.wave == 0) { const float s1 = wave_sum(lq1_[F.lane] * lk1_[F.lane]), s2 = wave_sum(lq2_[F.lane] * lk2_[F.lane]); if (F.lane == 0) lam_[0] = expf(s1) - expf(s2) + LAM_INIT; }
    {
        LAS bf16* scr = (LAS bf16*)(F.lds + RING_OFF + F.wave * 8448);
        const int gw = F.vcu * NWAVES + F.wave, NGW = F.G * NWAVES;
        constexpr int I_IN = 16 * (INC / 64), I_A = 16 * 16, I_O = 16 * 16;
        constexpr int NITEMS = I_IN + I_A + I_O;
        for (int it = gw; it < NITEMS; it += NGW) {
            int r = it;
            if (r < I_IN) { const int kb = r / (INC / 64), nb = r % (INC / 64);
                tr_item(w_in_, INC, kb * 64, nb * 64, Win_t_, D, kb * 64, [=](int nn) { return nb * 64 + ((nb < 32 && nn < 16) ? ((nn & 7) * 2 + (nn >> 3)) : nn); }, scr, F.lane, false); continue; } r -= I_IN;
            if (r < I_A) { const int kb = r / 16, nb = r % 16;
                tr_item(w_proj_a_, D, kb * 64, nb * 64, Wa_t_, DW, kb * 64, [=](int nn) { return nb * 64 + nn; }, scr, F.lane, false); continue; } r -= I_A;
            { const int kb = r / 16, nb = r % 16;
                tr_item(w_out_, D, kb * 64, nb * 64, Wout_t_, D, kb * 64, [=](int nn) { return nb * 64 + nn; }, scr, F.lane, false); }
        }
        const int nfree = (F.G > 96) ? F.G - 96 : F.G, myfree = (F.G > 96) ? (int)blockIdx.x - 96 : (int)blockIdx.x;
        for (int it = myfree * NWAVES + F.wave; myfree >= 0 && it < 16 * 64; it += nfree * NWAVES) {
            const int n = (it & 15) * 64 + F.lane, kk0 = (it >> 4) * 8, g = kk0 >> 7, c0 = kk0 & 127;
            const float* wp = w_pool_ + (size_t)g * 128 * 128 + (size_t)c0 * 128; const float* sc = pool_scale_ + g * 128; const float* wb = w_proj_b_ + (size_t)(g * 128) * D + n;
            float wr0[8], wr1[8];
            { const float s0 = sc[F.lane], s1 = sc[64 + F.lane];
#pragma unroll
              for (int q = 0; q < 8; ++q) { wr0[q] = wp[q * 128 + F.lane] * s0; wr1[q] = wp[q * 128 + 64 + F.lane] * s1; } }
            float acc[8];
#pragma unroll
            for (int q = 0; q < 8; ++q) acc[q] = 0.f;
#pragma unroll 1
            for (int j0 = 0; j0 < 128; j0 += 32) {
                float b[32];
#pragma unroll
                for (int u = 0; u < 32; ++u) b[u] = wb[(size_t)(j0 + u) * D];
#pragma unroll
                for (int u = 0; u < 32; ++u) { const int jx = j0 + u;
#pragma unroll
                    for (int q = 0; q < 8; ++q) { const float w = __builtin_bit_cast(float, __builtin_amdgcn_readlane(__builtin_bit_cast(int, (j0 < 64) ? wr0[q] : wr1[q]), jx & 63)); acc[q] += w * b[u]; } }
            }
            *(GAS v4u*)(Wb_t_ + (size_t)n * PW + kk0) = (v4u){pk2(acc[0], acc[1]), pk2(acc[2], acc[3]), pk2(acc[4], acc[5]), pk2(acc[6], acc[7])};
        }
    }
}

__device__ __forceinline__ void p1_norm(Frame& F) {
    const float* const g_pre_mix_ = (const float*)inp(F, 5); const float* const x_ = (const float*)inp(F, 0); float* const mod_ = (float*)(F.ws + WS_MOD); bf16* const h_ = (bf16*)(F.ws + WS_H);
    const int gw = F.vcu * NWAVES + F.wave, NGW = F.G * NWAVES;
    f32x4 gv[4];
#pragma unroll
    for (int j = 0; j < 4; ++j) gv[j] = *((const GAS f32x4*)g_pre_mix_ + F.lane + 64 * j);
    f32x4 shv[4], scv[4]; int curb = -1;
    for (int mi_ = gw; mi_ < T; mi_ += NGW) {
        const int m = ((mi_ & 2047) >> 8) * SEQ + (mi_ >> 11) * 256 + (mi_ & 255);
        const GAS f32x4* xr = (const GAS f32x4*)(x_ + (size_t)m * D) + F.lane; const float* mb = mod_ + (m / SEQ) * (NMOD * D);
        f32x4 v[4]; float s = 0.f;
#pragma unroll
        for (int j = 0; j < 4; ++j) v[j] = xr[64 * j];
        if (m / SEQ != curb) { curb = m / SEQ;
#pragma unroll
            for (int j = 0; j < 4; ++j) { shv[j] = *((const GAS f32x4*)mb + F.lane + 64 * j); scv[j] = *((const GAS f32x4*)(mb + D) + F.lane + 64 * j) + 1.f; } }
#pragma unroll
        for (int j = 0; j < 4; ++j) s += (v[j].x * v[j].x + v[j].y * v[j].y) + (v[j].z * v[j].z + v[j].w * v[j].w);
        const float r = rsqrtf(wave_sum(s) * (1.f / D) + NORM_EPS);
        GAS v2u* o8 = (GAS v2u*)(h_ + (size_t)m * D) + F.lane;
#pragma unroll
        for (int j = 0; j < 4; ++j) { const f32x4 o = v[j] * r * gv[j] * scv[j] + shv[j]; o8[64 * j] = (v2u){pk2(o.x, o.y), pk2(o.z, o.w)}; }
    }
}
__device__ __forceinline__ void p3_poold(Frame& F) {
    bf16* const u_ = (bf16*)(F.ws + WS_U); bf16* const dd_ = (bf16*)(F.ws + WS_DD);
    LAS unsigned* col = (LAS unsigned*)(F.lds + RING_OFF + F.wave * 16384);
    const int gw = F.vcu * NWAVES + F.wave, NGW = F.G * NWAVES;
    for (int it = gw; it < (T / 32) * 4; it += NGW) {
        const int g = it & 3, blk = it >> 2, t0 = blk * 32, tin0 = t0 % SEQ, w = 2 << g;
        const bf16* up = u_ + (size_t)t0 * PW + g * 128 + 2 * F.lane;
        unsigned vals[48];
#pragma unroll
        for (int r = 0; r < 48; ++r) { vals[r] = 0u; if (tin0 - 16 + r >= 0) vals[r] = *(const GAS unsigned*)(up + (ptrdiff_t)(r - 16) * PW); }
#pragma unroll
        for (int r = 0; r < 48; ++r) col[r * 64 + F.lane] = vals[r];
        LDS_WAIT(); asm volatile("" ::: "memory");
        float s0 = 0.f, s1 = 0.f;
        for (int j = 1; j <= w; ++j) { const unsigned val = col[(16 - j) * 64 + F.lane]; s0 += bflo(val); s1 += bfhi(val); }
        bf16* dp = dd_ + (size_t)t0 * PW + g * 128 + 2 * F.lane;
        for (int r = 0; r < 32; ++r) { const unsigned cur = col[(16 + r) * 64 + F.lane], old = col[(16 + r - w) * 64 + F.lane];
            s0 += bflo(cur) - bflo(old); s1 += bfhi(cur) - bfhi(old);
            const float inv = 1.f / (float)min(tin0 + r + 1, w);
            *(GAS unsigned*)(dp + (size_t)r * PW) = pk2(s0 * inv - bflo(cur), s1 * inv - bfhi(cur)); }
        LDS_WAIT(); asm volatile("" ::: "memory");
    }
}
__device__ __forceinline__ void p3_combine(Frame& F, int b, int h, int qb) {
    const float* const g_subln_ = (const float*)inp(F, 11); const float* const lam_ = (const float*)(F.ws + WS_MOD + 256 * 1024);
    const bf16* const O0_ = (const bf16*)(F.ws + WS_O0); const bf16* const O1_ = (const bf16*)(F.ws + WS_O1); bf16* const oc_ = (bf16*)(F.ws + WS_OC);
    asm volatile("s_waitcnt vmcnt(0)" ::: "memory"); __syncthreads();
    const __amdgpu_buffer_rsrc_t r0 = __builtin_amdgcn_make_buffer_rsrc((void*)O0_, 0, T * DW * 2, 0x00020000), r1 = __builtin_amdgcn_make_buffer_rsrc((void*)O1_, 0, T * DW * 2, 0x00020000);
    int lane = F.lane; asm volatile("" : "+v"(lane));
    const float lam = lam_[0];
    float gs[16];
#pragma unroll
    for (int i = 0; i < 16; ++i) gs[i] = g_subln_[16 * (lane & 7) + i] * (1.f - LAM_INIT);
#pragma unroll 2
    for (int st = 0; st < 4; ++st) {
        const int row = b * SEQ + qb * 256 + F.wave * 32 + st * 8 + (lane >> 3);
        const size_t off = (size_t)row * DW + h * 128 + 16 * (lane & 7);
        const unsigned ob = (unsigned)(off * 2);
        const v4u a0 = __builtin_amdgcn_raw_buffer_load_b128(r0, ob, 0, 16), a1 = __builtin_amdgcn_raw_buffer_load_b128(r0, ob + 16, 0, 16), b0 = __builtin_amdgcn_raw_buffer_load_b128(r1, ob, 0, 16), b1 = __builtin_amdgcn_raw_buffer_load_b128(r1, ob + 16, 0, 16);
        float v[16];
#pragma unroll
        for (int i = 0; i < 4; ++i) { v[2 * i] = bflo(a0[i]) - lam * bflo(b0[i]); v[2 * i + 1] = bfhi(a0[i]) - lam * bfhi(b0[i]); v[8 + 2 * i] = bflo(a1[i]) - lam * bflo(b1[i]); v[8 + 2 * i + 1] = bfhi(a1[i]) - lam * bfhi(b1[i]); }
        float ss = 0.f;
#pragma unroll
        for (int i = 0; i < 16; ++i) ss += v[i] * v[i];
        ss = sum8(ss);
        const float r = rsqrtf(ss * (1.f / 128.f) + SUBLN_EPS);
        v4u o0, o1;
#pragma unroll
        for (int i = 0; i < 4; ++i) { o0[i] = pk2(v[2 * i] * r * gs[2 * i], v[2 * i + 1] * r * gs[2 * i + 1]); o1[i] = pk2(v[8 + 2 * i] * r * gs[8 + 2 * i], v[9 + 2 * i] * r * gs[9 + 2 * i]); }
        *(GAS v4u*)(oc_ + off) = o0; *(GAS v4u*)(oc_ + off + 8) = o1;
    }
}
__device__ __forceinline__ void p7_router(Frame& F, const int npass) {
    const float* const w_router_ = (const float*)inp(F, 19); const float* const b_router_ = (const float*)inp(F, 20); float* const mod_ = (float*)(F.ws + WS_MOD); float* const mx_ = (float*)(F.ws + WS_MX); const float* const x_ = (const float*)inp(F, 0); const float* const g_post_mix_ = (const float*)inp(F, 17); float* const out_ = (float*)inp(F, 26); const float* const g_pre_ffn_ = (const float*)inp(F, 18); bf16* const h2_ = (bf16*)(F.ws + WS_H2); int* const list_ = (int*)(F.ws + WS_LIST); unsigned* const tokslot_ = (unsigned*)(F.ws + WS_TOK); float* const tokw_ = (float*)(F.ws + WS_TOK + 256 * 1024);
    constexpr int HP = 2064;
    LAS unsigned char* hhi = F.lds + RING_OFF; LAS unsigned char* hlo = F.lds + RING_OFF + 16 * HP;
    LAS float* part = (LAS float*)(F.lds + RING_OFF + 66048);
    LAS unsigned* sel = (LAS unsigned*)(F.lds + RING_OFF + 98304);
    LAS float* selw = (LAS float*)(F.lds + RING_OFF + 98304 + 2048);
    LAS int* selt = (LAS int*)(F.lds + RING_OFF + 98304 + 4096);
    LAS unsigned* lcnt = (LAS unsigned*)(F.lds + RING_OFF + 98304 + 4608);
    if (F.tid < 64) lcnt[F.tid] = 0u;
    const int e = F.lane & 31;
    pg8::bf16x8 bhi[4][2], blo[4][2];
#pragma unroll
    for (int ks = 0; ks < 4; ++ks)
#pragma unroll
        for (int nb2 = 0; nb2 < 2; ++nb2) { unsigned hh[4], ll[4];
#pragma unroll
            for (int jp = 0; jp < 4; ++jp) { const size_t k0 = (size_t)(128 * F.wave + 32 * ks + 8 * (F.lane >> 4) + 2 * jp); const float w0 = w_router_[k0 * NE + 16 * nb2 + (F.lane & 15)], w1 = w_router_[(k0 + 1) * NE + 16 * nb2 + (F.lane & 15)];
                hh[jp] = pk2(w0, w1); ll[jp] = pk2(w0 - bflo(hh[jp]), w1 - bfhi(hh[jp])); }
            bhi[ks][nb2] = __builtin_bit_cast(pg8::bf16x8, (v4u){hh[0], hh[1], hh[2], hh[3]}); blo[ks][nb2] = __builtin_bit_cast(pg8::bf16x8, (v4u){ll[0], ll[1], ll[2], ll[3]}); }
    const float bre = b_router_[e];
    __syncthreads();
    int nb = 0;
    for (int pass = 0; pass < npass; ++pass) {
    if (pass > 0) { __syncthreads(); if (F.tid < 64) lcnt[F.tid] = 0u; __syncthreads(); }
    nb = 0;
    for (int bi = F.vcu; bi < T / 16; bi += F.G, ++nb) {
        const int bt = ((bi & 255) >> 5) * (SEQ / 16) + (bi >> 8) * 32 + (bi & 31);
        {
            const int t0 = bt * 16 + 2 * F.wave; const float* mb = mod_ + (t0 / SEQ) * (NMOD * D);
            f32x4 mv[2][4], xv[2][4];
#pragma unroll
            for (int rr = 0; rr < 2; ++rr)
#pragma unroll
                for (int j = 0; j < 4; ++j) { { const v2u mw = *((const GAS v2u*)((const bf16*)mx_ + (size_t)(t0 + rr) * D) + F.lane + 64 * j); mv[rr][j] = (f32x4){bflo(mw.x), bfhi(mw.x), bflo(mw.y), bfhi(mw.y)}; } xv[rr][j] = *((const GAS f32x4*)(x_ + (size_t)(t0 + rr) * D) + F.lane + 64 * j); }
#pragma unroll
            for (int rr = 0; rr < 2; ++rr) {
                const int r = 2 * F.wave + rr, t = t0 + rr; float s = 0.f;
#pragma unroll
                for (int j = 0; j < 4; ++j) s += (mv[rr][j].x * mv[rr][j].x + mv[rr][j].y * mv[rr][j].y) + (mv[rr][j].z * mv[rr][j].z + mv[rr][j].w * mv[rr][j].w);
                float rs = rsqrtf(wave_sum(s) * (1.f / D) + NORM_EPS); s = 0.f;
#pragma unroll
                for (int j = 0; j < 4; ++j) { const f32x4 gp = *((const GAS f32x4*)g_post_mix_ + F.lane + 64 * j), gt = *((const GAS f32x4*)(mb + 2 * D) + F.lane + 64 * j);
                    xv[rr][j] = xv[rr][j] + gt * (mv[rr][j] * rs * gp); *((GAS v2u*)(F.ws + WS_X1 + (size_t)t * D * 2) + F.lane + 64 * j) = (v2u){pk2(xv[rr][j].x, xv[rr][j].y), pk2(xv[rr][j].z, xv[rr][j].w)};     s += (xv[rr][j].x * xv[rr][j].x + xv[rr][j].y * xv[rr][j].y) + (xv[rr][j].z * xv[rr][j].z + xv[rr][j].w * xv[rr][j].w); }
                rs = rsqrtf(wave_sum(s) * (1.f / D) + NORM_EPS);
#pragma unroll
                for (int j = 0; j < 4; ++j) { const f32x4 gq = *((const GAS f32x4*)g_pre_ffn_ + F.lane + 64 * j), sh = *((const GAS f32x4*)(mb + 3 * D) + F.lane + 64 * j), sc = *((const GAS f32x4*)(mb + 4 * D) + F.lane + 64 * j);
                    const f32x4 hv = xv[rr][j] * rs * gq * (sc + 1.f) + sh;
                    if (!MK_SINGLE) *((GAS v2u*)(h2_ + (size_t)t * D) + F.lane + 64 * j) = (v2u){pk2(hv.x, hv.y), pk2(hv.z, hv.w)};
                    { int w8 = 0; w8 = __builtin_amdgcn_cvt_pk_fp8_f32(hv.x, hv.y, w8, false); w8 = __builtin_amdgcn_cvt_pk_fp8_f32(hv.z, hv.w, w8, true); *((GAS unsigned*)(F.ws + WS_H2F + (size_t)t * D) + F.lane + 64 * j) = (unsigned)w8; }
                    { const unsigned h0 = pk2(hv.x, hv.y), h1 = pk2(hv.z, hv.w); *(LAS v2u*)(hhi + r * HP + 8 * (F.lane + 64 * j)) = (v2u){h0, h1};
                      *(LAS v2u*)(hlo + r * HP + 8 * (F.lane + 64 * j)) = (v2u){pk2(hv.x - bflo(h0), hv.y - bfhi(h0)), pk2(hv.z - bflo(h1), hv.w - bfhi(h1))}; } }
            }
        }
        __syncthreads();
        { pg8::f32x4 acc2[2] = {{0.f, 0.f, 0.f, 0.f}, {0.f, 0.f, 0.f, 0.f}};
#pragma unroll
          for (int ks = 0; ks < 4; ++ks) { const int ao = (F.lane & 15) * HP + 2 * (128 * F.wave + 32 * ks + 8 * (F.lane >> 4));
              const pg8::bf16x8 ahi = *(const LAS pg8::bf16x8*)(hhi + ao), alo = *(const LAS pg8::bf16x8*)(hlo + ao);
#pragma unroll
              for (int nb2 = 0; nb2 < 2; ++nb2) { acc2[nb2] = __builtin_amdgcn_mfma_f32_16x16x32_bf16(ahi, bhi[ks][nb2], acc2[nb2], 0, 0, 0); acc2[nb2] = __builtin_amdgcn_mfma_f32_16x16x32_bf16(ahi, blo[ks][nb2], acc2[nb2], 0, 0, 0);
                  acc2[nb2] = __builtin_amdgcn_mfma_f32_16x16x32_bf16(alo, bhi[ks][nb2], acc2[nb2], 0, 0, 0); } }
#pragma unroll
          for (int nb2 = 0; nb2 < 2; ++nb2)
#pragma unroll
              for (int i2 = 0; i2 < 4; ++i2) part[(F.wave * 16 + 4 * (F.lane >> 4) + i2) * 32 + 16 * nb2 + (F.lane & 15)] = acc2[nb2][i2]; }
        __syncthreads();
        {
            const int r = 2 * F.wave + (F.lane >> 5), t = bt * 16 + r; float lg = bre;
#pragma unroll
            for (int w = 0; w < 8; ++w) lg += part[(w * 16 + r) * 32 + e];
            float val = lg, tv[4]; int ti[4];
#pragma unroll
            for (int kk = 0; kk < 4; ++kk) { const float m = max32(val);
                const unsigned long long bal = __ballot(val == m); const unsigned hb = (F.lane >> 5) ? (unsigned)(bal >> 32) : (unsigned)bal; const int idx = __builtin_ctz(hb);
                tv[kk] = m; ti[kk] = idx; if (e == idx) val = -INFINITY; }
            if (e == 0) { float pw[4], den = 0.f;
#pragma unroll
                for (int kk = 0; kk < 4; ++kk) { pw[kk] = __expf(tv[kk] - tv[0]); den += pw[kk]; }
                const float inv = 1.f / den; const int lr = nb * 16 + r; selt[lr] = t;
#pragma unroll
                for (int kk = 0; kk < 4; ++kk) { const unsigned lp = __hip_atomic_fetch_add(lcnt + ti[kk], 1u, __ATOMIC_RELAXED, __HIP_MEMORY_SCOPE_WORKGROUP); sel[lr * 4 + kk] = ((unsigned)ti[kk] << 16) | lp; selw[lr * 4 + kk] = pw[kk] * inv; } }
        }
    }
    }
    __syncthreads();
    if (PROBE_DUP == 77) { if (F.tid < NE) lcnt[32 + F.tid] = __hip_atomic_fetch_add((unsigned*)(F.ctl + CW_CNT + 64 * F.tid), 0u, RLX_AGENT); __syncthreads(); }
    if (F.tid < NE) lcnt[32 + F.tid] = __hip_atomic_fetch_add((unsigned*)(F.ctl + CW_CNT + 64 * F.tid), lcnt[F.tid], RLX_AGENT);
    __syncthreads();
    for (int s = F.tid; s < nb * 64; s += NWAVES * 64) { const unsigned sv = sel[s]; const int ee = sv >> 16; const unsigned pos = lcnt[32 + ee] + (sv & 0xffffu); const int t = selt[s >> 2];
        list_[ee * T + pos] = t; tokslot_[t * 4 + (s & 3)] = ((unsigned)ee << 16) | pos; tokw_[t * 4 + (s & 3)] = selw[s]; }
    __syncthreads();
}
__device__ __forceinline__ void moe_tables(Frame& F) {

    LAS int* tstart = (LAS int*)(F.lds + L_TSTART); LAS int* cntl = (LAS int*)(F.lds + L_CNT); LAS int* tile_e = (LAS int*)(F.lds + L_TILEE);
    if (F.tid < NE) cntl[F.tid] = (int)__hip_atomic_load((unsigned*)(F.ctl + CW_CNT + 64 * F.tid), RLX_AGENT);
    __syncthreads();
    if (F.tid == 0) { int s = 0; for (int e = 0; e < NE; ++e) { tstart[e] = s; s += (cntl[e] + 255) >> 8; } tstart[NE] = s; }
    __syncthreads();
    for (int pm = F.tid; pm < MT_MAX; pm += NWAVES * 64) { int e = 0;
#pragma unroll
        for (int j = 1; j < NE; ++j) e += (pm >= tstart[j]) ? 1 : 0;
        tile_e[pm] = e; }
    __syncthreads();
}
__device__ __forceinline__ void p10_final(Frame& F, const bool dry) {
    const float* const g_post_ffn_ = (const float*)inp(F, 25); const unsigned* const tokslot_ = (const unsigned*)(F.ws + WS_TOK); const float* const tokw_ = (const float*)(F.ws + WS_TOK + 256 * 1024);
    const unsigned char* const ye_ = (const unsigned char*)(F.ws + WS_YE); const float* const mod_ = (const float*)(F.ws + WS_MOD); float* const out_ = (float*)inp(F, 26);
    const LAS int* tstart = (const LAS int*)(F.lds + L_TSTART);
    const int gw = F.vcu * NWAVES + F.wave, NGW = F.G * NWAVES;
    f32x4 gp[4];
#pragma unroll
    for (int j = 0; j < 4; ++j) gp[j] = *((const GAS f32x4*)g_post_ffn_ + F.lane + 64 * j);
    v4u tsA, tsB; f32x4 twA, twB;
    { const int t0 = gw, tb = (gw + NGW < T) ? gw + NGW : gw; if (t0 < T) { tsA = *(const GAS v4u*)(tokslot_ + t0 * 4); tsB = *(const GAS v4u*)(tokslot_ + tb * 4); twA = *(const GAS f32x4*)(tokw_ + t0 * 4); twB = *(const GAS f32x4*)(tokw_ + tb * 4); } }
    for (int t0 = gw; t0 < T; t0 += 2 * NGW) {
        const int t1 = t0 + NGW; const bool two = t1 < T; const int tb = two ? t1 : t0;
        unsigned ya[4][4], yb[4][4];
#pragma unroll
        for (int kk = 0; kk < 4; ++kk) { const GAS unsigned* ra = (const GAS unsigned*)(ye_ + (size_t)(256 * tstart[tsA[kk] >> 16] + (tsA[kk] & 0xffff)) * D); const GAS unsigned* rb = (const GAS unsigned*)(ye_ + (size_t)(256 * tstart[tsB[kk] >> 16] + (tsB[kk] & 0xffff)) * D);
#pragma unroll
            for (int j = 0; j < 4; ++j) { ya[kk][j] = ra[F.lane + 64 * j]; yb[kk][j] = rb[F.lane + 64 * j]; } }
        v2u xa[4], xb[4];
#pragma unroll
        for (int j = 0; j < 4; ++j) { xa[j] = *((const GAS v2u*)(F.ws + WS_X1 + (size_t)t0 * D * 2) + F.lane + 64 * j); xb[j] = *((const GAS v2u*)(F.ws + WS_X1 + (size_t)tb * D * 2) + F.lane + 64 * j); }
        f32x4 gtA[4], gtB[4];
#pragma unroll
        for (int j = 0; j < 4; ++j) { gtA[j] = *((const GAS f32x4*)(mod_ + (t0 / SEQ) * (NMOD * D) + 5 * D) + F.lane + 64 * j); gtB[j] = *((const GAS f32x4*)(mod_ + (tb / SEQ) * (NMOD * D) + 5 * D) + F.lane + 64 * j); }
        const f32x4 twA0 = twA, twB0 = twB;
        { const int n0 = t0 + 2 * NGW, nb2 = (n0 + NGW < T) ? n0 + NGW : n0; if (n0 < T) { tsA = *(const GAS v4u*)(tokslot_ + n0 * 4); tsB = *(const GAS v4u*)(tokslot_ + nb2 * 4); twA = *(const GAS f32x4*)(tokw_ + n0 * 4); twB = *(const GAS f32x4*)(tokw_ + nb2 * 4); } }
#pragma unroll
        for (int rr = 0; rr < 2; ++rr) {
            if (rr == 1 && !two) break;
            const int t = rr ? t1 : t0;
            float f[16];
#pragma unroll
            for (int i = 0; i < 16; ++i) f[i] = 0.f;
#pragma unroll
            for (int kk = 0; kk < 4; ++kk) { const float ws = (rr ? twB0[kk] : twA0[kk]) * pg8::YE_INV;
#pragma unroll
                for (int j = 0; j < 4; ++j) { const int a = (int)(rr ? yb[kk][j] : ya[kk][j]); const auto lo = __builtin_amdgcn_cvt_pk_f32_fp8(a, false), hi = __builtin_amdgcn_cvt_pk_f32_fp8(a, true);
                    f[4 * j] += ws * lo[0]; f[4 * j + 1] += ws * lo[1]; f[4 * j + 2] += ws * hi[0]; f[4 * j + 3] += ws * hi[1]; } }
            float ss = 0.f;
#pragma unroll
            for (int i = 0; i < 16; ++i) ss += f[i] * f[i];
            const float r = rsqrtf(wave_sum(ss) * (1.f / D) + NORM_EPS);
            GAS f32x4* op = (GAS f32x4*)(out_ + (size_t)t * D) + F.lane;
#pragma unroll
            for (int j = 0; j < 4; ++j) { const f32x4 gt = rr ? gtB[j] : gtA[j]; const v2u xw = rr ? xb[j] : xa[j]; const f32x4 x1 = {bflo(xw.x), bfhi(xw.x), bflo(xw.y), bfhi(xw.y)};
                const f32x4 fv = {f[4 * j], f[4 * j + 1], f[4 * j + 2], f[4 * j + 3]}; if (!dry) op[64 * j] = x1 + gt * (fv * r * gp[j]); }
        }
    }
}

struct Args { const void* in[26]; float* out; unsigned char* ws; int ph_lo, ph_hi; };
__global__ void __launch_bounds__(NWAVES * 64, 2) mega_fwd(Args args) {
    extern __shared__ __attribute__((aligned(16))) unsigned char lds[];
    Frame F;
    F.lds = (LAS unsigned char*)lds;
    F.MISC = (volatile LAS unsigned*)(F.lds + MISC_OFF);
    F.tid = threadIdx.x; F.lane = F.tid & 63; F.wave = __builtin_amdgcn_readfirstlane(F.tid >> 6);
    F.G = gridDim.x; { const int bx = blockIdx.x; F.vcu = (F.G % 8 == 0) ? (bx % 8) * (F.G / 8) + bx / 8 : bx; F.vb = bx; }
    F.ws = args.ws; F.ctl = (gu32*)(args.ws + WS_CTL);
    for (int u = F.tid; u < (LDS_BYTES - LDSCTL_OFF) / 4; u += NWAVES * 64) ((LAS unsigned*)(F.lds + LDSCTL_OFF))[u] = 0u;
    __syncthreads();
    if (F.tid == 0) { LAS unsigned long long* pt = (LAS unsigned long long*)(F.lds + L_PTRS);
#define PT(i) pt[i] = (unsigned long long)args.in[i];
        PT(0) PT(1) PT(2) PT(3) PT(4) PT(5) PT(6) PT(7) PT(8) PT(9) PT(10) PT(11) PT(12) PT(13) PT(14) PT(15) PT(16) PT(17) PT(18) PT(19) PT(20) PT(21) PT(22) PT(23) PT(24) PT(25)
#undef PT
        pt[26] = (unsigned long long)args.out; }
    __syncthreads();
    const int lo = args.ph_lo, hi = args.ph_hi;
    const bool single = (hi - lo) > 1;
    XcdBarrier bar; bar.bar = (unsigned*)(F.ctl + CW_BAR); bar.x = 0; bar.st = nullptr;
    if (single) bar = xcd_barrier_post((unsigned*)(F.ctl + CW_BAR), F.MISC + 8);
#define IN(k) (lo <= (k) && (k) < hi)
#define NREP(k) ((PROBE_DUP == (k) || (PROBE_DUP == 35 && (k) == 3)) ? 2 : 1)
#define SEAM(k) do { if (IN(k) && IN((k) + 1)) { xcd_barrier(bar); if (PROBE_DUP == 100 && (k) < 5) xcd_barrier(bar); } } while (0)
#define SEAML(k) do { if (IN(k) && IN((k) + 1)) { if (grp) xcc_local_barrier(bar); else xcd_barrier(bar); } } while (0)
    bool grp = false;
    const LAS int* gtab = (const LAS int*)(F.lds + L_GTAB);
#define REFRESH() do { int t_ = (int)threadIdx.x; asm volatile("" : "+v"(t_)); F.tid = t_; F.lane = t_ & 63; } while (0)

    _Pragma("unroll") for (int allrep_ = 0; allrep_ < ((PROBE_DUP == 200) ? 2 : 1); ++allrep_) {
    if (allrep_ > 0) { xcd_barrier(bar); if (blockIdx.x == 0 && F.tid < NE) __hip_atomic_store((unsigned*)(F.ctl + CW_CNT + 64 * F.tid), 0u, RLX_AGENT); xcd_barrier(bar); }
    if (IN(0)) _Pragma("unroll") for (int rep_ = 0; rep_ < NREP(0); ++rep_) { REFRESH(); p0_prologue(F); if (NREP(0) > 1) __syncthreads(); } SEAM(0);
    if (single && allrep_ == 0) { const unsigned md = __builtin_amdgcn_readfirstlane(F.MISC[10]), rk = __builtin_amdgcn_readfirstlane(F.MISC[11]);
        if (md == 2u && PROBE_DUP != 101) { grp = true; F.vcu = (int)bar.x * 32 + (int)rk; F.vb = (int)rk * 8 + (int)bar.x; } }
    if (IN(1)) _Pragma("unroll") for (int rep_ = 0; rep_ < NREP(1); ++rep_) { REFRESH(); p1_norm(F); } SEAML(1);
    if (IN(2)) _Pragma("unroll") for (int rep_ = 0; rep_ < NREP(2); ++rep_) { REFRESH();
        pg8::Gemm g{((bf16*)(F.ws + WS_H)), ((bf16*)(F.ws + WS_WIN)), D, 0, 0}; pg8::StaticOrder S; S.init(T, INC, F.G, F.vb);
        pg8::EpiZ E{((bf16*)(F.ws + WS_Q)), ((bf16*)(F.ws + WS_K)), ((bf16*)(F.ws + WS_V)), ((bf16*)(F.ws + WS_U)), ((bf16*)(F.ws + WS_GA)), ((bf16*)(F.ws + WS_GB)), ((float*)(F.ws + WS_ROPE))};
        pg8::gemm_phase<pg8::EpiZ, pg8::StaticOrder, true, false>(F.lds + RING_OFF, g, S, E, gtab);
        if (rep_ == NREP(2) - 1) conv_in_idle_round(F, (T / 256) * (INC / 256), 0, CONV_W2_IN_P2);
    } SEAML(2);
    if (IN(3)) _Pragma("unroll") for (int rep_ = 0; rep_ < NREP(3); ++rep_) { REFRESH();
        p3_poold(F);
        __syncthreads();
        const attn_body::Combine CB{false, (const attn_body::bf16*)(F.ws + WS_O0), (attn_body::bf16*)(F.ws + WS_OC), (const float*)inp(F, 11), ((const float*)(F.ws + WS_MOD + 256 * 1024))[0], SUBLN_EPS, 1.f - LAM_INIT};
        const attn_body::AttnTensors AT{(const attn_body::bf16*)(F.ws + WS_Q), (const attn_body::bf16*)(F.ws + WS_K), (const attn_body::bf16*)(F.ws + WS_V), (attn_body::bf16*)(F.ws + WS_O0), CB};
        attn_body::attn_phase<16>((char*)lds + RING_OFF, AT, F.vcu, F.G,
            [&](int i, int nun) { if (!((PROBE_DUP == 3 || PROBE_DUP == 35) && rep_ > 0)) { conv_expert_items(F, CONV_W2_ALL, CONV_ALL - CONV_W2_ALL, F.vcu, F.G, i, nun, F.lds + RING_OFF + F.wave * 4352);
                if (PROBE_DUP == 36) { const float* w1 = (const float*)inp(F, 21); int lane = F.lane; asm volatile("" : "+v"(lane));
                    for (int q = 0; q < 2; ++q) { CItem a; a.src = w1 + (size_t)(F.wave * 64) * (2 * FF); a.ldw = 2 * FF; a.dst = F.ws + WS_Y + (size_t)(blockIdx.x * 8 + F.wave) * 65536; a.ldk = D; a.base = 0; a.mode = 0; f32x4 va[4][4]; conv_load(a, va, lane); conv_store(a, va, F.lds + RING_OFF + F.wave * 4352, lane); } }
                asm volatile("s_waitcnt lgkmcnt(0)\n\ts_barrier" ::: "memory"); } });
        __builtin_amdgcn_s_setprio(0);
    } SEAML(3);
    if (IN(5)) _Pragma("unroll") for (int rep_ = 0; rep_ < NREP(5); ++rep_) { REFRESH();
        pg8::Gemm2 g{((bf16*)(F.ws + WS_DD)), ((bf16*)(F.ws + WS_WB)), ((bf16*)(F.ws + WS_OC)), ((bf16*)(F.ws + WS_WA)), PW, DW};
        pg8::StaticOrder S; S.init(T, D, F.G, F.vb);
        pg8::EpiChain E{((const bf16*)(F.ws + WS_GA)), ((const bf16*)(F.ws + WS_GB)), ((bf16*)(F.ws + WS_MI))};
        pg8::gemm_chain2<pg8::EpiChain, pg8::StaticOrder>(F.lds + RING_OFF, g, S, E);
    } SEAML(5);
    if (IN(6)) _Pragma("unroll") for (int rep_ = 0; rep_ < NREP(6); ++rep_) { REFRESH();
        pg8::Gemm g{((bf16*)(F.ws + WS_MI)), ((bf16*)(F.ws + WS_WOUT)), D, 0, 0}; pg8::StaticOrder S; S.init(T, D, F.G, F.vb);
        pg8::EpiBf16Plain E{((bf16*)(F.ws + WS_MX))};
        pg8::gemm_phase<pg8::EpiBf16Plain, pg8::StaticOrder, true, false>(F.lds + RING_OFF, g, S, E, gtab);
    } SEAML(6);
    if (IN(7)) { REFRESH(); p7_router(F, NREP(7)); } SEAM(7);
    if (IN(8) || IN(9) || IN(10)) { REFRESH(); moe_tables(F); }
    if (IN(8)) _Pragma("unroll") for (int rep_ = 0; rep_ < NREP(8); ++rep_) { REFRESH();
        const LAS int* tstart = (const LAS int*)(F.lds + L_TSTART); const LAS int* cntl = (const LAS int*)(F.lds + L_CNT);
        { pg8::MoeOrder S0; S0.init(tstart[NE], 2 * FF, F.G, F.vb, (const LAS int*)(F.lds + L_TILEE));
          pg8::Unit un; LAS int* gt = (LAS int*)(F.lds + L_GTAB); LAS int* ul = (LAS int*)(F.lds + L_ULIST); int n = 0;
          _Pragma("unroll 1") for (int i = 0; i < MAXU && S0.next(i, un); ++i, ++n) if (F.tid == 0) { ul[4 + 4 * i] = un.pm; ul[5 + 4 * i] = un.pn; ul[6 + 4 * i] = un.e; }
          if (F.tid == 0) ul[0] = n;
          __syncthreads();
          int tokv[MAXU / 2];
#pragma unroll
          for (int j = 0; j < MAXU / 2; ++j) { const int x = F.tid + 512 * j, i = x >> 8, r = x & 255; tokv[j] = 0;
              if (i < n) { const int pm = ul[4 + 4 * i], e = ul[6 + 4 * i], pos = (pm - tstart[e]) * 256 + r; if (pos < cntl[e]) tokv[j] = ((const int*)(F.ws + WS_LIST))[e * T + pos]; } }
#pragma unroll
          for (int j = 0; j < MAXU / 2; ++j) { const int x = F.tid + 512 * j; if ((x >> 8) < n) gt[x] = tokv[j]; }
          __syncthreads(); }
        const pg8::ListOrder S{(const LAS int*)(F.lds + L_ULIST)};
        pg8::Gemm g{((bf16*)(F.ws + WS_H2F)), ((bf16*)(F.ws + WS_W1)), D / 2, 0, (size_t)2 * FF * D};
        pg8::EpiSwiglu E{(unsigned char*)(F.ws + WS_A), ((const float*)inp(F, 22))};
        pg8::gemm_phase<pg8::EpiSwiglu, pg8::ListOrder, true, true, true>(F.lds + RING_OFF, g, S, E, gtab);
        if (rep_ == NREP(8) - 1) conv_in_idle_round(F, tstart[NE] * (2 * FF / 256), CONV_W2_IN_P2, CONV_W2_ALL - CONV_W2_IN_P2);
    } SEAM(8);
    if (IN(9)) _Pragma("unroll") for (int rep_ = 0; rep_ < NREP(9); ++rep_) { REFRESH();
        const LAS int* tstart = (const LAS int*)(F.lds + L_TSTART);
        { pg8::MoeOrder S0; S0.init(tstart[NE], D, F.G, F.vb, (const LAS int*)(F.lds + L_TILEE));
          pg8::Unit un; LAS int* ul = (LAS int*)(F.lds + L_ULIST); int n = 0;
          __syncthreads();
          _Pragma("unroll 1") for (int i = 0; i < MAXU && S0.next(i, un); ++i, ++n) if (F.tid == 0) { ul[4 + 4 * i] = un.pm; ul[5 + 4 * i] = un.pn; ul[6 + 4 * i] = un.e; }
          if (F.tid == 0) ul[0] = n;
          __syncthreads(); }
        const pg8::ListOrder S{(const LAS int*)(F.lds + L_ULIST)};
        pg8::Gemm g{((bf16*)(F.ws + WS_A)), ((bf16*)(F.ws + WS_W2)), FF / 2, 0, (size_t)D * FF};
        pg8::EpiYe E{(unsigned char*)(F.ws + WS_YE), ((const float*)inp(F, 24))};
        pg8::gemm_phase<pg8::EpiYe, pg8::ListOrder, true, false, true>(F.lds + RING_OFF, g, S, E, gtab);
    } SEAM(9);
    if (IN(10)) { REFRESH(); if (NREP(10) > 1) p10_final(F, true); p10_final(F, false); }
    }
#undef IN
#undef SEAM
#undef SEAML
}
#ifndef MK_SINGLE
#define MK_SINGLE 1
#endif
#ifndef OPT_MASK
#define OPT_MASK 0x7ff
#endif
extern "C" void kernel_launch(void* const* d_in, const int* in_sizes, int n_in, void* d_out, int out_size, void* d_ws, size_t ws_size, hipStream_t stream) {
    static int grid = 0;
    if (grid == 0) {
        if (n_in != 26 || in_sizes[0] != T * D || out_size != T * D || ws_size < WS_END) { fprintf(stderr, "kernel_launch: unexpected shapes (n_in %d, in0 %d, out %d, ws %zu); nothing launched\n", n_in, n_in > 0 ? in_sizes[0] : -1, out_size, ws_size); grid = -1; return; }
        int dev = 0, cus = 0, per_cu = 0;
        if (hipGetDevice(&dev) != hipSuccess || hipDeviceGetAttribute(&cus, hipDeviceAttributeMultiprocessorCount, dev) != hipSuccess) { fprintf(stderr, "kernel_launch: device query failed\n"); grid = -1; return; }
        if (hipFuncSetAttribute((const void*)mega_fwd, hipFuncAttributeMaxDynamicSharedMemorySize, LDS_BYTES) != hipSuccess) { fprintf(stderr, "kernel_launch: hipFuncSetAttribute failed\n"); grid = -1; return; }
        if (hipOccupancyMaxActiveBlocksPerMultiprocessor(&per_cu, (const void*)mega_fwd, NWAVES * 64, LDS_BYTES) != hipSuccess || per_cu < 1) fprintf(stderr, "kernel_launch: note: occupancy query reports %d workgroups per CU\n", per_cu);
        (void)hipGetLastError();
        grid = cus;
    }
    if (grid < 0) return;
    unsigned char* ws = (unsigned char*)d_ws;
    (void)hipMemsetAsync(ws + WS_CTL, 0, CTL_ZERO_BYTES, stream);
    Args a{};
    for (int i = 0; i < 26; ++i) a.in[i] = d_in[i];
    a.out = (float*)d_out; a.ws = ws;
#if MK_SINGLE
    a.ph_lo = 0; a.ph_hi = NPHASE;
    hipLaunchKernelGGL(mega_fwd, dim3(grid), dim3(NWAVES * 64), LDS_BYTES, stream, a);
#else
    const float* x = (const float*)d_in[0]; const float* c = (const float*)d_in[1]; const int* positions = (const int*)d_in[2];
    const float* w_ada = (const float*)d_in[3]; const float* b_ada = (const float*)d_in[4]; const float* g_pre_mix = (const float*)d_in[5]; const float* w_in = (const float*)d_in[6];
    const float* lq1 = (const float*)d_in[7]; const float* lk1 = (const float*)d_in[8]; const float* lq2 = (const float*)d_in[9]; const float* lk2 = (const float*)d_in[10];
    const float* g_subln = (const float*)d_in[11]; const float* w_pool = (const float*)d_in[12]; const float* pool_scale = (const float*)d_in[13];
    const float* w_proj_a = (const float*)d_in[14]; const float* w_proj_b = (const float*)d_in[15]; const float* w_out = (const float*)d_in[16];
    const float* g_post_mix = (const float*)d_in[17]; const float* g_pre_ffn = (const float*)d_in[18]; const float* w_router = (const float*)d_in[19]; const float* b_router = (const float*)d_in[20];
    const float* w_exp1 = (const float*)d_in[21]; const float* b_exp1 = (const float*)d_in[22]; const float* w_exp2 = (const float*)d_in[23]; const float* b_exp2 = (const float*)d_in[24];
    const float* g_post_ffn = (const float*)d_in[25];
    float* out = (float*)d_out;
    using nv::bf;
    unsigned* ctl = (unsigned*)(ws + WS_CTL); unsigned* cnt = ctl + CW_CNT;
    float* mod = (float*)(ws + WS_MOD); float* lam = (float*)(ws + WS_MOD + 256 * 1024); int* tstart = (int*)(ws + WS_MOD + 260 * 1024);
    float* rope = (float*)(ws + WS_ROPE); int* list = (int*)(ws + WS_LIST); unsigned* tokslot = (unsigned*)(ws + WS_TOK); float* tokw = (float*)(ws + WS_TOK + 256 * 1024);
    bf* h = (bf*)(ws + WS_H); bf* q = (bf*)(ws + WS_Q); bf* k = (bf*)(ws + WS_K); bf* v = (bf*)(ws + WS_V); bf* u = (bf*)(ws + WS_U); bf* ga = (bf*)(ws + WS_GA); bf* gb = (bf*)(ws + WS_GB);
    bf* dd = (bf*)(ws + WS_DD); bf* O0 = (bf*)(ws + WS_O0); bf* O1 = (bf*)(ws + WS_O1); bf* oc = (bf*)(ws + WS_OC); bf* pp = (bf*)(ws + WS_PP); float* Y = (float*)(ws + WS_Y);
    bf* mi = (bf*)(ws + WS_MI); float* mx = (float*)(ws + WS_MX); bf* h2 = (bf*)(ws + WS_H2); bf* abuf = (bf*)(ws + WS_A); bf* ye = (bf*)(ws + WS_YE);
#define OPT(kk) ((OPT_MASK >> (kk)) & 1)
#define LAUNCH_OPT(kk) do { a.ph_lo = (kk); a.ph_hi = (kk) + 1; hipLaunchKernelGGL(mega_fwd, dim3(grid), dim3(NWAVES * 64), LDS_BYTES, stream, a); } while (0)
    if (OPT_MASK != 0) LAUNCH_OPT(0);
    if (!OPT(0)) { nv::k_mod<<<NB * NMOD * D / 256, 256, 0, stream>>>(c, w_ada, b_ada, lq1, lk1, lq2, lk2, mod, lam); nv::k_rope<<<T * 8 / 256, 256, 0, stream>>>(positions, rope); }
    if (OPT(1)) LAUNCH_OPT(1); else nv::k_norm1<<<T, 256, 0, stream>>>(x, g_pre_mix, mod, 0, D, h);
    if (OPT(2)) LAUNCH_OPT(2); else { nv::k_gemm<<<dim3(INC / 64, T / 64), 256, 0, stream>>>(nv::RmPlain{h, w_in, D, INC}, nv::EpZ{q, k, v, u, ga, gb}, D); nv::k_rope_apply<<<T * 1024 / 256, 256, 0, stream>>>(q, k, rope); }
    if (OPT(3)) LAUNCH_OPT(3); else { nv::k_attn<<<NB * 16 * SEQ / 4, 256, 0, stream>>>(q, k, v, O0, O1); nv::k_poold<<<T * PW / 256, 256, 0, stream>>>(u, dd); }
    if (OPT(4)) LAUNCH_OPT(4); else { nv::k_combine<<<T * NH / 4, 256, 0, stream>>>(O0, O1, lam, g_subln, oc);
        for (int g = 0; g < 4; ++g) nv::k_gemm<<<dim3(128 / 64, T / 64), 256, 0, stream>>>(nv::RmPlain{dd + g * 128, w_pool + g * 128 * 128, PW, 128}, nv::EpPool{pp, pool_scale, g, 0}, 128); }
    if (OPT(5)) LAUNCH_OPT(5); else { nv::k_gemm<<<dim3(D / 64, T / 64), 256, 0, stream>>>(nv::RmPlain{oc, w_proj_a, D, D}, nv::EpGateY{Y, ga}, DW);
        nv::k_gemm<<<dim3(D / 64, T / 64), 256, 0, stream>>>(nv::RmPlain{pp, w_proj_b, PW, D}, nv::EpGateAdd{Y, gb, mi}, PW); }
    if (OPT(6)) LAUNCH_OPT(6); else nv::k_gemm<<<dim3(D / 64, T / 64), 256, 0, stream>>>(nv::RmPlain{mi, w_out, D, D}, nv::EpF32{mx}, D);
    if (OPT(7)) LAUNCH_OPT(7); else nv::k_router<<<T / 4, 256, 0, stream>>>(x, mx, mod, g_post_mix, g_pre_ffn, w_router, b_router, out, h2, cnt, list, tokslot, tokw);
    nv::k_tstart<<<1, 64, 0, stream>>>(cnt, tstart);
    if (OPT(8)) LAUNCH_OPT(8); else nv::k_moe1<<<dim3(2 * FF / 64, MPAD / 64), 256, 0, stream>>>(nv::RmMoe{h2, tstart, cnt, list, w_exp1, (size_t)D * 2 * FF, 2 * FF, 1}, b_exp1, abuf);
    if (OPT(9)) LAUNCH_OPT(9); else nv::k_gemm<<<dim3(D / 64, MPAD / 64), 256, 0, stream>>>(nv::RmMoe{abuf, tstart, cnt, list, w_exp2, (size_t)FF * D, D, 0}, nv::EpYe{ye, b_exp2}, FF);
    if (OPT(10)) LAUNCH_OPT(10); else nv::k_final<<<T / 4, 256, 0, stream>>>(ye, tstart, tokslot, tokw, mod, g_post_ffn, out);
#endif
}
```

```cpp
#include <hip/hip_runtime.h>
#include <cstdio>
#include <cstdint>
#include <cmath>

constexpr int NB = 8, SEQ = 2048, D = 1024, T = NB * SEQ;
constexpr int NH = 8, HD = 64, VD = 128, DW = 1024, PW = 512, INC = 3 * DW + PW + 2 * D;
constexpr int NE = 32, TOPK = 4, FF = 1024, NMOD = 6;
constexpr int MPAD = TOPK * T + NE * 256, MT_MAX = MPAD / 256;
constexpr float NORM_EPS = 1e-6f, SUBLN_EPS = 1e-5f, LAM_INIT = 0.2f, SW_ALPHA = 1.702f, SW_LIMIT = 7.0f;
constexpr float QSCALE = 0.125f * 1.4426950408889634f;

constexpr size_t MiB = 1u << 20;
constexpr size_t WS_CTL = 0, CTL_ZERO_BYTES = 32768;
constexpr size_t WS_MOD = 1 * MiB;
constexpr size_t WS_ROPE = 2 * MiB;
constexpr size_t WS_LIST = 3 * MiB;
constexpr size_t WS_TOK = 5 * MiB;
constexpr size_t WS_WIN = 6 * MiB, WS_WA = 17 * MiB, WS_WB = 19 * MiB, WS_WPOOL = 20 * MiB, WS_WOUT = 21 * MiB, WS_W1 = 24 * MiB, WS_W2 = 152 * MiB;
constexpr size_t WS_H = 216 * MiB, WS_Q = 248 * MiB, WS_K = 280 * MiB, WS_V = 312 * MiB, WS_U = 344 * MiB, WS_GA = 360 * MiB, WS_GB = 392 * MiB, WS_DD = 424 * MiB;
constexpr size_t WS_O0 = 440 * MiB, WS_O1 = 472 * MiB, WS_OC = 504 * MiB, WS_PP = 536 * MiB, WS_Y = 552 * MiB, WS_MI = 616 * MiB, WS_MX = 648 * MiB, WS_X1 = 680 * MiB, WS_H2 = 712 * MiB, WS_H2F = 744 * MiB, WS_END = 760 * MiB;
constexpr size_t WS_A = 216 * MiB;
constexpr size_t WS_YE = 392 * MiB;
static_assert((size_t)MPAD * 1024 * 2 == 144 * MiB && WS_A + 144 * MiB <= WS_GA && WS_YE + 144 * MiB <= WS_PP, "overlay map");
constexpr int CW_TMO = 0, CW_CODE = 1;
constexpr int CW_CNT = 1024;
constexpr int CW_BAR = 4096;
static_assert((CW_BAR + 3456) * 4 <= (int)CTL_ZERO_BYTES && (CW_CNT + 64 * NE) * 4 <= (int)CTL_ZERO_BYTES, "control words inside the per-call memset");

__device__ __forceinline__ void rope_cs(int pos, int i, float& cs, float& sn) {
    const double invf = (i == 0) ? 1.0 : (i == 1) ? 0.19392274474868576 : (i == 2) ? 0.03760603093086393 : (i == 3) ? 0.007292664737217109 : (i == 4) ? 0.001414213562373095
                      : (i == 5) ? 0.0002742481756762073 : (i == 6) ? 5.318295896944988e-05 : 1.031338537721246e-05;
    const double ang = (double)pos * invf;
    const double qd = __builtin_rint(ang * 0.6366197723675814);
    const double r = ang - qd * 1.5707963267948966 - qd * 6.123233995736766e-17;
    const double r2 = r * r;
    const double s = r * (1.0 + r2 * (-1.0 / 6 + r2 * (1.0 / 120 + r2 * (-1.0 / 5040 + r2 * (1.0 / 362880 + r2 * (-1.0 / 39916800 + r2 * (1.0 / 6227020800.0)))))));
    const double c = 1.0 + r2 * (-0.5 + r2 * (1.0 / 24 + r2 * (-1.0 / 720 + r2 * (1.0 / 40320 + r2 * (-1.0 / 3628800 + r2 * (1.0 / 479001600.0 + r2 * (-1.0 / 87178291200.0)))))));
    const int n = (int)qd & 3;
    const double so = (n == 0) ? s : (n == 1) ? c : (n == 2) ? -s : -c;
    const double co = (n == 0) ? c : (n == 1) ? -s : (n == 2) ? -c : s;
    cs = (float)co; sn = (float)so;
}
#define MK_SINGLE 1
#define OPT_MASK 0x7ff
namespace pg8 {
#define PG8_LAS __attribute__((address_space(3)))
typedef unsigned short bf16_t;
typedef short bf16x8 __attribute__((ext_vector_type(8)));
typedef float f32x4 __attribute__((ext_vector_type(4)));
typedef unsigned u32x4 __attribute__((ext_vector_type(4)));
constexpr int BM = 256, BK = 64, HALF = 128, HTB = HALF * BK * 2  , STAGE_BYTES = 8 * HTB, NXCD = 8, WGM = 8;

__host__ __device__ __forceinline__ int lds_byte(int r, int c) { const int st = (r >> 4) * 2 + (c >> 5), rr = r & 15, cc = c & 31, ob = rr * 64 + cc * 2; return st * 1024 + (ob ^ (((ob >> 9) & 1) << 5)); }
__host__ __device__ __forceinline__ void stage_rc(int b, int& R, int& C) { const int st = b / 1024, sb = b % 1024, swz = sb ^ (((sb >> 9) & 1) << 5); R = (st >> 1) * 16 + swz / 64; C = (st & 1) * 32 + (swz % 64) / 2; }
__host__ __device__ __forceinline__ int perm32(int rho) { const int n = rho >> 4, i = rho & 15; return 8 * (i >> 2) + 4 * n + (i & 3); }

typedef int i32x8 __attribute__((ext_vector_type(8))); typedef int i32x4 __attribute__((ext_vector_type(4)));
__device__ __forceinline__ i32x8 cat8(const bf16x8 a, const bf16x8 b) { const i32x4 x = __builtin_bit_cast(i32x4, a), y = __builtin_bit_cast(i32x4, b); return __builtin_shufflevector(x, y, 0, 1, 2, 3, 4, 5, 6, 7); }
__device__ __forceinline__ void mfma_fp8(f32x4& acc, const i32x8 a, const i32x8 b) { asm volatile("v_mfma_f32_16x16x128_f8f6f4 %0, %1, %2, %0" : "+v"(acc) : "v"(a), "v"(b)); }
struct Unit { int pm, pn, e; };
struct Gemm { const bf16_t* A; const bf16_t* Bt; int K; int pad; size_t bstride; };

struct StaticOrder {
    int nM, nN, nwg, G, c;
    __device__ void init(int M, int N, int G_, int c_) { nM = M / BM; nN = N / BM; nwg = nM * nN; G = G_; c = c_; }
    __device__ bool next(int i, Unit& u) const {
        const long L = (long)i * G + c; if (L >= nwg) return false;
        int wgid = (int)L; { const int q = nwg / NXCD, r = nwg % NXCD, xcd = wgid % NXCD, off = wgid / NXCD; wgid = (xcd < r ? xcd * (q + 1) : r * (q + 1) + (xcd - r) * q) + off; }
        const int nig = WGM * nN, gid = wgid / nig, fm = gid * WGM, gsz = (nM - fm) < WGM ? (nM - fm) : WGM;
        u.pm = fm + ((wgid % nig) % gsz); u.pn = (wgid % nig) / gsz; u.e = 0; return true;
    }
};
struct MoeOrder {
    int nM, nN, nwg, G, c; const PG8_LAS int* tile_e;
    __device__ void init(int nM_, int N, int G_, int c_, const PG8_LAS int* te) { nM = nM_; nN = N / BM; nwg = nM * nN; G = G_; c = c_; tile_e = te; }
    __device__ bool next(int i, Unit& u) const {
        const long L = (long)i * G + c; if (L >= nwg) return false;
        int wgid = (int)L; { const int q = nwg / NXCD, r = nwg % NXCD, xcd = wgid % NXCD, off = wgid / NXCD; wgid = (xcd < r ? xcd * (q + 1) : r * (q + 1) + (xcd - r) * q) + off; }
        const int nig = WGM * nN, gid = wgid / nig, fm = gid * WGM, gsz = (nM - fm) < WGM ? (nM - fm) : WGM;
        u.pm = fm + ((wgid % nig) % gsz); u.pn = (wgid % nig) / gsz; u.e = tile_e[u.pm]; return true;
    }
};

struct ListOrder {
    const PG8_LAS int* ul;
    __device__ bool next(int i, Unit& u) const { if (i >= ul[0]) return false; u.pm = ul[4 + 4 * i]; u.pn = ul[5 + 4 * i]; u.e = ul[6 + 4 * i]; return true; }
};
__device__ __forceinline__ unsigned cvt_pk_bf16(float lo, float hi) { unsigned r; asm volatile("v_cvt_pk_bf16_f32 %0, %1, %2" : "=v"(r) : "v"(lo), "v"(hi)); return r; }
__device__ __forceinline__ float bflo(unsigned w) { return __uint_as_float(w << 16); }
__device__ __forceinline__ float bfhi(unsigned w) { return __uint_as_float(w & 0xffff0000u); }
__device__ __forceinline__ float sigm(float v) { return __builtin_amdgcn_rcpf(1.f + __builtin_amdgcn_exp2f(-1.4426950408889634f * v)); }
__device__ __forceinline__ u32x4 pack8(const f32x4 v0, const f32x4 v1) { u32x4 w; w.x = cvt_pk_bf16(v0[0], v0[1]); w.y = cvt_pk_bf16(v0[2], v0[3]); w.z = cvt_pk_bf16(v1[0], v1[1]); w.w = cvt_pk_bf16(v1[2], v1[3]); return w; }

typedef unsigned u32x2 __attribute__((ext_vector_type(2)));
__device__ __forceinline__ u32x2 pack8_fp8(const f32x4 v0, const f32x4 v1) { int a = 0, b = 0; a = __builtin_amdgcn_cvt_pk_fp8_f32(v0[0], v0[1], a, false); a = __builtin_amdgcn_cvt_pk_fp8_f32(v0[2], v0[3], a, true);
    b = __builtin_amdgcn_cvt_pk_fp8_f32(v1[0], v1[1], b, false); b = __builtin_amdgcn_cvt_pk_fp8_f32(v1[2], v1[3], b, true); return (u32x2){(unsigned)a, (unsigned)b}; }
constexpr float W8_SCALE = 32.f, W8_INV = 1.f / 32.f;
struct EpiZ {
    static constexpr bool PERM = true;
    bf16_t *q, *k, *v, *u, *ga, *gb; const float* rope;
    __device__ __forceinline__ void operator()(const f32x4 (&acc)[2][2][4][2], const Unit& un, int wr, int wc, int fr, int fq) const {
        const int pn = un.pn, row0 = un.pm * BM + wr * 64 + fr;
        int kind, ldc, colt; bf16_t* base;
        if (pn < 4) { kind = 0; base = q; ldc = 1024; colt = pn * 256; }
        else if (pn < 8) { kind = 1; base = k; ldc = 1024; colt = (pn - 4) * 256; }
        else if (pn < 12) { kind = 2; base = v; ldc = 1024; colt = (pn - 8) * 256; }
        else if (pn < 14) { kind = 2; base = u; ldc = 512; colt = (pn - 12) * 256; }
        else if (pn < 18) { kind = 3; base = ga; ldc = 1024; colt = (pn - 14) * 256; }
        else { kind = 3; base = gb; ldc = 1024; colt = (pn - 18) * 256; }
        const int col0 = colt + wc * 32 + 8 * fq;
        const bool ropew = (kind <= 1) && ((wc & 1) == 0);
        const bool rl = fq < 2;
#pragma unroll
        for (int ai = 0; ai < 2; ++ai)
#pragma unroll
            for (int m = 0; m < 4; ++m) {
                const int row = row0 + ai * HALF + m * 16; bf16_t* rowp = base + (size_t)row * ldc + col0;
                f32x4 cs = {1.f, 1.f, 1.f, 1.f}, sn = {0.f, 0.f, 0.f, 0.f};
                if (ropew && rl) { const f32x4* rp = (const f32x4*)(rope + (size_t)row * 16); cs = rp[fq]; sn = rp[2 + fq]; }
#pragma unroll
                for (int bj = 0; bj < 2; ++bj) {
                    f32x4 v0 = acc[ai][bj][m][0], v1 = acc[ai][bj][m][1];
                    if (ropew) {
                        const f32x4 r0 = {v0[0] * cs[0] - v0[1] * sn[0], v0[1] * cs[0] + v0[0] * sn[0], v0[2] * cs[1] - v0[3] * sn[1], v0[3] * cs[1] + v0[2] * sn[1]};
                        const f32x4 r1 = {v1[0] * cs[2] - v1[1] * sn[2], v1[1] * cs[2] + v1[0] * sn[2], v1[2] * cs[3] - v1[3] * sn[3], v1[3] * cs[3] + v1[2] * sn[3]};
                        v0 = r0; v1 = r1;
                    }
                    if (kind == 0) { v0 = v0 * QSCALE; v1 = v1 * QSCALE; }
                    if (kind == 3) {
#pragma unroll
                        for (int x = 0; x < 4; ++x) { v0[x] = sigm(v0[x]); v1[x] = sigm(v1[x]); } }
                    *(u32x4*)(rowp + bj * HALF) = pack8(v0, v1);
                }
            }
    }
};
struct EpiPool {
    static constexpr bool PERM = true;
    bf16_t* p; const float* scale;
    __device__ __forceinline__ void operator()(const f32x4 (&acc)[2][2][4][2], const Unit& un, int wr, int wc, int fr, int fq) const {
        const int row0 = un.pm * BM + wr * 64 + fr, col0 = un.pn * BM + wc * 32 + 8 * fq;
        f32x4 sv[2][2];
#pragma unroll
        for (int bj = 0; bj < 2; ++bj) { sv[bj][0] = *(const f32x4*)(scale + col0 + bj * HALF); sv[bj][1] = *(const f32x4*)(scale + col0 + bj * HALF + 4); }
#pragma unroll
        for (int ai = 0; ai < 2; ++ai)
#pragma unroll
            for (int m = 0; m < 4; ++m) { bf16_t* rowp = p + (size_t)(row0 + ai * HALF + m * 16) * PW + col0;
#pragma unroll
                for (int bj = 0; bj < 2; ++bj) *(u32x4*)(rowp + bj * HALF) = pack8(acc[ai][bj][m][0] * sv[bj][0], acc[ai][bj][m][1] * sv[bj][1]); }
    }
};
struct EpiGateY {
    static constexpr bool PERM = true;
    bf16_t* Y; const bf16_t* ga;
    __device__ __forceinline__ void operator()(const f32x4 (&acc)[2][2][4][2], const Unit& un, int wr, int wc, int fr, int fq) const {
        const int row0 = un.pm * BM + wr * 64 + fr, col0 = un.pn * BM + wc * 32 + 8 * fq;
#pragma unroll
        for (int ai = 0; ai < 2; ++ai)
#pragma unroll
            for (int m = 0; m < 4; ++m) { const size_t off = (size_t)(row0 + ai * HALF + m * 16) * D + col0;
#pragma unroll
                for (int bj = 0; bj < 2; ++bj) { const u32x4 g = *(const u32x4*)(ga + off + bj * HALF);
                    const f32x4 g0 = {bflo(g.x), bfhi(g.x), bflo(g.y), bfhi(g.y)}, g1 = {bflo(g.z), bfhi(g.z), bflo(g.w), bfhi(g.w)};
                    *(u32x4*)(Y + off + bj * HALF) = pack8(acc[ai][bj][m][0] * g0, acc[ai][bj][m][1] * g1); } }
    }
};
struct EpiGateAdd {
    static constexpr bool PERM = true;
    const bf16_t* Y; const bf16_t* gb; bf16_t* mi;
    __device__ __forceinline__ void operator()(const f32x4 (&acc)[2][2][4][2], const Unit& un, int wr, int wc, int fr, int fq) const {
        const int row0 = un.pm * BM + wr * 64 + fr, col0 = un.pn * BM + wc * 32 + 8 * fq;
#pragma unroll
        for (int ai = 0; ai < 2; ++ai)
#pragma unroll
            for (int m = 0; m < 4; ++m) { const size_t off = (size_t)(row0 + ai * HALF + m * 16) * D + col0;
#pragma unroll
                for (int bj = 0; bj < 2; ++bj) { const u32x4 g = *(const u32x4*)(gb + off + bj * HALF), y = *(const u32x4*)(Y + off + bj * HALF);
                    const f32x4 g0 = {bflo(g.x), bfhi(g.x), bflo(g.y), bfhi(g.y)}, g1 = {bflo(g.z), bfhi(g.z), bflo(g.w), bfhi(g.w)};
                    const f32x4 y0 = {bflo(y.x), bfhi(y.x), bflo(y.y), bfhi(y.y)}, y1 = {bflo(y.z), bfhi(y.z), bflo(y.w), bfhi(y.w)};
                    *(u32x4*)(mi + off + bj * HALF) = pack8(y0 + acc[ai][bj][m][0] * g0, y1 + acc[ai][bj][m][1] * g1); } }
    }
};
struct EpiChain {
    static constexpr bool PERM = true;
    const bf16_t* ga; const bf16_t* gb; bf16_t* mi;
    __device__ __forceinline__ void mid(f32x4 (&acc)[2][2][4][2], const Unit& un, int wr, int wc, int fr, int fq, const bool zero) const {
        const int row0 = un.pm * BM + wr * 64 + fr, col0 = un.pn * BM + wc * 32 + 8 * fq;
#pragma unroll
        for (int ai = 0; ai < 2; ++ai)
#pragma unroll
            for (int m = 0; m < 4; ++m) { const size_t off = (size_t)(row0 + ai * HALF + m * 16) * D + col0;
#pragma unroll
                for (int bj = 0; bj < 2; ++bj) { f32x4 f0 = {0.f, 0.f, 0.f, 0.f}, f1 = f0;
                    if (!zero) { const u32x4 a = *(const u32x4*)(ga + off + bj * HALF), b = *(const u32x4*)(gb + off + bj * HALF);
                        f32x4 a0 = {bflo(a.x), bfhi(a.x), bflo(a.y), bfhi(a.y)}, a1 = {bflo(a.z), bfhi(a.z), bflo(a.w), bfhi(a.w)};
                        const f32x4 b0 = {bflo(b.x), bfhi(b.x), bflo(b.y), bfhi(b.y)}, b1 = {bflo(b.z), bfhi(b.z), bflo(b.w), bfhi(b.w)};
#pragma unroll
                        for (int x = 0; x < 4; ++x) { a0[x] = __builtin_amdgcn_rcpf(fmaxf(a0[x], 1e-20f)); a1[x] = __builtin_amdgcn_rcpf(fmaxf(a1[x], 1e-20f)); }
                        f0 = b0 * a0; f1 = b1 * a1; }
                    acc[ai][bj][m][0] = acc[ai][bj][m][0] * f0; acc[ai][bj][m][1] = acc[ai][bj][m][1] * f1; }
                asm volatile("" : "+v"(acc[ai][0][m][0]), "+v"(acc[ai][0][m][1]), "+v"(acc[ai][1][m][0]), "+v"(acc[ai][1][m][1]) :: "memory"); }
    }
    __device__ __forceinline__ void operator()(const f32x4 (&acc)[2][2][4][2], const Unit& un, int wr, int wc, int fr, int fq) const {
        const int row0 = un.pm * BM + wr * 64 + fr, col0 = un.pn * BM + wc * 32 + 8 * fq;
#pragma unroll
        for (int ai = 0; ai < 2; ++ai)
#pragma unroll
            for (int m = 0; m < 4; ++m) { const size_t off = (size_t)(row0 + ai * HALF + m * 16) * D + col0;
#pragma unroll
                for (int bj = 0; bj < 2; ++bj) { const u32x4 a = *(const u32x4*)(ga + off + bj * HALF);
                    const f32x4 a0 = {bflo(a.x), bfhi(a.x), bflo(a.y), bfhi(a.y)}, a1 = {bflo(a.z), bfhi(a.z), bflo(a.w), bfhi(a.w)};
                    *(u32x4*)(mi + off + bj * HALF) = pack8(acc[ai][bj][m][0] * a0, acc[ai][bj][m][1] * a1); } }
    }
};
struct EpiBf16Plain {
    static constexpr bool PERM = true;
    bf16_t* O;
    __device__ __forceinline__ void operator()(const f32x4 (&acc)[2][2][4][2], const Unit& un, int wr, int wc, int fr, int fq) const {
        const int row0 = un.pm * BM + wr * 64 + fr, col0 = un.pn * BM + wc * 32 + 8 * fq;
#pragma unroll
        for (int ai = 0; ai < 2; ++ai)
#pragma unroll
            for (int m = 0; m < 4; ++m) { const size_t off = (size_t)(row0 + ai * HALF + m * 16) * D + col0;
#pragma unroll
                for (int bj = 0; bj < 2; ++bj) *(u32x4*)(O + off + bj * HALF) = pack8(acc[ai][bj][m][0], acc[ai][bj][m][1]); }
    }
};
struct EpiSwiglu {
    static constexpr bool PERM = true;
    unsigned char* a; const float* b1;
    __device__ __forceinline__ void operator()(const f32x4 (&acc)[2][2][4][2], const Unit& un, int wr, int wc, int fr, int fq) const {
        const int row0 = un.pm * BM + wr * 64 + fr, j0 = un.pn * HALF + wc * 32 + 8 * fq;
        const f32x4* bp = (const f32x4*)(b1 + (size_t)un.e * 2 * FF + 2 * j0);
        const f32x4 b0 = bp[0], b1v = bp[1], b2 = bp[2], b3 = bp[3];
        const f32x4 bg0 = {b0[0], b0[2], b1v[0], b1v[2]}, bu0 = {b0[1], b0[3], b1v[1], b1v[3]}, bg1 = {b2[0], b2[2], b3[0], b3[2]}, bu1 = {b2[1], b2[3], b3[1], b3[3]};
#pragma unroll
        for (int ai = 0; ai < 2; ++ai)
#pragma unroll
            for (int m = 0; m < 4; ++m) {
                f32x4 o[2];
#pragma unroll
                for (int n = 0; n < 2; ++n) {
                    f32x4 g = acc[ai][0][m][n] * W8_INV + (n ? bg1 : bg0), up = acc[ai][1][m][n] * W8_INV + (n ? bu1 : bu0), e, r;
#pragma unroll
                    for (int x = 0; x < 4; ++x) { g[x] = fminf(g[x], SW_LIMIT); up[x] = __builtin_amdgcn_fmed3f(up[x], -SW_LIMIT, SW_LIMIT); }
                    const f32x4 ex = g * (-SW_ALPHA * 1.4426950408889634f);
#pragma unroll
                    for (int x = 0; x < 4; ++x) e[x] = __builtin_amdgcn_exp2f(ex[x]);
                    e = e + 1.f;
#pragma unroll
                    for (int x = 0; x < 4; ++x) r[x] = __builtin_amdgcn_rcpf(e[x]);
                    const f32x4 gs = g * r; o[n] = gs * up + gs; }
                *(u32x2*)(a + (size_t)(row0 + ai * HALF + m * 16) * FF + j0) = pack8_fp8(o[0], o[1]);
            }
    }
};
constexpr float YE_SCALE = 4.f, YE_INV = 0.25f;
struct EpiYe {
    static constexpr bool PERM = true;
    unsigned char* ye; const float* b2;
    __device__ __forceinline__ void operator()(const f32x4 (&acc)[2][2][4][2], const Unit& un, int wr, int wc, int fr, int fq) const {
        const int row0 = un.pm * BM + wr * 64 + fr, col0 = un.pn * BM + wc * 32 + 8 * fq;
        f32x4 bv[2][2];
#pragma unroll
        for (int bj = 0; bj < 2; ++bj) { bv[bj][0] = *(const f32x4*)(b2 + (size_t)un.e * D + col0 + bj * HALF); bv[bj][1] = *(const f32x4*)(b2 + (size_t)un.e * D + col0 + bj * HALF + 4); }
#pragma unroll
        for (int ai = 0; ai < 2; ++ai)
#pragma unroll
            for (int m = 0; m < 4; ++m) { unsigned char* rowp = ye + (size_t)(row0 + ai * HALF + m * 16) * D + col0;
#pragma unroll
                for (int bj = 0; bj < 2; ++bj) *(u32x2*)(rowp + bj * HALF) = pack8_fp8((acc[ai][bj][m][0] * W8_INV + bv[bj][0]) * YE_SCALE, (acc[ai][bj][m][1] * W8_INV + bv[bj][1]) * YE_SCALE); }
    }
};

template <class Epi, class Sched, bool ALIGN_EPI, bool GATHER, bool FP8 = false>
__device__ __forceinline__ void gemm_phase(PG8_LAS unsigned char* lds, const Gemm g, const Sched& S, const Epi& E, const PG8_LAS int* gtab) {
    int tid_ = (int)threadIdx.x; asm volatile("" : "+v"(tid_));
    const int tid = tid_, wid = __builtin_amdgcn_readfirstlane(tid >> 6), lane = tid & 63, wr = wid >> 2, wc = wid & 3, fr = lane & 15, fq = lane >> 4;
    const int K = g.K, nt = K / BK;
    unsigned voffB[2];
#pragma unroll
    for (int i = 0; i < 2; ++i) { int R, C; stage_rc(tid * 16 + i * 8192, R, C); const int Rb = Epi::PERM ? ((R & ~31) + perm32(R & 31)) : R; voffB[i] = (unsigned)(Rb * K + C) * 2u; }
    const size_t kstep = (size_t)(BK * 2);
    const size_t hstep = (size_t)HALF * K * 2;
    const size_t tstep = 2 * hstep;
    const unsigned ldsw = (unsigned)wid * 1024u;
    const int aoff = lds_byte(wr * 64 + fr, fq * 8), boff = lds_byte(wc * 32 + fr, fq * 8);
#define PG8_SA(b, h) (((b) * 2 + (h)) * HTB)
#define PG8_SB(b, h) ((4 + (b) * 2 + (h)) * HTB)
#define PG8_STAGE(bufoff, gbase, voff) do { _Pragma("unroll") for (int _i = 0; _i < 2; ++_i) \
        __builtin_amdgcn_global_load_lds((const unsigned*)((const char*)(gbase) + (voff)[_i]), (PG8_LAS unsigned*)(lds + (bufoff) + ldsw + _i * 8192), 16, 0, 0); } while (0)
#define PG8_LDA(dst, b, h) do { _Pragma("unroll") for (int m = 0; m < 4; ++m) _Pragma("unroll") for (int k = 0; k < 2; ++k) dst[m][k] = *(const PG8_LAS bf16x8*)(lds + PG8_SA(b, h) + aoff + m * 2048 + k * 1024); } while (0)
#define PG8_LDB(dst, b, h) do { _Pragma("unroll") for (int n = 0; n < 2; ++n) _Pragma("unroll") for (int k = 0; k < 2; ++k) dst[n][k] = *(const PG8_LAS bf16x8*)(lds + PG8_SB(b, h) + boff + n * 2048 + k * 1024); } while (0)
#define PG8_MMA(ai, bj, At, Bt) do { __builtin_amdgcn_s_setprio(1); if constexpr (FP8) { _Pragma("unroll") for (int m = 0; m < 4; ++m) _Pragma("unroll") for (int n = 0; n < 2; ++n) \
        mfma_fp8(acc[ai][bj][m][n], cat8(Bt[n][0], Bt[n][1]), cat8(At[m][0], At[m][1])); } else { \
        _Pragma("unroll") for (int m = 0; m < 4; ++m) _Pragma("unroll") for (int n = 0; n < 2; ++n) _Pragma("unroll") for (int k = 0; k < 2; ++k) \
        acc[ai][bj][m][n] = __builtin_amdgcn_mfma_f32_16x16x32_bf16(Bt[n][k], At[m][k], acc[ai][bj][m][n], 0, 0, 0); } __builtin_amdgcn_s_setprio(0); } while (0)
#define PG8_WAIT_V(n) asm volatile("s_waitcnt vmcnt(" #n ")" ::: "memory")
#define PG8_WAIT_L(n) asm volatile("s_waitcnt lgkmcnt(" #n ")" ::: "memory")
#define PG8_BAR __builtin_amdgcn_s_barrier()
#define PG8_SCHED __builtin_amdgcn_sched_barrier(0)
#define PG8_AOFF(dst, u, uidx) do { _Pragma("unroll") for (int _i = 0; _i < 2; ++_i) { int _R, _C; stage_rc(tid * 16 + _i * 8192, _R, _C); _Pragma("unroll") for (int _h = 0; _h < 2; ++_h) { \
        const int _row = GATHER ? gtab[(uidx) * 256 + _h * HALF + _R] : ((u).pm * BM + _h * HALF + _R); dst[_h][_i] = (unsigned)(_row * K + _C) * 2u; } } } while (0)
    Unit cur, nxt; int ui = 0;
    if (!S.next(0, cur)) return;
    f32x4 acc[2][2][4][2];
#pragma unroll
    for (int a = 0; a < 2; ++a)
#pragma unroll
        for (int b = 0; b < 2; ++b)
#pragma unroll
            for (int m = 0; m < 4; ++m)
#pragma unroll
                for (int n = 0; n < 2; ++n) acc[a][b][m][n] = (f32x4){0.f, 0.f, 0.f, 0.f};
    bf16x8 At[4][2], B0[2][2], B1[2][2];
    unsigned vAc[2][2], vAn[2][2];
    const char* const Ab = (const char*)g.A;
    const char* cB = (const char*)g.Bt + (size_t)cur.e * g.bstride + (size_t)cur.pn * tstep;
    PG8_AOFF(vAc, cur, 0);
    PG8_STAGE(PG8_SB(0, 0), cB, voffB); PG8_STAGE(PG8_SB(0, 1), cB + hstep, voffB); PG8_STAGE(PG8_SA(0, 0), Ab, vAc[0]); PG8_STAGE(PG8_SA(0, 1), Ab, vAc[1]);
    if (wr == 1) PG8_BAR;
    PG8_WAIT_V(2); PG8_BAR;
    PG8_STAGE(PG8_SB(1, 0), cB + kstep, voffB); PG8_STAGE(PG8_SA(1, 0), Ab + kstep, vAc[0]); PG8_STAGE(PG8_SB(1, 1), cB + hstep + kstep, voffB);
    PG8_WAIT_V(6); PG8_BAR;
    for (;;) {
        const bool has_next = S.next(ui + 1, nxt);
        const char* nB = has_next ? (const char*)g.Bt + (size_t)nxt.e * g.bstride + (size_t)nxt.pn * tstep : cB;
        if (has_next) { PG8_AOFF(vAn, nxt, ui + 1); }
        else {
#pragma unroll
            for (int h = 0; h < 2; ++h)
#pragma unroll
                for (int i = 0; i < 2; ++i) vAn[h][i] = vAc[h][i]; }
        _Pragma("nounroll") for (int t = 0; t < nt; t += 2) {
            const bool last = (t == nt - 2);
            const char* a1 = Ab + (size_t)(t + 1) * kstep;
            const char* a2 = last ? Ab : Ab + (size_t)(t + 2) * kstep; const char* b2 = last ? nB : cB + (size_t)(t + 2) * kstep;
            const char* a3 = a2 + kstep; const char* b3 = b2 + kstep;
            unsigned s0[2], s1[2];
#pragma unroll
            for (int i = 0; i < 2; ++i) { s0[i] = last ? vAn[0][i] : vAc[0][i]; s1[i] = last ? vAn[1][i] : vAc[1][i]; }
            PG8_LDB(B0, 0, 0); PG8_LDB(B1, 0, 1); PG8_SCHED; PG8_LDA(At, 0, 0); PG8_STAGE(PG8_SA(1, 1), a1, vAc[1]);
            PG8_WAIT_V(8); PG8_WAIT_L(0); PG8_BAR; PG8_MMA(0, 0, At, B0); PG8_MMA(0, 1, At, B1); PG8_BAR; PG8_SCHED;
            PG8_LDA(At, 0, 1); PG8_STAGE(PG8_SB(0, 0), b2, voffB); PG8_STAGE(PG8_SB(0, 1), b2 + hstep, voffB); PG8_STAGE(PG8_SA(0, 0), a2, s0);
            PG8_WAIT_V(8); PG8_WAIT_L(0); PG8_BAR; PG8_MMA(1, 0, At, B0); PG8_MMA(1, 1, At, B1); PG8_BAR; PG8_SCHED;
            PG8_LDB(B0, 1, 0); PG8_LDB(B1, 1, 1); PG8_SCHED; PG8_LDA(At, 1, 0); PG8_STAGE(PG8_SA(0, 1), a2, s1);
            PG8_WAIT_V(8); PG8_WAIT_L(0); PG8_BAR; PG8_MMA(0, 0, At, B0); PG8_MMA(0, 1, At, B1); PG8_BAR; PG8_SCHED;
            PG8_LDA(At, 1, 1); PG8_STAGE(PG8_SB(1, 0), b3, voffB); PG8_STAGE(PG8_SB(1, 1), b3 + hstep, voffB); PG8_STAGE(PG8_SA(1, 0), a3, s0);
            PG8_WAIT_V(8); PG8_WAIT_L(0); PG8_BAR; PG8_MMA(1, 0, At, B0); PG8_MMA(1, 1, At, B1); PG8_BAR; PG8_SCHED;
        }
        if constexpr (ALIGN_EPI) { if (wr == 0) PG8_BAR; }
        if constexpr (FP8) asm volatile("s_nop 15\n\ts_nop 15" ::: "memory");
        E(acc, cur, wr, wc, fr, fq);
        if (!has_next) break;
#pragma unroll
        for (int a = 0; a < 2; ++a)
#pragma unroll
            for (int b = 0; b < 2; ++b)
#pragma unroll
                for (int m = 0; m < 4; ++m)
#pragma unroll
                    for (int n = 0; n < 2; ++n) acc[a][b][m][n] = (f32x4){0.f, 0.f, 0.f, 0.f};
        cur = nxt; cB = nB; ++ui;
#pragma unroll
        for (int h = 0; h < 2; ++h)
#pragma unroll
            for (int i = 0; i < 2; ++i) vAc[h][i] = vAn[h][i];
        if constexpr (ALIGN_EPI) { if (wr == 1) PG8_BAR; }
    }
    PG8_WAIT_V(0);
    if constexpr (!ALIGN_EPI) { if (wr == 0) PG8_BAR; }
    PG8_BAR;
#undef PG8_SA
#undef PG8_SB
#undef PG8_STAGE
#undef PG8_LDA
#undef PG8_LDB
#undef PG8_MMA
#undef PG8_WAIT_V
#undef PG8_WAIT_L
#undef PG8_BAR
#undef PG8_SCHED
#undef PG8_AOFF
}
struct Gemm2 { const bf16_t* A0; const bf16_t* Bt0; const bf16_t* A1; const bf16_t* Bt1; int K0, K1; };
template <class Epi, class Sched>
__device__ __forceinline__ void gemm_chain2(PG8_LAS unsigned char* lds, const Gemm2 g, const Sched& S, const Epi& E) {
    constexpr bool ALIGN_EPI = true, GATHER = false, FP8 = false; const PG8_LAS int* gtab = nullptr; (void)gtab;
    int tid_ = (int)threadIdx.x; asm volatile("" : "+v"(tid_));
    const int tid = tid_, wid = __builtin_amdgcn_readfirstlane(tid >> 6), lane = tid & 63, wr = wid >> 2, wc = wid & 3, fr = lane & 15, fq = lane >> 4;
#define PG8_VOFFB(dst, Kx) do { _Pragma("unroll") for (int _i = 0; _i < 2; ++_i) { int _R, _C; stage_rc(tid * 16 + _i * 8192, _R, _C); const int _Rb = Epi::PERM ? ((_R & ~31) + perm32(_R & 31)) : _R; dst[_i] = (unsigned)(_Rb * (Kx) + _C) * 2u; } } while (0)
    int Kc = g.K0, Kn = g.K1, segc = 0;
    unsigned voffB[2], voffBn[2];
    PG8_VOFFB(voffB, Kc);
    const size_t kstep = (size_t)(BK * 2);
    size_t hstep = (size_t)HALF * Kc * 2, hstepn = hstep;
    const char* Ab = (const char*)g.A0; const char* Abn = Ab;
    const unsigned ldsw = (unsigned)wid * 1024u;
    const int aoff = lds_byte(wr * 64 + fr, fq * 8), boff = lds_byte(wc * 32 + fr, fq * 8);
#define PG8_SA(b, h) (((b) * 2 + (h)) * HTB)
#define PG8_SB(b, h) ((4 + (b) * 2 + (h)) * HTB)
#define PG8_STAGE(bufoff, gbase, voff) do { _Pragma("unroll") for (int _i = 0; _i < 2; ++_i) \
        __builtin_amdgcn_global_load_lds((const unsigned*)((const char*)(gbase) + (voff)[_i]), (PG8_LAS unsigned*)(lds + (bufoff) + ldsw + _i * 8192), 16, 0, 0); } while (0)
#define PG8_LDA(dst, b, h) do { _Pragma("unroll") for (int m = 0; m < 4; ++m) _Pragma("unroll") for (int k = 0; k < 2; ++k) dst[m][k] = *(const PG8_LAS bf16x8*)(lds + PG8_SA(b, h) + aoff + m * 2048 + k * 1024); } while (0)
#define PG8_LDB(dst, b, h) do { _Pragma("unroll") for (int n = 0; n < 2; ++n) _Pragma("unroll") for (int k = 0; k < 2; ++k) dst[n][k] = *(const PG8_LAS bf16x8*)(lds + PG8_SB(b, h) + boff + n * 2048 + k * 1024); } while (0)
#define PG8_MMA(ai, bj, At, Bt) do { __builtin_amdgcn_s_setprio(1); if constexpr (FP8) { _Pragma("unroll") for (int m = 0; m < 4; ++m) _Pragma("unroll") for (int n = 0; n < 2; ++n) \
        mfma_fp8(acc[ai][bj][m][n], cat8(Bt[n][0], Bt[n][1]), cat8(At[m][0], At[m][1])); } else { \
        _Pragma("unroll") for (int m = 0; m < 4; ++m) _Pragma("unroll") for (int n = 0; n < 2; ++n) _Pragma("unroll") for (int k = 0; k < 2; ++k) \
        acc[ai][bj][m][n] = __builtin_amdgcn_mfma_f32_16x16x32_bf16(Bt[n][k], At[m][k], acc[ai][bj][m][n], 0, 0, 0); } __builtin_amdgcn_s_setprio(0); } while (0)
#define PG8_WAIT_V(n) asm volatile("s_waitcnt vmcnt(" #n ")" ::: "memory")
#define PG8_WAIT_L(n) asm volatile("s_waitcnt lgkmcnt(" #n ")" ::: "memory")
#define PG8_BAR __builtin_amdgcn_s_barrier()
#define PG8_SCHED __builtin_amdgcn_sched_barrier(0)
#define PG8_AOFF(dst, u, uidx) do { _Pragma("unroll") for (int _i = 0; _i < 2; ++_i) { int _R, _C; stage_rc(tid * 16 + _i * 8192, _R, _C); _Pragma("unroll") for (int _h = 0; _h < 2; ++_h) { \
        const int _row = (u).pm * BM + _h * HALF + _R; dst[_h][_i] = (unsigned)(_row * (uidx) + _C) * 2u; } } } while (0)
    Unit cur, nxt; int ui = 0;
    if (!S.next(0, cur)) return;
    f32x4 acc[2][2][4][2];
#pragma unroll
    for (int a = 0; a < 2; ++a)
#pragma unroll
        for (int b = 0; b < 2; ++b)
#pragma unroll
            for (int m = 0; m < 4; ++m)
#pragma unroll
                for (int n = 0; n < 2; ++n) acc[a][b][m][n] = (f32x4){0.f, 0.f, 0.f, 0.f};
    bf16x8 At[4][2], B0[2][2], B1[2][2];
    unsigned vAc[2][2], vAn[2][2];
    const char* cB = (const char*)g.Bt0 + (size_t)cur.pn * 2 * hstep;
    PG8_AOFF(vAc, cur, Kc);
    PG8_STAGE(PG8_SB(0, 0), cB, voffB); PG8_STAGE(PG8_SB(0, 1), cB + hstep, voffB); PG8_STAGE(PG8_SA(0, 0), Ab, vAc[0]); PG8_STAGE(PG8_SA(0, 1), Ab, vAc[1]);
    if (wr == 1) PG8_BAR;
    PG8_WAIT_V(2); PG8_BAR;
    PG8_STAGE(PG8_SB(1, 0), cB + kstep, voffB); PG8_STAGE(PG8_SA(1, 0), Ab + kstep, vAc[0]); PG8_STAGE(PG8_SB(1, 1), cB + hstep + kstep, voffB);
    PG8_WAIT_V(6); PG8_BAR;
    for (;;) {
        bool has_next; const char* nB;
        if (segc == 0) { has_next = true; nxt = cur; Kn = g.K1; Abn = (const char*)g.A1; hstepn = (size_t)HALF * Kn * 2; nB = (const char*)g.Bt1 + (size_t)cur.pn * 2 * hstepn; PG8_VOFFB(voffBn, Kn); PG8_AOFF(vAn, cur, Kn); }
        else { has_next = S.next(ui + 1, nxt);
            if (has_next) { Kn = g.K0; Abn = (const char*)g.A0; hstepn = (size_t)HALF * Kn * 2; nB = (const char*)g.Bt0 + (size_t)nxt.pn * 2 * hstepn; PG8_VOFFB(voffBn, Kn); PG8_AOFF(vAn, nxt, Kn); }
            else { Kn = Kc; Abn = Ab; hstepn = hstep; nB = cB;
#pragma unroll
                for (int h = 0; h < 2; ++h)
#pragma unroll
                    for (int i = 0; i < 2; ++i) vAn[h][i] = vAc[h][i];
#pragma unroll
                for (int i = 0; i < 2; ++i) voffBn[i] = voffB[i]; } }
        const int nt = Kc / BK;
        _Pragma("nounroll") for (int t = 0; t < nt; t += 2) {
            const bool last = (t == nt - 2);
            const char* a1 = Ab + (size_t)(t + 1) * kstep;
            const char* a2 = last ? Abn : Ab + (size_t)(t + 2) * kstep; const char* b2 = last ? nB : cB + (size_t)(t + 2) * kstep;
            const size_t h2 = last ? hstepn : hstep; unsigned vB2[2];
#pragma unroll
            for (int i = 0; i < 2; ++i) vB2[i] = last ? voffBn[i] : voffB[i];
            const char* a3 = a2 + kstep; const char* b3 = b2 + kstep;
            unsigned s0[2], s1[2];
#pragma unroll
            for (int i = 0; i < 2; ++i) { s0[i] = last ? vAn[0][i] : vAc[0][i]; s1[i] = last ? vAn[1][i] : vAc[1][i]; }
            PG8_LDB(B0, 0, 0); PG8_LDB(B1, 0, 1); PG8_SCHED; PG8_LDA(At, 0, 0); PG8_STAGE(PG8_SA(1, 1), a1, vAc[1]);
            PG8_WAIT_V(8); PG8_WAIT_L(0); PG8_BAR; PG8_MMA(0, 0, At, B0); PG8_MMA(0, 1, At, B1); PG8_BAR; PG8_SCHED;
            PG8_LDA(At, 0, 1); PG8_STAGE(PG8_SB(0, 0), b2, vB2); PG8_STAGE(PG8_SB(0, 1), b2 + h2, vB2); PG8_STAGE(PG8_SA(0, 0), a2, s0);
            PG8_WAIT_V(8); PG8_WAIT_L(0); PG8_BAR; PG8_MMA(1, 0, At, B0); PG8_MMA(1, 1, At, B1); PG8_BAR; PG8_SCHED;
            PG8_LDB(B0, 1, 0); PG8_LDB(B1, 1, 1); PG8_SCHED; PG8_LDA(At, 1, 0); PG8_STAGE(PG8_SA(0, 1), a2, s1);
            PG8_WAIT_V(8); PG8_WAIT_L(0); PG8_BAR; PG8_MMA(0, 0, At, B0); PG8_MMA(0, 1, At, B1); PG8_BAR; PG8_SCHED;
            PG8_LDA(At, 1, 1); PG8_STAGE(PG8_SB(1, 0), b3, vB2); PG8_STAGE(PG8_SB(1, 1), b3 + h2, vB2); PG8_STAGE(PG8_SA(1, 0), a3, s0);
            PG8_WAIT_V(8); PG8_WAIT_L(0); PG8_BAR; PG8_MMA(1, 0, At, B0); PG8_MMA(1, 1, At, B1); PG8_BAR; PG8_SCHED;
        }
        if constexpr (ALIGN_EPI) { if (wr == 0) PG8_BAR; }
        if (segc == 1) { E(acc, cur, wr, wc, fr, fq); if (!has_next) break; }
        E.mid(acc, cur, wr, wc, fr, fq, segc == 1);
        if (segc == 1) { cur = nxt; ++ui; }
        segc ^= 1; Kc = Kn; Ab = Abn; hstep = hstepn; cB = nB;
#pragma unroll
        for (int i = 0; i < 2; ++i) voffB[i] = voffBn[i];
#pragma unroll
        for (int h = 0; h < 2; ++h)
#pragma unroll
            for (int i = 0; i < 2; ++i) vAc[h][i] = vAn[h][i];
        if constexpr (ALIGN_EPI) { if (wr == 1) PG8_BAR; }
    }
    PG8_WAIT_V(0);
    if constexpr (!ALIGN_EPI) { if (wr == 0) PG8_BAR; }
    PG8_BAR;
#undef PG8_SA
#undef PG8_SB
#undef PG8_STAGE
#undef PG8_LDA
#undef PG8_LDB
#undef PG8_MMA
#undef PG8_WAIT_V
#undef PG8_WAIT_L
#undef PG8_BAR
#undef PG8_SCHED
#undef PG8_AOFF
#undef PG8_VOFFB
}
}
#include <hip/hip_bf16.h>
#include <cmath>
namespace attn_body {
using bf16=__hip_bfloat16;
using bf16x8=__attribute__((ext_vector_type(8)))short;
using s16x4=__attribute__((ext_vector_type(4)))short;
using f32x16=__attribute__((ext_vector_type(16)))float;
using u32x4=__attribute__((ext_vector_type(4)))unsigned;
constexpr int BATCH=8,NHEAD=16,SEQ=2048,D=64,DM=NHEAD*D;
constexpr int NW=8,QBLK=32,QB=QBLK*NW,KVBLK=64,NQB=SEQ/QB;
constexpr int ATTN_PITCH=DM, ATTN_UNIT_ROWS=QB;
__device__ __forceinline__ int crow(int r,int hi){return (r&3)+8*(r>>2)+4*hi;}
#define SBAR() __builtin_amdgcn_sched_barrier(0)
__device__ __forceinline__ void cmask(f32x16&p0,f32x16&p1,int jb,int qrel,int hi){
  const float NEG=-INFINITY; int kb=64*jb+4*hi;
  #pragma unroll
  for(int r=0;r<16;++r){int kv=kb+(r&3)+8*(r>>2); if(kv>qrel)p0[r]=NEG; if(kv+32>qrel)p1[r]=NEG;}
}

constexpr int NSLOT=3, SLOTB=8192;
constexpr int LDS_K=0, LDS_V=NSLOT*SLOTB, LDS_WS=2*NSLOT*SLOTB, LDS_OST=LDS_WS+NW*64*4, LDS_BYTES=LDS_OST+NW*4096;
constexpr float C2=0.125f*1.4426950408889634f;
__device__ __forceinline__ void glds16(const void*gsrc,unsigned lds_dst){unsigned keep;
  asm volatile("s_mov_b32 %0, m0\n\ts_mov_b32 m0, %2\n\ts_nop 0\n\tglobal_load_lds_dwordx4 %1, off\n\ts_mov_b32 m0, %0":"=&s"(keep):"v"(gsrc),"s"(lds_dst):"memory");}
__device__ __forceinline__ float max3f(float a,float b,float c){float r;asm("v_max3_f32 %0, %1, %2, %3":"=v"(r):"v"(a),"v"(b),"v"(c));return r;}
__device__ __forceinline__ float max2f(float a,float b){float r;asm("v_max_f32_e32 %0, %1, %2":"=v"(r):"v"(a),"v"(b));return r;}
__device__ __forceinline__ float fadd_s(float a,float b){float r;asm("v_add_f32_e32 %0, %1, %2":"=v"(r):"v"(a),"v"(b));return r;}
__device__ __forceinline__ float fsub_s(float a,float b){float r;asm("v_sub_f32_e32 %0, %1, %2":"=v"(r):"v"(a),"v"(b));return r;}
typedef float f32x2_t __attribute__((ext_vector_type(2))); typedef __bf16 bf16x2_t __attribute__((ext_vector_type(2)));
__device__ __forceinline__ unsigned cvtpk_s(float lo,float hi){f32x2_t v={lo,hi};bf16x2_t b=__builtin_convertvector(v,bf16x2_t);return __builtin_bit_cast(unsigned,b);}
#define WAIT_BAR(N) asm volatile("s_waitcnt vmcnt(" #N ") lgkmcnt(0)\n\ts_barrier":::"memory")

__device__ __forceinline__ void qkt(f32x16&p0,f32x16&p1,const char*Kslot,const bf16x8*qr,const f32x16&negm,int r32,int hi){
  const char*kb=Kslot+hi*1024+r32*16;
  #pragma unroll
  for(int d0=0;d0<4;++d0){
    const bf16x8 b0=*reinterpret_cast<const bf16x8*>(kb+d0*2048);
    const bf16x8 b1=*reinterpret_cast<const bf16x8*>(kb+d0*2048+512);
    if(d0==0){p0=__builtin_amdgcn_mfma_f32_32x32x16_bf16(b0,qr[0],negm,0,0,0);p1=__builtin_amdgcn_mfma_f32_32x32x16_bf16(b1,qr[0],negm,0,0,0);}
    else{p0=__builtin_amdgcn_mfma_f32_32x32x16_bf16(b0,qr[d0],p0,0,0,0);p1=__builtin_amdgcn_mfma_f32_32x32x16_bf16(b1,qr[d0],p1,0,0,0);}}
}
typedef __attribute__((address_space(3))) const char* lds_cptr;
typedef short v4i16_t __attribute__((ext_vector_type(4)));
__device__ __forceinline__ void kload8(bf16x8*kf,lds_cptr kp){
  kf[0]=*(const __attribute__((address_space(3))) bf16x8*)(kp);      kf[1]=*(const __attribute__((address_space(3))) bf16x8*)(kp+512);
  kf[2]=*(const __attribute__((address_space(3))) bf16x8*)(kp+2048); kf[3]=*(const __attribute__((address_space(3))) bf16x8*)(kp+2560);
  kf[4]=*(const __attribute__((address_space(3))) bf16x8*)(kp+4096); kf[5]=*(const __attribute__((address_space(3))) bf16x8*)(kp+4608);
  kf[6]=*(const __attribute__((address_space(3))) bf16x8*)(kp+6144); kf[7]=*(const __attribute__((address_space(3))) bf16x8*)(kp+6656);
}
__device__ __forceinline__ void kload2(bf16x8*kf,lds_cptr kp,int j){ kf[2*j]=*(const __attribute__((address_space(3))) bf16x8*)(kp+j*2048); kf[2*j+1]=*(const __attribute__((address_space(3))) bf16x8*)(kp+j*2048+512); }
__device__ __forceinline__ s16x4 vtr(lds_cptr p){ return __builtin_bit_cast(s16x4,__builtin_amdgcn_ds_read_tr16_b64_v4i16((__attribute__((address_space(3))) v4i16_t*)p)); }
__device__ __forceinline__ float rowmax(const f32x16&p0,const f32x16&p1){
  float a=max3f(p0[0],p0[1],p1[0]),b=max3f(p0[2],p0[3],p1[1]);a=max3f(a,p1[2],p1[3]);
  #pragma unroll
  for(int r=4;r<16;r+=4){a=max3f(a,p0[r],p0[r+1]);b=max3f(b,p0[r+2],p0[r+3]);a=max3f(a,p1[r],p1[r+1]);b=max3f(b,p1[r+2],p1[r+3]);}
  const float m=max2f(a,b);
  auto rr=__builtin_amdgcn_permlane32_swap(__float_as_uint(m),__float_as_uint(m),false,false);
  return max2f(__uint_as_float(rr[0]),__uint_as_float(rr[1]));
}
__device__ __forceinline__ void pv(f32x16*o,int vb,bf16x8 pa0,bf16x8 pa1,bf16x8 pa2,bf16x8 pa3){
  #pragma unroll
  for(int d0=0;d0<2;++d0){s16x4 lo[4],hi[4];
    #pragma unroll
    for(int ks=0;ks<4;++ks){
      asm volatile("ds_read_b64_tr_b16 %0,%1 offset:%c2":"=&v"(lo[ks]):"v"(vb),"i"(d0*4096+ks*1024):"memory");
      asm volatile("ds_read_b64_tr_b16 %0,%1 offset:%c2":"=&v"(hi[ks]):"v"(vb),"i"(d0*4096+ks*1024+512):"memory");}
    asm volatile("s_waitcnt lgkmcnt(0)":::"memory");SBAR();
    #define PK(k) (bf16x8){lo[k][0],lo[k][1],lo[k][2],lo[k][3],hi[k][0],hi[k][1],hi[k][2],hi[k][3]}
    o[d0]=__builtin_amdgcn_mfma_f32_32x32x16_bf16(pa0,PK(0),o[d0],0,0,0);
    o[d0]=__builtin_amdgcn_mfma_f32_32x32x16_bf16(pa1,PK(1),o[d0],0,0,0);
    o[d0]=__builtin_amdgcn_mfma_f32_32x32x16_bf16(pa2,PK(2),o[d0],0,0,0);
    o[d0]=__builtin_amdgcn_mfma_f32_32x32x16_bf16(pa3,PK(3),o[d0],0,0,0);
    #undef PK
  }
}

#ifndef ATTN_STORE16
#define ATTN_STORE16(p,v) (*(u32x4*)(p)=(v))
#endif
template<int THRL> __device__ __forceinline__ void attn_unit(int b,int h,int hv,int qb,const bf16*Q,const bf16*__restrict__ K,const bf16*__restrict__ V,bf16*O,char*shm){
  int tid_=threadIdx.x; asm volatile("":"+v"(tid_));
  const int tid=tid_,lane=tid&63,r32=lane&31,hi=lane>>5; const int wid=__builtin_amdgcn_readfirstlane(tid>>6);
  const long rowbase=(long)b*SEQ; const int q0=qb*QB;
  const bf16*Qw=Q+(rowbase+q0+wid*QBLK)*DM+h*D;
  const bf16*Kh=K+rowbase*DM+h*D,*Vh=V+rowbase*DM+hv*D;
  const unsigned lds0=(unsigned)(uintptr_t)shm;
  float*wsf=(float*)(shm+LDS_WS)+wid*64;
  const bf16*ksrc=Kh+(long)lane*DM+wid*8;
  const bf16*vsrc=Vh+(long)(16*(wid&3)+(lane>>2))*DM+(wid>>2)*32+(lane&3)*8;
  const unsigned kdst=lds0+LDS_K+wid*1024, vdst=lds0+LDS_V+wid*1024;
  #define DMA_K(t,slot) glds16(ksrc+(long)(t)*KVBLK*DM,(unsigned)__builtin_amdgcn_readfirstlane(kdst+(slot)))
  #define DMA_V(t,slot) glds16(vsrc+(long)(t)*KVBLK*DM,(unsigned)__builtin_amdgcn_readfirstlane(vdst+(slot)))
  const int vb0=(int)(lds0+LDS_V)+((lane>>4)&1)*32+(lane&3)*8+(4*hi+((lane&15)>>2))*64;
  const char*Kbase=shm+LDS_K; bf16x8 kf[8];
  const lds_cptr shm3=(lds_cptr)shm; const lds_cptr kp0=shm3+LDS_K+hi*1024+r32*16; const lds_cptr vp0=shm3+LDS_V+((lane>>4)&1)*32+(lane&3)*8+(4*hi+((lane&15)>>2))*64;
  const int NT=(q0+QB)/KVBLK;
  DMA_K(0,0);DMA_V(0,0);DMA_K(1,SLOTB);
  bf16x8 qr[4];
  #pragma unroll
  for(int d0=0;d0<4;++d0)qr[d0]=*reinterpret_cast<const bf16x8*>(&Qw[(long)r32*DM+d0*16+hi*8]);
  float zz_=0.f; asm volatile("":"+v"(zz_));
  float mhat=0.f,l_reg=0.f;f32x16 o[2];
  #pragma unroll
  for(int r=0;r<16;++r){o[0][r]=zz_;o[1][r]=zz_;}
  f32x16 negm;
  #pragma unroll
  for(int r=0;r<16;++r)negm[r]=zz_;
  asm volatile("":"+v"(negm));
  const int qrel=wid*QBLK+r32;
  #define CMASK(P0,P1,t) do{int jb_=(t)-(NT-4); if(jb_>=0)cmask(P0,P1,jb_,qrel,hi);}while(0)
  bool resc=false;
  #define START(P0,P1) do{ const float rm=rowmax(P0,P1); resc=false; \
    { const float dl=rm; mhat=fadd_s(mhat,dl); \
      _Pragma("unroll") for(int r=0;r<16;++r){P0[r]=fsub_s(P0[r],dl);P1[r]=fsub_s(P1[r],dl);} \
      _Pragma("unroll") for(int r=0;r<16;++r)negm[r]=-mhat; asm volatile("":"+v"(negm)); } \
    _Pragma("unroll") for(int r=0;r<16;++r)P0[r]=__builtin_amdgcn_exp2f(P0[r]); }while(0)
  #define RESC() do{ if(resc){ asm volatile("s_waitcnt lgkmcnt(0)":::"memory"); \
      _Pragma("unroll") for(int d_=0;d_<2;++d_) _Pragma("unroll") for(int r=0;r<16;++r)o[d_][r]*=wsf[crow(r,hi)]; } }while(0)
  f32x16 pA0,pA1,pB0,pB1;
  int sl_prev=0,sl_cur=0,sl_next=SLOTB;
  #define ROT() do{sl_prev=sl_cur;sl_cur=sl_next;sl_next=(sl_next==(NSLOT-1)*SLOTB)?0:sl_next+SLOTB;}while(0)
  DMA_K(2,2*SLOTB);
  WAIT_BAR(3);
  qkt(pA0,pA1,Kbase,qr,negm,r32,hi);asm volatile("s_nop 15\n\ts_nop 7":"+v"(pA0),"+v"(pA1));CMASK(pA0,pA1,0);
  START(pA0,pA1);
  _Pragma("unroll") for(int r=0;r<16;++r)pA1[r]=__builtin_amdgcn_exp2f(pA1[r]);
  WAIT_BAR(0);
  DMA_K(3,0);DMA_V(1,SLOTB);
  ROT();
  kload8(kf,kp0+sl_cur);
  WAIT_BAR(2);
  s16x4 vlo[8],vhi[8]; u32x4 pw0,pw1,pw2,pw3;
  #define PKW(P,B) cvtpk_s(P[B],P[B+1])
  #define PAF(k) __builtin_bit_cast(bf16x8,pw##k)
  #define VFR(i) (bf16x8){vlo[i][0],vlo[i][1],vlo[i][2],vlo[i][3],vhi[i][0],vhi[i][1],vhi[i][2],vhi[i][3]}
  #define PIN(x) asm volatile("":"+v"(x))
  #define MX3(a,b,c) __builtin_fmaxf(__builtin_fmaxf((a),(b)),(c))
  #define GAPA(MF,A0,A1,A2,A3,W0,W1,PW) do{ MF; sacc+=A0; sacc+=A1; sacc+=A2; sacc+=A3; PIN(sacc); W0; W1; PIN(PW); SBAR(); }while(0)
  #define EX(v) __builtin_amdgcn_exp2f(v)
  #define GAPB(MF,X,B) do{ MF; X[B]=EX(X[B]); X[B+1]=EX(X[B+1]); X[B+2]=EX(X[B+2]); X[B+3]=EX(X[B+3]); PIN(X); SBAR(); }while(0)
  #define VRD(i) do{ vlo[i]=vtr(vp_+(((i)>>2)*4096+((i)&3)*1024)); vhi[i]=vtr(vp_+(((i)>>2)*4096+((i)&3)*1024+512)); }while(0)
  #define KRD(G,j) do{ if(G){ kload2(kf,kp0+sl_next,j); SBAR(); } }while(0)
  #define STEP(C0,C1,P0,P1,t,GK,GV,GL) do{ SBAR(); \
    const lds_cptr vp_=vp0+sl_prev; \
    VRD(0); SBAR(); float sacc=(P0[0]+P0[1]); \
    GAPA(C0=__builtin_amdgcn_mfma_f32_32x32x16_bf16(kf[0],qr[0],negm,0,0,0), P0[2],P0[3],P0[4],P0[5],     pw0[0]=PKW(P0,0), pw0[1]=PKW(P0,2), pw0); \
    VRD(4); SBAR(); GAPA(C1=__builtin_amdgcn_mfma_f32_32x32x16_bf16(kf[1],qr[0],negm,0,0,0), P0[6],P0[7],P0[8],P0[9],     pw0[2]=PKW(P0,4), pw0[3]=PKW(P0,6), pw0); \
    VRD(1); SBAR(); GAPA(C0=__builtin_amdgcn_mfma_f32_32x32x16_bf16(kf[2],qr[1],C0,0,0,0),   P0[10],P0[11],P0[12],P0[13], pw1[0]=PKW(P0,8), pw1[1]=PKW(P0,10), pw1); \
    VRD(5); SBAR(); GAPA(C1=__builtin_amdgcn_mfma_f32_32x32x16_bf16(kf[3],qr[1],C1,0,0,0),   P0[14],P0[15],P1[0],P1[1],   pw1[2]=PKW(P0,12),pw1[3]=PKW(P0,14), pw1); \
    VRD(2); SBAR(); GAPA(C0=__builtin_amdgcn_mfma_f32_32x32x16_bf16(kf[4],qr[2],C0,0,0,0),   P1[2],P1[3],P1[4],P1[5],     pw2[0]=PKW(P1,0), pw2[1]=PKW(P1,2), pw2); \
    VRD(6); SBAR(); GAPA(C1=__builtin_amdgcn_mfma_f32_32x32x16_bf16(kf[5],qr[2],C1,0,0,0),   P1[6],P1[7],P1[8],P1[9],     pw2[2]=PKW(P1,4), pw2[3]=PKW(P1,6), pw2); \
    VRD(3); SBAR(); GAPA(C0=__builtin_amdgcn_mfma_f32_32x32x16_bf16(kf[6],qr[3],C0,0,0,0),   P1[10],P1[11],P1[12],P1[13], pw3[0]=PKW(P1,8), pw3[1]=PKW(P1,10), pw3); \
    VRD(7); SBAR(); GAPA(C1=__builtin_amdgcn_mfma_f32_32x32x16_bf16(kf[7],qr[3],C1,0,0,0),   P1[14],P1[15],0.f,0.f,       pw3[2]=PKW(P1,12),pw3[3]=PKW(P1,14), pw3); \
    l_reg+=sacc; \
    if(GK){DMA_K((t)+3,sl_cur);} if(GV){DMA_V((t)+1,sl_next);} \
    CMASK(C0,C1,t); \
    { float a=MX3(C0[0],C0[1],C1[0]),b=MX3(C0[2],C0[3],C1[1]); a=MX3(a,C1[2],C1[3]); \
      _Pragma("unroll") for(int r=4;r<16;r+=4){a=MX3(a,C0[r],C0[r+1]);b=MX3(b,C0[r+2],C0[r+3]);a=MX3(a,C1[r],C1[r+1]);b=MX3(b,C1[r+2],C1[r+3]);} \
      float rm=__builtin_fmaxf(a,b); { auto rr=__builtin_amdgcn_permlane32_swap(__float_as_uint(rm),__float_as_uint(rm),false,false); rm=__builtin_fmaxf(__uint_as_float(rr[0]),__uint_as_float(rr[1])); } \
      resc=false; \
      if(__builtin_expect(__any(rm>(float)THRL),0)){ const float dl=__builtin_fmaxf(rm,0.f); mhat+=dl; \
        _Pragma("unroll") for(int r=0;r<16;++r){C0[r]-=dl;C1[r]-=dl;} \
        _Pragma("unroll") for(int r=0;r<16;++r)negm[r]=-mhat; asm volatile("":"+v"(negm)); \
        const float f=__builtin_amdgcn_exp2f(-dl); l_reg*=f; if(hi==0)wsf[r32]=f; resc=true; } } \
    SBAR(); \
    GAPB(o[0]=__builtin_amdgcn_mfma_f32_32x32x16_bf16(PAF(0),VFR(0),o[0],0,0,0), C0,0); \
    GAPB(o[1]=__builtin_amdgcn_mfma_f32_32x32x16_bf16(PAF(0),VFR(4),o[1],0,0,0), C0,4); \
    KRD(GL,0); GAPB(o[0]=__builtin_amdgcn_mfma_f32_32x32x16_bf16(PAF(1),VFR(1),o[0],0,0,0), C0,8); \
    KRD(GL,1); GAPB(o[1]=__builtin_amdgcn_mfma_f32_32x32x16_bf16(PAF(1),VFR(5),o[1],0,0,0), C0,12); \
    KRD(GL,2); GAPB(o[0]=__builtin_amdgcn_mfma_f32_32x32x16_bf16(PAF(2),VFR(2),o[0],0,0,0), C1,0); \
    KRD(GL,3); GAPB(o[1]=__builtin_amdgcn_mfma_f32_32x32x16_bf16(PAF(2),VFR(6),o[1],0,0,0), C1,4); \
    GAPB(o[0]=__builtin_amdgcn_mfma_f32_32x32x16_bf16(PAF(3),VFR(3),o[0],0,0,0), C1,8); \
    GAPB(o[1]=__builtin_amdgcn_mfma_f32_32x32x16_bf16(PAF(3),VFR(7),o[1],0,0,0), C1,12); \
    }while(0)
  int t=1;
  #undef CMASK
  #define CMASK(P0,P1,t) do{}while(0)
  for(;t+5<NT;t+=2){
    STEP(pB0,pB1,pA0,pA1,t,true,true,true);     WAIT_BAR(2); RESC(); ROT();
    STEP(pA0,pA1,pB0,pB1,t+1,true,true,true);   WAIT_BAR(2); RESC(); ROT();
  }
  #undef CMASK
  #define CMASK(P0,P1,t) do{int jb_=(t)-(NT-4); if(jb_>=0)cmask(P0,P1,jb_,qrel,hi);}while(0)
  #define ENDW(tt) do{ if((tt)+3<NT){WAIT_BAR(2);} else if((tt)+2<NT){WAIT_BAR(1);} else {WAIT_BAR(0);} }while(0)
  for(;t+1<NT;t+=2){
    STEP(pB0,pB1,pA0,pA1,t,(t+3<NT),(t+1<NT),(t+1<NT));       ENDW(t);   RESC(); ROT();
    STEP(pA0,pA1,pB0,pB1,t+1,(t+4<NT),(t+2<NT),(t+2<NT));     ENDW(t+1); RESC(); ROT();
  }
  STEP(pB0,pB1,pA0,pA1,NT-1,false,false,false); RESC();
  { float sacc=pB0[0]+pB0[1]; _Pragma("unroll") for(int r=2;r<16;++r)sacc+=pB0[r]; _Pragma("unroll") for(int r=0;r<16;++r)sacc+=pB1[r]; l_reg+=sacc;
    pw0=(u32x4){PKW(pB0,0),PKW(pB0,2),PKW(pB0,4),PKW(pB0,6)};pw1=(u32x4){PKW(pB0,8),PKW(pB0,10),PKW(pB0,12),PKW(pB0,14)};pw2=(u32x4){PKW(pB1,0),PKW(pB1,2),PKW(pB1,4),PKW(pB1,6)};pw3=(u32x4){PKW(pB1,8),PKW(pB1,10),PKW(pB1,12),PKW(pB1,14)};
    SBAR(); pv(o,vb0+sl_cur,PAF(0),PAF(1),PAF(2),PAF(3)); }
  #undef PKW
  #undef PAF
  #undef VFR
  #undef PIN
  #undef MX3
  #undef GAPA
  #undef GAPB
  #undef EX
  #undef VRD
  #undef KRD
  #undef STEP
  #undef ENDW
  {auto rr=__builtin_amdgcn_permlane32_swap(__float_as_uint(l_reg),__float_as_uint(l_reg),false,false);l_reg=__uint_as_float(rr[0])+__uint_as_float(rr[1]);}
  if(hi==0)wsf[32+r32]=l_reg;asm volatile("s_waitcnt lgkmcnt(0)":::"memory");
  float rli[16];
  #pragma unroll
  for(int r=0;r<16;++r)rli[r]=__builtin_amdgcn_rcpf(wsf[32+crow(r,hi)]);
  bf16*Ow=O+(rowbase+q0+wid*QBLK)*DM+hv*D;
  { bf16*stg=(bf16*)(shm+LDS_OST)+wid*2048;
    #pragma unroll
    for(int r=0;r<16;++r){const int orow=crow(r,hi);
      #pragma unroll
      for(int d0=0;d0<2;++d0)stg[orow*64+d0*32+r32]=__float2bfloat16(o[d0][r]*rli[r]);}
    asm volatile("s_waitcnt lgkmcnt(0)":::"memory");
    #pragma unroll
    for(int i=0;i<4;++i){const int row=i*8+(lane>>3),ch=lane&7; const u32x4 v=*(const u32x4*)(stg+row*64+ch*8); ATTN_STORE16(Ow+(long)row*DM+ch*8,v);} }
  asm volatile("s_waitcnt lgkmcnt(0)\n\ts_barrier":::"memory");
  #undef DMA_K
  #undef DMA_V
  #undef CMASK
  #undef START
  #undef RESC
  #undef ROT
}
constexpr int LDSW_K=0, LDSW_V=NSLOT*SLOTB, LDSW_WS=LDSW_V+NSLOT*2*SLOTB, LDSW_OST=LDSW_WS+NW*64*4, LDSW_BYTES=LDSW_OST+NW*4096;
struct Combine { bool on; const bf16* O0; bf16* oc; const float* g; float lam, eps, post; };
template<int THRL> __device__ __forceinline__ void attn_unit_w(int b,int h,int hh,int qb,const bf16*Q,const bf16*__restrict__ K,const bf16*__restrict__ V,bf16*O,char*shm,const Combine CB){
  int tid_=threadIdx.x; asm volatile("":"+v"(tid_));
  const int tid=tid_,lane=tid&63,r32=lane&31,hi=lane>>5; const int wid=__builtin_amdgcn_readfirstlane(tid>>6);
  const long rowbase=(long)b*SEQ; const int q0=qb*QB;
  const bf16*Qw=Q+(rowbase+q0+wid*QBLK)*DM+h*D;
  const bf16*Kh=K+rowbase*DM+h*D,*Vh=V+rowbase*DM+hh*128;
  const unsigned lds0=(unsigned)(uintptr_t)shm;
  float*wsf=(float*)(shm+LDSW_WS)+wid*64;
  const bf16*ksrc=Kh+(long)lane*DM+wid*8;
  const bf16*vsrc=Vh+(long)(16*(wid&3)+(lane>>2))*DM+(wid>>2)*32+(lane&3)*8;
  const unsigned kdst=lds0+LDSW_K+wid*1024, vdst=lds0+LDSW_V+wid*1024;
  #define DMA_K(t,slot) glds16(ksrc+(long)(t)*KVBLK*DM,(unsigned)__builtin_amdgcn_readfirstlane(kdst+(slot)))
  #define DMA_V(t,slot) do{ glds16(vsrc+(long)(t)*KVBLK*DM,(unsigned)__builtin_amdgcn_readfirstlane(vdst+2*(slot))); glds16(vsrc+(long)(t)*KVBLK*DM+64,(unsigned)__builtin_amdgcn_readfirstlane(vdst+2*(slot)+8192)); }while(0)
  const int vb0=(int)(lds0+LDSW_V)+((lane>>4)&1)*32+(lane&3)*8+(4*hi+((lane&15)>>2))*64;
  const char*Kbase=shm+LDSW_K; bf16x8 kf[8];
  const lds_cptr shm3=(lds_cptr)shm; const lds_cptr kp0=shm3+LDSW_K+hi*1024+r32*16; const lds_cptr vp0=shm3+LDSW_V+((lane>>4)&1)*32+(lane&3)*8+(4*hi+((lane&15)>>2))*64;
  const int NT=(q0+QB)/KVBLK;
  DMA_K(0,0);DMA_V(0,0);DMA_K(1,SLOTB);
  bf16x8 qr[4];
  #pragma unroll
  for(int d0=0;d0<4;++d0)qr[d0]=*reinterpret_cast<const bf16x8*>(&Qw[(long)r32*DM+d0*16+hi*8]);
  float zz_=0.f; asm volatile("":"+v"(zz_));
  float mhat=0.f,l_reg=0.f;f32x16 o[4];
  #pragma unroll
  for(int r=0;r<16;++r){o[0][r]=zz_;o[1][r]=zz_;o[2][r]=zz_;o[3][r]=zz_;}
  const f32x16 zero16={};
  const int qrel=wid*QBLK+r32;
  #define CMASK(P0,P1,t) do{int jb_=(t)-(NT-4); if(jb_>=0)cmask(P0,P1,jb_,qrel,hi);}while(0)
  bool resc=false;
  #define START(P0,P1) do{ const float rm=rowmax(P0,P1); resc=false; \
    { const float dl=(__builtin_fabsf(rm)>(float)THRL)?rm:0.f; mhat=fadd_s(mhat,dl);     \
      _Pragma("unroll") for(int r=0;r<16;++r){P0[r]=fsub_s(P0[r],dl);P1[r]=fsub_s(P1[r],dl);} } \
    _Pragma("unroll") for(int r=0;r<16;++r)P0[r]=__builtin_amdgcn_exp2f(P0[r]); }while(0)
  #define RESC() do{ if(resc){ asm volatile("s_waitcnt lgkmcnt(0)":::"memory"); \
      _Pragma("unroll") for(int d_=0;d_<4;++d_) _Pragma("unroll") for(int r=0;r<16;++r)o[d_][r]*=wsf[crow(r,hi)]; } }while(0)
  f32x16 pA0,pA1,pB0,pB1;
  int sl_prev=0,sl_cur=0,sl_next=SLOTB;
  #define ROT() do{sl_prev=sl_cur;sl_cur=sl_next;sl_next=(sl_next==(NSLOT-1)*SLOTB)?0:sl_next+SLOTB;}while(0)
  DMA_K(2,2*SLOTB);
  WAIT_BAR(4);
  qkt(pA0,pA1,Kbase,qr,zero16,r32,hi);asm volatile("s_nop 15\n\ts_nop 7":"+v"(pA0),"+v"(pA1));CMASK(pA0,pA1,0);
  START(pA0,pA1);
  _Pragma("unroll") for(int r=0;r<16;++r)pA1[r]=__builtin_amdgcn_exp2f(pA1[r]);
  WAIT_BAR(0);
  DMA_K(3,0);DMA_V(1,SLOTB);
  ROT();
  kload8(kf,kp0+sl_cur);
  WAIT_BAR(3);
  s16x4 vlo[4],vhi[4]; u32x4 pw0,pw1,pw2,pw3;
  #define GAPB2(MF,X,B) do{ MF; X[B]=EX(X[B]); X[B+1]=EX(X[B+1]); PIN(X); SBAR(); }while(0)
  #define PKW(P,B) cvtpk_s(P[B],P[B+1])
  #define PAF(k) __builtin_bit_cast(bf16x8,pw##k)
  #define VFR(i) (bf16x8){vlo[i][0],vlo[i][1],vlo[i][2],vlo[i][3],vhi[i][0],vhi[i][1],vhi[i][2],vhi[i][3]}
  #define PIN(x) asm volatile("":"+v"(x))
  #define MX3(a,b,c) __builtin_fmaxf(__builtin_fmaxf((a),(b)),(c))
  #define GAPA(MF,A0,A1,A2,A3,W0,W1,PW) do{ MF; sacc+=A0; sacc+=A1; sacc+=A2; sacc+=A3; PIN(sacc); W0; W1; PIN(PW); SBAR(); }while(0)
  #define EX(v) __builtin_amdgcn_exp2f(v)
  #define GAPB(MF,X,B) do{ MF; X[B]=EX(X[B]); X[B+1]=EX(X[B+1]); X[B+2]=EX(X[B+2]); X[B+3]=EX(X[B+3]); PIN(X); SBAR(); }while(0)
  #define VLD(sl,hf,i) do{ vlo[sl]=vtr(vp_+((hf)*8192+((i)>>2)*4096+((i)&3)*1024)); vhi[sl]=vtr(vp_+((hf)*8192+((i)>>2)*4096+((i)&3)*1024+512)); }while(0)
  #define KRD(G,j) do{ if(G){ kload2(kf,kp0+sl_next,j); SBAR(); } }while(0)
  #define STEP(C0,C1,P0,P1,t,GK,GV,GL) do{ SBAR(); \
    const lds_cptr vp_=vp0+2*sl_prev; \
    float sacc=(P0[0]+P0[1]); \
    GAPA(C0=__builtin_amdgcn_mfma_f32_32x32x16_bf16(kf[0],qr[0],zero16,0,0,0), P0[2],P0[3],P0[4],P0[5],     pw0[0]=PKW(P0,0), pw0[1]=PKW(P0,2), pw0); \
    GAPA(C1=__builtin_amdgcn_mfma_f32_32x32x16_bf16(kf[1],qr[0],zero16,0,0,0), P0[6],P0[7],P0[8],P0[9],     pw0[2]=PKW(P0,4), pw0[3]=PKW(P0,6), pw0); \
    GAPA(C0=__builtin_amdgcn_mfma_f32_32x32x16_bf16(kf[2],qr[1],C0,0,0,0),   P0[10],P0[11],P0[12],P0[13], pw1[0]=PKW(P0,8), pw1[1]=PKW(P0,10), pw1); \
    GAPA(C1=__builtin_amdgcn_mfma_f32_32x32x16_bf16(kf[3],qr[1],C1,0,0,0),   P0[14],P0[15],P1[0],P1[1],   pw1[2]=PKW(P0,12),pw1[3]=PKW(P0,14), pw1); \
    VLD(0,0,0); SBAR(); GAPA(C0=__builtin_amdgcn_mfma_f32_32x32x16_bf16(kf[4],qr[2],C0,0,0,0),   P1[2],P1[3],P1[4],P1[5],     pw2[0]=PKW(P1,0), pw2[1]=PKW(P1,2), pw2); \
    VLD(1,0,4); SBAR(); GAPA(C1=__builtin_amdgcn_mfma_f32_32x32x16_bf16(kf[5],qr[2],C1,0,0,0),   P1[6],P1[7],P1[8],P1[9],     pw2[2]=PKW(P1,4), pw2[3]=PKW(P1,6), pw2); \
    VLD(2,0,1); SBAR(); GAPA(C0=__builtin_amdgcn_mfma_f32_32x32x16_bf16(kf[6],qr[3],C0,0,0,0),   P1[10],P1[11],P1[12],P1[13], pw3[0]=PKW(P1,8), pw3[1]=PKW(P1,10), pw3); \
    VLD(3,0,5); SBAR(); GAPA(C1=__builtin_amdgcn_mfma_f32_32x32x16_bf16(kf[7],qr[3],C1,0,0,0),   P1[14],P1[15],0.f,0.f,       pw3[2]=PKW(P1,12),pw3[3]=PKW(P1,14), pw3); \
    l_reg+=sacc; \
    if(__any(mhat!=0.f)){ _Pragma("unroll") for(int r=0;r<16;++r){C0[r]-=mhat;C1[r]-=mhat;} } \
    if(GK){DMA_K((t)+3,sl_cur);} if(GV){DMA_V((t)+1,sl_next);} \
    CMASK(C0,C1,t); \
    { float a=MX3(C0[0],C0[1],C1[0]),b=MX3(C0[2],C0[3],C1[1]); a=MX3(a,C1[2],C1[3]); \
      _Pragma("unroll") for(int r=4;r<16;r+=4){a=MX3(a,C0[r],C0[r+1]);b=MX3(b,C0[r+2],C0[r+3]);a=MX3(a,C1[r],C1[r+1]);b=MX3(b,C1[r+2],C1[r+3]);} \
      float rm=__builtin_fmaxf(a,b); { auto rr=__builtin_amdgcn_permlane32_swap(__float_as_uint(rm),__float_as_uint(rm),false,false); rm=__builtin_fmaxf(__uint_as_float(rr[0]),__uint_as_float(rr[1])); } \
      resc=false; \
      if(__builtin_expect(__any(rm>(float)THRL),0)){ const float dl=__builtin_fmaxf(rm,0.f); mhat+=dl; \
        _Pragma("unroll") for(int r=0;r<16;++r){C0[r]-=dl;C1[r]-=dl;} \
        const float f=__builtin_amdgcn_exp2f(-dl); l_reg*=f; if(hi==0)wsf[r32]=f; resc=true; } } \
    SBAR(); \
    GAPB2(o[0]=__builtin_amdgcn_mfma_f32_32x32x16_bf16(PAF(0),VFR(0),o[0],0,0,0), C0,0); VLD(0,0,2); SBAR(); \
    GAPB2(o[1]=__builtin_amdgcn_mfma_f32_32x32x16_bf16(PAF(0),VFR(1),o[1],0,0,0), C0,2); VLD(1,0,6); SBAR(); \
    GAPB2(o[0]=__builtin_amdgcn_mfma_f32_32x32x16_bf16(PAF(1),VFR(2),o[0],0,0,0), C0,4); VLD(2,0,3); SBAR(); \
    GAPB2(o[1]=__builtin_amdgcn_mfma_f32_32x32x16_bf16(PAF(1),VFR(3),o[1],0,0,0), C0,6); VLD(3,0,7); SBAR(); \
    GAPB2(o[0]=__builtin_amdgcn_mfma_f32_32x32x16_bf16(PAF(2),VFR(0),o[0],0,0,0), C0,8); VLD(0,1,0); SBAR(); \
    GAPB2(o[1]=__builtin_amdgcn_mfma_f32_32x32x16_bf16(PAF(2),VFR(1),o[1],0,0,0), C0,10); VLD(1,1,4); SBAR(); \
    GAPB2(o[0]=__builtin_amdgcn_mfma_f32_32x32x16_bf16(PAF(3),VFR(2),o[0],0,0,0), C0,12); VLD(2,1,1); SBAR(); \
    GAPB2(o[1]=__builtin_amdgcn_mfma_f32_32x32x16_bf16(PAF(3),VFR(3),o[1],0,0,0), C0,14); VLD(3,1,5); SBAR(); \
    GAPB2(o[2]=__builtin_amdgcn_mfma_f32_32x32x16_bf16(PAF(0),VFR(0),o[2],0,0,0), C1,0); VLD(0,1,2); SBAR(); \
    GAPB2(o[3]=__builtin_amdgcn_mfma_f32_32x32x16_bf16(PAF(0),VFR(1),o[3],0,0,0), C1,2); VLD(1,1,6); SBAR(); \
    KRD(GL,0); GAPB2(o[2]=__builtin_amdgcn_mfma_f32_32x32x16_bf16(PAF(1),VFR(2),o[2],0,0,0), C1,4); VLD(2,1,3); SBAR(); \
    KRD(GL,1); GAPB2(o[3]=__builtin_amdgcn_mfma_f32_32x32x16_bf16(PAF(1),VFR(3),o[3],0,0,0), C1,6); VLD(3,1,7); SBAR(); \
    KRD(GL,2); GAPB2(o[2]=__builtin_amdgcn_mfma_f32_32x32x16_bf16(PAF(2),VFR(0),o[2],0,0,0), C1,8); \
    KRD(GL,3); GAPB2(o[3]=__builtin_amdgcn_mfma_f32_32x32x16_bf16(PAF(2),VFR(1),o[3],0,0,0), C1,10); \
    GAPB2(o[2]=__builtin_amdgcn_mfma_f32_32x32x16_bf16(PAF(3),VFR(2),o[2],0,0,0), C1,12); \
    GAPB2(o[3]=__builtin_amdgcn_mfma_f32_32x32x16_bf16(PAF(3),VFR(3),o[3],0,0,0), C1,14); \
    }while(0)
  int t=1;
  #undef CMASK
  #define CMASK(P0,P1,t) do{}while(0)
  for(;t+5<NT;t+=2){
    STEP(pB0,pB1,pA0,pA1,t,true,true,true);     WAIT_BAR(3); RESC(); ROT();
    STEP(pA0,pA1,pB0,pB1,t+1,true,true,true);   WAIT_BAR(3); RESC(); ROT();
  }
  #undef CMASK
  #define CMASK(P0,P1,t) do{int jb_=(t)-(NT-4); if(jb_>=0)cmask(P0,P1,jb_,qrel,hi);}while(0)
  #define ENDW(tt) do{ if((tt)+3<NT){WAIT_BAR(3);} else if((tt)+2<NT){WAIT_BAR(2);} else {WAIT_BAR(0);} }while(0)
  for(;t+1<NT;t+=2){
    STEP(pB0,pB1,pA0,pA1,t,(t+3<NT),(t+1<NT),(t+1<NT));       ENDW(t);   RESC(); ROT();
    STEP(pA0,pA1,pB0,pB1,t+1,(t+4<NT),(t+2<NT),(t+2<NT));     ENDW(t+1); RESC(); ROT();
  }
  STEP(pB0,pB1,pA0,pA1,NT-1,false,false,false); RESC();
  { float sacc=pB0[0]+pB0[1]; _Pragma("unroll") for(int r=2;r<16;++r)sacc+=pB0[r]; _Pragma("unroll") for(int r=0;r<16;++r)sacc+=pB1[r]; l_reg+=sacc;
    pw0=(u32x4){PKW(pB0,0),PKW(pB0,2),PKW(pB0,4),PKW(pB0,6)};pw1=(u32x4){PKW(pB0,8),PKW(pB0,10),PKW(pB0,12),PKW(pB0,14)};pw2=(u32x4){PKW(pB1,0),PKW(pB1,2),PKW(pB1,4),PKW(pB1,6)};pw3=(u32x4){PKW(pB1,8),PKW(pB1,10),PKW(pB1,12),PKW(pB1,14)};
    SBAR(); pv(o,vb0+2*sl_cur,PAF(0),PAF(1),PAF(2),PAF(3)); pv(o+2,vb0+2*sl_cur+8192,PAF(0),PAF(1),PAF(2),PAF(3)); }
  #undef PKW
  #undef PAF
  #undef VFR
  #undef PIN
  #undef MX3
  #undef GAPA
  #undef GAPB
  #undef GAPB2
  #undef EX
  #undef VLD
  #undef KRD
  #undef STEP
  #undef ENDW
  {auto rr=__builtin_amdgcn_permlane32_swap(__float_as_uint(l_reg),__float_as_uint(l_reg),false,false);l_reg=__uint_as_float(rr[0])+__uint_as_float(rr[1]);}
  if(hi==0)wsf[32+r32]=l_reg;asm volatile("s_waitcnt lgkmcnt(0)":::"memory");
  float rli[16];
  #pragma unroll
  for(int r=0;r<16;++r)rli[r]=__builtin_amdgcn_rcpf(wsf[32+crow(r,hi)]);
  bf16*Ow=O+(rowbase+q0+wid*QBLK)*DM+hh*128;
  bf16*stg=(bf16*)(shm+LDSW_OST)+wid*2048;
  if(!CB.on){
    #pragma unroll
    for(int hf=0;hf<2;++hf){
      #pragma unroll
      for(int r=0;r<16;++r){const int orow=crow(r,hi);
        #pragma unroll
        for(int d0=0;d0<2;++d0)stg[orow*64+d0*32+r32]=__float2bfloat16(o[2*hf+d0][r]*rli[r]);}
      asm volatile("s_waitcnt lgkmcnt(0)":::"memory");
      #pragma unroll
      for(int i=0;i<4;++i){const int row=i*8+(lane>>3),ch=lane&7; const u32x4 v=*(const u32x4*)(stg+row*64+ch*8); ATTN_STORE16(Ow+(long)row*DM+hf*64+ch*8,v);}
      asm volatile("s_waitcnt lgkmcnt(0)":::"memory"); }
  } else {
    const bf16*O0w=CB.O0+(rowbase+q0+wid*QBLK)*DM+hh*128; bf16*Cw=CB.oc+(rowbase+q0+wid*QBLK)*DM+hh*128;
    float av[2][4][8]; float ss[4]={0.f,0.f,0.f,0.f};
    #pragma unroll
    for(int hf=0;hf<2;++hf){
      #pragma unroll
      for(int r=0;r<16;++r){const int orow=crow(r,hi);
        #pragma unroll
        for(int d0=0;d0<2;++d0)stg[orow*64+d0*32+r32]=__float2bfloat16(o[2*hf+d0][r]*rli[r]);}
      asm volatile("s_waitcnt lgkmcnt(0)":::"memory");
      #pragma unroll
      for(int i=0;i<4;++i){const int row=i*8+(lane>>3),ch=lane&7; const u32x4 v1=*(const u32x4*)(stg+row*64+ch*8); const u32x4 v0=*(const u32x4*)(O0w+(long)row*DM+hf*64+ch*8);
        #pragma unroll
        for(int x=0;x<4;++x){ const float a0=__uint_as_float(v0[x]<<16)-CB.lam*__uint_as_float(v1[x]<<16), a1=__uint_as_float(v0[x]&0xffff0000u)-CB.lam*__uint_as_float(v1[x]&0xffff0000u);
          av[hf][i][2*x]=a0; av[hf][i][2*x+1]=a1; ss[i]+=a0*a0+a1*a1; } }
      asm volatile("s_waitcnt lgkmcnt(0)":::"memory"); }
    #pragma unroll
    for(int i=0;i<4;++i){ float t=ss[i];
      t+=__builtin_bit_cast(float,__builtin_amdgcn_update_dpp(0,__builtin_bit_cast(int,t),0xB1,0xf,0xf,false)); t+=__builtin_bit_cast(float,__builtin_amdgcn_update_dpp(0,__builtin_bit_cast(int,t),0x4E,0xf,0xf,false));
      t+=__builtin_bit_cast(float,__builtin_amdgcn_update_dpp(0,__builtin_bit_cast(int,t),0x141,0xf,0xf,false));
      const float rn=__builtin_amdgcn_rsqf(t*(1.f/128.f)+CB.eps)*CB.post; const int row=i*8+(lane>>3),ch=lane&7;
      #pragma unroll
      for(int hf=0;hf<2;++hf){ const float*gp=CB.g+hf*64+ch*8; u32x4 w;
        #pragma unroll
        for(int x=0;x<4;++x)w[x]=cvtpk_s(av[hf][i][2*x]*rn*gp[2*x],av[hf][i][2*x+1]*rn*gp[2*x+1]);
        ATTN_STORE16(Cw+(long)row*DM+hf*64+ch*8,w); } }
  }
  asm volatile("s_waitcnt lgkmcnt(0)\n\ts_barrier":::"memory");
  #undef DMA_K
  #undef DMA_V
  #undef CMASK
  #undef START
  #undef RESC
  #undef ROT
}
constexpr int ATTN_LDS_BYTES=LDS_BYTES;
struct AttnTensors { const bf16* Q; const bf16* K; const bf16* V; bf16* O0; Combine cb; };
template<int THRL=8,class Gap> __device__ __forceinline__ void attn_phase(char*lds,const AttnTensors&T,int vcu,int G,Gap gap){
  const int nbig=(512-vcu+G-1)/G; int i=0;
  if(__builtin_amdgcn_readfirstlane((int)threadIdx.x)>=256) __builtin_amdgcn_s_setprio(1);
  for(int L=vcu;L<512;L+=G){ const int rnd=L>>8,v=L&255,r=v&7,qb=rnd?r:(NQB-1-r); const int b=v>>5,h=rnd*4+((v&31)>>3);
    #pragma unroll 1
    for(int c=0;c<2;++c){ Combine cb=T.cb; cb.on=(c==1); attn_unit_w<THRL>(b,2*h+c,h,qb,T.Q,T.K,T.V,T.O0,lds,cb); gap(i,2*nbig); ++i; } }
}
#undef SBAR
#undef WAIT_BAR
}
#ifndef PROBE_DUP
#define PROBE_DUP (-1)
#endif
constexpr int NWAVES = 8;
constexpr int NPHASE = 11;
constexpr int RING_OFF = 0, RING_BYTES = 131072;
constexpr int LDSCTL_OFF = RING_BYTES, MISC_OFF = LDSCTL_OFF + 320;
constexpr int L_PTRS = LDSCTL_OFF;
constexpr int L_TSTART = 131584;
constexpr int L_CNT = 131744;
constexpr int L_TILEE = 131872;
constexpr int L_GTAB = 133120, MAXU = 12;
constexpr int L_ULIST = L_GTAB + MAXU * 1024;
constexpr int LDS_BYTES = 147456;
static_assert(MISC_OFF + 128 <= L_TSTART && L_TILEE + MT_MAX * 4 <= L_GTAB && L_ULIST + 16 + 16 * MAXU <= LDS_BYTES, "LDS map");

#define GAS __attribute__((address_space(1)))
#define LAS __attribute__((address_space(3)))
typedef unsigned short bf16;
typedef unsigned v4u __attribute__((ext_vector_type(4)));
typedef unsigned v2u __attribute__((ext_vector_type(2)));
typedef float f32x4 __attribute__((ext_vector_type(4)));
typedef GAS unsigned gu32;
#define RLX_AGENT __ATOMIC_RELAXED, __HIP_MEMORY_SCOPE_AGENT
#define LDS_WAIT() asm volatile("s_waitcnt lgkmcnt(0)" ::: "memory")
#define VM_WAIT() asm volatile("s_waitcnt vmcnt(0)" ::: "memory")
__device__ __forceinline__ unsigned pk2(float lo, float hi) { return pg8::cvt_pk_bf16(lo, hi); }
__device__ __forceinline__ float bflo(unsigned w) { return __uint_as_float(w << 16); }
__device__ __forceinline__ float bfhi(unsigned w) { return __uint_as_float(w & 0xffff0000u); }

#define XB_TMO      128
#define XB_XCNT(j)  (256  + 64 * (j))
#define XB_XSUB(j)  (1280 + 64 * (j))
#define XB_XGEN(j)  (2304 + 64 * (j))
#define XB_TOP      3328
#define XB_TOPGEN   3392
#define XCD_BAR_WORDS 3456
#define XB_LSUB(j)  (-1024 + 64 * (j))
#define XB_LGEN(j)  (-512 + 64 * (j))
#define XB_SPIN_CAP (1u << 18)
__device__ __forceinline__ unsigned xb_ld(unsigned* p)              { return __hip_atomic_load(p, __ATOMIC_RELAXED, __HIP_MEMORY_SCOPE_AGENT); }
__device__ __forceinline__ unsigned xb_add(unsigned* p, unsigned v) { return __hip_atomic_fetch_add(p, v, __ATOMIC_RELAXED, __HIP_MEMORY_SCOPE_AGENT); }
__device__ __forceinline__ unsigned xb_xcc_id() { return (unsigned)__builtin_amdgcn_s_getreg((3 << 11) | 20) & 0xFu; }
#define XB_SPIN(cond, bar) do { unsigned _sp = 0; while (cond) { __builtin_amdgcn_s_sleep(1); \
    if ((++_sp & 255u) == 0u) { if (xb_ld(&(bar)[XB_TMO])) break; if (_sp > XB_SPIN_CAP) { atomicAdd(&(bar)[XB_TMO], 1u); break; } } } } while (0)
struct XcdBarrier { unsigned* bar; unsigned x; volatile LAS unsigned* st; };
__device__ __forceinline__ XcdBarrier xcd_barrier_post(unsigned* bar, volatile LAS unsigned* st) {
    XcdBarrier b; b.bar = bar; b.x = xb_xcc_id(); b.st = st;
    if (threadIdx.x == 0) st[3] = xb_add(&bar[XB_XCNT(b.x)], 1u);
    return b;
}
__device__ __forceinline__ void xcd_barrier_complete(unsigned* bar, unsigned x, unsigned& nloc, unsigned& nx, unsigned& even) {
    const unsigned G = gridDim.x * gridDim.y * gridDim.z;
    unsigned sum, cnt, mine, sp = 0u;
    for (;;) {
        sum = 0u; cnt = 0u; mine = 0u; even = (G == 256u) ? 1u : 0u;
#pragma unroll
        for (unsigned j = 0; j < 16; ++j) { const unsigned c = xb_ld(&bar[XB_XCNT(j)]); sum += c; cnt += (c > 0u) ? 1u : 0u; mine = (j == x) ? c : mine; even = (c == (j < 8u ? 32u : 0u)) ? even : 0u; }
        if (sum == G) break;
        __builtin_amdgcn_s_sleep(1);
        if ((++sp & 255u) == 0u) { if (xb_ld(&bar[XB_TMO])) break; if (sp > XB_SPIN_CAP) { atomicAdd(&bar[XB_TMO], 1u); break; } }
    }
    nloc = mine > 0u ? mine : 1u; nx = cnt > 0u ? cnt : 1u;
}
__device__ __forceinline__ void xcd_barrier(const XcdBarrier& b) {
    asm volatile("s_waitcnt vmcnt(0)" ::: "memory");
    __syncthreads();
    if (threadIdx.x == 0) {
        unsigned* bar = b.bar;
        __builtin_amdgcn_s_waitcnt(0);
        unsigned nloc = b.st[0], nx = b.st[1];
        if (nloc == 0u) { unsigned even; xcd_barrier_complete(bar, b.x, nloc, nx, even); b.st[0] = nloc; b.st[1] = nx; b.st[2] = 1u + even; }
        const unsigned old = xb_add(&bar[XB_XSUB(b.x)], 1u);
        const unsigned gen = old / nloc;
        if (old + 1u == (gen + 1u) * nloc) {
            __builtin_amdgcn_fence(__ATOMIC_RELEASE, "agent");
            asm volatile("s_waitcnt vmcnt(0)" ::: "memory");
            const unsigned og = xb_add(&bar[XB_TOP], 1u);
            const unsigned tg = og / nx;
            if (og + 1u == (tg + 1u) * nx) xb_add(&bar[XB_TOPGEN], 1u);
            else XB_SPIN(xb_ld(&bar[XB_TOPGEN]) == tg, bar);
            __builtin_amdgcn_fence(__ATOMIC_ACQUIRE, "agent");
            xb_add(&bar[XB_XGEN(b.x)], 1u);
            asm volatile("s_waitcnt vmcnt(0)" ::: "memory");
        } else {
            XB_SPIN(xb_ld(&bar[XB_XGEN(b.x)]) == gen, bar);
            __builtin_amdgcn_fence(__ATOMIC_ACQUIRE, "agent");
            asm volatile("s_waitcnt vmcnt(0)" ::: "memory");
        }
    }
    __syncthreads();
}

__device__ __forceinline__ void xcc_local_barrier(const XcdBarrier& b) {
    asm volatile("s_waitcnt vmcnt(0)" ::: "memory");
    __syncthreads();
    if (threadIdx.x == 0) {
        unsigned* bar = b.bar;
        __builtin_amdgcn_s_waitcnt(0);
        const unsigned old = xb_add(&bar[XB_LSUB((int)b.x)], 1u);
        const unsigned gen = old >> 5;
        if (old + 1u == (gen + 1u) << 5) xb_add(&bar[XB_LGEN((int)b.x)], 1u);
        else XB_SPIN(xb_ld(&bar[XB_LGEN((int)b.x)]) == gen, bar);
        __builtin_amdgcn_fence(__ATOMIC_ACQUIRE, "agent");
        asm volatile("s_waitcnt vmcnt(0)" ::: "memory");
    }
    __syncthreads();
}

struct Frame {
    LAS unsigned char* lds;
    volatile LAS unsigned* MISC;
    gu32* ctl;
    int tid, lane, wave;
    int vcu, G, vb;
    unsigned char* ws;
};
__device__ __forceinline__ const void* inp(const Frame& F, int i) {
    const LAS unsigned* p = (const LAS unsigned*)(F.lds + L_PTRS) + 2 * i;
    const unsigned lo = __builtin_amdgcn_readfirstlane(p[0]), hi = __builtin_amdgcn_readfirstlane(p[1]);
    return (const void*)(const GAS char*)(((unsigned long long)hi << 32) | lo);
}
template <int CTRL> __device__ __forceinline__ float dpp_f(float v) { return __builtin_bit_cast(float, __builtin_amdgcn_update_dpp(0, __builtin_bit_cast(int, v), CTRL, 0xf, 0xf, false)); }
#define XSUM16(v) do { const auto r_ = __builtin_amdgcn_permlane16_swap(__float_as_uint(v), __float_as_uint(v), false, false); v = __uint_as_float(r_[0]) + __uint_as_float(r_[1]); } while (0)
#define XSUM32(v) do { const auto r_ = __builtin_amdgcn_permlane32_swap(__float_as_uint(v), __float_as_uint(v), false, false); v = __uint_as_float(r_[0]) + __uint_as_float(r_[1]); } while (0)
#define XMAX16(v) do { const auto r_ = __builtin_amdgcn_permlane16_swap(__float_as_uint(v), __float_as_uint(v), false, false); v = fmaxf(__uint_as_float(r_[0]), __uint_as_float(r_[1])); } while (0)
__device__ __forceinline__ float sum8(float v) { v += dpp_f<0xB1>(v); v += dpp_f<0x4E>(v); v += dpp_f<0x141>(v); return v; }
__device__ __forceinline__ float wave_sum(float v) {
    v = sum8(v); v += dpp_f<0x140>(v);
    XSUM16(v); XSUM32(v);
    return v;
}
__device__ __forceinline__ float max32(float v) {
    v = fmaxf(v, dpp_f<0xB1>(v)); v = fmaxf(v, dpp_f<0x4E>(v)); v = fmaxf(v, dpp_f<0x141>(v)); v = fmaxf(v, dpp_f<0x140>(v));
    XMAX16(v); return v;
}

template <class RowFn>
__device__ __forceinline__ void tr_item(const float* W, int ldw, int k0, int n0, bf16* dst, int ldk, int kd0, RowFn drow, LAS bf16* scr, int lane, bool zero) {
    const int c4 = lane & 15, kr = lane >> 4;
    if (!zero) {
        f32x4 v[16];
#pragma unroll
        for (int s = 0; s < 16; ++s) v[s] = *(const GAS f32x4*)(W + (size_t)(k0 + kr + 4 * s) * ldw + n0 + 4 * c4);
#pragma unroll
        for (int s = 0; s < 16; ++s) { const int kk = kr + 4 * s; const unsigned lo = pk2(v[s][0], v[s][1]), hi = pk2(v[s][2], v[s][3]);
            scr[(4 * c4 + 0) * 66 + kk] = (bf16)(lo & 0xffff); scr[(4 * c4 + 1) * 66 + kk] = (bf16)(lo >> 16); scr[(4 * c4 + 2) * 66 + kk] = (bf16)(hi & 0xffff); scr[(4 * c4 + 3) * 66 + kk] = (bf16)(hi >> 16); }
        LDS_WAIT(); asm volatile("" ::: "memory");
    }
    const int ch = lane & 7;
#pragma unroll
    for (int j = 0; j < 8; ++j) { const int nn = (lane >> 3) + 8 * j; v4u o = {0u, 0u, 0u, 0u};
        if (!zero) { const LAS unsigned* sp = (const LAS unsigned*)(scr + nn * 66 + 8 * ch); o.x = sp[0]; o.y = sp[1]; o.z = sp[2]; o.w = sp[3]; }
        *(GAS v4u*)(dst + (size_t)drow(nn) * ldk + kd0 + 8 * ch) = o; }
    LDS_WAIT(); asm volatile("" ::: "memory");
}

template <class RowFn>
__device__ __forceinline__ void tr_item_fp8(const float* W, int ldw, int k0, int n0, unsigned char* dst, int ldk, int kd0, RowFn drow, LAS unsigned char* scr, int lane) {
    const int c4 = lane & 15, kr = lane >> 4;
    f32x4 v[4][4];
#pragma unroll
    for (int s = 0; s < 4; ++s)
#pragma unroll
        for (int j = 0; j < 4; ++j) v[s][j] = *(const GAS f32x4*)(W + (size_t)(k0 + 16 * s + 4 * kr + j) * ldw + n0 + 4 * c4);
#pragma unroll
    for (int s = 0; s < 4; ++s)
#pragma unroll
        for (int x = 0; x < 4; ++x) { int w = 0; w = __builtin_amdgcn_cvt_pk_fp8_f32(v[s][0][x] * pg8::W8_SCALE, v[s][1][x] * pg8::W8_SCALE, w, false); w = __builtin_amdgcn_cvt_pk_fp8_f32(v[s][2][x] * pg8::W8_SCALE, v[s][3][x] * pg8::W8_SCALE, w, true);
            *(LAS unsigned*)(scr + (4 * c4 + x) * 68 + 16 * s + 4 * kr) = (unsigned)w; }
    LDS_WAIT(); asm volatile("" ::: "memory");
    const int ch = lane & 3;
#pragma unroll
    for (int j = 0; j < 4; ++j) { const int nn = (lane >> 2) + 16 * j; const LAS unsigned* sp = (const LAS unsigned*)(scr + nn * 68 + 16 * ch); v4u o; o.x = sp[0]; o.y = sp[1]; o.z = sp[2]; o.w = sp[3];
        *(GAS v4u*)(dst + (size_t)drow(nn) * ldk + kd0 + 16 * ch) = o; }
    LDS_WAIT(); asm volatile("" ::: "memory");
}

struct CItem { const float* src; unsigned char* dst; int ldw, ldk, base, mode; };
__device__ __forceinline__ CItem conv_item(const float* w_exp1, const float* w_exp2, unsigned char* ws, int r) {
    constexpr int I_2 = NE * 16 * 16;
    CItem it;
    if (r >= I_2) { r -= I_2; const int e = r / 512, rr = r % 512, kb = rr / 32, nb = rr % 32, n0 = nb * 64, j2 = n0 >> 1, pn = j2 >> 7, j = j2 & 127;
        it.src = w_exp1 + (size_t)e * D * 2 * FF + (size_t)(kb * 64) * (2 * FF) + n0; it.ldw = 2 * FF; it.dst = ws + WS_W1 + (size_t)e * 2 * FF * D + kb * 64; it.ldk = D; it.base = 256 * pn + j; it.mode = 1; }
    else { const int e = r / 256, rr = r % 256, kb = rr / 16, nb = rr % 16;
        it.src = w_exp2 + (size_t)e * FF * D + (size_t)(kb * 64) * D + nb * 64; it.ldw = D; it.dst = ws + WS_W2 + (size_t)e * D * FF + kb * 64; it.ldk = FF; it.base = nb * 64; it.mode = 0; }
    return it;
}
__device__ __forceinline__ void conv_load(const CItem& it, f32x4 (&v)[4][4], int lane) {
    const int c4 = lane & 15, kr = lane >> 4;
#pragma unroll
    for (int s = 0; s < 4; ++s)
#pragma unroll
        for (int j = 0; j < 4; ++j) v[s][j] = __builtin_nontemporal_load((const GAS f32x4*)(it.src + (size_t)(16 * s + 4 * kr + j) * it.ldw + 4 * c4));
}
__device__ __forceinline__ void conv_store(const CItem& it, const f32x4 (&v)[4][4], LAS unsigned char* scr, int lane) {
    const int c4 = lane & 15, kr = lane >> 4;
#pragma unroll
    for (int s = 0; s < 4; ++s)
#pragma unroll
        for (int x = 0; x < 4; ++x) { int w = 0; w = __builtin_amdgcn_cvt_pk_fp8_f32(v[s][0][x] * pg8::W8_SCALE, v[s][1][x] * pg8::W8_SCALE, w, false); w = __builtin_amdgcn_cvt_pk_fp8_f32(v[s][2][x] * pg8::W8_SCALE, v[s][3][x] * pg8::W8_SCALE, w, true);
            *(LAS unsigned*)(scr + (4 * c4 + x) * 68 + 16 * s + 4 * kr) = (unsigned)w; }
    LDS_WAIT(); asm volatile("" ::: "memory");
    const int ch = lane & 3;
#pragma unroll
    for (int j = 0; j < 4; ++j) { const int nn = (lane >> 2) + 16 * j; const LAS unsigned* sp = (const LAS unsigned*)(scr + nn * 68 + 16 * ch); v4u o; o.x = sp[0]; o.y = sp[1]; o.z = sp[2]; o.w = sp[3];
        const int row = it.mode ? it.base + 128 * (nn & 1) + (nn >> 1) : it.base + nn;
        *(GAS v4u*)(it.dst + (size_t)row * it.ldk + 16 * ch) = o; }
    LDS_WAIT(); asm volatile("" ::: "memory");
}
__device__ __forceinline__ void conv_expert_items(Frame& F, int first, int count, int k, int n, int part, int nparts, LAS unsigned char* scr) {
    const float* const w_exp1_ = (const float*)inp(F, 21); const float* const w_exp2_ = (const float*)inp(F, 23);
    const int ipw = (count + n - 1) / n, base = k * ipw, own = (ipw - F.wave + 7) / 8;
    const int j0 = own * part / nparts, j1 = own * (part + 1) / nparts;
    int lane = F.lane; asm volatile("" : "+v"(lane));
    int jj = j0;
    for (; jj + 1 < j1; jj += 2) {
        const int r0 = base + F.wave + 8 * jj, r1 = r0 + 8; if (r1 >= count) break;
        const CItem a = conv_item(w_exp1_, w_exp2_, F.ws, first + r0), b = conv_item(w_exp1_, w_exp2_, F.ws, first + r1);
        f32x4 va[4][4], vb[4][4]; conv_load(a, va, lane); conv_load(b, vb, lane); conv_store(a, va, scr, lane); conv_store(b, vb, scr, lane);
    }
    for (; jj < j1; ++jj) {
        const int r0 = base + F.wave + 8 * jj; if (r0 >= count) break;
        const CItem a = conv_item(w_exp1_, w_exp2_, F.ws, first + r0); f32x4 va[4][4]; conv_load(a, va, lane); conv_store(a, va, scr, lane);
    }
}
__device__ __forceinline__ void conv_in_idle_round(Frame& F, int nwg, int first, int count) {
    const int r = nwg % F.G, c = F.vb;
    if (r != 0 && c < r) return;
    conv_expert_items(F, first, count, r ? c - r : c, r ? F.G - r : F.G, 0, 1, F.lds + RING_OFF + F.wave * 4352);
}
constexpr int CONV_W2_IN_P2 = 5120, CONV_W2_ALL = NE * 16 * 16, CONV_ALL = NE * 16 * 16 + NE * 16 * 32;
__device__ __forceinline__ void p0_prologue(Frame& F) {
    const float* const c_ = (const float*)inp(F, 1); const float* const w_ada_ = (const float*)inp(F, 3); const float* const b_ada_ = (const float*)inp(F, 4); float* const mod_ = (float*)(F.ws + WS_MOD); const int* const positions_ = (const int*)inp(F, 2); float* const rope_ = (float*)(F.ws + WS_ROPE); const float* const lq1_ = (const float*)inp(F, 7); const float* const lk1_ = (const float*)inp(F, 8); const float* const lq2_ = (const float*)inp(F, 9); const float* const lk2_ = (const float*)inp(F, 10); float* const lam_ = (float*)(F.ws + WS_MOD + 256 * 1024); const float* const w_exp1_ = (const float*)inp(F, 21); bf16* const W1_t_ = (bf16*)(F.ws + WS_W1); const float* const w_exp2_ = (const float*)inp(F, 23); bf16* const W2_t_ = (bf16*)(F.ws + WS_W2); const float* const w_in_ = (const float*)inp(F, 6); bf16* const Win_t_ = (bf16*)(F.ws + WS_WIN); const float* const w_proj_a_ = (const float*)inp(F, 14); bf16* const Wa_t_ = (bf16*)(F.ws + WS_WA); const float* const w_proj_b_ = (const float*)inp(F, 15); bf16* const Wb_t_ = (bf16*)(F.ws + WS_WB); const float* const w_pool_ = (const float*)inp(F, 12); const float* const pool_scale_ = (const float*)inp(F, 13); bf16* const Wpool_t_ = (bf16*)(F.ws + WS_WPOOL); const float* const w_out_ = (const float*)inp(F, 16); bf16* const Wout_t_ = (bf16*)(F.ws + WS_WOUT);
    {
        LAS float* sc = (LAS float*)(F.lds + RING_OFF);
        LAS float* red = (LAS float*)(F.lds + RING_OFF + 32768);
        bool staged = false;
        for (int it = blockIdx.x; it < 96; it += F.G) {
            if (!staged) { for (int i = F.tid; i < NB * D; i += NWAVES * 64) { const int b = i >> 10, kk = i & 1023; const float v = c_[i]; sc[kk * 8 + b] = v / (1.f + __expf(-v)); } __syncthreads(); staged = true; }
            const int j0 = it * 64, cg = F.lane & 15, kq = F.lane >> 4;
            float acc[8][4];
#pragma unroll
            for (int b = 0; b < 8; ++b)
#pragma unroll
                for (int xx = 0; xx < 4; ++xx) acc[b][xx] = 0.f;
#pragma unroll 8
            for (int s = 0; s < 32; ++s) { const int kk = 32 * s + 4 * F.wave + kq;
                const f32x4 w = *(const GAS f32x4*)(w_ada_ + (size_t)kk * (NMOD * D) + j0 + 4 * cg);
                const f32x4 s0 = *(const LAS f32x4*)(sc + kk * 8), s1 = *(const LAS f32x4*)(sc + kk * 8 + 4);
#pragma unroll
                for (int xx = 0; xx < 4; ++xx) { acc[0][xx] += s0[0] * w[xx]; acc[1][xx] += s0[1] * w[xx]; acc[2][xx] += s0[2] * w[xx]; acc[3][xx] += s0[3] * w[xx];
                    acc[4][xx] += s1[0] * w[xx]; acc[5][xx] += s1[1] * w[xx]; acc[6][xx] += s1[2] * w[xx]; acc[7][xx] += s1[3] * w[xx]; } }
#pragma unroll
            for (int b = 0; b < 8; ++b)
#pragma unroll
                for (int xx = 0; xx < 4; ++xx) { float a = acc[b][xx]; a += __shfl_xor(a, 16); a += __shfl_xor(a, 32); if (kq == 0) red[(F.wave * 8 + b) * 64 + 4 * cg + xx] = a; }
            __syncthreads();
            { const int b = F.tid >> 6, col = F.tid & 63; float a = b_ada_[j0 + col];
#pragma unroll
              for (int w = 0; w < 8; ++w) a += red[(w * 8 + b) * 64 + col];
              mod_[b * (NMOD * D) + j0 + col] = a; }
            __syncthreads();
        }
        if (staged) __syncthreads();
    }
    for (int idx = F.vcu * (NWAVES * 64) + F.tid; idx < T * 8; idx += F.G * NWAVES * 64) { const int t = idx >> 3, i = idx & 7; float cs, sn; rope_cs(positions_[t], i, cs, sn); rope_[t * 16 + i] = cs; rope_[t * 16 + 8 + i] = sn; }
    if (blockIdx.x == 0 && F.wave == 0) { const float s1 = wave_sum(lq1_[F.lane] * lk1_[F.lane]), s2 = wave_sum(lq2_[F.lane] * lk2_[F.lane]); if (F.lane == 0) lam_[0] = expf(s1) - expf(s2) + LAM_INIT; }
    {
        LAS bf16* scr = (LAS bf16*)(F.lds + RING_OFF + F.wave * 8448);
        const int gw = F.vcu * NWAVES + F.wave, NGW = F.G * NWAVES;
        constexpr int I_IN = 16 * (INC / 64), I_A = 16 * 16, I_O = 16 * 16;
        constexpr int NITEMS = I_IN + I_A + I_O;
        for (int it = gw; it < NITEMS; it += NGW) {
            int r = it;
            if (r < I_IN) { const int kb = r / (INC / 64), nb = r % (INC / 64);
                tr_item(w_in_, INC, kb * 64, nb * 64, Win_t_, D, kb * 64, [=](int nn) { return nb * 64 + ((nb < 32 && nn < 16) ? ((nn & 7) * 2 + (nn >> 3)) : nn); }, scr, F.lane, false); continue; } r -= I_IN;
            if (r < I_A) { const int kb = r / 16, nb = r % 16;
                tr_item(w_proj_a_, D, kb * 64, nb * 64, Wa_t_, DW, kb * 64, [=](int nn) { return nb * 64 + nn; }, scr, F.lane, false); continue; } r -= I_A;
            { const int kb = r / 16, nb = r % 16;
                tr_item(w_out_, D, kb * 64, nb * 64, Wout_t_, D, kb * 64, [=](int nn) { return nb * 64 + nn; }, scr, F.lane, false); }
        }
        const int nfree = (F.G > 96) ? F.G - 96 : F.G, myfree = (F.G > 96) ? (int)blockIdx.x - 96 : (int)blockIdx.x;
        for (int it = myfree * NWAVES + F.wave; myfree >= 0 && it < 16 * 64; it += nfree * NWAVES) {
            const int n = (it & 15) * 64 + F.lane, kk0 = (it >> 4) * 8, g = kk0 >> 7, c0 = kk0 & 127;
            const float* wp = w_pool_ + (size_t)g * 128 * 128 + (size_t)c0 * 128; const float* sc = pool_scale_ + g * 128; const float* wb = w_proj_b_ + (size_t)(g * 128) * D + n;
            float wr0[8], wr1[8];
            { const float s0 = sc[F.lane], s1 = sc[64 + F.lane];
#pragma unroll
              for (int q = 0; q < 8; ++q) { wr0[q] = wp[q * 128 + F.lane] * s0; wr1[q] = wp[q * 128 + 64 + F.lane] * s1; } }
            float acc[8];
#pragma unroll
            for (int q = 0; q < 8; ++q) acc[q] = 0.f;
#pragma unroll 1
            for (int j0 = 0; j0 < 128; j0 += 32) {
                float b[32];
#pragma unroll
                for (int u = 0; u < 32; ++u) b[u] = wb[(size_t)(j0 + u) * D];
#pragma unroll
                for (int u = 0; u < 32; ++u) { const int jx = j0 + u;
#pragma unroll
                    for (int q = 0; q < 8; ++q) { const float w = __builtin_bit_cast(float, __builtin_amdgcn_readlane(__builtin_bit_cast(int, (j0 < 64) ? wr0[q] : wr1[q]), jx & 63)); acc[q] += w * b[u]; } }
            }
            *(GAS v4u*)(Wb_t_ + (size_t)n * PW + kk0) = (v4u){pk2(acc[0], acc[1]), pk2(acc[2], acc[3]), pk2(acc[4], acc[5]), pk2(acc[6], acc[7])};
        }
    }
}

__device__ __forceinline__ void p1_norm(Frame& F) {
    const float* const g_pre_mix_ = (const float*)inp(F, 5); const float* const x_ = (const float*)inp(F, 0); float* const mod_ = (float*)(F.ws + WS_MOD); bf16* const h_ = (bf16*)(F.ws + WS_H);
    const int gw = F.vcu * NWAVES + F.wave, NGW = F.G * NWAVES;
    f32x4 gv[4];
#pragma unroll
    for (int j = 0; j < 4; ++j) gv[j] = *((const GAS f32x4*)g_pre_mix_ + F.lane + 64 * j);
    f32x4 shv[4], scv[4]; int curb = -1;
    for (int mi_ = gw; mi_ < T; mi_ += NGW) {
        const int m = ((mi_ & 2047) >> 8) * SEQ + (mi_ >> 11) * 256 + (mi_ & 255);
        const GAS f32x4* xr = (const GAS f32x4*)(x_ + (size_t)m * D) + F.lane; const float* mb = mod_ + (m / SEQ) * (NMOD * D);
        f32x4 v[4]; float s = 0.f;
#pragma unroll
        for (int j = 0; j < 4; ++j) v[j] = xr[64 * j];
        if (m / SEQ != curb) { curb = m / SEQ;
#pragma unroll
            for (int j = 0; j < 4; ++j) { shv[j] = *((const GAS f32x4*)mb + F.lane + 64 * j); scv[j] = *((const GAS f32x4*)(mb + D) + F.lane + 64 * j) + 1.f; } }
#pragma unroll
        for (int j = 0; j < 4; ++j) s += (v[j].x * v[j].x + v[j].y * v[j].y) + (v[j].z * v[j].z + v[j].w * v[j].w);
        const float r = rsqrtf(wave_sum(s) * (1.f / D) + NORM_EPS);
        GAS v2u* o8 = (GAS v2u*)(h_ + (size_t)m * D) + F.lane;
#pragma unroll
        for (int j = 0; j < 4; ++j) { const f32x4 o = v[j] * r * gv[j] * scv[j] + shv[j]; o8[64 * j] = (v2u){pk2(o.x, o.y), pk2(o.z, o.w)}; }
    }
}
__device__ __forceinline__ void p3_poold(Frame& F) {
    bf16* const u_ = (bf16*)(F.ws + WS_U); bf16* const dd_ = (bf16*)(F.ws + WS_DD);
    LAS unsigned* col = (LAS unsigned*)(F.lds + RING_OFF + F.wave * 16384);
    const int gw = F.vcu * NWAVES + F.wave, NGW = F.G * NWAVES;
    for (int it = gw; it < (T / 32) * 4; it += NGW) {
        const int g = it & 3, blk = it >> 2, t0 = blk * 32, tin0 = t0 % SEQ, w = 2 << g;
        const bf16* up = u_ + (size_t)t0 * PW + g * 128 + 2 * F.lane;
        unsigned vals[48];
#pragma unroll
        for (int r = 0; r < 48; ++r) { vals[r] = 0u; if (tin0 - 16 + r >= 0) vals[r] = *(const GAS unsigned*)(up + (ptrdiff_t)(r - 16) * PW); }
#pragma unroll
        for (int r = 0; r < 48; ++r) col[r * 64 + F.lane] = vals[r];
        LDS_WAIT(); asm volatile("" ::: "memory");
        float s0 = 0.f, s1 = 0.f;
        for (int j = 1; j <= w; ++j) { const unsigned val = col[(16 - j) * 64 + F.lane]; s0 += bflo(val); s1 += bfhi(val); }
        bf16* dp = dd_ + (size_t)t0 * PW + g * 128 + 2 * F.lane;
        for (int r = 0; r < 32; ++r) { const unsigned cur = col[(16 + r) * 64 + F.lane], old = col[(16 + r - w) * 64 + F.lane];
            s0 += bflo(cur) - bflo(old); s1 += bfhi(cur) - bfhi(old);
            const float inv = 1.f / (float)min(tin0 + r + 1, w);
            *(GAS unsigned*)(dp + (size_t)r * PW) = pk2(s0 * inv - bflo(cur), s1 * inv - bfhi(cur)); }
        LDS_WAIT(); asm volatile("" ::: "memory");
    }
}
__device__ __forceinline__ void p3_combine(Frame& F, int b, int h, int qb) {
    const float* const g_subln_ = (const float*)inp(F, 11); const float* const lam_ = (const float*)(F.ws + WS_MOD + 256 * 1024);
    const bf16* const O0_ = (const bf16*)(F.ws + WS_O0); const bf16* const O1_ = (const bf16*)(F.ws + WS_O1); bf16* const oc_ = (bf16*)(F.ws + WS_OC);
    asm volatile("s_waitcnt vmcnt(0)" ::: "memory"); __syncthreads();
    const __amdgpu_buffer_rsrc_t r0 = __builtin_amdgcn_make_buffer_rsrc((void*)O0_, 0, T * DW * 2, 0x00020000), r1 = __builtin_amdgcn_make_buffer_rsrc((void*)O1_, 0, T * DW * 2, 0x00020000);
    int lane = F.lane; asm volatile("" : "+v"(lane));
    const float lam = lam_[0];
    float gs[16];
#pragma unroll
    for (int i = 0; i < 16; ++i) gs[i] = g_subln_[16 * (lane & 7) + i] * (1.f - LAM_INIT);
#pragma unroll 2
    for (int st = 0; st < 4; ++st) {
        const int row = b * SEQ + qb * 256 + F.wave * 32 + st * 8 + (lane >> 3);
        const size_t off = (size_t)row * DW + h * 128 + 16 * (lane & 7);
        const unsigned ob = (unsigned)(off * 2);
        const v4u a0 = __builtin_amdgcn_raw_buffer_load_b128(r0, ob, 0, 16), a1 = __builtin_amdgcn_raw_buffer_load_b128(r0, ob + 16, 0, 16), b0 = __builtin_amdgcn_raw_buffer_load_b128(r1, ob, 0, 16), b1 = __builtin_amdgcn_raw_buffer_load_b128(r1, ob + 16, 0, 16);
        float v[16];
#pragma unroll
        for (int i = 0; i < 4; ++i) { v[2 * i] = bflo(a0[i]) - lam * bflo(b0[i]); v[2 * i + 1] = bfhi(a0[i]) - lam * bfhi(b0[i]); v[8 + 2 * i] = bflo(a1[i]) - lam * bflo(b1[i]); v[8 + 2 * i + 1] = bfhi(a1[i]) - lam * bfhi(b1[i]); }
        float ss = 0.f;
#pragma unroll
        for (int i = 0; i < 16; ++i) ss += v[i] * v[i];
        ss = sum8(ss);
        const float r = rsqrtf(ss * (1.f / 128.f) + SUBLN_EPS);
        v4u o0, o1;
#pragma unroll
        for (int i = 0; i < 4; ++i) { o0[i] = pk2(v[2 * i] * r * gs[2 * i], v[2 * i + 1] * r * gs[2 * i + 1]); o1[i] = pk2(v[8 + 2 * i] * r * gs[8 + 2 * i], v[9 + 2 * i] * r * gs[9 + 2 * i]); }
        *(GAS v4u*)(oc_ + off) = o0; *(GAS v4u*)(oc_ + off + 8) = o1;
    }
}
__device__ __forceinline__ void p7_router(Frame& F, const int npass) {
    const float* const w_router_ = (const float*)inp(F, 19); const float* const b_router_ = (const float*)inp(F, 20); float* const mod_ = (float*)(F.ws + WS_MOD); float* const mx_ = (float*)(F.ws + WS_MX); const float* const x_ = (const float*)inp(F, 0); const float* const g_post_mix_ = (const float*)inp(F, 17); float* const out_ = (float*)inp(F, 26); const float* const g_pre_ffn_ = (const float*)inp(F, 18); bf16* const h2_ = (bf16*)(F.ws + WS_H2); int* const list_ = (int*)(F.ws + WS_LIST); unsigned* const tokslot_ = (unsigned*)(F.ws + WS_TOK); float* const tokw_ = (float*)(F.ws + WS_TOK + 256 * 1024);
    constexpr int HP = 2064;
    LAS unsigned char* hhi = F.lds + RING_OFF; LAS unsigned char* hlo = F.lds + RING_OFF + 16 * HP;
    LAS float* part = (LAS float*)(F.lds + RING_OFF + 66048);
    LAS unsigned* sel = (LAS unsigned*)(F.lds + RING_OFF + 98304);
    LAS float* selw = (LAS float*)(F.lds + RING_OFF + 98304 + 2048);
    LAS int* selt = (LAS int*)(F.lds + RING_OFF + 98304 + 4096);
    LAS unsigned* lcnt = (LAS unsigned*)(F.lds + RING_OFF + 98304 + 4608);
    LAS f32x4* cv = (LAS f32x4*)(F.lds + RING_OFF + 106496);
    int curb = -1;
    if (F.tid < 64) lcnt[F.tid] = 0u;
    const int e = F.lane & 31;
    pg8::bf16x8 bhi[4][2], blo[4][2];
#pragma unroll
    for (int ks = 0; ks < 4; ++ks)
#pragma unroll
        for (int nb2 = 0; nb2 < 2; ++nb2) { unsigned hh[4], ll[4];
#pragma unroll
            for (int jp = 0; jp < 4; ++jp) { const size_t k0 = (size_t)(128 * F.wave + 32 * ks + 8 * (F.lane >> 4) + 2 * jp); const float w0 = w_router_[k0 * NE + 16 * nb2 + (F.lane & 15)], w1 = w_router_[(k0 + 1) * NE + 16 * nb2 + (F.lane & 15)];
                hh[jp] = pk2(w0, w1); ll[jp] = pk2(w0 - bflo(hh[jp]), w1 - bfhi(hh[jp])); }
            bhi[ks][nb2] = __builtin_bit_cast(pg8::bf16x8, (v4u){hh[0], hh[1], hh[2], hh[3]}); blo[ks][nb2] = __builtin_bit_cast(pg8::bf16x8, (v4u){ll[0], ll[1], ll[2], ll[3]}); }
    const float bre = b_router_[e];
    __syncthreads();
    int nb = 0;
    for (int pass = 0; pass < npass; ++pass) {
    if (pass > 0) { __syncthreads(); if (F.tid < 64) lcnt[F.tid] = 0u; __syncthreads(); }
    nb = 0;
    for (int bi = F.vcu; bi < T / 16; bi += F.G, ++nb) {
        const int bt = ((bi & 255) >> 5) * (SEQ / 16) + (bi >> 8) * 32 + (bi & 31);
        if ((bt * 16) / SEQ != curb) { curb = (bt * 16) / SEQ; const float* mb = mod_ + curb * (NMOD * D);
            for (int i = F.tid; i < 5 * 256; i += NWAVES * 64) { const int v = i >> 8, c = i & 255;
                const GAS f32x4* src = (v == 0) ? (const GAS f32x4*)g_post_mix_ : (v == 1) ? (const GAS f32x4*)g_pre_ffn_ : (const GAS f32x4*)(mb + v * D);
                f32x4 val = src[c]; if (v == 4) val = val + 1.f; cv[i] = val; }
            __syncthreads(); }
        {
            const int t0 = bt * 16 + 2 * F.wave;
            f32x4 mv[2][4], xv[2][4];
#pragma unroll
            for (int rr = 0; rr < 2; ++rr)
#pragma unroll
                for (int j = 0; j < 4; ++j) { { const v2u mw = *((const GAS v2u*)((const bf16*)mx_ + (size_t)(t0 + rr) * D) + F.lane + 64 * j); mv[rr][j] = (f32x4){bflo(mw.x), bfhi(mw.x), bflo(mw.y), bfhi(mw.y)}; } xv[rr][j] = *((const GAS f32x4*)(x_ + (size_t)(t0 + rr) * D) + F.lane + 64 * j); }
#pragma unroll
            for (int rr = 0; rr < 2; ++rr) {
                const int r = 2 * F.wave + rr, t = t0 + rr; float s = 0.f;
#pragma unroll
                for (int j = 0; j < 4; ++j) s += (mv[rr][j].x * mv[rr][j].x + mv[rr][j].y * mv[rr][j].y) + (mv[rr][j].z * mv[rr][j].z + mv[rr][j].w * mv[rr][j].w);
                float rs = rsqrtf(wave_sum(s) * (1.f / D) + NORM_EPS); s = 0.f;
#pragma unroll
                for (int j = 0; j < 4; ++j) { const f32x4 gp = cv[F.lane + 64 * j], gt = cv[512 + F.lane + 64 * j];
                    xv[rr][j] = xv[rr][j] + gt * (mv[rr][j] * rs * gp); *((GAS v2u*)(F.ws + WS_X1 + (size_t)t * D * 2) + F.lane + 64 * j) = (v2u){pk2(xv[rr][j].x, xv[rr][j].y), pk2(xv[rr][j].z, xv[rr][j].w)};     s += (xv[rr][j].x * xv[rr][j].x + xv[rr][j].y * xv[rr][j].y) + (xv[rr][j].z * xv[rr][j].z + xv[rr][j].w * xv[rr][j].w); }
                rs = rsqrtf(wave_sum(s) * (1.f / D) + NORM_EPS);
#pragma unroll
                for (int j = 0; j < 4; ++j) { const f32x4 gq = cv[256 + F.lane + 64 * j], sh = cv[768 + F.lane + 64 * j], sc1 = cv[1024 + F.lane + 64 * j];
                    const f32x4 hv = xv[rr][j] * rs * gq * sc1 + sh;
                    if (!MK_SINGLE) *((GAS v2u*)(h2_ + (size_t)t * D) + F.lane + 64 * j) = (v2u){pk2(hv.x, hv.y), pk2(hv.z, hv.w)};
                    { int w8 = 0; w8 = __builtin_amdgcn_cvt_pk_fp8_f32(hv.x, hv.y, w8, false); w8 = __builtin_amdgcn_cvt_pk_fp8_f32(hv.z, hv.w, w8, true); *((GAS unsigned*)(F.ws + WS_H2F + (size_t)t * D) + F.lane + 64 * j) = (unsigned)w8; }
                    { const unsigned h0 = pk2(hv.x, hv.y), h1 = pk2(hv.z, hv.w); *(LAS v2u*)(hhi + r * HP + 8 * (F.lane + 64 * j)) = (v2u){h0, h1};
                      *(LAS v2u*)(hlo + r * HP + 8 * (F.lane + 64 * j)) = (v2u){pk2(hv.x - bflo(h0), hv.y - bfhi(h0)), pk2(hv.z - bflo(h1), hv.w - bfhi(h1))}; } }
            }
        }
        __syncthreads();
        { pg8::f32x4 acc2[2] = {{0.f, 0.f, 0.f, 0.f}, {0.f, 0.f, 0.f, 0.f}};
#pragma unroll
          for (int ks = 0; ks < 4; ++ks) { const int ao = (F.lane & 15) * HP + 2 * (128 * F.wave + 32 * ks + 8 * (F.lane >> 4));
              const pg8::bf16x8 ahi = *(const LAS pg8::bf16x8*)(hhi + ao), alo = *(const LAS pg8::bf16x8*)(hlo + ao);
#pragma unroll
              for (int nb2 = 0; nb2 < 2; ++nb2) { acc2[nb2] = __builtin_amdgcn_mfma_f32_16x16x32_bf16(ahi, bhi[ks][nb2], acc2[nb2], 0, 0, 0); acc2[nb2] = __builtin_amdgcn_mfma_f32_16x16x32_bf16(ahi, blo[ks][nb2], acc2[nb2], 0, 0, 0);
                  acc2[nb2] = __builtin_amdgcn_mfma_f32_16x16x32_bf16(alo, bhi[ks][nb2], acc2[nb2], 0, 0, 0); } }
#pragma unroll
          for (int nb2 = 0; nb2 < 2; ++nb2)
#pragma unroll
              for (int i2 = 0; i2 < 4; ++i2) part[(F.wave * 16 + 4 * (F.lane >> 4) + i2) * 32 + 16 * nb2 + (F.lane & 15)] = acc2[nb2][i2]; }
        __syncthreads();
        {
            const int r = 2 * F.wave + (F.lane >> 5), t = bt * 16 + r; float lg = bre;
#pragma unroll
            for (int w = 0; w < 8; ++w) lg += part[(w * 16 + r) * 32 + e];
            float val = lg, tv[4]; int ti[4];
#pragma unroll
            for (int kk = 0; kk < 4; ++kk) { const float m = max32(val);
                const unsigned long long bal = __ballot(val == m); const unsigned hb = (F.lane >> 5) ? (unsigned)(bal >> 32) : (unsigned)bal; const int idx = __builtin_ctz(hb);
                tv[kk] = m; ti[kk] = idx; if (e == idx) val = -INFINITY; }
            if (e == 0) { float pw[4], den = 0.f;
#pragma unroll
                for (int kk = 0; kk < 4; ++kk) { pw[kk] = __expf(tv[kk] - tv[0]); den += pw[kk]; }
                const float inv = 1.f / den; const int lr = nb * 16 + r; selt[lr] = t;
#pragma unroll
                for (int kk = 0; kk < 4; ++kk) { const unsigned lp = __hip_atomic_fetch_add(lcnt + ti[kk], 1u, __ATOMIC_RELAXED, __HIP_MEMORY_SCOPE_WORKGROUP); sel[lr * 4 + kk] = ((unsigned)ti[kk] << 16) | lp; selw[lr * 4 + kk] = pw[kk] * inv; } }
        }
    }
    }
    __syncthreads();
    if (PROBE_DUP == 77) { if (F.tid < NE) lcnt[32 + F.tid] = __hip_atomic_fetch_add((unsigned*)(F.ctl + CW_CNT + 64 * F.tid), 0u, RLX_AGENT); __syncthreads(); }
    if (F.tid < NE) lcnt[32 + F.tid] = __hip_atomic_fetch_add((unsigned*)(F.ctl + CW_CNT + 64 * F.tid), lcnt[F.tid], RLX_AGENT);
    __syncthreads();
    for (int s = F.tid; s < nb * 64; s += NWAVES * 64) { const unsigned sv = sel[s]; const int ee = sv >> 16; const unsigned pos = lcnt[32 + ee] + (sv & 0xffffu); const int t = selt[s >> 2];
        list_[ee * T + pos] = t; tokslot_[t * 4 + (s & 3)] = ((unsigned)ee << 16) | pos; tokw_[t * 4 + (s & 3)] = selw[s]; }
    __syncthreads();
}
__device__ __forceinline__ void moe_tables(Frame& F) {

    LAS int* tstart = (LAS int*)(F.lds + L_TSTART); LAS int* cntl = (LAS int*)(F.lds + L_CNT); LAS int* tile_e = (LAS int*)(F.lds + L_TILEE);
    if (F.tid < NE) cntl[F.tid] = (int)__hip_atomic_load((unsigned*)(F.ctl + CW_CNT + 64 * F.tid), RLX_AGENT);
    __syncthreads();
    if (F.tid == 0) { int s = 0; for (int e = 0; e < NE; ++e) { tstart[e] = s; s += (cntl[e] + 255) >> 8; } tstart[NE] = s; }
    __syncthreads();
    for (int pm = F.tid; pm < MT_MAX; pm += NWAVES * 64) { int e = 0;
#pragma unroll
        for (int j = 1; j < NE; ++j) e += (pm >= tstart[j]) ? 1 : 0;
        tile_e[pm] = e; }
    __syncthreads();
}
__device__ __forceinline__ void p10_final(Frame& F, const bool dry) {
    const float* const g_post_ffn_ = (const float*)inp(F, 25); const unsigned* const tokslot_ = (const unsigned*)(F.ws + WS_TOK); const float* const tokw_ = (const float*)(F.ws + WS_TOK + 256 * 1024);
    const unsigned char* const ye_ = (const unsigned char*)(F.ws + WS_YE); const float* const mod_ = (const float*)(F.ws + WS_MOD); float* const out_ = (float*)inp(F, 26);
    const LAS int* tstart = (const LAS int*)(F.lds + L_TSTART);
    const int gw = F.vcu * NWAVES + F.wave, NGW = F.G * NWAVES;
    f32x4 gp[4];
#pragma unroll
    for (int j = 0; j < 4; ++j) gp[j] = *((const GAS f32x4*)g_post_ffn_ + F.lane + 64 * j);
    v4u tsA, tsB; f32x4 twA, twB;
    { const int t0 = gw, tb = (gw + NGW < T) ? gw + NGW : gw; if (t0 < T) { tsA = *(const GAS v4u*)(tokslot_ + t0 * 4); tsB = *(const GAS v4u*)(tokslot_ + tb * 4); twA = *(const GAS f32x4*)(tokw_ + t0 * 4); twB = *(const GAS f32x4*)(tokw_ + tb * 4); } }
    for (int t0 = gw; t0 < T; t0 += 2 * NGW) {
        const int t1 = t0 + NGW; const bool two = t1 < T; const int tb = two ? t1 : t0;
        unsigned ya[4][4], yb[4][4];
#pragma unroll
        for (int kk = 0; kk < 4; ++kk) { const GAS unsigned* ra = (const GAS unsigned*)(ye_ + (size_t)(256 * tstart[tsA[kk] >> 16] + (tsA[kk] & 0xffff)) * D); const GAS unsigned* rb = (const GAS unsigned*)(ye_ + (size_t)(256 * tstart[tsB[kk] >> 16] + (tsB[kk] & 0xffff)) * D);
#pragma unroll
            for (int j = 0; j < 4; ++j) { ya[kk][j] = ra[F.lane + 64 * j]; yb[kk][j] = rb[F.lane + 64 * j]; } }
        v2u xa[4], xb[4];
#pragma unroll
        for (int j = 0; j < 4; ++j) { xa[j] = *((const GAS v2u*)(F.ws + WS_X1 + (size_t)t0 * D * 2) + F.lane + 64 * j); xb[j] = *((const GAS v2u*)(F.ws + WS_X1 + (size_t)tb * D * 2) + F.lane + 64 * j); }
        f32x4 gtA[4], gtB[4];
#pragma unroll
        for (int j = 0; j < 4; ++j) { gtA[j] = *((const GAS f32x4*)(mod_ + (t0 / SEQ) * (NMOD * D) + 5 * D) + F.lane + 64 * j); gtB[j] = *((const GAS f32x4*)(mod_ + (tb / SEQ) * (NMOD * D) + 5 * D) + F.lane + 64 * j); }
        const f32x4 twA0 = twA, twB0 = twB;
        { const int n0 = t0 + 2 * NGW, nb2 = (n0 + NGW < T) ? n0 + NGW : n0; if (n0 < T) { tsA = *(const GAS v4u*)(tokslot_ + n0 * 4); tsB = *(const GAS v4u*)(tokslot_ + nb2 * 4); twA = *(const GAS f32x4*)(tokw_ + n0 * 4); twB = *(const GAS f32x4*)(tokw_ + nb2 * 4); } }
#pragma unroll
        for (int rr = 0; rr < 2; ++rr) {
            if (rr == 1 && !two) break;
            const int t = rr ? t1 : t0;
            float f[16];
#pragma unroll
            for (int i = 0; i < 16; ++i) f[i] = 0.f;
#pragma unroll
            for (int kk = 0; kk < 4; ++kk) { const float ws = (rr ? twB0[kk] : twA0[kk]) * pg8::YE_INV;
#pragma unroll
                for (int j = 0; j < 4; ++j) { const int a = (int)(rr ? yb[kk][j] : ya[kk][j]); const auto lo = __builtin_amdgcn_cvt_pk_f32_fp8(a, false), hi = __builtin_amdgcn_cvt_pk_f32_fp8(a, true);
                    f[4 * j] += ws * lo[0]; f[4 * j + 1] += ws * lo[1]; f[4 * j + 2] += ws * hi[0]; f[4 * j + 3] += ws * hi[1]; } }
            float ss = 0.f;
#pragma unroll
            for (int i = 0; i < 16; ++i) ss += f[i] * f[i];
            const float r = rsqrtf(wave_sum(ss) * (1.f / D) + NORM_EPS);
            GAS f32x4* op = (GAS f32x4*)(out_ + (size_t)t * D) + F.lane;
#pragma unroll
            for (int j = 0; j < 4; ++j) { const f32x4 gt = rr ? gtB[j] : gtA[j]; const v2u xw = rr ? xb[j] : xa[j]; const f32x4 x1 = {bflo(xw.x), bfhi(xw.x), bflo(xw.y), bfhi(xw.y)};
                const f32x4 fv = {f[4 * j], f[4 * j + 1], f[4 * j + 2], f[4 * j + 3]}; if (!dry) op[64 * j] = x1 + gt * (fv * r * gp[j]); }
        }
    }
}

struct Args { const void* in[26]; float* out; unsigned char* ws; int ph_lo, ph_hi; };
__global__ void __launch_bounds__(NWAVES * 64, 2) mega_fwd(Args args) {
    extern __shared__ __attribute__((aligned(16))) unsigned char lds[];
    Frame F;
    F.lds = (LAS unsigned char*)lds;
    F.MISC = (volatile LAS unsigned*)(F.lds + MISC_OFF);
    F.tid = threadIdx.x; F.lane = F.tid & 63; F.wave = __builtin_amdgcn_readfirstlane(F.tid >> 6);
    F.G = gridDim.x; { const int bx = blockIdx.x; F.vcu = (F.G % 8 == 0) ? (bx % 8) * (F.G / 8) + bx / 8 : bx; F.vb = bx; }
    F.ws = args.ws; F.ctl = (gu32*)(args.ws + WS_CTL);
    for (int u = F.tid; u < (LDS_BYTES - LDSCTL_OFF) / 4; u += NWAVES * 64) ((LAS unsigned*)(F.lds + LDSCTL_OFF))[u] = 0u;
    __syncthreads();
    if (F.tid == 0) { LAS unsigned long long* pt = (LAS unsigned long long*)(F.lds + L_PTRS);
#define PT(i) pt[i] = (unsigned long long)args.in[i];
        PT(0) PT(1) PT(2) PT(3) PT(4) PT(5) PT(6) PT(7) PT(8) PT(9) PT(10) PT(11) PT(12) PT(13) PT(14) PT(15) PT(16) PT(17) PT(18) PT(19) PT(20) PT(21) PT(22) PT(23) PT(24) PT(25)
#undef PT
        pt[26] = (unsigned long long)args.out; }
    __syncthreads();
    const int lo = args.ph_lo, hi = args.ph_hi;
    const bool single = (hi - lo) > 1;
    XcdBarrier bar; bar.bar = (unsigned*)(F.ctl + CW_BAR); bar.x = 0; bar.st = nullptr;
    if (single) bar = xcd_barrier_post((unsigned*)(F.ctl + CW_BAR), F.MISC + 8);
#define IN(k) (lo <= (k) && (k) < hi)
#define NREP(k) ((PROBE_DUP == (k) || (PROBE_DUP == 35 && (k) == 3)) ? 2 : 1)
#define SEAM(k) do { if (IN(k) && IN((k) + 1)) { xcd_barrier(bar); if (PROBE_DUP == 100 && (k) < 5) xcd_barrier(bar); } } while (0)
#define SEAML(k) do { if (IN(k) && IN((k) + 1)) { if (grp) xcc_local_barrier(bar); else xcd_barrier(bar); } } while (0)
    bool grp = false;
    const LAS int* gtab = (const LAS int*)(F.lds + L_GTAB);
#define REFRESH() do { int t_ = (int)threadIdx.x; asm volatile("" : "+v"(t_)); F.tid = t_; F.lane = t_ & 63; } while (0)

    _Pragma("unroll") for (int allrep_ = 0; allrep_ < ((PROBE_DUP == 200) ? 2 : 1); ++allrep_) {
    if (allrep_ > 0) { xcd_barrier(bar); if (blockIdx.x == 0 && F.tid < NE) __hip_atomic_store((unsigned*)(F.ctl + CW_CNT + 64 * F.tid), 0u, RLX_AGENT); xcd_barrier(bar); }
    if (IN(0)) _Pragma("unroll") for (int rep_ = 0; rep_ < NREP(0); ++rep_) { REFRESH(); p0_prologue(F); if (NREP(0) > 1) __syncthreads(); } SEAM(0);
    if (single && allrep_ == 0) { const unsigned md = __builtin_amdgcn_readfirstlane(F.MISC[10]), rk = __builtin_amdgcn_readfirstlane(F.MISC[11]);
        if (md == 2u && PROBE_DUP != 101) { grp = true; F.vcu = (int)bar.x * 32 + (int)rk; F.vb = (int)rk * 8 + (int)bar.x; } }
    if (IN(1)) _Pragma("unroll") for (int rep_ = 0; rep_ < NREP(1); ++rep_) { REFRESH(); p1_norm(F); } SEAML(1);
    if (IN(2)) _Pragma("unroll") for (int rep_ = 0; rep_ < NREP(2); ++rep_) { REFRESH();
        pg8::Gemm g{((bf16*)(F.ws + WS_H)), ((bf16*)(F.ws + WS_WIN)), D, 0, 0}; pg8::StaticOrder S; S.init(T, INC, F.G, F.vb);
        pg8::EpiZ E{((bf16*)(F.ws + WS_Q)), ((bf16*)(F.ws + WS_K)), ((bf16*)(F.ws + WS_V)), ((bf16*)(F.ws + WS_U)), ((bf16*)(F.ws + WS_GA)), ((bf16*)(F.ws + WS_GB)), ((float*)(F.ws + WS_ROPE))};
        pg8::gemm_phase<pg8::EpiZ, pg8::StaticOrder, true, false>(F.lds + RING_OFF, g, S, E, gtab);
        if (rep_ == NREP(2) - 1) conv_in_idle_round(F, (T / 256) * (INC / 256), 0, CONV_W2_IN_P2);
    } SEAML(2);
    if (IN(3)) _Pragma("unroll") for (int rep_ = 0; rep_ < NREP(3); ++rep_) { REFRESH();
        p3_poold(F);
        __syncthreads();
        const attn_body::Combine CB{false, (const attn_body::bf16*)(F.ws + WS_O0), (attn_body::bf16*)(F.ws + WS_OC), (const float*)inp(F, 11), ((const float*)(F.ws + WS_MOD + 256 * 1024))[0], SUBLN_EPS, 1.f - LAM_INIT};
        const attn_body::AttnTensors AT{(const attn_body::bf16*)(F.ws + WS_Q), (const attn_body::bf16*)(F.ws + WS_K), (const attn_body::bf16*)(F.ws + WS_V), (attn_body::bf16*)(F.ws + WS_O0), CB};
        attn_body::attn_phase<16>((char*)lds + RING_OFF, AT, F.vcu, F.G,
            [&](int i, int nun) { if (!((PROBE_DUP == 3 || PROBE_DUP == 35) && rep_ > 0)) { conv_expert_items(F, CONV_W2_ALL, CONV_ALL - CONV_W2_ALL, F.vcu, F.G, i, nun, F.lds + RING_OFF + F.wave * 4352);
                if (PROBE_DUP == 36) { const float* w1 = (const float*)inp(F, 21); int lane = F.lane; asm volatile("" : "+v"(lane));
                    for (int q = 0; q < 2; ++q) { CItem a; a.src = w1 + (size_t)(F.wave * 64) * (2 * FF); a.ldw = 2 * FF; a.dst = F.ws + WS_Y + (size_t)(blockIdx.x * 8 + F.wave) * 65536; a.ldk = D; a.base = 0; a.mode = 0; f32x4 va[4][4]; conv_load(a, va, lane); conv_store(a, va, F.lds + RING_OFF + F.wave * 4352, lane); } }
                asm volatile("s_waitcnt lgkmcnt(0)\n\ts_barrier" ::: "memory"); } });
        __builtin_amdgcn_s_setprio(0);
    } SEAML(3);
    if (IN(5)) _Pragma("unroll") for (int rep_ = 0; rep_ < NREP(5); ++rep_) { REFRESH();
        pg8::Gemm2 g{((bf16*)(F.ws + WS_DD)), ((bf16*)(F.ws + WS_WB)), ((bf16*)(F.ws + WS_OC)), ((bf16*)(F.ws + WS_WA)), PW, DW};
        pg8::StaticOrder S; S.init(T, D, F.G, F.vb);
        pg8::EpiChain E{((const bf16*)(F.ws + WS_GA)), ((const bf16*)(F.ws + WS_GB)), ((bf16*)(F.ws + WS_MI))};
        pg8::gemm_chain2<pg8::EpiChain, pg8::StaticOrder>(F.lds + RING_OFF, g, S, E);
    } SEAML(5);
    if (IN(6)) _Pragma("unroll") for (int rep_ = 0; rep_ < NREP(6); ++rep_) { REFRESH();
        pg8::Gemm g{((bf16*)(F.ws + WS_MI)), ((bf16*)(F.ws + WS_WOUT)), D, 0, 0}; pg8::StaticOrder S; S.init(T, D, F.G, F.vb);
        pg8::EpiBf16Plain E{((bf16*)(F.ws + WS_MX))};
        pg8::gemm_phase<pg8::EpiBf16Plain, pg8::StaticOrder, true, false>(F.lds + RING_OFF, g, S, E, gtab);
    } SEAML(6);
    if (IN(7)) { REFRESH(); p7_router(F, NREP(7)); } SEAM(7);
    if (IN(8) || IN(9) || IN(10)) { REFRESH(); moe_tables(F); }
    if (IN(8)) _Pragma("unroll") for (int rep_ = 0; rep_ < NREP(8); ++rep_) { REFRESH();
        const LAS int* tstart = (const LAS int*)(F.lds + L_TSTART); const LAS int* cntl = (const LAS int*)(F.lds + L_CNT);
        { pg8::MoeOrder S0; S0.init(tstart[NE], 2 * FF, F.G, F.vb, (const LAS int*)(F.lds + L_TILEE));
          pg8::Unit un; LAS int* gt = (LAS int*)(F.lds + L_GTAB); LAS int* ul = (LAS int*)(F.lds + L_ULIST); int n = 0;
          _Pragma("unroll 1") for (int i = 0; i < MAXU && S0.next(i, un); ++i, ++n) if (F.tid == 0) { ul[4 + 4 * i] = un.pm; ul[5 + 4 * i] = un.pn; ul[6 + 4 * i] = un.e; }
          if (F.tid == 0) ul[0] = n;
          __syncthreads();
          int tokv[MAXU / 2];
#pragma unroll
          for (int j = 0; j < MAXU / 2; ++j) { const int x = F.tid + 512 * j, i = x >> 8, r = x & 255; tokv[j] = 0;
              if (i < n) { const int pm = ul[4 + 4 * i], e = ul[6 + 4 * i], pos = (pm - tstart[e]) * 256 + r; if (pos < cntl[e]) tokv[j] = ((const int*)(F.ws + WS_LIST))[e * T + pos]; } }
#pragma unroll
          for (int j = 0; j < MAXU / 2; ++j) { const int x = F.tid + 512 * j; if ((x >> 8) < n) gt[x] = tokv[j]; }
          __syncthreads(); }
        const pg8::ListOrder S{(const LAS int*)(F.lds + L_ULIST)};
        pg8::Gemm g{((bf16*)(F.ws + WS_H2F)), ((bf16*)(F.ws + WS_W1)), D / 2, 0, (size_t)2 * FF * D};
        pg8::EpiSwiglu E{(unsigned char*)(F.ws + WS_A), ((const float*)inp(F, 22))};
        pg8::gemm_phase<pg8::EpiSwiglu, pg8::ListOrder, true, true, true>(F.lds + RING_OFF, g, S, E, gtab);
        if (rep_ == NREP(8) - 1) conv_in_idle_round(F, tstart[NE] * (2 * FF / 256), CONV_W2_IN_P2, CONV_W2_ALL - CONV_W2_IN_P2);
    } SEAM(8);
    if (IN(9)) _Pragma("unroll") for (int rep_ = 0; rep_ < NREP(9); ++rep_) { REFRESH();
        const LAS int* tstart = (const LAS int*)(F.lds + L_TSTART);
        { pg8::MoeOrder S0; S0.init(tstart[NE], D, F.G, F.vb, (const LAS int*)(F.lds + L_TILEE));
          pg8::Unit un; LAS int* ul = (LAS int*)(F.lds + L_ULIST); int n = 0;
          __syncthreads();
          _Pragma("unroll 1") for (int i = 0; i < MAXU && S0.next(i, un); ++i, ++n) if (F.tid == 0) { ul[4 + 4 * i] = un.pm; ul[5 + 4 * i] = un.pn; ul[6 + 4 * i] = un.e; }
          if (F.tid == 0) ul[0] = n;
          __syncthreads(); }
        const pg8::ListOrder S{(const LAS int*)(F.lds + L_ULIST)};
        pg8::Gemm g{((bf16*)(F.ws + WS_A)), ((bf16*)(F.ws + WS_W2)), FF / 2, 0, (size_t)D * FF};
        pg8::EpiYe E{(unsigned char*)(F.ws + WS_YE), ((const float*)inp(F, 24))};
        pg8::gemm_phase<pg8::EpiYe, pg8::ListOrder, true, false, true>(F.lds + RING_OFF, g, S, E, gtab);
    } SEAM(9);
    if (IN(10)) { REFRESH(); if (NREP(10) > 1) p10_final(F, true); p10_final(F, false); }
    }
#undef IN
#undef SEAM
#undef SEAML
}
#ifndef MK_SINGLE
#define MK_SINGLE 1
#endif
#ifndef OPT_MASK
#define OPT_MASK 0x7ff
#endif
extern "C" void kernel_launch(void* const* d_in, const int* in_sizes, int n_in, void* d_out, int out_size, void* d_ws, size_t ws_size, hipStream_t stream) {
    static int grid = 0;
    if (grid == 0) {
        if (n_in != 26 || in_sizes[0] != T * D || out_size != T * D || ws_size < WS_END) { fprintf(stderr, "kernel_launch: unexpected shapes (n_in %d, in0 %d, out %d, ws %zu); nothing launched\n", n_in, n_in > 0 ? in_sizes[0] : -1, out_size, ws_size); grid = -1; return; }
        int dev = 0, cus = 0, per_cu = 0;
        if (hipGetDevice(&dev) != hipSuccess || hipDeviceGetAttribute(&cus, hipDeviceAttributeMultiprocessorCount, dev) != hipSuccess) { fprintf(stderr, "kernel_launch: device query failed\n"); grid = -1; return; }
        if (hipFuncSetAttribute((const void*)mega_fwd, hipFuncAttributeMaxDynamicSharedMemorySize, LDS_BYTES) != hipSuccess) { fprintf(stderr, "kernel_launch: hipFuncSetAttribute failed\n"); grid = -1; return; }
        if (hipOccupancyMaxActiveBlocksPerMultiprocessor(&per_cu, (const void*)mega_fwd, NWAVES * 64, LDS_BYTES) != hipSuccess || per_cu < 1) fprintf(stderr, "kernel_launch: note: occupancy query reports %d workgroups per CU\n", per_cu);
        (void)hipGetLastError();
        grid = cus;
    }
    if (grid < 0) return;
    unsigned char* ws = (unsigned char*)d_ws;
    (void)hipMemsetAsync(ws + WS_CTL, 0, CTL_ZERO_BYTES, stream);
    Args a{};
    for (int i = 0; i < 26; ++i) a.in[i] = d_in[i];
    a.out = (float*)d_out; a.ws = ws;
#if MK_SINGLE
    a.ph_lo = 0; a.ph_hi = NPHASE;
    hipLaunchKernelGGL(mega_fwd, dim3(grid), dim3(NWAVES * 64), LDS_BYTES, stream, a);
#else
    const float* x = (const float*)d_in[0]; const float* c = (const float*)d_in[1]; const int* positions = (const int*)d_in[2];
    const float* w_ada = (const float*)d_in[3]; const float* b_ada = (const float*)d_in[4]; const float* g_pre_mix = (const float*)d_in[5]; const float* w_in = (const float*)d_in[6];
    const float* lq1 = (const float*)d_in[7]; const float* lk1 = (const float*)d_in[8]; const float* lq2 = (const float*)d_in[9]; const float* lk2 = (const float*)d_in[10];
    const float* g_subln = (const float*)d_in[11]; const float* w_pool = (const float*)d_in[12]; const float* pool_scale = (const float*)d_in[13];
    const float* w_proj_a = (const float*)d_in[14]; const float* w_proj_b = (const float*)d_in[15]; const float* w_out = (const float*)d_in[16];
    const float* g_post_mix = (const float*)d_in[17]; const float* g_pre_ffn = (const float*)d_in[18]; const float* w_router = (const float*)d_in[19]; const float* b_router = (const float*)d_in[20];
    const float* w_exp1 = (const float*)d_in[21]; const float* b_exp1 = (const float*)d_in[22]; const float* w_exp2 = (const float*)d_in[23]; const float* b_exp2 = (const float*)d_in[24];
    const float* g_post_ffn = (const float*)d_in[25];
    float* out = (float*)d_out;
    using nv::bf;
    unsigned* ctl = (unsigned*)(ws + WS_CTL); unsigned* cnt = ctl + CW_CNT;
    float* mod = (float*)(ws + WS_MOD); float* lam = (float*)(ws + WS_MOD + 256 * 1024); int* tstart = (int*)(ws + WS_MOD + 260 * 1024);
    float* rope = (float*)(ws + WS_ROPE); int* list = (int*)(ws + WS_LIST); unsigned* tokslot = (unsigned*)(ws + WS_TOK); float* tokw = (float*)(ws + WS_TOK + 256 * 1024);
    bf* h = (bf*)(ws + WS_H); bf* q = (bf*)(ws + WS_Q); bf* k = (bf*)(ws + WS_K); bf* v = (bf*)(ws + WS_V); bf* u = (bf*)(ws + WS_U); bf* ga = (bf*)(ws + WS_GA); bf* gb = (bf*)(ws + WS_GB);
    bf* dd = (bf*)(ws + WS_DD); bf* O0 = (bf*)(ws + WS_O0); bf* O1 = (bf*)(ws + WS_O1); bf* oc = (bf*)(ws + WS_OC); bf* pp = (bf*)(ws + WS_PP); float* Y = (float*)(ws + WS_Y);
    bf* mi = (bf*)(ws + WS_MI); float* mx = (float*)(ws + WS_MX); bf* h2 = (bf*)(ws + WS_H2); bf* abuf = (bf*)(ws + WS_A); bf* ye = (bf*)(ws + WS_YE);
#define OPT(kk) ((OPT_MASK >> (kk)) & 1)
#define LAUNCH_OPT(kk) do { a.ph_lo = (kk); a.ph_hi = (kk) + 1; hipLaunchKernelGGL(mega_fwd, dim3(grid), dim3(NWAVES * 64), LDS_BYTES, stream, a); } while (0)
    if (OPT_MASK != 0) LAUNCH_OPT(0);
    if (!OPT(0)) { nv::k_mod<<<NB * NMOD * D / 256, 256, 0, stream>>>(c, w_ada, b_ada, lq1, lk1, lq2, lk2, mod, lam); nv::k_rope<<<T * 8 / 256, 256, 0, stream>>>(positions, rope); }
    if (OPT(1)) LAUNCH_OPT(1); else nv::k_norm1<<<T, 256, 0, stream>>>(x, g_pre_mix, mod, 0, D, h);
    if (OPT(2)) LAUNCH_OPT(2); else { nv::k_gemm<<<dim3(INC / 64, T / 64), 256, 0, stream>>>(nv::RmPlain{h, w_in, D, INC}, nv::EpZ{q, k, v, u, ga, gb}, D); nv::k_rope_apply<<<T * 1024 / 256, 256, 0, stream>>>(q, k, rope); }
    if (OPT(3)) LAUNCH_OPT(3); else { nv::k_attn<<<NB * 16 * SEQ / 4, 256, 0, stream>>>(q, k, v, O0, O1); nv::k_poold<<<T * PW / 256, 256, 0, stream>>>(u, dd); }
    if (OPT(4)) LAUNCH_OPT(4); else { nv::k_combine<<<T * NH / 4, 256, 0, stream>>>(O0, O1, lam, g_subln, oc);
        for (int g = 0; g < 4; ++g) nv::k_gemm<<<dim3(128 / 64, T / 64), 256, 0, stream>>>(nv::RmPlain{dd + g * 128, w_pool + g * 128 * 128, PW, 128}, nv::EpPool{pp, pool_scale, g, 0}, 128); }
    if (OPT(5)) LAUNCH_OPT(5); else { nv::k_gemm<<<dim3(D / 64, T / 64), 256, 0, stream>>>(nv::RmPlain{oc, w_proj_a, D, D}, nv::EpGateY{Y, ga}, DW);
        nv::k_gemm<<<dim3(D / 64, T / 64), 256, 0, stream>>>(nv::RmPlain{pp, w_proj_b, PW, D}, nv::EpGateAdd{Y, gb, mi}, PW); }
    if (OPT(6)) LAUNCH_OPT(6); else nv::k_gemm<<<dim3(D / 64, T / 64), 256, 0, stream>>>(nv::RmPlain{mi, w_out, D, D}, nv::EpF32{mx}, D);
    if (OPT(7)) LAUNCH_OPT(7); else nv::k_router<<<T / 4, 256, 0, stream>>>(x, mx, mod, g_post_mix, g_pre_ffn, w_router, b_router, out, h2, cnt, list, tokslot, tokw);
    nv::k_tstart<<<1, 64, 0, stream>>>(cnt, tstart);
    if (OPT(8)) LAUNCH_OPT(8); else nv::k_moe1<<<dim3(2 * FF / 64, MPAD / 64), 256, 0, stream>>>(nv::RmMoe{h2, tstart, cnt, list, w_exp1, (size_t)D * 2 * FF, 2 * FF, 1}, b_exp1, abuf);
    if (OPT(9)) LAUNCH_OPT(9); else nv::k_gemm<<<dim3(D / 64, MPAD / 64), 256, 0, stream>>>(nv::RmMoe{abuf, tstart, cnt, list, w_exp2, (size_t)FF * D, D, 0}, nv::EpYe{ye, b_exp2}, FF);
    if (OPT(10)) LAUNCH_OPT(10); else nv::k_final<<<T / 4, 256, 0, stream>>>(ye, tstart, tokslot, tokw, mod, g_post_ffn, out);
#endif
}
```

```cpp
#include <hip/hip_runtime.h>
#include <cstdio>
#include <cstdint>
#include <cmath>

constexpr int NB = 8, SEQ = 2048, D = 1024, T = NB * SEQ;
constexpr int NH = 8, HD = 64, VD = 128, DW = 1024, PW = 512, INC = 3 * DW + PW + 2 * D;
constexpr int NE = 32, TOPK = 4, FF = 1024, NMOD = 6;
constexpr int MPAD = TOPK * T + NE * 256, MT_MAX = MPAD / 256;
constexpr float NORM_EPS = 1e-6f, SUBLN_EPS = 1e-5f, LAM_INIT = 0.2f, SW_ALPHA = 1.702f, SW_LIMIT = 7.0f;
constexpr float QSCALE = 0.125f * 1.4426950408889634f;

constexpr size_t MiB = 1u << 20;
constexpr size_t WS_CTL = 0, CTL_ZERO_BYTES = 32768;
constexpr size_t WS_MOD = 1 * MiB;
constexpr size_t WS_ROPE = 2 * MiB;
constexpr size_t WS_LIST = 3 * MiB;
constexpr size_t WS_TOK = 5 * MiB;
constexpr size_t WS_WIN = 6 * MiB, WS_WA = 17 * MiB, WS_WB = 19 * MiB, WS_WPOOL = 20 * MiB, WS_WOUT = 21 * MiB, WS_W1 = 24 * MiB, WS_W2 = 152 * MiB;
constexpr size_t WS_H = 216 * MiB, WS_Q = 248 * MiB, WS_K = 280 * MiB, WS_V = 312 * MiB, WS_U = 344 * MiB, WS_GA = 360 * MiB, WS_GB = 392 * MiB, WS_DD = 424 * MiB;
constexpr size_t WS_O0 = 440 * MiB, WS_O1 = 472 * MiB, WS_OC = 504 * MiB, WS_PP = 536 * MiB, WS_Y = 552 * MiB, WS_MI = 616 * MiB, WS_MX = 648 * MiB, WS_X1 = 680 * MiB, WS_H2 = 712 * MiB, WS_H2F = 744 * MiB, WS_END = 760 * MiB;
constexpr size_t WS_A = 216 * MiB;
constexpr size_t WS_YE = 392 * MiB;
static_assert((size_t)MPAD * 1024 * 2 == 144 * MiB && WS_A + 144 * MiB <= WS_GA && WS_YE + 144 * MiB <= WS_PP, "overlay map");
constexpr int CW_TMO = 0, CW_CODE = 1;
constexpr int CW_CNT = 1024;
constexpr int CW_BAR = 4096;
static_assert((CW_BAR + 3456) * 4 <= (int)CTL_ZERO_BYTES && (CW_CNT + 64 * NE) * 4 <= (int)CTL_ZERO_BYTES, "control words inside the per-call memset");

__device__ __forceinline__ void rope_cs(int pos, int i, float& cs, float& sn) {
    const double invf = (i == 0) ? 1.0 : (i == 1) ? 0.19392274474868576 : (i == 2) ? 0.03760603093086393 : (i == 3) ? 0.007292664737217109 : (i == 4) ? 0.001414213562373095
                      : (i == 5) ? 0.0002742481756762073 : (i == 6) ? 5.318295896944988e-05 : 1.031338537721246e-05;
    const double ang = (double)pos * invf;
    const double qd = __builtin_rint(ang * 0.6366197723675814);
    const double r = ang - qd * 1.5707963267948966 - qd * 6.123233995736766e-17;
    const double r2 = r * r;
    const double s = r * (1.0 + r2 * (-1.0 / 6 + r2 * (1.0 / 120 + r2 * (-1.0 / 5040 + r2 * (1.0 / 362880 + r2 * (-1.0 / 39916800 + r2 * (1.0 / 6227020800.0)))))));
    const double c = 1.0 + r2 * (-0.5 + r2 * (1.0 / 24 + r2 * (-1.0 / 720 + r2 * (1.0 / 40320 + r2 * (-1.0 / 3628800 + r2 * (1.0 / 479001600.0 + r2 * (-1.0 / 87178291200.0)))))));
    const int n = (int)qd & 3;
    const double so = (n == 0) ? s : (n == 1) ? c : (n == 2) ? -s : -c;
    const double co = (n == 0) ? c : (n == 1) ? -s : (n == 2) ? -c : s;
    cs = (float)co; sn = (float)so;
}
#define MK_SINGLE 1
#define OPT_MASK 0x7ff
namespace pg8 {
#define PG8_LAS __attribute__((address_space(3)))
typedef unsigned short bf16_t;
typedef short bf16x8 __attribute__((ext_vector_type(8)));
typedef float f32x4 __attribute__((ext_vector_type(4)));
typedef unsigned u32x4 __attribute__((ext_vector_type(4)));
constexpr int BM = 256, BK = 64, HALF = 128, HTB = HALF * BK * 2  , STAGE_BYTES = 8 * HTB, NXCD = 8, WGM = 8;

__host__ __device__ __forceinline__ int lds_byte(int r, int c) { const int st = (r >> 4) * 2 + (c >> 5), rr = r & 15, cc = c & 31, ob = rr * 64 + cc * 2; return st * 1024 + (ob ^ (((ob >> 9) & 1) << 5)); }
__host__ __device__ __forceinline__ void stage_rc(int b, int& R, int& C) { const int st = b / 1024, sb = b % 1024, swz = sb ^ (((sb >> 9) & 1) << 5); R = (st >> 1) * 16 + swz / 64; C = (st & 1) * 32 + (swz % 64) / 2; }
__host__ __device__ __forceinline__ int perm32(int rho) { const int n = rho >> 4, i = rho & 15; return 8 * (i >> 2) + 4 * n + (i & 3); }

typedef int i32x8 __attribute__((ext_vector_type(8))); typedef int i32x4 __attribute__((ext_vector_type(4)));
__device__ __forceinline__ i32x8 cat8(const bf16x8 a, const bf16x8 b) { const i32x4 x = __builtin_bit_cast(i32x4, a), y = __builtin_bit_cast(i32x4, b); return __builtin_shufflevector(x, y, 0, 1, 2, 3, 4, 5, 6, 7); }
__device__ __forceinline__ void mfma_fp8(f32x4& acc, const i32x8 a, const i32x8 b) { asm volatile("v_mfma_f32_16x16x128_f8f6f4 %0, %1, %2, %0" : "+v"(acc) : "v"(a), "v"(b)); }
struct Unit { int pm, pn, e; };
struct Gemm { const bf16_t* A; const bf16_t* Bt; int K; int pad; size_t bstride; };

struct StaticOrder {
    int nM, nN, nwg, G, c;
    __device__ void init(int M, int N, int G_, int c_) { nM = M / BM; nN = N / BM; nwg = nM * nN; G = G_; c = c_; }
    __device__ bool next(int i, Unit& u) const {
        const long L = (long)i * G + c; if (L >= nwg) return false;
        int wgid = (int)L; { const int q = nwg / NXCD, r = nwg % NXCD, xcd = wgid % NXCD, off = wgid / NXCD; wgid = (xcd < r ? xcd * (q + 1) : r * (q + 1) + (xcd - r) * q) + off; }
        const int nig = WGM * nN, gid = wgid / nig, fm = gid * WGM, gsz = (nM - fm) < WGM ? (nM - fm) : WGM;
        u.pm = fm + ((wgid % nig) % gsz); u.pn = (wgid % nig) / gsz; u.e = 0; return true;
    }
};
struct MoeOrder {
    int nM, nN, nwg, G, c; const PG8_LAS int* tile_e;
    __device__ void init(int nM_, int N, int G_, int c_, const PG8_LAS int* te) { nM = nM_; nN = N / BM; nwg = nM * nN; G = G_; c = c_; tile_e = te; }
    __device__ bool next(int i, Unit& u) const {
        const long L = (long)i * G + c; if (L >= nwg) return false;
        int wgid = (int)L; { const int q = nwg / NXCD, r = nwg % NXCD, xcd = wgid % NXCD, off = wgid / NXCD; wgid = (xcd < r ? xcd * (q + 1) : r * (q + 1) + (xcd - r) * q) + off; }
        const int nig = WGM * nN, gid = wgid / nig, fm = gid * WGM, gsz = (nM - fm) < WGM ? (nM - fm) : WGM;
        u.pm = fm + ((wgid % nig) % gsz); u.pn = (wgid % nig) / gsz; u.e = tile_e[u.pm]; return true;
    }
};

struct ListOrder {
    const PG8_LAS int* ul;
    __device__ bool next(int i, Unit& u) const { if (i >= ul[0]) return false; u.pm = ul[4 + 4 * i]; u.pn = ul[5 + 4 * i]; u.e = ul[6 + 4 * i]; return true; }
};
__device__ __forceinline__ unsigned cvt_pk_bf16(float lo, float hi) { unsigned r; asm volatile("v_cvt_pk_bf16_f32 %0, %1, %2" : "=v"(r) : "v"(lo), "v"(hi)); return r; }
__device__ __forceinline__ float bflo(unsigned w) { return __uint_as_float(w << 16); }
__device__ __forceinline__ float bfhi(unsigned w) { return __uint_as_float(w & 0xffff0000u); }
__device__ __forceinline__ float sigm(float v) { return __builtin_amdgcn_rcpf(1.f + __builtin_amdgcn_exp2f(-1.4426950408889634f * v)); }
__device__ __forceinline__ u32x4 pack8(const f32x4 v0, const f32x4 v1) { u32x4 w; w.x = cvt_pk_bf16(v0[0], v0[1]); w.y = cvt_pk_bf16(v0[2], v0[3]); w.z = cvt_pk_bf16(v1[0], v1[1]); w.w = cvt_pk_bf16(v1[2], v1[3]); return w; }

typedef unsigned u32x2 __attribute__((ext_vector_type(2)));
__device__ __forceinline__ u32x2 pack8_fp8(const f32x4 v0, const f32x4 v1) { int a = 0, b = 0; a = __builtin_amdgcn_cvt_pk_fp8_f32(v0[0], v0[1], a, false); a = __builtin_amdgcn_cvt_pk_fp8_f32(v0[2], v0[3], a, true);
    b = __builtin_amdgcn_cvt_pk_fp8_f32(v1[0], v1[1], b, false); b = __builtin_amdgcn_cvt_pk_fp8_f32(v1[2], v1[3], b, true); return (u32x2){(unsigned)a, (unsigned)b}; }
constexpr float W8_SCALE = 32.f, W8_INV = 1.f / 32.f;
struct EpiZ {
    static constexpr bool PERM = true;
    bf16_t *q, *k, *v, *u, *ga, *gb; const float* rope;
    __device__ __forceinline__ void operator()(const f32x4 (&acc)[2][2][4][2], const Unit& un, int wr, int wc, int fr, int fq) const {
        const int pn = un.pn, row0 = un.pm * BM + wr * 64 + fr;
        int kind, ldc, colt; bf16_t* base;
        if (pn < 4) { kind = 0; base = q; ldc = 1024; colt = pn * 256; }
        else if (pn < 8) { kind = 1; base = k; ldc = 1024; colt = (pn - 4) * 256; }
        else if (pn < 12) { kind = 2; base = v; ldc = 1024; colt = (pn - 8) * 256; }
        else if (pn < 14) { kind = 2; base = u; ldc = 512; colt = (pn - 12) * 256; }
        else if (pn < 18) { kind = 3; base = ga; ldc = 1024; colt = (pn - 14) * 256; }
        else { kind = 3; base = gb; ldc = 1024; colt = (pn - 18) * 256; }
        const int col0 = colt + wc * 32 + 8 * fq;
        const bool ropew = (kind <= 1) && ((wc & 1) == 0);
        const bool rl = fq < 2;
#pragma unroll
        for (int ai = 0; ai < 2; ++ai)
#pragma unroll
            for (int m = 0; m < 4; ++m) {
                const int row = row0 + ai * HALF + m * 16; bf16_t* rowp = base + (size_t)row * ldc + col0;
                f32x4 cs = {1.f, 1.f, 1.f, 1.f}, sn = {0.f, 0.f, 0.f, 0.f};
                if (ropew && rl) { const f32x4* rp = (const f32x4*)(rope + (size_t)row * 16); cs = rp[fq]; sn = rp[2 + fq]; }
#pragma unroll
                for (int bj = 0; bj < 2; ++bj) {
                    f32x4 v0 = acc[ai][bj][m][0], v1 = acc[ai][bj][m][1];
                    if (ropew) {
                        const f32x4 r0 = {v0[0] * cs[0] - v0[1] * sn[0], v0[1] * cs[0] + v0[0] * sn[0], v0[2] * cs[1] - v0[3] * sn[1], v0[3] * cs[1] + v0[2] * sn[1]};
                        const f32x4 r1 = {v1[0] * cs[2] - v1[1] * sn[2], v1[1] * cs[2] + v1[0] * sn[2], v1[2] * cs[3] - v1[3] * sn[3], v1[3] * cs[3] + v1[2] * sn[3]};
                        v0 = r0; v1 = r1;
                    }
                    if (kind == 0) { v0 = v0 * QSCALE; v1 = v1 * QSCALE; }
                    if (kind == 3) {
#pragma unroll
                        for (int x = 0; x < 4; ++x) { v0[x] = sigm(v0[x]); v1[x] = sigm(v1[x]); } }
                    *(u32x4*)(rowp + bj * HALF) = pack8(v0, v1);
                }
            }
    }
};
struct EpiPool {
    static constexpr bool PERM = true;
    bf16_t* p; const float* scale;
    __device__ __forceinline__ void operator()(const f32x4 (&acc)[2][2][4][2], const Unit& un, int wr, int wc, int fr, int fq) const {
        const int row0 = un.pm * BM + wr * 64 + fr, col0 = un.pn * BM + wc * 32 + 8 * fq;
        f32x4 sv[2][2];
#pragma unroll
        for (int bj = 0; bj < 2; ++bj) { sv[bj][0] = *(const f32x4*)(scale + col0 + bj * HALF); sv[bj][1] = *(const f32x4*)(scale + col0 + bj * HALF + 4); }
#pragma unroll
        for (int ai = 0; ai < 2; ++ai)
#pragma unroll
            for (int m = 0; m < 4; ++m) { bf16_t* rowp = p + (size_t)(row0 + ai * HALF + m * 16) * PW + col0;
#pragma unroll
                for (int bj = 0; bj < 2; ++bj) *(u32x4*)(rowp + bj * HALF) = pack8(acc[ai][bj][m][0] * sv[bj][0], acc[ai][bj][m][1] * sv[bj][1]); }
    }
};
struct EpiGateY {
    static constexpr bool PERM = true;
    bf16_t* Y; const bf16_t* ga;
    __device__ __forceinline__ void operator()(const f32x4 (&acc)[2][2][4][2], const Unit& un, int wr, int wc, int fr, int fq) const {
        const int row0 = un.pm * BM + wr * 64 + fr, col0 = un.pn * BM + wc * 32 + 8 * fq;
#pragma unroll
        for (int ai = 0; ai < 2; ++ai)
#pragma unroll
            for (int m = 0; m < 4; ++m) { const size_t off = (size_t)(row0 + ai * HALF + m * 16) * D + col0;
#pragma unroll
                for (int bj = 0; bj < 2; ++bj) { const u32x4 g = *(const u32x4*)(ga + off + bj * HALF);
                    const f32x4 g0 = {bflo(g.x), bfhi(g.x), bflo(g.y), bfhi(g.y)}, g1 = {bflo(g.z), bfhi(g.z), bflo(g.w), bfhi(g.w)};
                    *(u32x4*)(Y + off + bj * HALF) = pack8(acc[ai][bj][m][0] * g0, acc[ai][bj][m][1] * g1); } }
    }
};
struct EpiGateAdd {
    static constexpr bool PERM = true;
    const bf16_t* Y; const bf16_t* gb; bf16_t* mi;
    __device__ __forceinline__ void operator()(const f32x4 (&acc)[2][2][4][2], const Unit& un, int wr, int wc, int fr, int fq) const {
        const int row0 = un.pm * BM + wr * 64 + fr, col0 = un.pn * BM + wc * 32 + 8 * fq;
#pragma unroll
        for (int ai = 0; ai < 2; ++ai)
#pragma unroll
            for (int m = 0; m < 4; ++m) { const size_t off = (size_t)(row0 + ai * HALF + m * 16) * D + col0;
#pragma unroll
                for (int bj = 0; bj < 2; ++bj) { const u32x4 g = *(const u32x4*)(gb + off + bj * HALF), y = *(const u32x4*)(Y + off + bj * HALF);
                    const f32x4 g0 = {bflo(g.x), bfhi(g.x), bflo(g.y), bfhi(g.y)}, g1 = {bflo(g.z), bfhi(g.z), bflo(g.w), bfhi(g.w)};
                    const f32x4 y0 = {bflo(y.x), bfhi(y.x), bflo(y.y), bfhi(y.y)}, y1 = {bflo(y.z), bfhi(y.z), bflo(y.w), bfhi(y.w)};
                    *(u32x4*)(mi + off + bj * HALF) = pack8(y0 + acc[ai][bj][m][0] * g0, y1 + acc[ai][bj][m][1] * g1); } }
    }
};
struct EpiChain {
    static constexpr bool PERM = true;
    const bf16_t* ga; const bf16_t* gb; bf16_t* mi;
    __device__ __forceinline__ void mid(f32x4 (&acc)[2][2][4][2], const Unit& un, int wr, int wc, int fr, int fq, const bool zero) const {
        const int row0 = un.pm * BM + wr * 64 + fr, col0 = un.pn * BM + wc * 32 + 8 * fq;
#pragma unroll
        for (int ai = 0; ai < 2; ++ai)
#pragma unroll
            for (int m = 0; m < 4; ++m) { const size_t off = (size_t)(row0 + ai * HALF + m * 16) * D + col0;
#pragma unroll
                for (int bj = 0; bj < 2; ++bj) { f32x4 f0 = {0.f, 0.f, 0.f, 0.f}, f1 = f0;
                    if (!zero) { const u32x4 a = *(const u32x4*)(ga + off + bj * HALF), b = *(const u32x4*)(gb + off + bj * HALF);
                        f32x4 a0 = {bflo(a.x), bfhi(a.x), bflo(a.y), bfhi(a.y)}, a1 = {bflo(a.z), bfhi(a.z), bflo(a.w), bfhi(a.w)};
                        const f32x4 b0 = {bflo(b.x), bfhi(b.x), bflo(b.y), bfhi(b.y)}, b1 = {bflo(b.z), bfhi(b.z), bflo(b.w), bfhi(b.w)};
#pragma unroll
                        for (int x = 0; x < 4; ++x) { a0[x] = __builtin_amdgcn_rcpf(fmaxf(a0[x], 1e-20f)); a1[x] = __builtin_amdgcn_rcpf(fmaxf(a1[x], 1e-20f)); }
                        f0 = b0 * a0; f1 = b1 * a1; }
                    acc[ai][bj][m][0] = acc[ai][bj][m][0] * f0; acc[ai][bj][m][1] = acc[ai][bj][m][1] * f1; }
                asm volatile("" : "+v"(acc[ai][0][m][0]), "+v"(acc[ai][0][m][1]), "+v"(acc[ai][1][m][0]), "+v"(acc[ai][1][m][1]) :: "memory"); }
    }
    __device__ __forceinline__ void operator()(const f32x4 (&acc)[2][2][4][2], const Unit& un, int wr, int wc, int fr, int fq) const {
        const int row0 = un.pm * BM + wr * 64 + fr, col0 = un.pn * BM + wc * 32 + 8 * fq;
#pragma unroll
        for (int ai = 0; ai < 2; ++ai)
#pragma unroll
            for (int m = 0; m < 4; ++m) { const size_t off = (size_t)(row0 + ai * HALF + m * 16) * D + col0;
#pragma unroll
                for (int bj = 0; bj < 2; ++bj) { const u32x4 a = *(const u32x4*)(ga + off + bj * HALF);
                    const f32x4 a0 = {bflo(a.x), bfhi(a.x), bflo(a.y), bfhi(a.y)}, a1 = {bflo(a.z), bfhi(a.z), bflo(a.w), bfhi(a.w)};
                    *(u32x4*)(mi + off + bj * HALF) = pack8(acc[ai][bj][m][0] * a0, acc[ai][bj][m][1] * a1); } }
    }
};
struct EpiBf16Plain {
    static constexpr bool PERM = true;
    bf16_t* O;
    __device__ __forceinline__ void operator()(const f32x4 (&acc)[2][2][4][2], const Unit& un, int wr, int wc, int fr, int fq) const {
        const int row0 = un.pm * BM + wr * 64 + fr, col0 = un.pn * BM + wc * 32 + 8 * fq;
#pragma unroll
        for (int ai = 0; ai < 2; ++ai)
#pragma unroll
            for (int m = 0; m < 4; ++m) { const size_t off = (size_t)(row0 + ai * HALF + m * 16) * D + col0;
#pragma unroll
                for (int bj = 0; bj < 2; ++bj) *(u32x4*)(O + off + bj * HALF) = pack8(acc[ai][bj][m][0], acc[ai][bj][m][1]); }
    }
};
struct EpiSwiglu {
    static constexpr bool PERM = true;
    unsigned char* a; const float* b1;
    __device__ __forceinline__ void operator()(const f32x4 (&acc)[2][2][4][2], const Unit& un, int wr, int wc, int fr, int fq) const {
        const int row0 = un.pm * BM + wr * 64 + fr, j0 = un.pn * HALF + wc * 32 + 8 * fq;
        const f32x4* bp = (const f32x4*)(b1 + (size_t)un.e * 2 * FF + 2 * j0);
        const f32x4 b0 = bp[0], b1v = bp[1], b2 = bp[2], b3 = bp[3];
        const f32x4 bg0 = {b0[0], b0[2], b1v[0], b1v[2]}, bu0 = {b0[1], b0[3], b1v[1], b1v[3]}, bg1 = {b2[0], b2[2], b3[0], b3[2]}, bu1 = {b2[1], b2[3], b3[1], b3[3]};
#pragma unroll
        for (int ai = 0; ai < 2; ++ai)
#pragma unroll
            for (int m = 0; m < 4; ++m) {
                f32x4 o[2];
#pragma unroll
                for (int n = 0; n < 2; ++n) {
                    f32x4 g = acc[ai][0][m][n] * W8_INV + (n ? bg1 : bg0), up = acc[ai][1][m][n] * W8_INV + (n ? bu1 : bu0), e, r;
#pragma unroll
                    for (int x = 0; x < 4; ++x) { g[x] = fminf(g[x], SW_LIMIT); up[x] = __builtin_amdgcn_fmed3f(up[x], -SW_LIMIT, SW_LIMIT); }
                    const f32x4 ex = g * (-SW_ALPHA * 1.4426950408889634f);
#pragma unroll
                    for (int x = 0; x < 4; ++x) e[x] = __builtin_amdgcn_exp2f(ex[x]);
                    e = e + 1.f;
#pragma unroll
                    for (int x = 0; x < 4; ++x) r[x] = __builtin_amdgcn_rcpf(e[x]);
                    const f32x4 gs = g * r; o[n] = gs * up + gs; }
                *(u32x2*)(a + (size_t)(row0 + ai * HALF + m * 16) * FF + j0) = pack8_fp8(o[0], o[1]);
            }
    }
};
constexpr float YE_SCALE = 4.f, YE_INV = 0.25f;
struct EpiYe {
    static constexpr bool PERM = true;
    unsigned char* ye; const float* b2;
    __device__ __forceinline__ void operator()(const f32x4 (&acc)[2][2][4][2], const Unit& un, int wr, int wc, int fr, int fq) const {
        const int row0 = un.pm * BM + wr * 64 + fr, col0 = un.pn * BM + wc * 32 + 8 * fq;
        f32x4 bv[2][2];
#pragma unroll
        for (int bj = 0; bj < 2; ++bj) { bv[bj][0] = *(const f32x4*)(b2 + (size_t)un.e * D + col0 + bj * HALF); bv[bj][1] = *(const f32x4*)(b2 + (size_t)un.e * D + col0 + bj * HALF + 4); }
#pragma unroll
        for (int ai = 0; ai < 2; ++ai)
#pragma unroll
            for (int m = 0; m < 4; ++m) { unsigned char* rowp = ye + (size_t)(row0 + ai * HALF + m * 16) * D + col0;
#pragma unroll
                for (int bj = 0; bj < 2; ++bj) *(u32x2*)(rowp + bj * HALF) = pack8_fp8((acc[ai][bj][m][0] * W8_INV + bv[bj][0]) * YE_SCALE, (acc[ai][bj][m][1] * W8_INV + bv[bj][1]) * YE_SCALE); }
    }
};

template <class Epi, class Sched, bool ALIGN_EPI, bool GATHER, bool FP8 = false>
__device__ __forceinline__ void gemm_phase(PG8_LAS unsigned char* lds, const Gemm g, const Sched& S, const Epi& E, const PG8_LAS int* gtab) {
    int tid_ = (int)threadIdx.x; asm volatile("" : "+v"(tid_));
    const int tid = tid_, wid = __builtin_amdgcn_readfirstlane(tid >> 6), lane = tid & 63, wr = wid >> 2, wc = wid & 3, fr = lane & 15, fq = lane >> 4;
    const int K = g.K, nt = K / BK;
    unsigned voffB[2];
#pragma unroll
    for (int i = 0; i < 2; ++i) { int R, C; stage_rc(tid * 16 + i * 8192, R, C); const int Rb = Epi::PERM ? ((R & ~31) + perm32(R & 31)) : R; voffB[i] = (unsigned)(Rb * K + C) * 2u; }
    const size_t kstep = (size_t)(BK * 2);
    const size_t hstep = (size_t)HALF * K * 2;
    const size_t tstep = 2 * hstep;
    const unsigned ldsw = (unsigned)wid * 1024u;
    const int aoff = lds_byte(wr * 64 + fr, fq * 8), boff = lds_byte(wc * 32 + fr, fq * 8);
#define PG8_SA(b, h) (((b) * 2 + (h)) * HTB)
#define PG8_SB(b, h) ((4 + (b) * 2 + (h)) * HTB)
#define PG8_STAGE(bufoff, gbase, voff) do { _Pragma("unroll") for (int _i = 0; _i < 2; ++_i) \
        __builtin_amdgcn_global_load_lds((const unsigned*)((const char*)(gbase) + (voff)[_i]), (PG8_LAS unsigned*)(lds + (bufoff) + ldsw + _i * 8192), 16, 0, 0); } while (0)
#define PG8_LDA(dst, b, h) do { _Pragma("unroll") for (int m = 0; m < 4; ++m) _Pragma("unroll") for (int k = 0; k < 2; ++k) dst[m][k] = *(const PG8_LAS bf16x8*)(lds + PG8_SA(b, h) + aoff + m * 2048 + k * 1024); } while (0)
#define PG8_LDB(dst, b, h) do { _Pragma("unroll") for (int n = 0; n < 2; ++n) _Pragma("unroll") for (int k = 0; k < 2; ++k) dst[n][k] = *(const PG8_LAS bf16x8*)(lds + PG8_SB(b, h) + boff + n * 2048 + k * 1024); } while (0)
#define PG8_MMA(ai, bj, At, Bt) do { __builtin_amdgcn_s_setprio(1); if constexpr (FP8) { _Pragma("unroll") for (int m = 0; m < 4; ++m) _Pragma("unroll") for (int n = 0; n < 2; ++n) \
        mfma_fp8(acc[ai][bj][m][n], cat8(Bt[n][0], Bt[n][1]), cat8(At[m][0], At[m][1])); } else { \
        _Pragma("unroll") for (int m = 0; m < 4; ++m) _Pragma("unroll") for (int n = 0; n < 2; ++n) _Pragma("unroll") for (int k = 0; k < 2; ++k) \
        acc[ai][bj][m][n] = __builtin_amdgcn_mfma_f32_16x16x32_bf16(Bt[n][k], At[m][k], acc[ai][bj][m][n], 0, 0, 0); } __builtin_amdgcn_s_setprio(0); } while (0)
#define PG8_WAIT_V(n) asm volatile("s_waitcnt vmcnt(" #n ")" ::: "memory")
#define PG8_WAIT_L(n) asm volatile("s_waitcnt lgkmcnt(" #n ")" ::: "memory")
#define PG8_BAR __builtin_amdgcn_s_barrier()
#define PG8_SCHED __builtin_amdgcn_sched_barrier(0)
#define PG8_AOFF(dst, u, uidx) do { _Pragma("unroll") for (int _i = 0; _i < 2; ++_i) { int _R, _C; stage_rc(tid * 16 + _i * 8192, _R, _C); _Pragma("unroll") for (int _h = 0; _h < 2; ++_h) { \
        const int _row = GATHER ? gtab[(uidx) * 256 + _h * HALF + _R] : ((u).pm * BM + _h * HALF + _R); dst[_h][_i] = (unsigned)(_row * K + _C) * 2u; } } } while (0)
    Unit cur, nxt; int ui = 0;
    if (!S.next(0, cur)) return;
    f32x4 acc[2][2][4][2];
#pragma unroll
    for (int a = 0; a < 2; ++a)
#pragma unroll
        for (int b = 0; b < 2; ++b)
#pragma unroll
            for (int m = 0; m < 4; ++m)
#pragma unroll
                for (int n = 0; n < 2; ++n) acc[a][b][m][n] = (f32x4){0.f, 0.f, 0.f, 0.f};
    bf16x8 At[4][2], B0[2][2], B1[2][2];
    unsigned vAc[2][2], vAn[2][2];
    const char* const Ab = (const char*)g.A;
    const char* cB = (const char*)g.Bt + (size_t)cur.e * g.bstride + (size_t)cur.pn * tstep;
    PG8_AOFF(vAc, cur, 0);
    PG8_STAGE(PG8_SB(0, 0), cB, voffB); PG8_STAGE(PG8_SB(0, 1), cB + hstep, voffB); PG8_STAGE(PG8_SA(0, 0), Ab, vAc[0]); PG8_STAGE(PG8_SA(0, 1), Ab, vAc[1]);
    if (wr == 1) PG8_BAR;
    PG8_WAIT_V(2); PG8_BAR;
    PG8_STAGE(PG8_SB(1, 0), cB + kstep, voffB); PG8_STAGE(PG8_SA(1, 0), Ab + kstep, vAc[0]); PG8_STAGE(PG8_SB(1, 1), cB + hstep + kstep, voffB);
    PG8_WAIT_V(6); PG8_BAR;
    for (;;) {
        const bool has_next = S.next(ui + 1, nxt);
        const char* nB = has_next ? (const char*)g.Bt + (size_t)nxt.e * g.bstride + (size_t)nxt.pn * tstep : cB;
        if (has_next) { PG8_AOFF(vAn, nxt, ui + 1); }
        else {
#pragma unroll
            for (int h = 0; h < 2; ++h)
#pragma unroll
                for (int i = 0; i < 2; ++i) vAn[h][i] = vAc[h][i]; }
        _Pragma("nounroll") for (int t = 0; t < nt; t += 2) {
            const bool last = (t == nt - 2);
            const char* a1 = Ab + (size_t)(t + 1) * kstep;
            const char* a2 = last ? Ab : Ab + (size_t)(t + 2) * kstep; const char* b2 = last ? nB : cB + (size_t)(t + 2) * kstep;
            const char* a3 = a2 + kstep; const char* b3 = b2 + kstep;
            unsigned s0[2], s1[2];
#pragma unroll
            for (int i = 0; i < 2; ++i) { s0[i] = last ? vAn[0][i] : vAc[0][i]; s1[i] = last ? vAn[1][i] : vAc[1][i]; }
            PG8_LDB(B0, 0, 0); PG8_LDB(B1, 0, 1); PG8_SCHED; PG8_LDA(At, 0, 0); PG8_STAGE(PG8_SA(1, 1), a1, vAc[1]);
            PG8_WAIT_V(8); PG8_WAIT_L(0); PG8_BAR; PG8_MMA(0, 0, At, B0); PG8_MMA(0, 1, At, B1); PG8_BAR; PG8_SCHED;
            PG8_LDA(At, 0, 1); PG8_STAGE(PG8_SB(0, 0), b2, voffB); PG8_STAGE(PG8_SB(0, 1), b2 + hstep, voffB); PG8_STAGE(PG8_SA(0, 0), a2, s0);
            PG8_WAIT_V(8); PG8_WAIT_L(0); PG8_BAR; PG8_MMA(1, 0, At, B0); PG8_MMA(1, 1, At, B1); PG8_BAR; PG8_SCHED;
            PG8_LDB(B0, 1, 0); PG8_LDB(B1, 1, 1); PG8_SCHED; PG8_LDA(At, 1, 0); PG8_STAGE(PG8_SA(0, 1), a2, s1);
            PG8_WAIT_V(8); PG8_WAIT_L(0); PG8_BAR; PG8_MMA(0, 0, At, B0); PG8_MMA(0, 1, At, B1); PG8_BAR; PG8_SCHED;
            PG8_LDA(At, 1, 1); PG8_STAGE(PG8_SB(1, 0), b3, voffB); PG8_STAGE(PG8_SB(1, 1), b3 + hstep, voffB); PG8_STAGE(PG8_SA(1, 0), a3, s0);
            PG8_WAIT_V(8); PG8_WAIT_L(0); PG8_BAR; PG8_MMA(1, 0, At, B0); PG8_MMA(1, 1, At, B1); PG8_BAR; PG8_SCHED;
        }
        if constexpr (ALIGN_EPI) { if (wr == 0) PG8_BAR; }
        if constexpr (FP8) asm volatile("s_nop 15\n\ts_nop 15" ::: "memory");
        E(acc, cur, wr, wc, fr, fq);
        if (!has_next) break;
#pragma unroll
        for (int a = 0; a < 2; ++a)
#pragma unroll
            for (int b = 0; b < 2; ++b)
#pragma unroll
                for (int m = 0; m < 4; ++m)
#pragma unroll
                    for (int n = 0; n < 2; ++n) acc[a][b][m][n] = (f32x4){0.f, 0.f, 0.f, 0.f};
        cur = nxt; cB = nB; ++ui;
#pragma unroll
        for (int h = 0; h < 2; ++h)
#pragma unroll
            for (int i = 0; i < 2; ++i) vAc[h][i] = vAn[h][i];
        if constexpr (ALIGN_EPI) { if (wr == 1) PG8_BAR; }
    }
    PG8_WAIT_V(0);
    if constexpr (!ALIGN_EPI) { if (wr == 0) PG8_BAR; }
    PG8_BAR;
#undef PG8_SA
#undef PG8_SB
#undef PG8_STAGE
#undef PG8_LDA
#undef PG8_LDB
#undef PG8_MMA
#undef PG8_WAIT_V
#undef PG8_WAIT_L
#undef PG8_BAR
#undef PG8_SCHED
#undef PG8_AOFF
}
struct Gemm2 { const bf16_t* A0; const bf16_t* Bt0; const bf16_t* A1; const bf16_t* Bt1; int K0, K1; };
template <class Epi, class Sched>
__device__ __forceinline__ void gemm_chain2(PG8_LAS unsigned char* lds, const Gemm2 g, const Sched& S, const Epi& E) {
    constexpr bool ALIGN_EPI = true, GATHER = false, FP8 = false; const PG8_LAS int* gtab = nullptr; (void)gtab;
    int tid_ = (int)threadIdx.x; asm volatile("" : "+v"(tid_));
    const int tid = tid_, wid = __builtin_amdgcn_readfirstlane(tid >> 6), lane = tid & 63, wr = wid >> 2, wc = wid & 3, fr = lane & 15, fq = lane >> 4;
#define PG8_VOFFB(dst, Kx) do { _Pragma("unroll") for (int _i = 0; _i < 2; ++_i) { int _R, _C; stage_rc(tid * 16 + _i * 8192, _R, _C); const int _Rb = Epi::PERM ? ((_R & ~31) + perm32(_R & 31)) : _R; dst[_i] = (unsigned)(_Rb * (Kx) + _C) * 2u; } } while (0)
    int Kc = g.K0, Kn = g.K1, segc = 0;
    unsigned voffB[2], voffBn[2];
    PG8_VOFFB(voffB, Kc);
    const size_t kstep = (size_t)(BK * 2);
    size_t hstep = (size_t)HALF * Kc * 2, hstepn = hstep;
    const char* Ab = (const char*)g.A0; const char* Abn = Ab;
    const unsigned ldsw = (unsigned)wid * 1024u;
    const int aoff = lds_byte(wr * 64 + fr, fq * 8), boff = lds_byte(wc * 32 + fr, fq * 8);
#define PG8_SA(b, h) (((b) * 2 + (h)) * HTB)
#define PG8_SB(b, h) ((4 + (b) * 2 + (h)) * HTB)
#define PG8_STAGE(bufoff, gbase, voff) do { _Pragma("unroll") for (int _i = 0; _i < 2; ++_i) \
        __builtin_amdgcn_global_load_lds((const unsigned*)((const char*)(gbase) + (voff)[_i]), (PG8_LAS unsigned*)(lds + (bufoff) + ldsw + _i * 8192), 16, 0, 0); } while (0)
#define PG8_LDA(dst, b, h) do { _Pragma("unroll") for (int m = 0; m < 4; ++m) _Pragma("unroll") for (int k = 0; k < 2; ++k) dst[m][k] = *(const PG8_LAS bf16x8*)(lds + PG8_SA(b, h) + aoff + m * 2048 + k * 1024); } while (0)
#define PG8_LDB(dst, b, h) do { _Pragma("unroll") for (int n = 0; n < 2; ++n) _Pragma("unroll") for (int k = 0; k < 2; ++k) dst[n][k] = *(const PG8_LAS bf16x8*)(lds + PG8_SB(b, h) + boff + n * 2048 + k * 1024); } while (0)
#define PG8_MMA(ai, bj, At, Bt) do { __builtin_amdgcn_s_setprio(1); if constexpr (FP8) { _Pragma("unroll") for (int m = 0; m < 4; ++m) _Pragma("unroll") for (int n = 0; n < 2; ++n) \
        mfma_fp8(acc[ai][bj][m][n], cat8(Bt[n][0], Bt[n][1]), cat8(At[m][0], At[m][1])); } else { \
        _Pragma("unroll") for (int m = 0; m < 4; ++m) _Pragma("unroll") for (int n = 0; n < 2; ++n) _Pragma("unroll") for (int k = 0; k < 2; ++k) \
        acc[ai][bj][m][n] = __builtin_amdgcn_mfma_f32_16x16x32_bf16(Bt[n][k], At[m][k], acc[ai][bj][m][n], 0, 0, 0); } __builtin_amdgcn_s_setprio(0); } while (0)
#define PG8_WAIT_V(n) asm volatile("s_waitcnt vmcnt(" #n ")" ::: "memory")
#define PG8_WAIT_L(n) asm volatile("s_waitcnt lgkmcnt(" #n ")" ::: "memory")
#define PG8_BAR __builtin_amdgcn_s_barrier()
#define PG8_SCHED __builtin_amdgcn_sched_barrier(0)
#define PG8_AOFF(dst, u, uidx) do { _Pragma("unroll") for (int _i = 0; _i < 2; ++_i) { int _R, _C; stage_rc(tid * 16 + _i * 8192, _R, _C); _Pragma("unroll") for (int _h = 0; _h < 2; ++_h) { \
        const int _row = (u).pm * BM + _h * HALF + _R; dst[_h][_i] = (unsigned)(_row * (uidx) + _C) * 2u; } } } while (0)
    Unit cur, nxt; int ui = 0;
    if (!S.next(0, cur)) return;
    f32x4 acc[2][2][4][2];
#pragma unroll
    for (int a = 0; a < 2; ++a)
#pragma unroll
        for (int b = 0; b < 2; ++b)
#pragma unroll
            for (int m = 0; m < 4; ++m)
#pragma unroll
                for (int n = 0; n < 2; ++n) acc[a][b][m][n] = (f32x4){0.f, 0.f, 0.f, 0.f};
    bf16x8 At[4][2], B0[2][2], B1[2][2];
    unsigned vAc[2][2], vAn[2][2];
    const char* cB = (const char*)g.Bt0 + (size_t)cur.pn * 2 * hstep;
    PG8_AOFF(vAc, cur, Kc);
    PG8_STAGE(PG8_SB(0, 0), cB, voffB); PG8_STAGE(PG8_SB(0, 1), cB + hstep, voffB); PG8_STAGE(PG8_SA(0, 0), Ab, vAc[0]); PG8_STAGE(PG8_SA(0, 1), Ab, vAc[1]);
    if (wr == 1) PG8_BAR;
    PG8_WAIT_V(2); PG8_BAR;
    PG8_STAGE(PG8_SB(1, 0), cB + kstep, voffB); PG8_STAGE(PG8_SA(1, 0), Ab + kstep, vAc[0]); PG8_STAGE(PG8_SB(1, 1), cB + hstep + kstep, voffB);
    PG8_WAIT_V(6); PG8_BAR;
    for (;;) {
        bool has_next; const char* nB;
        if (segc == 0) { has_next = true; nxt = cur; Kn = g.K1; Abn = (const char*)g.A1; hstepn = (size_t)HALF * Kn * 2; nB = (const char*)g.Bt1 + (size_t)cur.pn * 2 * hstepn; PG8_VOFFB(voffBn, Kn); PG8_AOFF(vAn, cur, Kn); }
        else { has_next = S.next(ui + 1, nxt);
            if (has_next) { Kn = g.K0; Abn = (const char*)g.A0; hstepn = (size_t)HALF * Kn * 2; nB = (const char*)g.Bt0 + (size_t)nxt.pn * 2 * hstepn; PG8_VOFFB(voffBn, Kn); PG8_AOFF(vAn, nxt, Kn); }
            else { Kn = Kc; Abn = Ab; hstepn = hstep; nB = cB;
#pragma unroll
                for (int h = 0; h < 2; ++h)
#pragma unroll
                    for (int i = 0; i < 2; ++i) vAn[h][i] = vAc[h][i];
#pragma unroll
                for (int i = 0; i < 2; ++i) voffBn[i] = voffB[i]; } }
        const int nt = Kc / BK;
        _Pragma("nounroll") for (int t = 0; t < nt; t += 2) {
            const bool last = (t == nt - 2);
            const char* a1 = Ab + (size_t)(t + 1) * kstep;
            const char* a2 = last ? Abn : Ab + (size_t)(t + 2) * kstep; const char* b2 = last ? nB : cB + (size_t)(t + 2) * kstep;
            const size_t h2 = last ? hstepn : hstep; unsigned vB2[2];
#pragma unroll
            for (int i = 0; i < 2; ++i) vB2[i] = last ? voffBn[i] : voffB[i];
            const char* a3 = a2 + kstep; const char* b3 = b2 + kstep;
            unsigned s0[2], s1[2];
#pragma unroll
            for (int i = 0; i < 2; ++i) { s0[i] = last ? vAn[0][i] : vAc[0][i]; s1[i] = last ? vAn[1][i] : vAc[1][i]; }
            PG8_LDB(B0, 0, 0); PG8_LDB(B1, 0, 1); PG8_SCHED; PG8_LDA(At, 0, 0); PG8_STAGE(PG8_SA(1, 1), a1, vAc[1]);
            PG8_WAIT_V(8); PG8_WAIT_L(0); PG8_BAR; PG8_MMA(0, 0, At, B0); PG8_MMA(0, 1, At, B1); PG8_BAR; PG8_SCHED;
            PG8_LDA(At, 0, 1); PG8_STAGE(PG8_SB(0, 0), b2, vB2); PG8_STAGE(PG8_SB(0, 1), b2 + h2, vB2); PG8_STAGE(PG8_SA(0, 0), a2, s0);
            PG8_WAIT_V(8); PG8_WAIT_L(0); PG8_BAR; PG8_MMA(1, 0, At, B0); PG8_MMA(1, 1, At, B1); PG8_BAR; PG8_SCHED;
            PG8_LDB(B0, 1, 0); PG8_LDB(B1, 1, 1); PG8_SCHED; PG8_LDA(At, 1, 0); PG8_STAGE(PG8_SA(0, 1), a2, s1);
            PG8_WAIT_V(8); PG8_WAIT_L(0); PG8_BAR; PG8_MMA(0, 0, At, B0); PG8_MMA(0, 1, At, B1); PG8_BAR; PG8_SCHED;
            PG8_LDA(At, 1, 1); PG8_STAGE(PG8_SB(1, 0), b3, vB2); PG8_STAGE(PG8_SB(1, 1), b3 + h2, vB2); PG8_STAGE(PG8_SA(1, 0), a3, s0);
            PG8_WAIT_V(8); PG8_WAIT_L(0); PG8_BAR; PG8_MMA(1, 0, At, B0); PG8_MMA(1, 1, At, B1); PG8_BAR; PG8_SCHED;
        }
        if constexpr (ALIGN_EPI) { if (wr == 0) PG8_BAR; }
        if (segc == 1) { E(acc, cur, wr, wc, fr, fq); if (!has_next) break; }
        E.mid(acc, cur, wr, wc, fr, fq, segc == 1);
        if (segc == 1) { cur = nxt; ++ui; }
        segc ^= 1; Kc = Kn; Ab = Abn; hstep = hstepn; cB = nB;
#pragma unroll
        for (int i = 0; i < 2; ++i) voffB[i] = voffBn[i];
#pragma unroll
        for (int h = 0; h < 2; ++h)
#pragma unroll
            for (int i = 0; i < 2; ++i) vAc[h][i] = vAn[h][i];
        if constexpr (ALIGN_EPI) { if (wr == 1) PG8_BAR; }
    }
    PG8_WAIT_V(0);
    if constexpr (!ALIGN_EPI) { if (wr == 0) PG8_BAR; }
    PG8_BAR;
#undef PG8_SA
#undef PG8_SB
#undef PG8_STAGE
#undef PG8_LDA
#undef PG8_LDB
#undef PG8_MMA
#undef PG8_WAIT_V
#undef PG8_WAIT_L
#undef PG8_BAR
#undef PG8_SCHED
#undef PG8_AOFF
#undef PG8_VOFFB
}
}
#include <hip/hip_bf16.h>
#include <cmath>
namespace attn_body {
using bf16=__hip_bfloat16;
using bf16x8=__attribute__((ext_vector_type(8)))short;
using s16x4=__attribute__((ext_vector_type(4)))short;
using f32x16=__attribute__((ext_vector_type(16)))float;
using u32x4=__attribute__((ext_vector_type(4)))unsigned;
constexpr int BATCH=8,NHEAD=16,SEQ=2048,D=64,DM=NHEAD*D;
constexpr int NW=8,QBLK=32,QB=QBLK*NW,KVBLK=64,NQB=SEQ/QB;
constexpr int ATTN_PITCH=DM, ATTN_UNIT_ROWS=QB;
__device__ __forceinline__ int crow(int r,int hi){return (r&3)+8*(r>>2)+4*hi;}
#define SBAR() __builtin_amdgcn_sched_barrier(0)
__device__ __forceinline__ void cmask(f32x16&p0,f32x16&p1,int jb,int qrel,int hi){
  const float NEG=-INFINITY; int kb=64*jb+4*hi;
  #pragma unroll
  for(int r=0;r<16;++r){int kv=kb+(r&3)+8*(r>>2); if(kv>qrel)p0[r]=NEG; if(kv+32>qrel)p1[r]=NEG;}
}

constexpr int NSLOT=3, SLOTB=8192;
constexpr int LDS_K=0, LDS_V=NSLOT*SLOTB, LDS_WS=2*NSLOT*SLOTB, LDS_OST=LDS_WS+NW*64*4, LDS_BYTES=LDS_OST+NW*4096;
constexpr float C2=0.125f*1.4426950408889634f;
__device__ __forceinline__ void glds16(const void*gsrc,unsigned lds_dst){unsigned keep;
  asm volatile("s_mov_b32 %0, m0\n\ts_mov_b32 m0, %2\n\ts_nop 0\n\tglobal_load_lds_dwordx4 %1, off\n\ts_mov_b32 m0, %0":"=&s"(keep):"v"(gsrc),"s"(lds_dst):"memory");}
__device__ __forceinline__ float max3f(float a,float b,float c){float r;asm("v_max3_f32 %0, %1, %2, %3":"=v"(r):"v"(a),"v"(b),"v"(c));return r;}
__device__ __forceinline__ float max2f(float a,float b){float r;asm("v_max_f32_e32 %0, %1, %2":"=v"(r):"v"(a),"v"(b));return r;}
__device__ __forceinline__ float fadd_s(float a,float b){float r;asm("v_add_f32_e32 %0, %1, %2":"=v"(r):"v"(a),"v"(b));return r;}
__device__ __forceinline__ float fsub_s(float a,float b){float r;asm("v_sub_f32_e32 %0, %1, %2":"=v"(r):"v"(a),"v"(b));return r;}
typedef float f32x2_t __attribute__((ext_vector_type(2))); typedef __bf16 bf16x2_t __attribute__((ext_vector_type(2)));
__device__ __forceinline__ unsigned cvtpk_s(float lo,float hi){f32x2_t v={lo,hi};bf16x2_t b=__builtin_convertvector(v,bf16x2_t);return __builtin_bit_cast(unsigned,b);}
#define WAIT_BAR(N) asm volatile("s_waitcnt vmcnt(" #N ") lgkmcnt(0)\n\ts_barrier":::"memory")

__device__ __forceinline__ void qkt(f32x16&p0,f32x16&p1,const char*Kslot,const bf16x8*qr,const f32x16&negm,int r32,int hi){
  const char*kb=Kslot+hi*1024+r32*16;
  #pragma unroll
  for(int d0=0;d0<4;++d0){
    const bf16x8 b0=*reinterpret_cast<const bf16x8*>(kb+d0*2048);
    const bf16x8 b1=*reinterpret_cast<const bf16x8*>(kb+d0*2048+512);
    if(d0==0){p0=__builtin_amdgcn_mfma_f32_32x32x16_bf16(b0,qr[0],negm,0,0,0);p1=__builtin_amdgcn_mfma_f32_32x32x16_bf16(b1,qr[0],negm,0,0,0);}
    else{p0=__builtin_amdgcn_mfma_f32_32x32x16_bf16(b0,qr[d0],p0,0,0,0);p1=__builtin_amdgcn_mfma_f32_32x32x16_bf16(b1,qr[d0],p1,0,0,0);}}
}
typedef __attribute__((address_space(3))) const char* lds_cptr;
typedef short v4i16_t __attribute__((ext_vector_type(4)));
__device__ __forceinline__ void kload8(bf16x8*kf,lds_cptr kp){
  kf[0]=*(const __attribute__((address_space(3))) bf16x8*)(kp);      kf[1]=*(const __attribute__((address_space(3))) bf16x8*)(kp+512);
  kf[2]=*(const __attribute__((address_space(3))) bf16x8*)(kp+2048); kf[3]=*(const __attribute__((address_space(3))) bf16x8*)(kp+2560);
  kf[4]=*(const __attribute__((address_space(3))) bf16x8*)(kp+4096); kf[5]=*(const __attribute__((address_space(3))) bf16x8*)(kp+4608);
  kf[6]=*(const __attribute__((address_space(3))) bf16x8*)(kp+6144); kf[7]=*(const __attribute__((address_space(3))) bf16x8*)(kp+6656);
}
__device__ __forceinline__ void kload2(bf16x8*kf,lds_cptr kp,int j){ kf[2*j]=*(const __attribute__((address_space(3))) bf16x8*)(kp+j*2048); kf[2*j+1]=*(const __attribute__((address_space(3))) bf16x8*)(kp+j*2048+512); }
__device__ __forceinline__ s16x4 vtr(lds_cptr p){ return __builtin_bit_cast(s16x4,__builtin_amdgcn_ds_read_tr16_b64_v4i16((__attribute__((address_space(3))) v4i16_t*)p)); }
__device__ __forceinline__ float rowmax(const f32x16&p0,const f32x16&p1){
  float a=max3f(p0[0],p0[1],p1[0]),b=max3f(p0[2],p0[3],p1[1]);a=max3f(a,p1[2],p1[3]);
  #pragma unroll
  for(int r=4;r<16;r+=4){a=max3f(a,p0[r],p0[r+1]);b=max3f(b,p0[r+2],p0[r+3]);a=max3f(a,p1[r],p1[r+1]);b=max3f(b,p1[r+2],p1[r+3]);}
  const float m=max2f(a,b);
  auto rr=__builtin_amdgcn_permlane32_swap(__float_as_uint(m),__float_as_uint(m),false,false);
  return max2f(__uint_as_float(rr[0]),__uint_as_float(rr[1]));
}
__device__ __forceinline__ void pv(f32x16*o,int vb,bf16x8 pa0,bf16x8 pa1,bf16x8 pa2,bf16x8 pa3){
  #pragma unroll
  for(int d0=0;d0<2;++d0){s16x4 lo[4],hi[4];
    #pragma unroll
    for(int ks=0;ks<4;++ks){
      asm volatile("ds_read_b64_tr_b16 %0,%1 offset:%c2":"=&v"(lo[ks]):"v"(vb),"i"(d0*4096+ks*1024):"memory");
      asm volatile("ds_read_b64_tr_b16 %0,%1 offset:%c2":"=&v"(hi[ks]):"v"(vb),"i"(d0*4096+ks*1024+512):"memory");}
    asm volatile("s_waitcnt lgkmcnt(0)":::"memory");SBAR();
    #define PK(k) (bf16x8){lo[k][0],lo[k][1],lo[k][2],lo[k][3],hi[k][0],hi[k][1],hi[k][2],hi[k][3]}
    o[d0]=__builtin_amdgcn_mfma_f32_32x32x16_bf16(pa0,PK(0),o[d0],0,0,0);
    o[d0]=__builtin_amdgcn_mfma_f32_32x32x16_bf16(pa1,PK(1),o[d0],0,0,0);
    o[d0]=__builtin_amdgcn_mfma_f32_32x32x16_bf16(pa2,PK(2),o[d0],0,0,0);
    o[d0]=__builtin_amdgcn_mfma_f32_32x32x16_bf16(pa3,PK(3),o[d0],0,0,0);
    #undef PK
  }
}

#ifndef ATTN_STORE16
#define ATTN_STORE16(p,v) (*(u32x4*)(p)=(v))
#endif
template<int THRL> __device__ __forceinline__ void attn_unit(int b,int h,int hv,int qb,const bf16*Q,const bf16*__restrict__ K,const bf16*__restrict__ V,bf16*O,char*shm){
  int tid_=threadIdx.x; asm volatile("":"+v"(tid_));
  const int tid=tid_,lane=tid&63,r32=lane&31,hi=lane>>5; const int wid=__builtin_amdgcn_readfirstlane(tid>>6);
  const long rowbase=(long)b*SEQ; const int q0=qb*QB;
  const bf16*Qw=Q+(rowbase+q0+wid*QBLK)*DM+h*D;
  const bf16*Kh=K+rowbase*DM+h*D,*Vh=V+rowbase*DM+hv*D;
  const unsigned lds0=(unsigned)(uintptr_t)shm;
  float*wsf=(float*)(shm+LDS_WS)+wid*64;
  const bf16*ksrc=Kh+(long)lane*DM+wid*8;
  const bf16*vsrc=Vh+(long)(16*(wid&3)+(lane>>2))*DM+(wid>>2)*32+(lane&3)*8;
  const unsigned kdst=lds0+LDS_K+wid*1024, vdst=lds0+LDS_V+wid*1024;
  #define DMA_K(t,slot) glds16(ksrc+(long)(t)*KVBLK*DM,(unsigned)__builtin_amdgcn_readfirstlane(kdst+(slot)))
  #define DMA_V(t,slot) glds16(vsrc+(long)(t)*KVBLK*DM,(unsigned)__builtin_amdgcn_readfirstlane(vdst+(slot)))
  const int vb0=(int)(lds0+LDS_V)+((lane>>4)&1)*32+(lane&3)*8+(4*hi+((lane&15)>>2))*64;
  const char*Kbase=shm+LDS_K; bf16x8 kf[8];
  const lds_cptr shm3=(lds_cptr)shm; const lds_cptr kp0=shm3+LDS_K+hi*1024+r32*16; const lds_cptr vp0=shm3+LDS_V+((lane>>4)&1)*32+(lane&3)*8+(4*hi+((lane&15)>>2))*64;
  const int NT=(q0+QB)/KVBLK;
  DMA_K(0,0);DMA_V(0,0);DMA_K(1,SLOTB);
  bf16x8 qr[4];
  #pragma unroll
  for(int d0=0;d0<4;++d0)qr[d0]=*reinterpret_cast<const bf16x8*>(&Qw[(long)r32*DM+d0*16+hi*8]);
  float zz_=0.f; asm volatile("":"+v"(zz_));
  float mhat=0.f,l_reg=0.f;f32x16 o[2];
  #pragma unroll
  for(int r=0;r<16;++r){o[0][r]=zz_;o[1][r]=zz_;}
  f32x16 negm;
  #pragma unroll
  for(int r=0;r<16;++r)negm[r]=zz_;
  asm volatile("":"+v"(negm));
  const int qrel=wid*QBLK+r32;
  #define CMASK(P0,P1,t) do{int jb_=(t)-(NT-4); if(jb_>=0)cmask(P0,P1,jb_,qrel,hi);}while(0)
  bool resc=false;
  #define START(P0,P1) do{ const float rm=rowmax(P0,P1); resc=false; \
    { const float dl=rm; mhat=fadd_s(mhat,dl); \
      _Pragma("unroll") for(int r=0;r<16;++r){P0[r]=fsub_s(P0[r],dl);P1[r]=fsub_s(P1[r],dl);} \
      _Pragma("unroll") for(int r=0;r<16;++r)negm[r]=-mhat; asm volatile("":"+v"(negm)); } \
    _Pragma("unroll") for(int r=0;r<16;++r)P0[r]=__builtin_amdgcn_exp2f(P0[r]); }while(0)
  #define RESC() do{ if(resc){ asm volatile("s_waitcnt lgkmcnt(0)":::"memory"); \
      _Pragma("unroll") for(int d_=0;d_<2;++d_) _Pragma("unroll") for(int r=0;r<16;++r)o[d_][r]*=wsf[crow(r,hi)]; } }while(0)
  f32x16 pA0,pA1,pB0,pB1;
  int sl_prev=0,sl_cur=0,sl_next=SLOTB;
  #define ROT() do{sl_prev=sl_cur;sl_cur=sl_next;sl_next=(sl_next==(NSLOT-1)*SLOTB)?0:sl_next+SLOTB;}while(0)
  DMA_K(2,2*SLOTB);
  WAIT_BAR(3);
  qkt(pA0,pA1,Kbase,qr,negm,r32,hi);asm volatile("s_nop 15\n\ts_nop 7":"+v"(pA0),"+v"(pA1));CMASK(pA0,pA1,0);
  START(pA0,pA1);
  _Pragma("unroll") for(int r=0;r<16;++r)pA1[r]=__builtin_amdgcn_exp2f(pA1[r]);
  WAIT_BAR(0);
  DMA_K(3,0);DMA_V(1,SLOTB);
  ROT();
  kload8(kf,kp0+sl_cur);
  WAIT_BAR(2);
  s16x4 vlo[8],vhi[8]; u32x4 pw0,pw1,pw2,pw3;
  #define PKW(P,B) cvtpk_s(P[B],P[B+1])
  #define PAF(k) __builtin_bit_cast(bf16x8,pw##k)
  #define VFR(i) (bf16x8){vlo[i][0],vlo[i][1],vlo[i][2],vlo[i][3],vhi[i][0],vhi[i][1],vhi[i][2],vhi[i][3]}
  #define PIN(x) asm volatile("":"+v"(x))
  #define MX3(a,b,c) __builtin_fmaxf(__builtin_fmaxf((a),(b)),(c))
  #define GAPA(MF,A0,A1,A2,A3,W0,W1,PW) do{ MF; sacc+=A0; sacc+=A1; sacc+=A2; sacc+=A3; PIN(sacc); W0; W1; PIN(PW); SBAR(); }while(0)
  #define EX(v) __builtin_amdgcn_exp2f(v)
  #define GAPB(MF,X,B) do{ MF; X[B]=EX(X[B]); X[B+1]=EX(X[B+1]); X[B+2]=EX(X[B+2]); X[B+3]=EX(X[B+3]); PIN(X); SBAR(); }while(0)
  #define VRD(i) do{ vlo[i]=vtr(vp_+(((i)>>2)*4096+((i)&3)*1024)); vhi[i]=vtr(vp_+(((i)>>2)*4096+((i)&3)*1024+512)); }while(0)
  #define KRD(G,j) do{ if(G){ kload2(kf,kp0+sl_next,j); SBAR(); } }while(0)
  #define STEP(C0,C1,P0,P1,t,GK,GV,GL) do{ SBAR(); \
    const lds_cptr vp_=vp0+sl_prev; \
    VRD(0); SBAR(); float sacc=(P0[0]+P0[1]); \
    GAPA(C0=__builtin_amdgcn_mfma_f32_32x32x16_bf16(kf[0],qr[0],negm,0,0,0), P0[2],P0[3],P0[4],P0[5],     pw0[0]=PKW(P0,0), pw0[1]=PKW(P0,2), pw0); \
    VRD(4); SBAR(); GAPA(C1=__builtin_amdgcn_mfma_f32_32x32x16_bf16(kf[1],qr[0],negm,0,0,0), P0[6],P0[7],P0[8],P0[9],     pw0[2]=PKW(P0,4), pw0[3]=PKW(P0,6), pw0); \
    VRD(1); SBAR(); GAPA(C0=__builtin_amdgcn_mfma_f32_32x32x16_bf16(kf[2],qr[1],C0,0,0,0),   P0[10],P0[11],P0[12],P0[13], pw1[0]=PKW(P0,8), pw1[1]=PKW(P0,10), pw1); \
    VRD(5); SBAR(); GAPA(C1=__builtin_amdgcn_mfma_f32_32x32x16_bf16(kf[3],qr[1],C1,0,0,0),   P0[14],P0[15],P1[0],P1[1],   pw1[2]=PKW(P0,12),pw1[3]=PKW(P0,14), pw1); \
    VRD(2); SBAR(); GAPA(C0=__builtin_amdgcn_mfma_f32_32x32x16_bf16(kf[4],qr[2],C0,0,0,0),   P1[2],P1[3],P1[4],P1[5],     pw2[0]=PKW(P1,0), pw2[1]=PKW(P1,2), pw2); \
    VRD(6); SBAR(); GAPA(C1=__builtin_amdgcn_mfma_f32_32x32x16_bf16(kf[5],qr[2],C1,0,0,0),   P1[6],P1[7],P1[8],P1[9],     pw2[2]=PKW(P1,4), pw2[3]=PKW(P1,6), pw2); \
    VRD(3); SBAR(); GAPA(C0=__builtin_amdgcn_mfma_f32_32x32x16_bf16(kf[6],qr[3],C0,0,0,0),   P1[10],P1[11],P1[12],P1[13], pw3[0]=PKW(P1,8), pw3[1]=PKW(P1,10), pw3); \
    VRD(7); SBAR(); GAPA(C1=__builtin_amdgcn_mfma_f32_32x32x16_bf16(kf[7],qr[3],C1,0,0,0),   P1[14],P1[15],0.f,0.f,       pw3[2]=PKW(P1,12),pw3[3]=PKW(P1,14), pw3); \
    l_reg+=sacc; \
    if(GK){DMA_K((t)+3,sl_cur);} if(GV){DMA_V((t)+1,sl_next);} \
    CMASK(C0,C1,t); \
    { float a=MX3(C0[0],C0[1],C1[0]),b=MX3(C0[2],C0[3],C1[1]); a=MX3(a,C1[2],C1[3]); \
      _Pragma("unroll") for(int r=4;r<16;r+=4){a=MX3(a,C0[r],C0[r+1]);b=MX3(b,C0[r+2],C0[r+3]);a=MX3(a,C1[r],C1[r+1]);b=MX3(b,C1[r+2],C1[r+3]);} \
      float rm=__builtin_fmaxf(a,b); { auto rr=__builtin_amdgcn_permlane32_swap(__float_as_uint(rm),__float_as_uint(rm),false,false); rm=__builtin_fmaxf(__uint_as_float(rr[0]),__uint_as_float(rr[1])); } \
      resc=false; \
      if(__builtin_expect(__any(rm>(float)THRL),0)){ const float dl=__builtin_fmaxf(rm,0.f); mhat+=dl; \
        _Pragma("unroll") for(int r=0;r<16;++r){C0[r]-=dl;C1[r]-=dl;} \
        _Pragma("unroll") for(int r=0;r<16;++r)negm[r]=-mhat; asm volatile("":"+v"(negm)); \
        const float f=__builtin_amdgcn_exp2f(-dl); l_reg*=f; if(hi==0)wsf[r32]=f; resc=true; } } \
    SBAR(); \
    GAPB(o[0]=__builtin_amdgcn_mfma_f32_32x32x16_bf16(PAF(0),VFR(0),o[0],0,0,0), C0,0); \
    GAPB(o[1]=__builtin_amdgcn_mfma_f32_32x32x16_bf16(PAF(0),VFR(4),o[1],0,0,0), C0,4); \
    KRD(GL,0); GAPB(o[0]=__builtin_amdgcn_mfma_f32_32x32x16_bf16(PAF(1),VFR(1),o[0],0,0,0), C0,8); \
    KRD(GL,1); GAPB(o[1]=__builtin_amdgcn_mfma_f32_32x32x16_bf16(PAF(1),VFR(5),o[1],0,0,0), C0,12); \
    KRD(GL,2); GAPB(o[0]=__builtin_amdgcn_mfma_f32_32x32x16_bf16(PAF(2),VFR(2),o[0],0,0,0), C1,0); \
    KRD(GL,3); GAPB(o[1]=__builtin_amdgcn_mfma_f32_32x32x16_bf16(PAF(2),VFR(6),o[1],0,0,0), C1,4); \
    GAPB(o[0]=__builtin_amdgcn_mfma_f32_32x32x16_bf16(PAF(3),VFR(3),o[0],0,0,0), C1,8); \
    GAPB(o[1]=__builtin_amdgcn_mfma_f32_32x32x16_bf16(PAF(3),VFR(7),o[1],0,0,0), C1,12); \
    }while(0)
  int t=1;
  #undef CMASK
  #define CMASK(P0,P1,t) do{}while(0)
  for(;t+5<NT;t+=2){
    STEP(pB0,pB1,pA0,pA1,t,true,true,true);     WAIT_BAR(2); RESC(); ROT();
    STEP(pA0,pA1,pB0,pB1,t+1,true,true,true);   WAIT_BAR(2); RESC(); ROT();
  }
  #undef CMASK
  #define CMASK(P0,P1,t) do{int jb_=(t)-(NT-4); if(jb_>=0)cmask(P0,P1,jb_,qrel,hi);}while(0)
  #define ENDW(tt) do{ if((tt)+3<NT){WAIT_BAR(2);} else if((tt)+2<NT){WAIT_BAR(1);} else {WAIT_BAR(0);} }while(0)
  for(;t+1<NT;t+=2){
    STEP(pB0,pB1,pA0,pA1,t,(t+3<NT),(t+1<NT),(t+1<NT));       ENDW(t);   RESC(); ROT();
    STEP(pA0,pA1,pB0,pB1,t+1,(t+4<NT),(t+2<NT),(t+2<NT));     ENDW(t+1); RESC(); ROT();
  }
  STEP(pB0,pB1,pA0,pA1,NT-1,false,false,false); RESC();
  { float sacc=pB0[0]+pB0[1]; _Pragma("unroll") for(int r=2;r<16;++r)sacc+=pB0[r]; _Pragma("unroll") for(int r=0;r<16;++r)sacc+=pB1[r]; l_reg+=sacc;
    pw0=(u32x4){PKW(pB0,0),PKW(pB0,2),PKW(pB0,4),PKW(pB0,6)};pw1=(u32x4){PKW(pB0,8),PKW(pB0,10),PKW(pB0,12),PKW(pB0,14)};pw2=(u32x4){PKW(pB1,0),PKW(pB1,2),PKW(pB1,4),PKW(pB1,6)};pw3=(u32x4){PKW(pB1,8),PKW(pB1,10),PKW(pB1,12),PKW(pB1,14)};
    SBAR(); pv(o,vb0+sl_cur,PAF(0),PAF(1),PAF(2),PAF(3)); }
  #undef PKW
  #undef PAF
  #undef VFR
  #undef PIN
  #undef MX3
  #undef GAPA
  #undef GAPB
  #undef EX
  #undef VRD
  #undef KRD
  #undef STEP
  #undef ENDW
  {auto rr=__builtin_amdgcn_permlane32_swap(__float_as_uint(l_reg),__float_as_uint(l_reg),false,false);l_reg=__uint_as_float(rr[0])+__uint_as_float(rr[1]);}
  if(hi==0)wsf[32+r32]=l_reg;asm volatile("s_waitcnt lgkmcnt(0)":::"memory");
  float rli[16];
  #pragma unroll
  for(int r=0;r<16;++r)rli[r]=__builtin_amdgcn_rcpf(wsf[32+crow(r,hi)]);
  bf16*Ow=O+(rowbase+q0+wid*QBLK)*DM+hv*D;
  { bf16*stg=(bf16*)(shm+LDS_OST)+wid*2048;
    #pragma unroll
    for(int r=0;r<16;++r){const int orow=crow(r,hi);
      #pragma unroll
      for(int d0=0;d0<2;++d0)stg[orow*64+d0*32+r32]=__float2bfloat16(o[d0][r]*rli[r]);}
    asm volatile("s_waitcnt lgkmcnt(0)":::"memory");
    #pragma unroll
    for(int i=0;i<4;++i){const int row=i*8+(lane>>3),ch=lane&7; const u32x4 v=*(const u32x4*)(stg+row*64+ch*8); ATTN_STORE16(Ow+(long)row*DM+ch*8,v);} }
  asm volatile("s_waitcnt lgkmcnt(0)\n\ts_barrier":::"memory");
  #undef DMA_K
  #undef DMA_V
  #undef CMASK
  #undef START
  #undef RESC
  #undef ROT
}
constexpr int LDSW_K=0, LDSW_V=NSLOT*SLOTB, LDSW_WS=LDSW_V+NSLOT*2*SLOTB, LDSW_OST=LDSW_WS+NW*64*4, LDSW_BYTES=LDSW_OST+NW*4096;
struct Combine { bool on; const bf16* O0; bf16* oc; const float* g; float lam, eps, post; };
template<int THRL> __device__ __forceinline__ void attn_unit_w(int b,int h,int hh,int qb,const bf16*Q,const bf16*__restrict__ K,const bf16*__restrict__ V,bf16*O,char*shm,const Combine CB){
  int tid_=threadIdx.x; asm volatile("":"+v"(tid_));
  const int tid=tid_,lane=tid&63,r32=lane&31,hi=lane>>5; const int wid=__builtin_amdgcn_readfirstlane(tid>>6);
  const long rowbase=(long)b*SEQ; const int q0=qb*QB;
  const bf16*Qw=Q+(rowbase+q0+wid*QBLK)*DM+h*D;
  const bf16*Kh=K+rowbase*DM+h*D,*Vh=V+rowbase*DM+hh*128;
  const unsigned lds0=(unsigned)(uintptr_t)shm;
  float*wsf=(float*)(shm+LDSW_WS)+wid*64;
  const bf16*ksrc=Kh+(long)lane*DM+wid*8;
  const bf16*vsrc=Vh+(long)(16*(wid&3)+(lane>>2))*DM+(wid>>2)*32+(lane&3)*8;
  const unsigned kdst=lds0+LDSW_K+wid*1024, vdst=lds0+LDSW_V+wid*1024;
  #define DMA_K(t,slot) glds16(ksrc+(long)(t)*KVBLK*DM,(unsigned)__builtin_amdgcn_readfirstlane(kdst+(slot)))
  #define DMA_V(t,slot) do{ glds16(vsrc+(long)(t)*KVBLK*DM,(unsigned)__builtin_amdgcn_readfirstlane(vdst+2*(slot))); glds16(vsrc+(long)(t)*KVBLK*DM+64,(unsigned)__builtin_amdgcn_readfirstlane(vdst+2*(slot)+8192)); }while(0)
  const int vb0=(int)(lds0+LDSW_V)+((lane>>4)&1)*32+(lane&3)*8+(4*hi+((lane&15)>>2))*64;
  const char*Kbase=shm+LDSW_K; bf16x8 kf[8];
  const lds_cptr shm3=(lds_cptr)shm; const lds_cptr kp0=shm3+LDSW_K+hi*1024+r32*16; const lds_cptr vp0=shm3+LDSW_V+((lane>>4)&1)*32+(lane&3)*8+(4*hi+((lane&15)>>2))*64;
  const int NT=(q0+QB)/KVBLK;
  DMA_K(0,0);DMA_V(0,0);DMA_K(1,SLOTB);
  bf16x8 qr[4];
  #pragma unroll
  for(int d0=0;d0<4;++d0)qr[d0]=*reinterpret_cast<const bf16x8*>(&Qw[(long)r32*DM+d0*16+hi*8]);
  float zz_=0.f; asm volatile("":"+v"(zz_));
  float mhat=0.f,l_reg=0.f;f32x16 o[4];
  #pragma unroll
  for(int r=0;r<16;++r){o[0][r]=zz_;o[1][r]=zz_;o[2][r]=zz_;o[3][r]=zz_;}
  const f32x16 zero16={};
  const int qrel=wid*QBLK+r32;
  #define CMASK(P0,P1,t) do{int jb_=(t)-(NT-4); if(jb_>=0)cmask(P0,P1,jb_,qrel,hi);}while(0)
  bool resc=false;
  #define START(P0,P1) do{ const float rm=rowmax(P0,P1); resc=false; \
    { const float dl=(__builtin_fabsf(rm)>(float)THRL)?rm:0.f; mhat=fadd_s(mhat,dl);     \
      _Pragma("unroll") for(int r=0;r<16;++r){P0[r]=fsub_s(P0[r],dl);P1[r]=fsub_s(P1[r],dl);} } \
    _Pragma("unroll") for(int r=0;r<16;++r)P0[r]=__builtin_amdgcn_exp2f(P0[r]); }while(0)
  #define RESC() do{ if(resc){ asm volatile("s_waitcnt lgkmcnt(0)":::"memory"); \
      _Pragma("unroll") for(int d_=0;d_<4;++d_) _Pragma("unroll") for(int r=0;r<16;++r)o[d_][r]*=wsf[crow(r,hi)]; } }while(0)
  f32x16 pA0,pA1,pB0,pB1;
  int sl_prev=0,sl_cur=0,sl_next=SLOTB;
  #define ROT() do{sl_prev=sl_cur;sl_cur=sl_next;sl_next=(sl_next==(NSLOT-1)*SLOTB)?0:sl_next+SLOTB;}while(0)
  DMA_K(2,2*SLOTB);
  WAIT_BAR(4);
  qkt(pA0,pA1,Kbase,qr,zero16,r32,hi);asm volatile("s_nop 15\n\ts_nop 7":"+v"(pA0),"+v"(pA1));CMASK(pA0,pA1,0);
  START(pA0,pA1);
  _Pragma("unroll") for(int r=0;r<16;++r)pA1[r]=__builtin_amdgcn_exp2f(pA1[r]);
  WAIT_BAR(0);
  DMA_K(3,0);DMA_V(1,SLOTB);
  ROT();
  kload8(kf,kp0+sl_cur);
  WAIT_BAR(3);
  s16x4 vlo[4],vhi[4]; u32x4 pw0,pw1,pw2,pw3;
  #define GAPB2(MF,X,B) do{ MF; X[B]=EX(X[B]); X[B+1]=EX(X[B+1]); PIN(X); SBAR(); }while(0)
  #define PKW(P,B) cvtpk_s(P[B],P[B+1])
  #define PAF(k) __builtin_bit_cast(bf16x8,pw##k)
  #define VFR(i) (bf16x8){vlo[i][0],vlo[i][1],vlo[i][2],vlo[i][3],vhi[i][0],vhi[i][1],vhi[i][2],vhi[i][3]}
  #define PIN(x) asm volatile("":"+v"(x))
  #define MX3(a,b,c) __builtin_fmaxf(__builtin_fmaxf((a),(b)),(c))
  #define GAPA(MF,A0,A1,A2,A3,W0,W1,PW) do{ MF; sacc+=A0; sacc+=A1; sacc+=A2; sacc+=A3; PIN(sacc); W0; W1; PIN(PW); SBAR(); }while(0)
  #define EX(v) __builtin_amdgcn_exp2f(v)
  #define GAPB(MF,X,B) do{ MF; X[B]=EX(X[B]); X[B+1]=EX(X[B+1]); X[B+2]=EX(X[B+2]); X[B+3]=EX(X[B+3]); PIN(X); SBAR(); }while(0)
  #define VLD(sl,hf,i) do{ vlo[sl]=vtr(vp_+((hf)*8192+((i)>>2)*4096+((i)&3)*1024)); vhi[sl]=vtr(vp_+((hf)*8192+((i)>>2)*4096+((i)&3)*1024+512)); }while(0)
  #define KRD(G,j) do{ if(G){ kload2(kf,kp0+sl_next,j); SBAR(); } }while(0)
  #define STEP(C0,C1,P0,P1,t,GK,GV,GL) do{ SBAR(); \
    const lds_cptr vp_=vp0+2*sl_prev; \
    float sacc=(P0[0]+P0[1]); \
    GAPA(C0=__builtin_amdgcn_mfma_f32_32x32x16_bf16(kf[0],qr[0],zero16,0,0,0), P0[2],P0[3],P0[4],P0[5],     pw0[0]=PKW(P0,0), pw0[1]=PKW(P0,2), pw0); \
    GAPA(C1=__builtin_amdgcn_mfma_f32_32x32x16_bf16(kf[1],qr[0],zero16,0,0,0), P0[6],P0[7],P0[8],P0[9],     pw0[2]=PKW(P0,4), pw0[3]=PKW(P0,6), pw0); \
    GAPA(C0=__builtin_amdgcn_mfma_f32_32x32x16_bf16(kf[2],qr[1],C0,0,0,0),   P0[10],P0[11],P0[12],P0[13], pw1[0]=PKW(P0,8), pw1[1]=PKW(P0,10), pw1); \
    GAPA(C1=__builtin_amdgcn_mfma_f32_32x32x16_bf16(kf[3],qr[1],C1,0,0,0),   P0[14],P0[15],P1[0],P1[1],   pw1[2]=PKW(P0,12),pw1[3]=PKW(P0,14), pw1); \
    VLD(0,0,0); SBAR(); GAPA(C0=__builtin_amdgcn_mfma_f32_32x32x16_bf16(kf[4],qr[2],C0,0,0,0),   P1[2],P1[3],P1[4],P1[5],     pw2[0]=PKW(P1,0), pw2[1]=PKW(P1,2), pw2); \
    VLD(1,0,4); SBAR(); GAPA(C1=__builtin_amdgcn_mfma_f32_32x32x16_bf16(kf[5],qr[2],C1,0,0,0),   P1[6],P1[7],P1[8],P1[9],     pw2[2]=PKW(P1,4), pw2[3]=PKW(P1,6), pw2); \
    VLD(2,0,1); SBAR(); GAPA(C0=__builtin_amdgcn_mfma_f32_32x32x16_bf16(kf[6],qr[3],C0,0,0,0),   P1[10],P1[11],P1[12],P1[13], pw3[0]=PKW(P1,8), pw3[1]=PKW(P1,10), pw3); \
    VLD(3,0,5); SBAR(); GAPA(C1=__builtin_amdgcn_mfma_f32_32x32x16_bf16(kf[7],qr[3],C1,0,0,0),   P1[14],P1[15],0.f,0.f,       pw3[2]=PKW(P1,12),pw3[3]=PKW(P1,14), pw3); \
    l_reg+=sacc; \
    if(__any(mhat!=0.f)){ _Pragma("unroll") for(int r=0;r<16;++r){C0[r]-=mhat;C1[r]-=mhat;} } \
    if(GK){DMA_K((t)+3,sl_cur);} if(GV){DMA_V((t)+1,sl_next);} \
    CMASK(C0,C1,t); \
    { float a=MX3(C0[0],C0[1],C1[0]),b=MX3(C0[2],C0[3],C1[1]); a=MX3(a,C1[2],C1[3]); \
      _Pragma("unroll") for(int r=4;r<16;r+=4){a=MX3(a,C0[r],C0[r+1]);b=MX3(b,C0[r+2],C0[r+3]);a=MX3(a,C1[r],C1[r+1]);b=MX3(b,C1[r+2],C1[r+3]);} \
      float rm=__builtin_fmaxf(a,b); { auto rr=__builtin_amdgcn_permlane32_swap(__float_as_uint(rm),__float_as_uint(rm),false,false); rm=__builtin_fmaxf(__uint_as_float(rr[0]),__uint_as_float(rr[1])); } \
      resc=false; \
      if(__builtin_expect(__any(rm>(float)THRL),0)){ const float dl=__builtin_fmaxf(rm,0.f); mhat+=dl; \
        _Pragma("unroll") for(int r=0;r<16;++r){C0[r]-=dl;C1[r]-=dl;} \
        const float f=__builtin_amdgcn_exp2f(-dl); l_reg*=f; if(hi==0)wsf[r32]=f; resc=true; } } \
    SBAR(); \
    GAPB2(o[0]=__builtin_amdgcn_mfma_f32_32x32x16_bf16(PAF(0),VFR(0),o[0],0,0,0), C0,0); VLD(0,0,2); SBAR(); \
    GAPB2(o[1]=__builtin_amdgcn_mfma_f32_32x32x16_bf16(PAF(0),VFR(1),o[1],0,0,0), C0,2); VLD(1,0,6); SBAR(); \
    GAPB2(o[0]=__builtin_amdgcn_mfma_f32_32x32x16_bf16(PAF(1),VFR(2),o[0],0,0,0), C0,4); VLD(2,0,3); SBAR(); \
    GAPB2(o[1]=__builtin_amdgcn_mfma_f32_32x32x16_bf16(PAF(1),VFR(3),o[1],0,0,0), C0,6); VLD(3,0,7); SBAR(); \
    GAPB2(o[0]=__builtin_amdgcn_mfma_f32_32x32x16_bf16(PAF(2),VFR(0),o[0],0,0,0), C0,8); VLD(0,1,0); SBAR(); \
    GAPB2(o[1]=__builtin_amdgcn_mfma_f32_32x32x16_bf16(PAF(2),VFR(1),o[1],0,0,0), C0,10); VLD(1,1,4); SBAR(); \
    GAPB2(o[0]=__builtin_amdgcn_mfma_f32_32x32x16_bf16(PAF(3),VFR(2),o[0],0,0,0), C0,12); VLD(2,1,1); SBAR(); \
    GAPB2(o[1]=__builtin_amdgcn_mfma_f32_32x32x16_bf16(PAF(3),VFR(3),o[1],0,0,0), C0,14); VLD(3,1,5); SBAR(); \
    GAPB2(o[2]=__builtin_amdgcn_mfma_f32_32x32x16_bf16(PAF(0),VFR(0),o[2],0,0,0), C1,0); VLD(0,1,2); SBAR(); \
    GAPB2(o[3]=__builtin_amdgcn_mfma_f32_32x32x16_bf16(PAF(0),VFR(1),o[3],0,0,0), C1,2); VLD(1,1,6); SBAR(); \
    KRD(GL,0); GAPB2(o[2]=__builtin_amdgcn_mfma_f32_32x32x16_bf16(PAF(1),VFR(2),o[2],0,0,0), C1,4); VLD(2,1,3); SBAR(); \
    KRD(GL,1); GAPB2(o[3]=__builtin_amdgcn_mfma_f32_32x32x16_bf16(PAF(1),VFR(3),o[3],0,0,0), C1,6); VLD(3,1,7); SBAR(); \
    KRD(GL,2); GAPB2(o[2]=__builtin_amdgcn_mfma_f32_32x32x16_bf16(PAF(2),VFR(0),o[2],0,0,0), C1,8); \
    KRD(GL,3); GAPB2(o[3]=__builtin_amdgcn_mfma_f32_32x32x16_bf16(PAF(2),VFR(1),o[3],0,0,0), C1,10); \
    GAPB2(o[2]=__builtin_amdgcn_mfma_f32_32x32x16_bf16(PAF(3),VFR(2),o[2],0,0,0), C1,12); \
    GAPB2(o[3]=__builtin_amdgcn_mfma_f32_32x32x16_bf16(PAF(3),VFR(3),o[3],0,0,0), C1,14); \
    }while(0)
  int t=1;
  #undef CMASK
  #define CMASK(P0,P1,t) do{}while(0)
  for(;t+5<NT;t+=2){
    STEP(pB0,pB1,pA0,pA1,t,true,true,true);     WAIT_BAR(3); RESC(); ROT();
    STEP(pA0,pA1,pB0,pB1,t+1,true,true,true);   WAIT_BAR(3); RESC(); ROT();
  }
  #undef CMASK
  #define CMASK(P0,P1,t) do{int jb_=(t)-(NT-4); if(jb_>=0)cmask(P0,P1,jb_,qrel,hi);}while(0)
  #define ENDW(tt) do{ if((tt)+3<NT){WAIT_BAR(3);} else if((tt)+2<NT){WAIT_BAR(2);} else {WAIT_BAR(0);} }while(0)
  for(;t+1<NT;t+=2){
    STEP(pB0,pB1,pA0,pA1,t,(t+3<NT),(t+1<NT),(t+1<NT));       ENDW(t);   RESC(); ROT();
    STEP(pA0,pA1,pB0,pB1,t+1,(t+4<NT),(t+2<NT),(t+2<NT));     ENDW(t+1); RESC(); ROT();
  }
  STEP(pB0,pB1,pA0,pA1,NT-1,false,false,false); RESC();
  { float sacc=pB0[0]+pB0[1]; _Pragma("unroll") for(int r=2;r<16;++r)sacc+=pB0[r]; _Pragma("unroll") for(int r=0;r<16;++r)sacc+=pB1[r]; l_reg+=sacc;
    pw0=(u32x4){PKW(pB0,0),PKW(pB0,2),PKW(pB0,4),PKW(pB0,6)};pw1=(u32x4){PKW(pB0,8),PKW(pB0,10),PKW(pB0,12),PKW(pB0,14)};pw2=(u32x4){PKW(pB1,0),PKW(pB1,2),PKW(pB1,4),PKW(pB1,6)};pw3=(u32x4){PKW(pB1,8),PKW(pB1,10),PKW(pB1,12),PKW(pB1,14)};
    SBAR(); pv(o,vb0+2*sl_cur,PAF(0),PAF(1),PAF(2),PAF(3)); pv(o+2,vb0+2*sl_cur+8192,PAF(0),PAF(1),PAF(2),PAF(3)); }
  #undef PKW
  #undef PAF
  #undef VFR
  #undef PIN
  #undef MX3
  #undef GAPA
  #undef GAPB
  #undef GAPB2
  #undef EX
  #undef VLD
  #undef KRD
  #undef STEP
  #undef ENDW
  {auto rr=__builtin_amdgcn_permlane32_swap(__float_as_uint(l_reg),__float_as_uint(l_reg),false,false);l_reg=__uint_as_float(rr[0])+__uint_as_float(rr[1]);}
  if(hi==0)wsf[32+r32]=l_reg;asm volatile("s_waitcnt lgkmcnt(0)":::"memory");
  float rli[16];
  #pragma unroll
  for(int r=0;r<16;++r)rli[r]=__builtin_amdgcn_rcpf(wsf[32+crow(r,hi)]);
  bf16*Ow=O+(rowbase+q0+wid*QBLK)*DM+hh*128;
  bf16*stg=(bf16*)(shm+LDSW_OST)+wid*2048;
  if(!CB.on){
    #pragma unroll
    for(int hf=0;hf<2;++hf){
      #pragma unroll
      for(int r=0;r<16;++r){const int orow=crow(r,hi);
        #pragma unroll
        for(int d0=0;d0<2;++d0)stg[orow*64+d0*32+r32]=__float2bfloat16(o[2*hf+d0][r]*rli[r]);}
      asm volatile("s_waitcnt lgkmcnt(0)":::"memory");
      #pragma unroll
      for(int i=0;i<4;++i){const int row=i*8+(lane>>3),ch=lane&7; const u32x4 v=*(const u32x4*)(stg+row*64+ch*8); ATTN_STORE16(Ow+(long)row*DM+hf*64+ch*8,v);}
      asm volatile("s_waitcnt lgkmcnt(0)":::"memory"); }
  } else {
    const bf16*O0w=CB.O0+(rowbase+q0+wid*QBLK)*DM+hh*128; bf16*Cw=CB.oc+(rowbase+q0+wid*QBLK)*DM+hh*128;
    float av[2][4][8]; float ss[4]={0.f,0.f,0.f,0.f};
    #pragma unroll
    for(int hf=0;hf<2;++hf){
      #pragma unroll
      for(int r=0;r<16;++r){const int orow=crow(r,hi);
        #pragma unroll
        for(int d0=0;d0<2;++d0)stg[orow*64+d0*32+r32]=__float2bfloat16(o[2*hf+d0][r]*rli[r]);}
      asm volatile("s_waitcnt lgkmcnt(0)":::"memory");
      #pragma unroll
      for(int i=0;i<4;++i){const int row=i*8+(lane>>3),ch=lane&7; const u32x4 v1=*(const u32x4*)(stg+row*64+ch*8); const u32x4 v0=*(const u32x4*)(O0w+(long)row*DM+hf*64+ch*8);
        #pragma unroll
        for(int x=0;x<4;++x){ const float a0=__uint_as_float(v0[x]<<16)-CB.lam*__uint_as_float(v1[x]<<16), a1=__uint_as_float(v0[x]&0xffff0000u)-CB.lam*__uint_as_float(v1[x]&0xffff0000u);
          av[hf][i][2*x]=a0; av[hf][i][2*x+1]=a1; ss[i]+=a0*a0+a1*a1; } }
      asm volatile("s_waitcnt lgkmcnt(0)":::"memory"); }
    #pragma unroll
    for(int i=0;i<4;++i){ float t=ss[i];
      t+=__builtin_bit_cast(float,__builtin_amdgcn_update_dpp(0,__builtin_bit_cast(int,t),0xB1,0xf,0xf,false)); t+=__builtin_bit_cast(float,__builtin_amdgcn_update_dpp(0,__builtin_bit_cast(int,t),0x4E,0xf,0xf,false));
      t+=__builtin_bit_cast(float,__builtin_amdgcn_update_dpp(0,__builtin_bit_cast(int,t),0x141,0xf,0xf,false));
      const float rn=__builtin_amdgcn_rsqf(t*(1.f/128.f)+CB.eps)*CB.post; const int row=i*8+(lane>>3),ch=lane&7;
      #pragma unroll
      for(int hf=0;hf<2;++hf){ const float*gp=CB.g+hf*64+ch*8; u32x4 w;
        #pragma unroll
        for(int x=0;x<4;++x)w[x]=cvtpk_s(av[hf][i][2*x]*rn*gp[2*x],av[hf][i][2*x+1]*rn*gp[2*x+1]);
        ATTN_STORE16(Cw+(long)row*DM+hf*64+ch*8,w); } }
  }
  asm volatile("s_waitcnt lgkmcnt(0)\n\ts_barrier":::"memory");
  #undef DMA_K
  #undef DMA_V
  #undef CMASK
  #undef START
  #undef RESC
  #undef ROT
}
constexpr int ATTN_LDS_BYTES=LDS_BYTES;
struct AttnTensors { const bf16* Q; const bf16* K; const bf16* V; bf16* O0; Combine cb; };
template<int THRL=8,class Gap> __device__ __forceinline__ void attn_phase(char*lds,const AttnTensors&T,int vcu,int G,Gap gap){
  const int nbig=(512-vcu+G-1)/G; int i=0;
  if(__builtin_amdgcn_readfirstlane((int)threadIdx.x)>=256) __builtin_amdgcn_s_setprio(1);
  for(int L=vcu;L<512;L+=G){ const int rnd=L>>8,v=L&255,r=v&7,qb=rnd?r:(NQB-1-r); const int b=v>>5,h=rnd*4+((v&31)>>3);
    #pragma unroll 1
    for(int c=0;c<2;++c){ Combine cb=T.cb; cb.on=(c==1); attn_unit_w<THRL>(b,2*h+c,h,qb,T.Q,T.K,T.V,T.O0,lds,cb); gap(i,2*nbig); ++i; } }
}
#undef SBAR
#undef WAIT_BAR
}
#ifndef PROBE_DUP
#define PROBE_DUP (-1)
#endif
constexpr int NWAVES = 8;
constexpr int NPHASE = 11;
constexpr int RING_OFF = 0, RING_BYTES = 131072;
constexpr int LDSCTL_OFF = RING_BYTES, MISC_OFF = LDSCTL_OFF + 320;
constexpr int L_PTRS = LDSCTL_OFF;
constexpr int L_TSTART = 131584;
constexpr int L_CNT = 131744;
constexpr int L_TILEE = 131872;
constexpr int L_GTAB = 133120, MAXU = 12;
constexpr int L_ULIST = L_GTAB + MAXU * 1024;
constexpr int LDS_BYTES = 147456;
static_assert(MISC_OFF + 128 <= L_TSTART && L_TILEE + MT_MAX * 4 <= L_GTAB && L_ULIST + 16 + 16 * MAXU <= LDS_BYTES, "LDS map");

#define GAS __attribute__((address_space(1)))
#define LAS __attribute__((address_space(3)))
typedef unsigned short bf16;
typedef unsigned v4u __attribute__((ext_vector_type(4)));
typedef unsigned v2u __attribute__((ext_vector_type(2)));
typedef float f32x4 __attribute__((ext_vector_type(4)));
typedef GAS unsigned gu32;
#define RLX_AGENT __ATOMIC_RELAXED, __HIP_MEMORY_SCOPE_AGENT
#define LDS_WAIT() asm volatile("s_waitcnt lgkmcnt(0)" ::: "memory")
#define VM_WAIT() asm volatile("s_waitcnt vmcnt(0)" ::: "memory")
__device__ __forceinline__ unsigned pk2(float lo, float hi) { return pg8::cvt_pk_bf16(lo, hi); }
__device__ __forceinline__ float bflo(unsigned w) { return __uint_as_float(w << 16); }
__device__ __forceinline__ float bfhi(unsigned w) { return __uint_as_float(w & 0xffff0000u); }

#define XB_TMO      128
#define XB_XCNT(j)  (256  + 64 * (j))
#define XB_XSUB(j)  (1280 + 64 * (j))
#define XB_XGEN(j)  (2304 + 64 * (j))
#define XB_TOP      3328
#define XB_TOPGEN   3392
#define XCD_BAR_WORDS 3456
#define XB_LSUB(j)  (-1024 + 64 * (j))
#define XB_LGEN(j)  (-512 + 64 * (j))
#define XB_SPIN_CAP (1u << 18)
__device__ __forceinline__ unsigned xb_ld(unsigned* p)              { return __hip_atomic_load(p, __ATOMIC_RELAXED, __HIP_MEMORY_SCOPE_AGENT); }
__device__ __forceinline__ unsigned xb_add(unsigned* p, unsigned v) { return __hip_atomic_fetch_add(p, v, __ATOMIC_RELAXED, __HIP_MEMORY_SCOPE_AGENT); }
__device__ __forceinline__ unsigned xb_xcc_id() { return (unsigned)__builtin_amdgcn_s_getreg((3 << 11) | 20) & 0xFu; }
#define XB_SPIN(cond, bar) do { unsigned _sp = 0; while (cond) { __builtin_amdgcn_s_sleep(1); \
    if ((++_sp & 255u) == 0u) { if (xb_ld(&(bar)[XB_TMO])) break; if (_sp > XB_SPIN_CAP) { atomicAdd(&(bar)[XB_TMO], 1u); break; } } } } while (0)
struct XcdBarrier { unsigned* bar; unsigned x; volatile LAS unsigned* st; };
__device__ __forceinline__ XcdBarrier xcd_barrier_post(unsigned* bar, volatile LAS unsigned* st) {
    XcdBarrier b; b.bar = bar; b.x = xb_xcc_id(); b.st = st;
    if (threadIdx.x == 0) st[3] = xb_add(&bar[XB_XCNT(b.x)], 1u);
    return b;
}
__device__ __forceinline__ void xcd_barrier_complete(unsigned* bar, unsigned x, unsigned& nloc, unsigned& nx, unsigned& even) {
    const unsigned G = gridDim.x * gridDim.y * gridDim.z;
    unsigned sum, cnt, mine, sp = 0u;
    for (;;) {
        sum = 0u; cnt = 0u; mine = 0u; even = (G == 256u) ? 1u : 0u;
#pragma unroll
        for (unsigned j = 0; j < 16; ++j) { const unsigned c = xb_ld(&bar[XB_XCNT(j)]); sum += c; cnt += (c > 0u) ? 1u : 0u; mine = (j == x) ? c : mine; even = (c == (j < 8u ? 32u : 0u)) ? even : 0u; }
        if (sum == G) break;
        __builtin_amdgcn_s_sleep(1);
        if ((++sp & 255u) == 0u) { if (xb_ld(&bar[XB_TMO])) break; if (sp > XB_SPIN_CAP) { atomicAdd(&bar[XB_TMO], 1u); break; } }
    }
    nloc = mine > 0u ? mine : 1u; nx = cnt > 0u ? cnt : 1u;
}
__device__ __forceinline__ void xcd_barrier(const XcdBarrier& b) {
    asm volatile("s_waitcnt vmcnt(0)" ::: "memory");
    __syncthreads();
    if (threadIdx.x == 0) {
        unsigned* bar = b.bar;
        __builtin_amdgcn_s_waitcnt(0);
        unsigned nloc = b.st[0], nx = b.st[1];
        if (nloc == 0u) { unsigned even; xcd_barrier_complete(bar, b.x, nloc, nx, even); b.st[0] = nloc; b.st[1] = nx; b.st[2] = 1u + even; }
        const unsigned old = xb_add(&bar[XB_XSUB(b.x)], 1u);
        const unsigned gen = old / nloc;
        if (old + 1u == (gen + 1u) * nloc) {
            __builtin_amdgcn_fence(__ATOMIC_RELEASE, "agent");
            asm volatile("s_waitcnt vmcnt(0)" ::: "memory");
            const unsigned og = xb_add(&bar[XB_TOP], 1u);
            const unsigned tg = og / nx;
            if (og + 1u == (tg + 1u) * nx) xb_add(&bar[XB_TOPGEN], 1u);
            else XB_SPIN(xb_ld(&bar[XB_TOPGEN]) == tg, bar);
            __builtin_amdgcn_fence(__ATOMIC_ACQUIRE, "agent");
            xb_add(&bar[XB_XGEN(b.x)], 1u);
            asm volatile("s_waitcnt vmcnt(0)" ::: "memory");
        } else {
            XB_SPIN(xb_ld(&bar[XB_XGEN(b.x)]) == gen, bar);
            __builtin_amdgcn_fence(__ATOMIC_ACQUIRE, "agent");
            asm volatile("s_waitcnt vmcnt(0)" ::: "memory");
        }
    }
    __syncthreads();
}

__device__ __forceinline__ void xcc_local_barrier(const XcdBarrier& b) {
    asm volatile("s_waitcnt vmcnt(0)" ::: "memory");
    __syncthreads();
    if (threadIdx.x == 0) {
        unsigned* bar = b.bar;
        __builtin_amdgcn_s_waitcnt(0);
        const unsigned old = xb_add(&bar[XB_LSUB((int)b.x)], 1u);
        const unsigned gen = old >> 5;
        if (old + 1u == (gen + 1u) << 5) xb_add(&bar[XB_LGEN((int)b.x)], 1u);
        else XB_SPIN(xb_ld(&bar[XB_LGEN((int)b.x)]) == gen, bar);
        __builtin_amdgcn_fence(__ATOMIC_ACQUIRE, "agent");
        asm volatile("s_waitcnt vmcnt(0)" ::: "memory");
    }
    __syncthreads();
}

struct Frame {
    LAS unsigned char* lds;
    volatile LAS unsigned* MISC;
    gu32* ctl;
    int tid, lane, wave;
    int vcu, G, vb;
    unsigned char* ws;
};
__device__ __forceinline__ const void* inp(const Frame& F, int i) {
    const LAS unsigned* p = (const LAS unsigned*)(F.lds + L_PTRS) + 2 * i;
    const unsigned lo = __builtin_amdgcn_readfirstlane(p[0]), hi = __builtin_amdgcn_readfirstlane(p[1]);
    return (const void*)(const GAS char*)(((unsigned long long)hi << 32) | lo);
}
template <int CTRL> __device__ __forceinline__ float dpp_f(float v) { return __builtin_bit_cast(float, __builtin_amdgcn_update_dpp(0, __builtin_bit_cast(int, v), CTRL, 0xf, 0xf, false)); }
#define XSUM16(v) do { const auto r_ = __builtin_amdgcn_permlane16_swap(__float_as_uint(v), __float_as_uint(v), false, false); v = __uint_as_float(r_[0]) + __uint_as_float(r_[1]); } while (0)
#define XSUM32(v) do { const auto r_ = __builtin_amdgcn_permlane32_swap(__float_as_uint(v), __float_as_uint(v), false, false); v = __uint_as_float(r_[0]) + __uint_as_float(r_[1]); } while (0)
#define XMAX16(v) do { const auto r_ = __builtin_amdgcn_permlane16_swap(__float_as_uint(v), __float_as_uint(v), false, false); v = fmaxf(__uint_as_float(r_[0]), __uint_as_float(r_[1])); } while (0)
__device__ __forceinline__ float sum8(float v) { v += dpp_f<0xB1>(v); v += dpp_f<0x4E>(v); v += dpp_f<0x141>(v); return v; }
__device__ __forceinline__ float wave_sum(float v) {
    v = sum8(v); v += dpp_f<0x140>(v);
    XSUM16(v); XSUM32(v);
    return v;
}
__device__ __forceinline__ float max32(float v) {
    v = fmaxf(v, dpp_f<0xB1>(v)); v = fmaxf(v, dpp_f<0x4E>(v)); v = fmaxf(v, dpp_f<0x141>(v)); v = fmaxf(v, dpp_f<0x140>(v));
    XMAX16(v); return v;
}

template <class RowFn>
__device__ __forceinline__ void tr_item(const float* W, int ldw, int k0, int n0, bf16* dst, int ldk, int kd0, RowFn drow, LAS bf16* scr, int lane, bool zero) {
    const int c4 = lane & 15, kr = lane >> 4;
    if (!zero) {
        f32x4 v[16];
#pragma unroll
        for (int s = 0; s < 16; ++s) v[s] = *(const GAS f32x4*)(W + (size_t)(k0 + kr + 4 * s) * ldw + n0 + 4 * c4);
#pragma unroll
        for (int s = 0; s < 16; ++s) { const int kk = kr + 4 * s; const unsigned lo = pk2(v[s][0], v[s][1]), hi = pk2(v[s][2], v[s][3]);
            scr[(4 * c4 + 0) * 66 + kk] = (bf16)(lo & 0xffff); scr[(4 * c4 + 1) * 66 + kk] = (bf16)(lo >> 16); scr[(4 * c4 + 2) * 66 + kk] = (bf16)(hi & 0xffff); scr[(4 * c4 + 3) * 66 + kk] = (bf16)(hi >> 16); }
        LDS_WAIT(); asm volatile("" ::: "memory");
    }
    const int ch = lane & 7;
#pragma unroll
    for (int j = 0; j < 8; ++j) { const int nn = (lane >> 3) + 8 * j; v4u o = {0u, 0u, 0u, 0u};
        if (!zero) { const LAS unsigned* sp = (const LAS unsigned*)(scr + nn * 66 + 8 * ch); o.x = sp[0]; o.y = sp[1]; o.z = sp[2]; o.w = sp[3]; }
        *(GAS v4u*)(dst + (size_t)drow(nn) * ldk + kd0 + 8 * ch) = o; }
    LDS_WAIT(); asm volatile("" ::: "memory");
}

template <class RowFn>
__device__ __forceinline__ void tr_item_fp8(const float* W, int ldw, int k0, int n0, unsigned char* dst, int ldk, int kd0, RowFn drow, LAS unsigned char* scr, int lane) {
    const int c4 = lane & 15, kr = lane >> 4;
    f32x4 v[4][4];
#pragma unroll
    for (int s = 0; s < 4; ++s)
#pragma unroll
        for (int j = 0; j < 4; ++j) v[s][j] = *(const GAS f32x4*)(W + (size_t)(k0 + 16 * s + 4 * kr + j) * ldw + n0 + 4 * c4);
#pragma unroll
    for (int s = 0; s < 4; ++s)
#pragma unroll
        for (int x = 0; x < 4; ++x) { int w = 0; w = __builtin_amdgcn_cvt_pk_fp8_f32(v[s][0][x] * pg8::W8_SCALE, v[s][1][x] * pg8::W8_SCALE, w, false); w = __builtin_amdgcn_cvt_pk_fp8_f32(v[s][2][x] * pg8::W8_SCALE, v[s][3][x] * pg8::W8_SCALE, w, true);
            *(LAS unsigned*)(scr + (4 * c4 + x) * 68 + 16 * s + 4 * kr) = (unsigned)w; }
    LDS_WAIT(); asm volatile("" ::: "memory");
    const int ch = lane & 3;
#pragma unroll
    for (int j = 0; j < 4; ++j) { const int nn = (lane >> 2) + 16 * j; const LAS unsigned* sp = (const LAS unsigned*)(scr + nn * 68 + 16 * ch); v4u o; o.x = sp[0]; o.y = sp[1]; o.z = sp[2]; o.w = sp[3];
        *(GAS v4u*)(dst + (size_t)drow(nn) * ldk + kd0 + 16 * ch) = o; }
    LDS_WAIT(); asm volatile("" ::: "memory");
}

struct CItem { const float* src; unsigned char* dst; int ldw, ldk, base, mode; };
__device__ __forceinline__ CItem conv_item(const float* w_exp1, const float* w_exp2, unsigned char* ws, int r) {
    constexpr int I_2 = NE * 16 * 16;
    CItem it;
    if (r >= I_2) { r -= I_2; const int e = r / 512, rr = r % 512, kb = rr / 32, nb = rr % 32, n0 = nb * 64, j2 = n0 >> 1, pn = j2 >> 7, j = j2 & 127;
        it.src = w_exp1 + (size_t)e * D * 2 * FF + (size_t)(kb * 64) * (2 * FF) + n0; it.ldw = 2 * FF; it.dst = ws + WS_W1 + (size_t)e * 2 * FF * D + kb * 64; it.ldk = D; it.base = 256 * pn + j; it.mode = 1; }
    else { const int e = r / 256, rr = r % 256, kb = rr / 16, nb = rr % 16;
        it.src = w_exp2 + (size_t)e * FF * D + (size_t)(kb * 64) * D + nb * 64; it.ldw = D; it.dst = ws + WS_W2 + (size_t)e * D * FF + kb * 64; it.ldk = FF; it.base = nb * 64; it.mode = 0; }
    return it;
}
__device__ __forceinline__ void conv_load(const CItem& it, f32x4 (&v)[4][4], int lane) {
    const int c4 = lane & 15, kr = lane >> 4;
#pragma unroll
    for (int s = 0; s < 4; ++s)
#pragma unroll
        for (int j = 0; j < 4; ++j) v[s][j] = __builtin_nontemporal_load((const GAS f32x4*)(it.src + (size_t)(16 * s + 4 * kr + j) * it.ldw + 4 * c4));
}
__device__ __forceinline__ void conv_store(const CItem& it, const f32x4 (&v)[4][4], LAS unsigned char* scr, int lane) {
    const int c4 = lane & 15, kr = lane >> 4;
#pragma unroll
    for (int s = 0; s < 4; ++s)
#pragma unroll
        for (int x = 0; x < 4; ++x) { int w = 0; w = __builtin_amdgcn_cvt_pk_fp8_f32(v[s][0][x] * pg8::W8_SCALE, v[s][1][x] * pg8::W8_SCALE, w, false); w = __builtin_amdgcn_cvt_pk_fp8_f32(v[s][2][x] * pg8::W8_SCALE, v[s][3][x] * pg8::W8_SCALE, w, true);
            *(LAS unsigned*)(scr + (4 * c4 + x) * 68 + 16 * s + 4 * kr) = (unsigned)w; }
    LDS_WAIT(); asm volatile("" ::: "memory");
    const int ch = lane & 3;
#pragma unroll
    for (int j = 0; j < 4; ++j) { const int nn = (lane >> 2) + 16 * j; const LAS unsigned* sp = (const LAS unsigned*)(scr + nn * 68 + 16 * ch); v4u o; o.x = sp[0]; o.y = sp[1]; o.z = sp[2]; o.w = sp[3];
        const int row = it.mode ? it.base + 128 * (nn & 1) + (nn >> 1) : it.base + nn;
        *(GAS v4u*)(it.dst + (size_t)row * it.ldk + 16 * ch) = o; }
    LDS_WAIT(); asm volatile("" ::: "memory");
}
__device__ __forceinline__ void conv_expert_items(Frame& F, int first, int count, int k, int n, int part, int nparts, LAS unsigned char* scr) {
    const float* const w_exp1_ = (const float*)inp(F, 21); const float* const w_exp2_ = (const float*)inp(F, 23);
    const int ipw = (count + n - 1) / n, base = k * ipw, own = (ipw - F.wave + 7) / 8;
    const int j0 = own * part / nparts, j1 = own * (part + 1) / nparts;
    int lane = F.lane; asm volatile("" : "+v"(lane));
    int jj = j0;
    for (; jj + 1 < j1; jj += 2) {
        const int r0 = base + F.wave + 8 * jj, r1 = r0 + 8; if (r1 >= count) break;
        const CItem a = conv_item(w_exp1_, w_exp2_, F.ws, first + r0), b = conv_item(w_exp1_, w_exp2_, F.ws, first + r1);
        f32x4 va[4][4], vb[4][4]; conv_load(a, va, lane); conv_load(b, vb, lane); conv_store(a, va, scr, lane); conv_store(b, vb, scr, lane);
    }
    for (; jj < j1; ++jj) {
        const int r0 = base + F.wave + 8 * jj; if (r0 >= count) break;
        const CItem a = conv_item(w_exp1_, w_exp2_, F.ws, first + r0); f32x4 va[4][4]; conv_load(a, va, lane); conv_store(a, va, scr, lane);
    }
}
__device__ __forceinline__ void conv_in_idle_round(Frame& F, int nwg, int first, int count) {
    const int r = nwg % F.G, c = F.vb;
    if (r != 0 && c < r) return;
    conv_expert_items(F, first, count, r ? c - r : c, r ? F.G - r : F.G, 0, 1, F.lds + RING_OFF + F.wave * 4352);
}
constexpr int CONV_W2_IN_P2 = 5120, CONV_W2_ALL = NE * 16 * 16, CONV_ALL = NE * 16 * 16 + NE * 16 * 32;
__device__ __forceinline__ void p0_prologue(Frame& F) {
    const float* const c_ = (const float*)inp(F, 1); const float* const w_ada_ = (const float*)inp(F, 3); const float* const b_ada_ = (const float*)inp(F, 4); float* const mod_ = (float*)(F.ws + WS_MOD); const int* const positions_ = (const int*)inp(F, 2); float* const rope_ = (float*)(F.ws + WS_ROPE); const float* const lq1_ = (const float*)inp(F, 7); const float* const lk1_ = (const float*)inp(F, 8); const float* const lq2_ = (const float*)inp(F, 9); const float* const lk2_ = (const float*)inp(F, 10); float* const lam_ = (float*)(F.ws + WS_MOD + 256 * 1024); const float* const w_exp1_ = (const float*)inp(F, 21); bf16* const W1_t_ = (bf16*)(F.ws + WS_W1); const float* const w_exp2_ = (const float*)inp(F, 23); bf16* const W2_t_ = (bf16*)(F.ws + WS_W2); const float* const w_in_ = (const float*)inp(F, 6); bf16* const Win_t_ = (bf16*)(F.ws + WS_WIN); const float* const w_proj_a_ = (const float*)inp(F, 14); bf16* const Wa_t_ = (bf16*)(F.ws + WS_WA); const float* const w_proj_b_ = (const float*)inp(F, 15); bf16* const Wb_t_ = (bf16*)(F.ws + WS_WB); const float* const w_pool_ = (const float*)inp(F, 12); const float* const pool_scale_ = (const float*)inp(F, 13); bf16* const Wpool_t_ = (bf16*)(F.ws + WS_WPOOL); const float* const w_out_ = (const float*)inp(F, 16); bf16* const Wout_t_ = (bf16*)(F.ws + WS_WOUT);
    {
        LAS float* sc = (LAS float*)(F.lds + RING_OFF);
        LAS float* red = (LAS float*)(F.lds + RING_OFF + 32768);
        bool staged = false;
        for (int it = blockIdx.x; it < 96; it += F.G) {
            if (!staged) { for (int i = F.tid; i < NB * D; i += NWAVES * 64) { const int b = i >> 10, kk = i & 1023; const float v = c_[i]; sc[kk * 8 + b] = v / (1.f + __expf(-v)); } __syncthreads(); staged = true; }
            const int j0 = it * 64, cg = F.lane & 15, kq = F.lane >> 4;
            float acc[8][4];
#pragma unroll
            for (int b = 0; b < 8; ++b)
#pragma unroll
                for (int xx = 0; xx < 4; ++xx) acc[b][xx] = 0.f;
#pragma unroll 8
            for (int s = 0; s < 32; ++s) { const int kk = 32 * s + 4 * F.wave + kq;
                const f32x4 w = *(const GAS f32x4*)(w_ada_ + (size_t)kk * (NMOD * D) + j0 + 4 * cg);
                const f32x4 s0 = *(const LAS f32x4*)(sc + kk * 8), s1 = *(const LAS f32x4*)(sc + kk * 8 + 4);
#pragma unroll
                for (int xx = 0; xx < 4; ++xx) { acc[0][xx] += s0[0] * w[xx]; acc[1][xx] += s0[1] * w[xx]; acc[2][xx] += s0[2] * w[xx]; acc[3][xx] += s0[3] * w[xx];
                    acc[4][xx] += s1[0] * w[xx]; acc[5][xx] += s1[1] * w[xx]; acc[6][xx] += s1[2] * w[xx]; acc[7][xx] += s1[3] * w[xx]; } }
#pragma unroll
            for (int b = 0; b < 8; ++b)
#pragma unroll
                for (int xx = 0; xx < 4; ++xx) { float a = acc[b][xx]; a += __shfl_xor(a, 16); a += __shfl_xor(a, 32); if (kq == 0) red[(F.wave * 8 + b) * 64 + 4 * cg + xx] = a; }
            __syncthreads();
            { const int b = F.tid >> 6, col = F.tid & 63; float a = b_ada_[j0 + col];
#pragma unroll
              for (int w = 0; w < 8; ++w) a += red[(w * 8 + b) * 64 + col];
              mod_[b * (NMOD * D) + j0 + col] = a; }
            __syncthreads();
        }
        if (staged) __syncthreads();
    }
    for (int idx = F.vcu * (NWAVES * 64) + F.tid; idx < T * 8; idx += F.G * NWAVES * 64) { const int t = idx >> 3, i = idx & 7; float cs, sn; rope_cs(positions_[t], i, cs, sn); rope_[t * 16 + i] = cs; rope_[t * 16 + 8 + i] = sn; }
    if (blockIdx.x == 0 && F.wave == 0) { const float s1 = wave_sum(lq1_[F.lane] * lk1_[F.lane]), s2 = wave_sum(lq2_[F.lane] * lk2_[F.lane]); if (F.lane == 0) lam_[0] = expf(s1) - expf(s2) + LAM_INIT; }
    {
        LAS bf16* scr = (LAS bf16*)(F.lds + RING_OFF + F.wave * 8448);
        const int gw = F.vcu * NWAVES + F.wave, NGW = F.G * NWAVES;
        constexpr int I_IN = 16 * (INC / 64), I_A = 16 * 16, I_O = 16 * 16;
        constexpr int NITEMS = I_IN + I_A + I_O;
        for (int it = gw; it < NITEMS; it += NGW) {
            int r = it;
            if (r < I_IN) { const int kb = r / (INC / 64), nb = r % (INC / 64);
                tr_item(w_in_, INC, kb * 64, nb * 64, Win_t_, D, kb * 64, [=](int nn) { return nb * 64 + ((nb < 32 && nn < 16) ? ((nn & 7) * 2 + (nn >> 3)) : nn); }, scr, F.lane, false); continue; } r -= I_IN;
            if (r < I_A) { const int kb = r / 16, nb = r % 16;
                tr_item(w_proj_a_, D, kb * 64, nb * 64, Wa_t_, DW, kb * 64, [=](int nn) { return nb * 64 + nn; }, scr, F.lane, false); continue; } r -= I_A;
            { const int kb = r / 16, nb = r % 16;
                tr_item(w_out_, D, kb * 64, nb * 64, Wout_t_, D, kb * 64, [=](int nn) { return nb * 64 + nn; }, scr, F.lane, false); }
        }
        const int nfree = (F.G > 96) ? F.G - 96 : F.G, myfree = (F.G > 96) ? (int)blockIdx.x - 96 : (int)blockIdx.x;
        for (int it = myfree * NWAVES + F.wave; myfree >= 0 && it < 16 * 64; it += nfree * NWAVES) {
            const int n = (it & 15) * 64 + F.lane, kk0 = (it >> 4) * 8, g = kk0 >> 7, c0 = kk0 & 127;
            const float* wp = w_pool_ + (size_t)g * 128 * 128 + (size_t)c0 * 128; const float* sc = pool_scale_ + g * 128; const float* wb = w_proj_b_ + (size_t)(g * 128) * D + n;
            float wr0[8], wr1[8];
            { const float s0 = sc[F.lane], s1 = sc[64 + F.lane];
#pragma unroll
              for (int q = 0; q < 8; ++q) { wr0[q] = wp[q * 128 + F.lane] * s0; wr1[q] = wp[q * 128 + 64 + F.lane] * s1; } }
            float acc[8];
#pragma unroll
            for (int q = 0; q < 8; ++q) acc[q] = 0.f;
#pragma unroll 1
            for (int j0 = 0; j0 < 128; j0 += 32) {
                float b[32];
#pragma unroll
                for (int u = 0; u < 32; ++u) b[u] = wb[(size_t)(j0 + u) * D];
#pragma unroll
                for (int u = 0; u < 32; ++u) { const int jx = j0 + u;
#pragma unroll
                    for (int q = 0; q < 8; ++q) { const float w = __builtin_bit_cast(float, __builtin_amdgcn_readlane(__builtin_bit_cast(int, (j0 < 64) ? wr0[q] : wr1[q]), jx & 63)); acc[q] += w * b[u]; } }
            }
            *(GAS v4u*)(Wb_t_ + (size_t)n * PW + kk0) = (v4u){pk2(acc[0], acc[1]), pk2(acc[2], acc[3]), pk2(acc[4], acc[5]), pk2(acc[6], acc[7])};
        }
    }
}

__device__ __forceinline__ void p1_norm(Frame& F) {
    const float* const g_pre_mix_ = (const float*)inp(F, 5); const float* const x_ = (const float*)inp(F, 0); float* const mod_ = (float*)(F.ws + WS_MOD); bf16* const h_ = (bf16*)(F.ws + WS_H);
    const int gw = F.vcu * NWAVES + F.wave, NGW = F.G * NWAVES;
    f32x4 gv[4];
#pragma unroll
    for (int j = 0; j < 4; ++j) gv[j] = *((const GAS f32x4*)g_pre_mix_ + F.lane + 64 * j);
    f32x4 shv[4], scv[4]; int curb = -1;
#define P1_ROW(i) ((((i) & 2047) >> 8) * SEQ + ((i) >> 11) * 256 + ((i) & 255))
#define P1_LOAD(dst, i) do { const GAS f32x4* xr_ = (const GAS f32x4*)(x_ + (size_t)P1_ROW(i) * D) + F.lane; _Pragma("unroll") for (int j = 0; j < 4; ++j) dst[j] = xr_[64 * j]; } while (0)
    f32x4 v[4], vb[4], vc[4];
    if (gw < T) P1_LOAD(v, gw);
    if (gw + NGW < T) P1_LOAD(vb, gw + NGW);
    for (int mi_ = gw; mi_ < T; mi_ += NGW) {
        const int m = P1_ROW(mi_);
        const float* mb = mod_ + (m / SEQ) * (NMOD * D);
        if (mi_ + 2 * NGW < T) P1_LOAD(vc, mi_ + 2 * NGW);
        float s = 0.f;
        if (m / SEQ != curb) { curb = m / SEQ;
#pragma unroll
            for (int j = 0; j < 4; ++j) { shv[j] = *((const GAS f32x4*)mb + F.lane + 64 * j); scv[j] = *((const GAS f32x4*)(mb + D) + F.lane + 64 * j) + 1.f; } }
#pragma unroll
        for (int j = 0; j < 4; ++j) s += (v[j].x * v[j].x + v[j].y * v[j].y) + (v[j].z * v[j].z + v[j].w * v[j].w);
        const float r = rsqrtf(wave_sum(s) * (1.f / D) + NORM_EPS);
        GAS v2u* o8 = (GAS v2u*)(h_ + (size_t)m * D) + F.lane;
#pragma unroll
        for (int j = 0; j < 4; ++j) { const f32x4 o = v[j] * r * gv[j] * scv[j] + shv[j]; o8[64 * j] = (v2u){pk2(o.x, o.y), pk2(o.z, o.w)}; }
#pragma unroll
        for (int j = 0; j < 4; ++j) { v[j] = vb[j]; vb[j] = vc[j]; }
    }
#undef P1_ROW
#undef P1_LOAD
}
__device__ __forceinline__ void p3_poold(Frame& F) {
    bf16* const u_ = (bf16*)(F.ws + WS_U); bf16* const dd_ = (bf16*)(F.ws + WS_DD);
    LAS unsigned* col = (LAS unsigned*)(F.lds + RING_OFF + F.wave * 16384);
    const int gw = F.vcu * NWAVES + F.wave, NGW = F.G * NWAVES;
    for (int it = gw; it < (T / 32) * 4; it += NGW) {
        const int g = it & 3, blk = it >> 2, t0 = blk * 32, tin0 = t0 % SEQ, w = 2 << g;
        const bf16* up = u_ + (size_t)t0 * PW + g * 128 + 2 * F.lane;
        unsigned vals[48];
#pragma unroll
        for (int r = 0; r < 48; ++r) { vals[r] = 0u; if (tin0 - 16 + r >= 0) vals[r] = *(const GAS unsigned*)(up + (ptrdiff_t)(r - 16) * PW); }
#pragma unroll
        for (int r = 0; r < 48; ++r) col[r * 64 + F.lane] = vals[r];
        LDS_WAIT(); asm volatile("" ::: "memory");
        float s0 = 0.f, s1 = 0.f;
        for (int j = 1; j <= w; ++j) { const unsigned val = col[(16 - j) * 64 + F.lane]; s0 += bflo(val); s1 += bfhi(val); }
        bf16* dp = dd_ + (size_t)t0 * PW + g * 128 + 2 * F.lane;
        for (int r = 0; r < 32; ++r) { const unsigned cur = col[(16 + r) * 64 + F.lane], old = col[(16 + r - w) * 64 + F.lane];
            s0 += bflo(cur) - bflo(old); s1 += bfhi(cur) - bfhi(old);
            const float inv = 1.f / (float)min(tin0 + r + 1, w);
            *(GAS unsigned*)(dp + (size_t)r * PW) = pk2(s0 * inv - bflo(cur), s1 * inv - bfhi(cur)); }
        LDS_WAIT(); asm volatile("" ::: "memory");
    }
}
__device__ __forceinline__ void p3_combine(Frame& F, int b, int h, int qb) {
    const float* const g_subln_ = (const float*)inp(F, 11); const float* const lam_ = (const float*)(F.ws + WS_MOD + 256 * 1024);
    const bf16* const O0_ = (const bf16*)(F.ws + WS_O0); const bf16* const O1_ = (const bf16*)(F.ws + WS_O1); bf16* const oc_ = (bf16*)(F.ws + WS_OC);
    asm volatile("s_waitcnt vmcnt(0)" ::: "memory"); __syncthreads();
    const __amdgpu_buffer_rsrc_t r0 = __builtin_amdgcn_make_buffer_rsrc((void*)O0_, 0, T * DW * 2, 0x00020000), r1 = __builtin_amdgcn_make_buffer_rsrc((void*)O1_, 0, T * DW * 2, 0x00020000);
    int lane = F.lane; asm volatile("" : "+v"(lane));
    const float lam = lam_[0];
    float gs[16];
#pragma unroll
    for (int i = 0; i < 16; ++i) gs[i] = g_subln_[16 * (lane & 7) + i] * (1.f - LAM_INIT);
#pragma unroll 2
    for (int st = 0; st < 4; ++st) {
        const int row = b * SEQ + qb * 256 + F.wave * 32 + st * 8 + (lane >> 3);
        const size_t off = (size_t)row * DW + h * 128 + 16 * (lane & 7);
        const unsigned ob = (unsigned)(off * 2);
        const v4u a0 = __builtin_amdgcn_raw_buffer_load_b128(r0, ob, 0, 16), a1 = __builtin_amdgcn_raw_buffer_load_b128(r0, ob + 16, 0, 16), b0 = __builtin_amdgcn_raw_buffer_load_b128(r1, ob, 0, 16), b1 = __builtin_amdgcn_raw_buffer_load_b128(r1, ob + 16, 0, 16);
        float v[16];
#pragma unroll
        for (int i = 0; i < 4; ++i) { v[2 * i] = bflo(a0[i]) - lam * bflo(b0[i]); v[2 * i + 1] = bfhi(a0[i]) - lam * bfhi(b0[i]); v[8 + 2 * i] = bflo(a1[i]) - lam * bflo(b1[i]); v[8 + 2 * i + 1] = bfhi(a1[i]) - lam * bfhi(b1[i]); }
        float ss = 0.f;
#pragma unroll
        for (int i = 0; i < 16; ++i) ss += v[i] * v[i];
        ss = sum8(ss);
        const float r = rsqrtf(ss * (1.f / 128.f) + SUBLN_EPS);
        v4u o0, o1;
#pragma unroll
        for (int i = 0; i < 4; ++i) { o0[i] = pk2(v[2 * i] * r * gs[2 * i], v[2 * i + 1] * r * gs[2 * i + 1]); o1[i] = pk2(v[8 + 2 * i] * r * gs[8 + 2 * i], v[9 + 2 * i] * r * gs[9 + 2 * i]); }
        *(GAS v4u*)(oc_ + off) = o0; *(GAS v4u*)(oc_ + off + 8) = o1;
    }
}
__device__ __forceinline__ void p7_router(Frame& F, const int npass) {
    const float* const w_router_ = (const float*)inp(F, 19); const float* const b_router_ = (const float*)inp(F, 20); float* const mod_ = (float*)(F.ws + WS_MOD); float* const mx_ = (float*)(F.ws + WS_MX); const float* const x_ = (const float*)inp(F, 0); const float* const g_post_mix_ = (const float*)inp(F, 17); float* const out_ = (float*)inp(F, 26); const float* const g_pre_ffn_ = (const float*)inp(F, 18); bf16* const h2_ = (bf16*)(F.ws + WS_H2); int* const list_ = (int*)(F.ws + WS_LIST); unsigned* const tokslot_ = (unsigned*)(F.ws + WS_TOK); float* const tokw_ = (float*)(F.ws + WS_TOK + 256 * 1024);
    constexpr int HP = 2064;
    LAS unsigned char* hhi = F.lds + RING_OFF; LAS unsigned char* hlo = F.lds + RING_OFF + 16 * HP;
    LAS float* part = (LAS float*)(F.lds + RING_OFF + 66048);
    LAS unsigned* sel = (LAS unsigned*)(F.lds + RING_OFF + 98304);
    LAS float* selw = (LAS float*)(F.lds + RING_OFF + 98304 + 2048);
    LAS int* selt = (LAS int*)(F.lds + RING_OFF + 98304 + 4096);
    LAS unsigned* lcnt = (LAS unsigned*)(F.lds + RING_OFF + 98304 + 4608);
    LAS f32x4* cv = (LAS f32x4*)(F.lds + RING_OFF + 106496);
    int curb = -1;
    if (F.tid < 64) lcnt[F.tid] = 0u;
    const int e = F.lane & 31;
    pg8::bf16x8 bhi[4][2], blo[4][2];
#pragma unroll
    for (int ks = 0; ks < 4; ++ks)
#pragma unroll
        for (int nb2 = 0; nb2 < 2; ++nb2) { unsigned hh[4], ll[4];
#pragma unroll
            for (int jp = 0; jp < 4; ++jp) { const size_t k0 = (size_t)(128 * F.wave + 32 * ks + 8 * (F.lane >> 4) + 2 * jp); const float w0 = w_router_[k0 * NE + 16 * nb2 + (F.lane & 15)], w1 = w_router_[(k0 + 1) * NE + 16 * nb2 + (F.lane & 15)];
                hh[jp] = pk2(w0, w1); ll[jp] = pk2(w0 - bflo(hh[jp]), w1 - bfhi(hh[jp])); }
            bhi[ks][nb2] = __builtin_bit_cast(pg8::bf16x8, (v4u){hh[0], hh[1], hh[2], hh[3]}); blo[ks][nb2] = __builtin_bit_cast(pg8::bf16x8, (v4u){ll[0], ll[1], ll[2], ll[3]}); }
    const float bre = b_router_[e];
    __syncthreads();
    int nb = 0;
    for (int pass = 0; pass < npass; ++pass) {
    if (pass > 0) { __syncthreads(); if (F.tid < 64) lcnt[F.tid] = 0u; __syncthreads(); }
    nb = 0;
    for (int bi = F.vcu; bi < T / 16; bi += F.G, ++nb) {
        const int bt = ((bi & 255) >> 5) * (SEQ / 16) + (bi >> 8) * 32 + (bi & 31);
        if ((bt * 16) / SEQ != curb) { curb = (bt * 16) / SEQ; const float* mb = mod_ + curb * (NMOD * D);
            for (int i = F.tid; i < 5 * 256; i += NWAVES * 64) { const int v = i >> 8, c = i & 255;
                const GAS f32x4* src = (v == 0) ? (const GAS f32x4*)g_post_mix_ : (v == 1) ? (const GAS f32x4*)g_pre_ffn_ : (const GAS f32x4*)(mb + v * D);
                f32x4 val = src[c]; if (v == 4) val = val + 1.f; cv[i] = val; }
            __syncthreads(); }
        {
            const int t0 = bt * 16 + 2 * F.wave;
            f32x4 mv[2][4], xv[2][4];
#pragma unroll
            for (int rr = 0; rr < 2; ++rr)
#pragma unroll
                for (int j = 0; j < 4; ++j) { { const v2u mw = *((const GAS v2u*)((const bf16*)mx_ + (size_t)(t0 + rr) * D) + F.lane + 64 * j); mv[rr][j] = (f32x4){bflo(mw.x), bfhi(mw.x), bflo(mw.y), bfhi(mw.y)}; } xv[rr][j] = *((const GAS f32x4*)(x_ + (size_t)(t0 + rr) * D) + F.lane + 64 * j); }
#pragma unroll
            for (int rr = 0; rr < 2; ++rr) {
                const int r = 2 * F.wave + rr, t = t0 + rr; float s = 0.f;
#pragma unroll
                for (int j = 0; j < 4; ++j) s += (mv[rr][j].x * mv[rr][j].x + mv[rr][j].y * mv[rr][j].y) + (mv[rr][j].z * mv[rr][j].z + mv[rr][j].w * mv[rr][j].w);
                float rs = rsqrtf(wave_sum(s) * (1.f / D) + NORM_EPS); s = 0.f;
#pragma unroll
                for (int j = 0; j < 4; ++j) { const f32x4 gp = cv[F.lane + 64 * j], gt = cv[512 + F.lane + 64 * j];
                    xv[rr][j] = xv[rr][j] + gt * (mv[rr][j] * rs * gp); *((GAS v2u*)(F.ws + WS_X1 + (size_t)t * D * 2) + F.lane + 64 * j) = (v2u){pk2(xv[rr][j].x, xv[rr][j].y), pk2(xv[rr][j].z, xv[rr][j].w)};     s += (xv[rr][j].x * xv[rr][j].x + xv[rr][j].y * xv[rr][j].y) + (xv[rr][j].z * xv[rr][j].z + xv[rr][j].w * xv[rr][j].w); }
                rs = rsqrtf(wave_sum(s) * (1.f / D) + NORM_EPS);
#pragma unroll
                for (int j = 0; j < 4; ++j) { const f32x4 gq = cv[256 + F.lane + 64 * j], sh = cv[768 + F.lane + 64 * j], sc1 = cv[1024 + F.lane + 64 * j];
                    const f32x4 hv = xv[rr][j] * rs * gq * sc1 + sh;
                    if (!MK_SINGLE) *((GAS v2u*)(h2_ + (size_t)t * D) + F.lane + 64 * j) = (v2u){pk2(hv.x, hv.y), pk2(hv.z, hv.w)};
                    { int w8 = 0; w8 = __builtin_amdgcn_cvt_pk_fp8_f32(hv.x, hv.y, w8, false); w8 = __builtin_amdgcn_cvt_pk_fp8_f32(hv.z, hv.w, w8, true); *((GAS unsigned*)(F.ws + WS_H2F + (size_t)t * D) + F.lane + 64 * j) = (unsigned)w8; }
                    { const unsigned h0 = pk2(hv.x, hv.y), h1 = pk2(hv.z, hv.w); *(LAS v2u*)(hhi + r * HP + 8 * (F.lane + 64 * j)) = (v2u){h0, h1};
                      *(LAS v2u*)(hlo + r * HP + 8 * (F.lane + 64 * j)) = (v2u){pk2(hv.x - bflo(h0), hv.y - bfhi(h0)), pk2(hv.z - bflo(h1), hv.w - bfhi(h1))}; } }
            }
        }
        __syncthreads();
        { pg8::f32x4 acc2[2] = {{0.f, 0.f, 0.f, 0.f}, {0.f, 0.f, 0.f, 0.f}};
#pragma unroll
          for (int ks = 0; ks < 4; ++ks) { const int ao = (F.lane & 15) * HP + 2 * (128 * F.wave + 32 * ks + 8 * (F.lane >> 4));
              const pg8::bf16x8 ahi = *(const LAS pg8::bf16x8*)(hhi + ao), alo = *(const LAS pg8::bf16x8*)(hlo + ao);
#pragma unroll
              for (int nb2 = 0; nb2 < 2; ++nb2) { acc2[nb2] = __builtin_amdgcn_mfma_f32_16x16x32_bf16(ahi, bhi[ks][nb2], acc2[nb2], 0, 0, 0); acc2[nb2] = __builtin_amdgcn_mfma_f32_16x16x32_bf16(ahi, blo[ks][nb2], acc2[nb2], 0, 0, 0);
                  acc2[nb2] = __builtin_amdgcn_mfma_f32_16x16x32_bf16(alo, bhi[ks][nb2], acc2[nb2], 0, 0, 0); } }
#pragma unroll
          for (int nb2 = 0; nb2 < 2; ++nb2)
#pragma unroll
              for (int i2 = 0; i2 < 4; ++i2) part[(F.wave * 16 + 4 * (F.lane >> 4) + i2) * 32 + 16 * nb2 + (F.lane & 15)] = acc2[nb2][i2]; }
        __syncthreads();
        {
            const int r = 2 * F.wave + (F.lane >> 5), t = bt * 16 + r; float lg = bre;
#pragma unroll
            for (int w = 0; w < 8; ++w) lg += part[(w * 16 + r) * 32 + e];
            float val = lg, tv[4]; int ti[4];
#pragma unroll
            for (int kk = 0; kk < 4; ++kk) { const float m = max32(val);
                const unsigned long long bal = __ballot(val == m); const unsigned hb = (F.lane >> 5) ? (unsigned)(bal >> 32) : (unsigned)bal; const int idx = __builtin_ctz(hb);
                tv[kk] = m; ti[kk] = idx; if (e == idx) val = -INFINITY; }
            if (e == 0) { float pw[4], den = 0.f;
#pragma unroll
                for (int kk = 0; kk < 4; ++kk) { pw[kk] = __expf(tv[kk] - tv[0]); den += pw[kk]; }
                const float inv = 1.f / den; const int lr = nb * 16 + r; selt[lr] = t;
#pragma unroll
                for (int kk = 0; kk < 4; ++kk) { const unsigned lp = __hip_atomic_fetch_add(lcnt + ti[kk], 1u, __ATOMIC_RELAXED, __HIP_MEMORY_SCOPE_WORKGROUP); sel[lr * 4 + kk] = ((unsigned)ti[kk] << 16) | lp; selw[lr * 4 + kk] = pw[kk] * inv; } }
        }
    }
    }
    __syncthreads();
    if (PROBE_DUP == 77) { if (F.tid < NE) lcnt[32 + F.tid] = __hip_atomic_fetch_add((unsigned*)(F.ctl + CW_CNT + 64 * F.tid), 0u, RLX_AGENT); __syncthreads(); }
    if (F.tid < NE) lcnt[32 + F.tid] = __hip_atomic_fetch_add((unsigned*)(F.ctl + CW_CNT + 64 * F.tid), lcnt[F.tid], RLX_AGENT);
    __syncthreads();
    for (int s = F.tid; s < nb * 64; s += NWAVES * 64) { const unsigned sv = sel[s]; const int ee = sv >> 16; const unsigned pos = lcnt[32 + ee] + (sv & 0xffffu); const int t = selt[s >> 2];
        list_[ee * T + pos] = t; tokslot_[t * 4 + (s & 3)] = ((unsigned)ee << 16) | pos; tokw_[t * 4 + (s & 3)] = selw[s]; }
    __syncthreads();
}
__device__ __forceinline__ void moe_tables(Frame& F) {

    LAS int* tstart = (LAS int*)(F.lds + L_TSTART); LAS int* cntl = (LAS int*)(F.lds + L_CNT); LAS int* tile_e = (LAS int*)(F.lds + L_TILEE);
    if (F.tid < NE) cntl[F.tid] = (int)__hip_atomic_load((unsigned*)(F.ctl + CW_CNT + 64 * F.tid), RLX_AGENT);
    __syncthreads();
    if (F.tid == 0) { int s = 0; for (int e = 0; e < NE; ++e) { tstart[e] = s; s += (cntl[e] + 255) >> 8; } tstart[NE] = s; }
    __syncthreads();
    for (int pm = F.tid; pm < MT_MAX; pm += NWAVES * 64) { int e = 0;
#pragma unroll
        for (int j = 1; j < NE; ++j) e += (pm >= tstart[j]) ? 1 : 0;
        tile_e[pm] = e; }
    __syncthreads();
}
__device__ __forceinline__ void p10_final(Frame& F, const bool dry) {
    const float* const g_post_ffn_ = (const float*)inp(F, 25); const unsigned* const tokslot_ = (const unsigned*)(F.ws + WS_TOK); const float* const tokw_ = (const float*)(F.ws + WS_TOK + 256 * 1024);
    const unsigned char* const ye_ = (const unsigned char*)(F.ws + WS_YE); const float* const mod_ = (const float*)(F.ws + WS_MOD); float* const out_ = (float*)inp(F, 26);
    const LAS int* tstart = (const LAS int*)(F.lds + L_TSTART);
    const int gw = F.vcu * NWAVES + F.wave, NGW = F.G * NWAVES;
    f32x4 gp[4];
#pragma unroll
    for (int j = 0; j < 4; ++j) gp[j] = *((const GAS f32x4*)g_post_ffn_ + F.lane + 64 * j);
    v4u tsA, tsB; f32x4 twA, twB;
    { const int t0 = gw, tb = (gw + NGW < T) ? gw + NGW : gw; if (t0 < T) { tsA = *(const GAS v4u*)(tokslot_ + t0 * 4); tsB = *(const GAS v4u*)(tokslot_ + tb * 4); twA = *(const GAS f32x4*)(tokw_ + t0 * 4); twB = *(const GAS f32x4*)(tokw_ + tb * 4); } }
    for (int t0 = gw; t0 < T; t0 += 2 * NGW) {
        const int t1 = t0 + NGW; const bool two = t1 < T; const int tb = two ? t1 : t0;
        unsigned ya[4][4], yb[4][4];
#pragma unroll
        for (int kk = 0; kk < 4; ++kk) { const GAS unsigned* ra = (const GAS unsigned*)(ye_ + (size_t)(256 * tstart[tsA[kk] >> 16] + (tsA[kk] & 0xffff)) * D); const GAS unsigned* rb = (const GAS unsigned*)(ye_ + (size_t)(256 * tstart[tsB[kk] >> 16] + (tsB[kk] & 0xffff)) * D);
#pragma unroll
            for (int j = 0; j < 4; ++j) { ya[kk][j] = ra[F.lane + 64 * j]; yb[kk][j] = rb[F.lane + 64 * j]; } }
        v2u xa[4], xb[4];
#pragma unroll
        for (int j = 0; j < 4; ++j) { xa[j] = *((const GAS v2u*)(F.ws + WS_X1 + (size_t)t0 * D * 2) + F.lane + 64 * j); xb[j] = *((const GAS v2u*)(F.ws + WS_X1 + (size_t)tb * D * 2) + F.lane + 64 * j); }
        f32x4 gtA[4], gtB[4];
#pragma unroll
        for (int j = 0; j < 4; ++j) { gtA[j] = *((const GAS f32x4*)(mod_ + (t0 / SEQ) * (NMOD * D) + 5 * D) + F.lane + 64 * j); gtB[j] = *((const GAS f32x4*)(mod_ + (tb / SEQ) * (NMOD * D) + 5 * D) + F.lane + 64 * j); }
        const f32x4 twA0 = twA, twB0 = twB;
        { const int n0 = t0 + 2 * NGW, nb2 = (n0 + NGW < T) ? n0 + NGW : n0; if (n0 < T) { tsA = *(const GAS v4u*)(tokslot_ + n0 * 4); tsB = *(const GAS v4u*)(tokslot_ + nb2 * 4); twA = *(const GAS f32x4*)(tokw_ + n0 * 4); twB = *(const GAS f32x4*)(tokw_ + nb2 * 4); } }
#pragma unroll
        for (int rr = 0; rr < 2; ++rr) {
            if (rr == 1 && !two) break;
            const int t = rr ? t1 : t0;
            float f[16];
#pragma unroll
            for (int i = 0; i < 16; ++i) f[i] = 0.f;
#pragma unroll
            for (int kk = 0; kk < 4; ++kk) { const float ws = (rr ? twB0[kk] : twA0[kk]) * pg8::YE_INV;
#pragma unroll
                for (int j = 0; j < 4; ++j) { const int a = (int)(rr ? yb[kk][j] : ya[kk][j]); const auto lo = __builtin_amdgcn_cvt_pk_f32_fp8(a, false), hi = __builtin_amdgcn_cvt_pk_f32_fp8(a, true);
                    f[4 * j] += ws * lo[0]; f[4 * j + 1] += ws * lo[1]; f[4 * j + 2] += ws * hi[0]; f[4 * j + 3] += ws * hi[1]; } }
            float ss = 0.f;
#pragma unroll
            for (int i = 0; i < 16; ++i) ss += f[i] * f[i];
            const float r = rsqrtf(wave_sum(ss) * (1.f / D) + NORM_EPS);
            GAS f32x4* op = (GAS f32x4*)(out_ + (size_t)t * D) + F.lane;
#pragma unroll
            for (int j = 0; j < 4; ++j) { const f32x4 gt = rr ? gtB[j] : gtA[j]; const v2u xw = rr ? xb[j] : xa[j]; const f32x4 x1 = {bflo(xw.x), bfhi(xw.x), bflo(xw.y), bfhi(xw.y)};
                const f32x4 fv = {f[4 * j], f[4 * j + 1], f[4 * j + 2], f[4 * j + 3]}; if (!dry) op[64 * j] = x1 + gt * (fv * r * gp[j]); }
        }
    }
}

struct Args { const void* in[26]; float* out; unsigned char* ws; int ph_lo, ph_hi; };
__global__ void __launch_bounds__(NWAVES * 64, 2) mega_fwd(Args args) {
    extern __shared__ __attribute__((aligned(16))) unsigned char lds[];
    Frame F;
    F.lds = (LAS unsigned char*)lds;
    F.MISC = (volatile LAS unsigned*)(F.lds + MISC_OFF);
    F.tid = threadIdx.x; F.lane = F.tid & 63; F.wave = __builtin_amdgcn_readfirstlane(F.tid >> 6);
    F.G = gridDim.x; { const int bx = blockIdx.x; F.vcu = (F.G % 8 == 0) ? (bx % 8) * (F.G / 8) + bx / 8 : bx; F.vb = bx; }
    F.ws = args.ws; F.ctl = (gu32*)(args.ws + WS_CTL);
    for (int u = F.tid; u < (LDS_BYTES - LDSCTL_OFF) / 4; u += NWAVES * 64) ((LAS unsigned*)(F.lds + LDSCTL_OFF))[u] = 0u;
    __syncthreads();
    if (F.tid == 0) { LAS unsigned long long* pt = (LAS unsigned long long*)(F.lds + L_PTRS);
#define PT(i) pt[i] = (unsigned long long)args.in[i];
        PT(0) PT(1) PT(2) PT(3) PT(4) PT(5) PT(6) PT(7) PT(8) PT(9) PT(10) PT(11) PT(12) PT(13) PT(14) PT(15) PT(16) PT(17) PT(18) PT(19) PT(20) PT(21) PT(22) PT(23) PT(24) PT(25)
#undef PT
        pt[26] = (unsigned long long)args.out; }
    __syncthreads();
    const int lo = args.ph_lo, hi = args.ph_hi;
    const bool single = (hi - lo) > 1;
    XcdBarrier bar; bar.bar = (unsigned*)(F.ctl + CW_BAR); bar.x = 0; bar.st = nullptr;
    if (single) bar = xcd_barrier_post((unsigned*)(F.ctl + CW_BAR), F.MISC + 8);
#define IN(k) (lo <= (k) && (k) < hi)
#define NREP(k) ((PROBE_DUP == (k) || (PROBE_DUP == 35 && (k) == 3)) ? 2 : 1)
#define SEAM(k) do { if (IN(k) && IN((k) + 1)) { xcd_barrier(bar); if (PROBE_DUP == 100 && (k) < 5) xcd_barrier(bar); } } while (0)
#define SEAML(k) do { if (IN(k) && IN((k) + 1)) { if (grp) xcc_local_barrier(bar); else xcd_barrier(bar); } } while (0)
    bool grp = false;
    const LAS int* gtab = (const LAS int*)(F.lds + L_GTAB);
#define REFRESH() do { int t_ = (int)threadIdx.x; asm volatile("" : "+v"(t_)); F.tid = t_; F.lane = t_ & 63; } while (0)

    _Pragma("unroll") for (int allrep_ = 0; allrep_ < ((PROBE_DUP == 200) ? 2 : 1); ++allrep_) {
    if (allrep_ > 0) { xcd_barrier(bar); if (blockIdx.x == 0 && F.tid < NE) __hip_atomic_store((unsigned*)(F.ctl + CW_CNT + 64 * F.tid), 0u, RLX_AGENT); xcd_barrier(bar); }
    if (IN(0)) _Pragma("unroll") for (int rep_ = 0; rep_ < NREP(0); ++rep_) { REFRESH(); p0_prologue(F); if (NREP(0) > 1) __syncthreads(); } SEAM(0);
    if (single && allrep_ == 0) { const unsigned md = __builtin_amdgcn_readfirstlane(F.MISC[10]), rk = __builtin_amdgcn_readfirstlane(F.MISC[11]);
        if (md == 2u && PROBE_DUP != 101) { grp = true; F.vcu = (int)bar.x * 32 + (int)rk; F.vb = (int)rk * 8 + (int)bar.x; } }
    if (IN(1)) _Pragma("unroll") for (int rep_ = 0; rep_ < NREP(1); ++rep_) { REFRESH(); p1_norm(F); } SEAML(1);
    if (IN(2)) _Pragma("unroll") for (int rep_ = 0; rep_ < NREP(2); ++rep_) { REFRESH();
        pg8::Gemm g{((bf16*)(F.ws + WS_H)), ((bf16*)(F.ws + WS_WIN)), D, 0, 0}; pg8::StaticOrder S; S.init(T, INC, F.G, F.vb);
        pg8::EpiZ E{((bf16*)(F.ws + WS_Q)), ((bf16*)(F.ws + WS_K)), ((bf16*)(F.ws + WS_V)), ((bf16*)(F.ws + WS_U)), ((bf16*)(F.ws + WS_GA)), ((bf16*)(F.ws + WS_GB)), ((float*)(F.ws + WS_ROPE))};
        pg8::gemm_phase<pg8::EpiZ, pg8::StaticOrder, true, false>(F.lds + RING_OFF, g, S, E, gtab);
        if (rep_ == NREP(2) - 1) conv_in_idle_round(F, (T / 256) * (INC / 256), 0, CONV_W2_IN_P2);
    } SEAML(2);
    if (IN(3)) _Pragma("unroll") for (int rep_ = 0; rep_ < NREP(3); ++rep_) { REFRESH();
        p3_poold(F);
        __syncthreads();
        const attn_body::Combine CB{false, (const attn_body::bf16*)(F.ws + WS_O0), (attn_body::bf16*)(F.ws + WS_OC), (const float*)inp(F, 11), ((const float*)(F.ws + WS_MOD + 256 * 1024))[0], SUBLN_EPS, 1.f - LAM_INIT};
        const attn_body::AttnTensors AT{(const attn_body::bf16*)(F.ws + WS_Q), (const attn_body::bf16*)(F.ws + WS_K), (const attn_body::bf16*)(F.ws + WS_V), (attn_body::bf16*)(F.ws + WS_O0), CB};
        attn_body::attn_phase<16>((char*)lds + RING_OFF, AT, F.vcu, F.G,
            [&](int i, int nun) { if (!((PROBE_DUP == 3 || PROBE_DUP == 35) && rep_ > 0)) { conv_expert_items(F, CONV_W2_ALL, CONV_ALL - CONV_W2_ALL, F.vcu, F.G, i, nun, F.lds + RING_OFF + F.wave * 4352);
                if (PROBE_DUP == 36) { const float* w1 = (const float*)inp(F, 21); int lane = F.lane; asm volatile("" : "+v"(lane));
                    for (int q = 0; q < 2; ++q) { CItem a; a.src = w1 + (size_t)(F.wave * 64) * (2 * FF); a.ldw = 2 * FF; a.dst = F.ws + WS_Y + (size_t)(blockIdx.x * 8 + F.wave) * 65536; a.ldk = D; a.base = 0; a.mode = 0; f32x4 va[4][4]; conv_load(a, va, lane); conv_store(a, va, F.lds + RING_OFF + F.wave * 4352, lane); } }
                asm volatile("s_waitcnt lgkmcnt(0)\n\ts_barrier" ::: "memory"); } });
        __builtin_amdgcn_s_setprio(0);
    } SEAML(3);
    if (IN(5)) _Pragma("unroll") for (int rep_ = 0; rep_ < NREP(5); ++rep_) { REFRESH();
        pg8::Gemm2 g{((bf16*)(F.ws + WS_DD)), ((bf16*)(F.ws + WS_WB)), ((bf16*)(F.ws + WS_OC)), ((bf16*)(F.ws + WS_WA)), PW, DW};
        pg8::StaticOrder S; S.init(T, D, F.G, F.vb);
        pg8::EpiChain E{((const bf16*)(F.ws + WS_GA)), ((const bf16*)(F.ws + WS_GB)), ((bf16*)(F.ws + WS_MI))};
        pg8::gemm_chain2<pg8::EpiChain, pg8::StaticOrder>(F.lds + RING_OFF, g, S, E);
    } SEAML(5);
    if (IN(6)) _Pragma("unroll") for (int rep_ = 0; rep_ < NREP(6); ++rep_) { REFRESH();
        pg8::Gemm g{((bf16*)(F.ws + WS_MI)), ((bf16*)(F.ws + WS_WOUT)), D, 0, 0}; pg8::StaticOrder S; S.init(T, D, F.G, F.vb);
        pg8::EpiBf16Plain E{((bf16*)(F.ws + WS_MX))};
        pg8::gemm_phase<pg8::EpiBf16Plain, pg8::StaticOrder, true, false>(F.lds + RING_OFF, g, S, E, gtab);
    } SEAML(6);
    if (IN(7)) { REFRESH(); p7_router(F, NREP(7)); } SEAM(7);
    if (IN(8) || IN(9) || IN(10)) { REFRESH(); moe_tables(F); }
    if (IN(8)) _Pragma("unroll") for (int rep_ = 0; rep_ < NREP(8); ++rep_) { REFRESH();
        const LAS int* tstart = (const LAS int*)(F.lds + L_TSTART); const LAS int* cntl = (const LAS int*)(F.lds + L_CNT);
        { pg8::MoeOrder S0; S0.init(tstart[NE], 2 * FF, F.G, F.vb, (const LAS int*)(F.lds + L_TILEE));
          pg8::Unit un; LAS int* gt = (LAS int*)(F.lds + L_GTAB); LAS int* ul = (LAS int*)(F.lds + L_ULIST); int n = 0;
          _Pragma("unroll 1") for (int i = 0; i < MAXU && S0.next(i, un); ++i, ++n) if (F.tid == 0) { ul[4 + 4 * i] = un.pm; ul[5 + 4 * i] = un.pn; ul[6 + 4 * i] = un.e; }
          if (F.tid == 0) ul[0] = n;
          __syncthreads();
          int tokv[MAXU / 2];
#pragma unroll
          for (int j = 0; j < MAXU / 2; ++j) { const int x = F.tid + 512 * j, i = x >> 8, r = x & 255; tokv[j] = 0;
              if (i < n) { const int pm = ul[4 + 4 * i], e = ul[6 + 4 * i], pos = (pm - tstart[e]) * 256 + r; if (pos < cntl[e]) tokv[j] = ((const int*)(F.ws + WS_LIST))[e * T + pos]; } }
#pragma unroll
          for (int j = 0; j < MAXU / 2; ++j) { const int x = F.tid + 512 * j; if ((x >> 8) < n) gt[x] = tokv[j]; }
          __syncthreads(); }
        const pg8::ListOrder S{(const LAS int*)(F.lds + L_ULIST)};
        pg8::Gemm g{((bf16*)(F.ws + WS_H2F)), ((bf16*)(F.ws + WS_W1)), D / 2, 0, (size_t)2 * FF * D};
        pg8::EpiSwiglu E{(unsigned char*)(F.ws + WS_A), ((const float*)inp(F, 22))};
        pg8::gemm_phase<pg8::EpiSwiglu, pg8::ListOrder, true, true, true>(F.lds + RING_OFF, g, S, E, gtab);
        if (rep_ == NREP(8) - 1) conv_in_idle_round(F, tstart[NE] * (2 * FF / 256), CONV_W2_IN_P2, CONV_W2_ALL - CONV_W2_IN_P2);
    } SEAM(8);
    if (IN(9)) _Pragma("unroll") for (int rep_ = 0; rep_ < NREP(9); ++rep_) { REFRESH();
        const LAS int* tstart = (const LAS int*)(F.lds + L_TSTART);
        { pg8::MoeOrder S0; S0.init(tstart[NE], D, F.G, F.vb, (const LAS int*)(F.lds + L_TILEE));
          pg8::Unit un; LAS int* ul = (LAS int*)(F.lds + L_ULIST); int n = 0;
          __syncthreads();
          _Pragma("unroll 1") for (int i = 0; i < MAXU && S0.next(i, un); ++i, ++n) if (F.tid == 0) { ul[4 + 4 * i] = un.pm; ul[5 + 4 * i] = un.pn; ul[6 + 4 * i] = un.e; }
          if (F.tid == 0) ul[0] = n;
          __syncthreads(); }
        const pg8::ListOrder S{(const LAS int*)(F.lds + L_ULIST)};
        pg8::Gemm g{((bf16*)(F.ws + WS_A)), ((bf16*)(F.ws + WS_W2)), FF / 2, 0, (size_t)D * FF};
        pg8::EpiYe E{(unsigned char*)(F.ws + WS_YE), ((const float*)inp(F, 24))};
        pg8::gemm_phase<pg8::EpiYe, pg8::ListOrder, true, false, true>(F.lds + RING_OFF, g, S, E, gtab);
    } SEAM(9);
    if (IN(10)) { REFRESH(); if (NREP(10) > 1) p10_final(F, true); p10_final(F, false); }
    }
#undef IN
#undef SEAM
#undef SEAML
}
#ifndef MK_SINGLE
#define MK_SINGLE 1
#endif
#ifndef OPT_MASK
#define OPT_MASK 0x7ff
#endif
extern "C" void kernel_launch(void* const* d_in, const int* in_sizes, int n_in, void* d_out, int out_size, void* d_ws, size_t ws_size, hipStream_t stream) {
    static int grid = 0;
    if (grid == 0) {
        if (n_in != 26 || in_sizes[0] != T * D || out_size != T * D || ws_size < WS_END) { fprintf(stderr, "kernel_launch: unexpected shapes (n_in %d, in0 %d, out %d, ws %zu); nothing launched\n", n_in, n_in > 0 ? in_sizes[0] : -1, out_size, ws_size); grid = -1; return; }
        int dev = 0, cus = 0, per_cu = 0;
        if (hipGetDevice(&dev) != hipSuccess || hipDeviceGetAttribute(&cus, hipDeviceAttributeMultiprocessorCount, dev) != hipSuccess) { fprintf(stderr, "kernel_launch: device query failed\n"); grid = -1; return; }
        if (hipFuncSetAttribute((const void*)mega_fwd, hipFuncAttributeMaxDynamicSharedMemorySize, LDS_BYTES) != hipSuccess) { fprintf(stderr, "kernel_launch: hipFuncSetAttribute failed\n"); grid = -1; return; }
        if (hipOccupancyMaxActiveBlocksPerMultiprocessor(&per_cu, (const void*)mega_fwd, NWAVES * 64, LDS_BYTES) != hipSuccess || per_cu < 1) fprintf(stderr, "kernel_launch: note: occupancy query reports %d workgroups per CU\n", per_cu);
        (void)hipGetLastError();
        grid = cus;
    }
    if (grid < 0) return;
    unsigned char* ws = (unsigned char*)d_ws;
    (void)hipMemsetAsync(ws + WS_CTL, 0, CTL_ZERO_BYTES, stream);
    Args a{};
    for (int i = 0; i < 26; ++i) a.in[i] = d_in[i];
    a.out = (float*)d_out; a.ws = ws;
#if MK_SINGLE
    a.ph_lo = 0; a.ph_hi = NPHASE;
    hipLaunchKernelGGL(mega_fwd, dim3(grid), dim3(NWAVES * 64), LDS_BYTES, stream, a);
#else
    const float* x = (const float*)d_in[0]; const float* c = (const float*)d_in[1]; const int* positions = (const int*)d_in[2];
    const float* w_ada = (const float*)d_in[3]; const float* b_ada = (const float*)d_in[4]; const float* g_pre_mix = (const float*)d_in[5]; const float* w_in = (const float*)d_in[6];
    const float* lq1 = (const float*)d_in[7]; const float* lk1 = (const float*)d_in[8]; const float* lq2 = (const float*)d_in[9]; const float* lk2 = (const float*)d_in[10];
    const float* g_subln = (const float*)d_in[11]; const float* w_pool = (const float*)d_in[12]; const float* pool_scale = (const float*)d_in[13];
    const float* w_proj_a = (const float*)d_in[14]; const float* w_proj_b = (const float*)d_in[15]; const float* w_out = (const float*)d_in[16];
    const float* g_post_mix = (const float*)d_in[17]; const float* g_pre_ffn = (const float*)d_in[18]; const float* w_router = (const float*)d_in[19]; const float* b_router = (const float*)d_in[20];
    const float* w_exp1 = (const float*)d_in[21]; const float* b_exp1 = (const float*)d_in[22]; const float* w_exp2 = (const float*)d_in[23]; const float* b_exp2 = (const float*)d_in[24];
    const float* g_post_ffn = (const float*)d_in[25];
    float* out = (float*)d_out;
    using nv::bf;
    unsigned* ctl = (unsigned*)(ws + WS_CTL); unsigned* cnt = ctl + CW_CNT;
    float* mod = (float*)(ws + WS_MOD); float* lam = (float*)(ws + WS_MOD + 256 * 1024); int* tstart = (int*)(ws + WS_MOD + 260 * 1024);
    float* rope = (float*)(ws + WS_ROPE); int* list = (int*)(ws + WS_LIST); unsigned* tokslot = (unsigned*)(ws + WS_TOK); float* tokw = (float*)(ws + WS_TOK + 256 * 1024);
    bf* h = (bf*)(ws + WS_H); bf* q = (bf*)(ws + WS_Q); bf* k = (bf*)(ws + WS_K); bf* v = (bf*)(ws + WS_V); bf* u = (bf*)(ws + WS_U); bf* ga = (bf*)(ws + WS_GA); bf* gb = (bf*)(ws + WS_GB);
    bf* dd = (bf*)(ws + WS_DD); bf* O0 = (bf*)(ws + WS_O0); bf* O1 = (bf*)(ws + WS_O1); bf* oc = (bf*)(ws + WS_OC); bf* pp = (bf*)(ws + WS_PP); float* Y = (float*)(ws + WS_Y);
    bf* mi = (bf*)(ws + WS_MI); float* mx = (float*)(ws + WS_MX); bf* h2 = (bf*)(ws + WS_H2); bf* abuf = (bf*)(ws + WS_A); bf* ye = (bf*)(ws + WS_YE);
#define OPT(kk) ((OPT_MASK >> (kk)) & 1)
#define LAUNCH_OPT(kk) do { a.ph_lo = (kk); a.ph_hi = (kk) + 1; hipLaunchKernelGGL(mega_fwd, dim3(grid), dim3(NWAVES * 64), LDS_BYTES, stream, a); } while (0)
    if (OPT_MASK != 0) LAUNCH_OPT(0);
    if (!OPT(0)) { nv::k_mod<<<NB * NMOD * D / 256, 256, 0, stream>>>(c, w_ada, b_ada, lq1, lk1, lq2, lk2, mod, lam); nv::k_rope<<<T * 8 / 256, 256, 0, stream>>>(positions, rope); }
    if (OPT(1)) LAUNCH_OPT(1); else nv::k_norm1<<<T, 256, 0, stream>>>(x, g_pre_mix, mod, 0, D, h);
    if (OPT(2)) LAUNCH_OPT(2); else { nv::k_gemm<<<dim3(INC / 64, T / 64), 256, 0, stream>>>(nv::RmPlain{h, w_in, D, INC}, nv::EpZ{q, k, v, u, ga, gb}, D); nv::k_rope_apply<<<T * 1024 / 256, 256, 0, stream>>>(q, k, rope); }
    if (OPT(3)) LAUNCH_OPT(3); else { nv::k_attn<<<NB * 16 * SEQ / 4, 256, 0, stream>>>(q, k, v, O0, O1); nv::k_poold<<<T * PW / 256, 256, 0, stream>>>(u, dd); }
    if (OPT(4)) LAUNCH_OPT(4); else { nv::k_combine<<<T * NH / 4, 256, 0, stream>>>(O0, O1, lam, g_subln, oc);
        for (int g = 0; g < 4; ++g) nv::k_gemm<<<dim3(128 / 64, T / 64), 256, 0, stream>>>(nv::RmPlain{dd + g * 128, w_pool + g * 128 * 128, PW, 128}, nv::EpPool{pp, pool_scale, g, 0}, 128); }
    if (OPT(5)) LAUNCH_OPT(5); else { nv::k_gemm<<<dim3(D / 64, T / 64), 256, 0, stream>>>(nv::RmPlain{oc, w_proj_a, D, D}, nv::EpGateY{Y, ga}, DW);
        nv::k_gemm<<<dim3(D / 64, T / 64), 256, 0, stream>>>(nv::RmPlain{pp, w_proj_b, PW, D}, nv::EpGateAdd{Y, gb, mi}, PW); }
    if (OPT(6)) LAUNCH_OPT(6); else nv::k_gemm<<<dim3(D / 64, T / 64), 256, 0, stream>>>(nv::RmPlain{mi, w_out, D, D}, nv::EpF32{mx}, D);
    if (OPT(7)) LAUNCH_OPT(7); else nv::k_router<<<T / 4, 256, 0, stream>>>(x, mx, mod, g_post_mix, g_pre_ffn, w_router, b_router, out, h2, cnt, list, tokslot, tokw);
    nv::k_tstart<<<1, 64, 0, stream>>>(cnt, tstart);
    if (OPT(8)) LAUNCH_OPT(8); else nv::k_moe1<<<dim3(2 * FF / 64, MPAD / 64), 256, 0, stream>>>(nv::RmMoe{h2, tstart, cnt, list, w_exp1, (size_t)D * 2 * FF, 2 * FF, 1}, b_exp1, abuf);
    if (OPT(9)) LAUNCH_OPT(9); else nv::k_gemm<<<dim3(D / 64, MPAD / 64), 256, 0, stream>>>(nv::RmMoe{abuf, tstart, cnt, list, w_exp2, (size_t)FF * D, D, 0}, nv::EpYe{ye, b_exp2}, FF);
    if (OPT(10)) LAUNCH_OPT(10); else nv::k_final<<<T / 4, 256, 0, stream>>>(ye, tstart, tokslot, tokw, mod, g_post_ffn, out);
#endif
}
```

```cpp
#include <hip/hip_runtime.h>
#include <cstdio>
#include <cstdint>
#include <cmath>

constexpr int NB = 8, SEQ = 2048, D = 1024, T = NB * SEQ;
constexpr int NH = 8, HD = 64, VD = 128, DW = 1024, PW = 512, INC = 3 * DW + PW + 2 * D;
constexpr int NE = 32, TOPK = 4, FF = 1024, NMOD = 6;
constexpr int MPAD = TOPK * T + NE * 256, MT_MAX = MPAD / 256;
constexpr float NORM_EPS = 1e-6f, SUBLN_EPS = 1e-5f, LAM_INIT = 0.2f, SW_ALPHA = 1.702f, SW_LIMIT = 7.0f;
constexpr float QSCALE = 0.125f * 1.4426950408889634f;

constexpr size_t MiB = 1u << 20;
constexpr size_t WS_CTL = 0, CTL_ZERO_BYTES = 32768;
constexpr size_t WS_MOD = 1 * MiB;
constexpr size_t WS_ROPE = 2 * MiB;
constexpr size_t WS_LIST = 3 * MiB;
constexpr size_t WS_TOK = 5 * MiB;
constexpr size_t WS_WIN = 6 * MiB, WS_WA = 17 * MiB, WS_WB = 19 * MiB, WS_WPOOL = 20 * MiB, WS_WOUT = 21 * MiB, WS_W1 = 24 * MiB, WS_W2 = 152 * MiB;
constexpr size_t WS_H = 216 * MiB, WS_Q = 248 * MiB, WS_K = 280 * MiB, WS_V = 312 * MiB, WS_U = 344 * MiB, WS_GA = 360 * MiB, WS_GB = 392 * MiB, WS_DD = 424 * MiB;
constexpr size_t WS_O0 = 440 * MiB, WS_O1 = 472 * MiB, WS_OC = 504 * MiB, WS_PP = 536 * MiB, WS_Y = 552 * MiB, WS_MI = 616 * MiB, WS_MX = 648 * MiB, WS_X1 = 680 * MiB, WS_H2 = 712 * MiB, WS_H2F = 744 * MiB, WS_END = 760 * MiB;
constexpr size_t WS_A = 216 * MiB;
constexpr size_t WS_YE = 392 * MiB;
static_assert((size_t)MPAD * 1024 * 2 == 144 * MiB && WS_A + 144 * MiB <= WS_GA && WS_YE + 144 * MiB <= WS_PP, "overlay map");
constexpr int CW_TMO = 0, CW_CODE = 1;
constexpr int CW_CNT = 1024;
constexpr int CW_BAR = 4096;
static_assert((CW_BAR + 3456) * 4 <= (int)CTL_ZERO_BYTES && (CW_CNT + 64 * NE) * 4 <= (int)CTL_ZERO_BYTES, "control words inside the per-call memset");

__device__ __forceinline__ void rope_cs(int pos, int i, float& cs, float& sn) {
    const double invf = (i == 0) ? 1.0 : (i == 1) ? 0.19392274474868576 : (i == 2) ? 0.03760603093086393 : (i == 3) ? 0.007292664737217109 : (i == 4) ? 0.001414213562373095
                      : (i == 5) ? 0.0002742481756762073 : (i == 6) ? 5.318295896944988e-05 : 1.031338537721246e-05;
    const double ang = (double)pos * invf;
    const double qd = __builtin_rint(ang * 0.6366197723675814);
    const double r = ang - qd * 1.5707963267948966 - qd * 6.123233995736766e-17;
    const double r2 = r * r;
    const double s = r * (1.0 + r2 * (-1.0 / 6 + r2 * (1.0 / 120 + r2 * (-1.0 / 5040 + r2 * (1.0 / 362880 + r2 * (-1.0 / 39916800 + r2 * (1.0 / 6227020800.0)))))));
    const double c = 1.0 + r2 * (-0.5 + r2 * (1.0 / 24 + r2 * (-1.0 / 720 + r2 * (1.0 / 40320 + r2 * (-1.0 / 3628800 + r2 * (1.0 / 479001600.0 + r2 * (-1.0 / 87178291200.0)))))));
    const int n = (int)qd & 3;
    const double so = (n == 0) ? s : (n == 1) ? c : (n == 2) ? -s : -c;
    const double co = (n == 0) ? c : (n == 1) ? -s : (n == 2) ? -c : s;
    cs = (float)co; sn = (float)so;
}
#define MK_SINGLE 1
#define OPT_MASK 0x7ff
namespace pg8 {
#define PG8_LAS __attribute__((address_space(3)))
typedef unsigned short bf16_t;
typedef short bf16x8 __attribute__((ext_vector_type(8)));
typedef float f32x4 __attribute__((ext_vector_type(4)));
typedef unsigned u32x4 __attribute__((ext_vector_type(4)));
constexpr int BM = 256, BK = 64, HALF = 128, HTB = HALF * BK * 2  , STAGE_BYTES = 8 * HTB, NXCD = 8, WGM = 8;

__host__ __device__ __forceinline__ int lds_byte(int r, int c) { const int st = (r >> 4) * 2 + (c >> 5), rr = r & 15, cc = c & 31, ob = rr * 64 + cc * 2; return st * 1024 + (ob ^ (((ob >> 9) & 1) << 5)); }
__host__ __device__ __forceinline__ void stage_rc(int b, int& R, int& C) { const int st = b / 1024, sb = b % 1024, swz = sb ^ (((sb >> 9) & 1) << 5); R = (st >> 1) * 16 + swz / 64; C = (st & 1) * 32 + (swz % 64) / 2; }
__host__ __device__ __forceinline__ int perm32(int rho) { const int n = rho >> 4, i = rho & 15; return 8 * (i >> 2) + 4 * n + (i & 3); }

typedef int i32x8 __attribute__((ext_vector_type(8))); typedef int i32x4 __attribute__((ext_vector_type(4)));
__device__ __forceinline__ i32x8 cat8(const bf16x8 a, const bf16x8 b) { const i32x4 x = __builtin_bit_cast(i32x4, a), y = __builtin_bit_cast(i32x4, b); return __builtin_shufflevector(x, y, 0, 1, 2, 3, 4, 5, 6, 7); }
__device__ __forceinline__ void mfma_fp8(f32x4& acc, const i32x8 a, const i32x8 b) { asm volatile("v_mfma_f32_16x16x128_f8f6f4 %0, %1, %2, %0" : "+v"(acc) : "v"(a), "v"(b)); }
struct Unit { int pm, pn, e; };
struct Gemm { const bf16_t* A; const bf16_t* Bt; int K; int pad; size_t bstride; };

struct StaticOrder {
    int nM, nN, nwg, G, c;
    __device__ void init(int M, int N, int G_, int c_) { nM = M / BM; nN = N / BM; nwg = nM * nN; G = G_; c = c_; }
    __device__ bool next(int i, Unit& u) const {
        const long L = (long)i * G + c; if (L >= nwg) return false;
        int wgid = (int)L; { const int q = nwg / NXCD, r = nwg % NXCD, xcd = wgid % NXCD, off = wgid / NXCD; wgid = (xcd < r ? xcd * (q + 1) : r * (q + 1) + (xcd - r) * q) + off; }
        const int nig = WGM * nN, gid = wgid / nig, fm = gid * WGM, gsz = (nM - fm) < WGM ? (nM - fm) : WGM;
        u.pm = fm + ((wgid % nig) % gsz); u.pn = (wgid % nig) / gsz; u.e = 0; return true;
    }
};
struct MoeOrder {
    int nM, nN, nwg, G, c; const PG8_LAS int* tile_e;
    __device__ void init(int nM_, int N, int G_, int c_, const PG8_LAS int* te) { nM = nM_; nN = N / BM; nwg = nM * nN; G = G_; c = c_; tile_e = te; }
    __device__ bool next(int i, Unit& u) const {
        const long L = (long)i * G + c; if (L >= nwg) return false;
        int wgid = (int)L; { const int q = nwg / NXCD, r = nwg % NXCD, xcd = wgid % NXCD, off = wgid / NXCD; wgid = (xcd < r ? xcd * (q + 1) : r * (q + 1) + (xcd - r) * q) + off; }
        const int nig = WGM * nN, gid = wgid / nig, fm = gid * WGM, gsz = (nM - fm) < WGM ? (nM - fm) : WGM;
        u.pm = fm + ((wgid % nig) % gsz); u.pn = (wgid % nig) / gsz; u.e = tile_e[u.pm]; return true;
    }
};

struct ListOrder {
    const PG8_LAS int* ul;
    __device__ bool next(int i, Unit& u) const { if (i >= ul[0]) return false; u.pm = ul[4 + 4 * i]; u.pn = ul[5 + 4 * i]; u.e = ul[6 + 4 * i]; return true; }
};
__device__ __forceinline__ unsigned cvt_pk_bf16(float lo, float hi) { unsigned r; asm volatile("v_cvt_pk_bf16_f32 %0, %1, %2" : "=v"(r) : "v"(lo), "v"(hi)); return r; }
__device__ __forceinline__ float bflo(unsigned w) { return __uint_as_float(w << 16); }
__device__ __forceinline__ float bfhi(unsigned w) { return __uint_as_float(w & 0xffff0000u); }
__device__ __forceinline__ float sigm(float v) { return __builtin_amdgcn_rcpf(1.f + __builtin_amdgcn_exp2f(-1.4426950408889634f * v)); }
__device__ __forceinline__ u32x4 pack8(const f32x4 v0, const f32x4 v1) { u32x4 w; w.x = cvt_pk_bf16(v0[0], v0[1]); w.y = cvt_pk_bf16(v0[2], v0[3]); w.z = cvt_pk_bf16(v1[0], v1[1]); w.w = cvt_pk_bf16(v1[2], v1[3]); return w; }

typedef unsigned u32x2 __attribute__((ext_vector_type(2)));
__device__ __forceinline__ u32x2 pack8_fp8(const f32x4 v0, const f32x4 v1) { int a = 0, b = 0; a = __builtin_amdgcn_cvt_pk_fp8_f32(v0[0], v0[1], a, false); a = __builtin_amdgcn_cvt_pk_fp8_f32(v0[2], v0[3], a, true);
    b = __builtin_amdgcn_cvt_pk_fp8_f32(v1[0], v1[1], b, false); b = __builtin_amdgcn_cvt_pk_fp8_f32(v1[2], v1[3], b, true); return (u32x2){(unsigned)a, (unsigned)b}; }
constexpr float W8_SCALE = 32.f, W8_INV = 1.f / 32.f;
struct EpiZ {
    static constexpr bool PERM = true;
    bf16_t *q, *k, *v, *u, *ga, *gb; const float* rope;
    __device__ __forceinline__ void operator()(const f32x4 (&acc)[2][2][4][2], const Unit& un, int wr, int wc, int fr, int fq) const {
        const int pn = un.pn, row0 = un.pm * BM + wr * 64 + fr;
        int kind, ldc, colt; bf16_t* base;
        if (pn < 4) { kind = 0; base = q; ldc = 1024; colt = pn * 256; }
        else if (pn < 8) { kind = 1; base = k; ldc = 1024; colt = (pn - 4) * 256; }
        else if (pn < 12) { kind = 2; base = v; ldc = 1024; colt = (pn - 8) * 256; }
        else if (pn < 14) { kind = 2; base = u; ldc = 512; colt = (pn - 12) * 256; }
        else if (pn < 18) { kind = 3; base = ga; ldc = 1024; colt = (pn - 14) * 256; }
        else { kind = 3; base = gb; ldc = 1024; colt = (pn - 18) * 256; }
        const int col0 = colt + wc * 32 + 8 * fq;
        const bool ropew = (kind <= 1) && ((wc & 1) == 0);
        const bool rl = fq < 2;
#pragma unroll
        for (int ai = 0; ai < 2; ++ai)
#pragma unroll
            for (int m = 0; m < 4; ++m) {
                const int row = row0 + ai * HALF + m * 16; bf16_t* rowp = base + (size_t)row * ldc + col0;
                f32x4 cs = {1.f, 1.f, 1.f, 1.f}, sn = {0.f, 0.f, 0.f, 0.f};
                if (ropew && rl) { const f32x4* rp = (const f32x4*)(rope + (size_t)row * 16); cs = rp[fq]; sn = rp[2 + fq]; }
#pragma unroll
                for (int bj = 0; bj < 2; ++bj) {
                    f32x4 v0 = acc[ai][bj][m][0], v1 = acc[ai][bj][m][1];
                    if (ropew) {
                        const f32x4 r0 = {v0[0] * cs[0] - v0[1] * sn[0], v0[1] * cs[0] + v0[0] * sn[0], v0[2] * cs[1] - v0[3] * sn[1], v0[3] * cs[1] + v0[2] * sn[1]};
                        const f32x4 r1 = {v1[0] * cs[2] - v1[1] * sn[2], v1[1] * cs[2] + v1[0] * sn[2], v1[2] * cs[3] - v1[3] * sn[3], v1[3] * cs[3] + v1[2] * sn[3]};
                        v0 = r0; v1 = r1;
                    }
                    if (kind == 0) { v0 = v0 * QSCALE; v1 = v1 * QSCALE; }
                    if (kind == 3) {
#pragma unroll
                        for (int x = 0; x < 4; ++x) { v0[x] = sigm(v0[x]); v1[x] = sigm(v1[x]); } }
                    *(u32x4*)(rowp + bj * HALF) = pack8(v0, v1);
                }
            }
    }
};
struct EpiPool {
    static constexpr bool PERM = true;
    bf16_t* p; const float* scale;
    __device__ __forceinline__ void operator()(const f32x4 (&acc)[2][2][4][2], const Unit& un, int wr, int wc, int fr, int fq) const {
        const int row0 = un.pm * BM + wr * 64 + fr, col0 = un.pn * BM + wc * 32 + 8 * fq;
        f32x4 sv[2][2];
#pragma unroll
        for (int bj = 0; bj < 2; ++bj) { sv[bj][0] = *(const f32x4*)(scale + col0 + bj * HALF); sv[bj][1] = *(const f32x4*)(scale + col0 + bj * HALF + 4); }
#pragma unroll
        for (int ai = 0; ai < 2; ++ai)
#pragma unroll
            for (int m = 0; m < 4; ++m) { bf16_t* rowp = p + (size_t)(row0 + ai * HALF + m * 16) * PW + col0;
#pragma unroll
                for (int bj = 0; bj < 2; ++bj) *(u32x4*)(rowp + bj * HALF) = pack8(acc[ai][bj][m][0] * sv[bj][0], acc[ai][bj][m][1] * sv[bj][1]); }
    }
};
struct EpiGateY {
    static constexpr bool PERM = true;
    bf16_t* Y; const bf16_t* ga;
    __device__ __forceinline__ void operator()(const f32x4 (&acc)[2][2][4][2], const Unit& un, int wr, int wc, int fr, int fq) const {
        const int row0 = un.pm * BM + wr * 64 + fr, col0 = un.pn * BM + wc * 32 + 8 * fq;
#pragma unroll
        for (int ai = 0; ai < 2; ++ai)
#pragma unroll
            for (int m = 0; m < 4; ++m) { const size_t off = (size_t)(row0 + ai * HALF + m * 16) * D + col0;
#pragma unroll
                for (int bj = 0; bj < 2; ++bj) { const u32x4 g = *(const u32x4*)(ga + off + bj * HALF);
                    const f32x4 g0 = {bflo(g.x), bfhi(g.x), bflo(g.y), bfhi(g.y)}, g1 = {bflo(g.z), bfhi(g.z), bflo(g.w), bfhi(g.w)};
                    *(u32x4*)(Y + off + bj * HALF) = pack8(acc[ai][bj][m][0] * g0, acc[ai][bj][m][1] * g1); } }
    }
};
struct EpiGateAdd {
    static constexpr bool PERM = true;
    const bf16_t* Y; const bf16_t* gb; bf16_t* mi;
    __device__ __forceinline__ void operator()(const f32x4 (&acc)[2][2][4][2], const Unit& un, int wr, int wc, int fr, int fq) const {
        const int row0 = un.pm * BM + wr * 64 + fr, col0 = un.pn * BM + wc * 32 + 8 * fq;
#pragma unroll
        for (int ai = 0; ai < 2; ++ai)
#pragma unroll
            for (int m = 0; m < 4; ++m) { const size_t off = (size_t)(row0 + ai * HALF + m * 16) * D + col0;
#pragma unroll
                for (int bj = 0; bj < 2; ++bj) { const u32x4 g = *(const u32x4*)(gb + off + bj * HALF), y = *(const u32x4*)(Y + off + bj * HALF);
                    const f32x4 g0 = {bflo(g.x), bfhi(g.x), bflo(g.y), bfhi(g.y)}, g1 = {bflo(g.z), bfhi(g.z), bflo(g.w), bfhi(g.w)};
                    const f32x4 y0 = {bflo(y.x), bfhi(y.x), bflo(y.y), bfhi(y.y)}, y1 = {bflo(y.z), bfhi(y.z), bflo(y.w), bfhi(y.w)};
                    *(u32x4*)(mi + off + bj * HALF) = pack8(y0 + acc[ai][bj][m][0] * g0, y1 + acc[ai][bj][m][1] * g1); } }
    }
};
struct EpiChain {
    static constexpr bool PERM = true;
    const bf16_t* ga; const bf16_t* gb; bf16_t* mi;
    __device__ __forceinline__ void mid(f32x4 (&acc)[2][2][4][2], const Unit& un, int wr, int wc, int fr, int fq, const bool zero) const {
        const int row0 = un.pm * BM + wr * 64 + fr, col0 = un.pn * BM + wc * 32 + 8 * fq;
#pragma unroll
        for (int ai = 0; ai < 2; ++ai)
#pragma unroll
            for (int m = 0; m < 4; ++m) { const size_t off = (size_t)(row0 + ai * HALF + m * 16) * D + col0;
#pragma unroll
                for (int bj = 0; bj < 2; ++bj) { f32x4 f0 = {0.f, 0.f, 0.f, 0.f}, f1 = f0;
                    if (!zero) { const u32x4 a = *(const u32x4*)(ga + off + bj * HALF), b = *(const u32x4*)(gb + off + bj * HALF);
                        f32x4 a0 = {bflo(a.x), bfhi(a.x), bflo(a.y), bfhi(a.y)}, a1 = {bflo(a.z), bfhi(a.z), bflo(a.w), bfhi(a.w)};
                        const f32x4 b0 = {bflo(b.x), bfhi(b.x), bflo(b.y), bfhi(b.y)}, b1 = {bflo(b.z), bfhi(b.z), bflo(b.w), bfhi(b.w)};
#pragma unroll
                        for (int x = 0; x < 4; ++x) { a0[x] = __builtin_amdgcn_rcpf(fmaxf(a0[x], 1e-20f)); a1[x] = __builtin_amdgcn_rcpf(fmaxf(a1[x], 1e-20f)); }
                        f0 = b0 * a0; f1 = b1 * a1; }
                    acc[ai][bj][m][0] = acc[ai][bj][m][0] * f0; acc[ai][bj][m][1] = acc[ai][bj][m][1] * f1; }
                asm volatile("" : "+v"(acc[ai][0][m][0]), "+v"(acc[ai][0][m][1]), "+v"(acc[ai][1][m][0]), "+v"(acc[ai][1][m][1]) :: "memory"); }
    }
    __device__ __forceinline__ void operator()(const f32x4 (&acc)[2][2][4][2], const Unit& un, int wr, int wc, int fr, int fq) const {
        const int row0 = un.pm * BM + wr * 64 + fr, col0 = un.pn * BM + wc * 32 + 8 * fq;
#pragma unroll
        for (int ai = 0; ai < 2; ++ai)
#pragma unroll
            for (int m = 0; m < 4; ++m) { const size_t off = (size_t)(row0 + ai * HALF + m * 16) * D + col0;
#pragma unroll
                for (int bj = 0; bj < 2; ++bj) { const u32x4 a = *(const u32x4*)(ga + off + bj * HALF);
                    const f32x4 a0 = {bflo(a.x), bfhi(a.x), bflo(a.y), bfhi(a.y)}, a1 = {bflo(a.z), bfhi(a.z), bflo(a.w), bfhi(a.w)};
                    *(u32x4*)(mi + off + bj * HALF) = pack8(acc[ai][bj][m][0] * a0, acc[ai][bj][m][1] * a1); } }
    }
};
struct EpiBf16Plain {
    static constexpr bool PERM = true;
    bf16_t* O;
    __device__ __forceinline__ void operator()(const f32x4 (&acc)[2][2][4][2], const Unit& un, int wr, int wc, int fr, int fq) const {
        const int row0 = un.pm * BM + wr * 64 + fr, col0 = un.pn * BM + wc * 32 + 8 * fq;
#pragma unroll
        for (int ai = 0; ai < 2; ++ai)
#pragma unroll
            for (int m = 0; m < 4; ++m) { const size_t off = (size_t)(row0 + ai * HALF + m * 16) * D + col0;
#pragma unroll
                for (int bj = 0; bj < 2; ++bj) *(u32x4*)(O + off + bj * HALF) = pack8(acc[ai][bj][m][0], acc[ai][bj][m][1]); }
    }
};
struct EpiSwiglu {
    static constexpr bool PERM = true;
    unsigned char* a; const float* b1;
    __device__ __forceinline__ void operator()(const f32x4 (&acc)[2][2][4][2], const Unit& un, int wr, int wc, int fr, int fq) const {
        const int row0 = un.pm * BM + wr * 64 + fr, j0 = un.pn * HALF + wc * 32 + 8 * fq;
        const f32x4* bp = (const f32x4*)(b1 + (size_t)un.e * 2 * FF + 2 * j0);
        const f32x4 b0 = bp[0], b1v = bp[1], b2 = bp[2], b3 = bp[3];
        const f32x4 bg0 = {b0[0], b0[2], b1v[0], b1v[2]}, bu0 = {b0[1], b0[3], b1v[1], b1v[3]}, bg1 = {b2[0], b2[2], b3[0], b3[2]}, bu1 = {b2[1], b2[3], b3[1], b3[3]};
#pragma unroll
        for (int ai = 0; ai < 2; ++ai)
#pragma unroll
            for (int m = 0; m < 4; ++m) {
                f32x4 o[2];
#pragma unroll
                for (int n = 0; n < 2; ++n) {
                    f32x4 g = acc[ai][0][m][n] * W8_INV + (n ? bg1 : bg0), up = acc[ai][1][m][n] * W8_INV + (n ? bu1 : bu0), e, r;
#pragma unroll
                    for (int x = 0; x < 4; ++x) { g[x] = fminf(g[x], SW_LIMIT); up[x] = __builtin_amdgcn_fmed3f(up[x], -SW_LIMIT, SW_LIMIT); }
                    const f32x4 ex = g * (-SW_ALPHA * 1.4426950408889634f);
#pragma unroll
                    for (int x = 0; x < 4; ++x) e[x] = __builtin_amdgcn_exp2f(ex[x]);
                    e = e + 1.f;
#pragma unroll
                    for (int x = 0; x < 4; ++x) r[x] = __builtin_amdgcn_rcpf(e[x]);
                    const f32x4 gs = g * r; o[n] = gs * up + gs; }
                *(u32x2*)(a + (size_t)(row0 + ai * HALF + m * 16) * FF + j0) = pack8_fp8(o[0], o[1]);
            }
    }
};
constexpr float YE_SCALE = 4.f, YE_INV = 0.25f;
struct EpiYe {
    static constexpr bool PERM = true;
    unsigned char* ye; const float* b2;
    __device__ __forceinline__ void operator()(const f32x4 (&acc)[2][2][4][2], const Unit& un, int wr, int wc, int fr, int fq) const {
        const int row0 = un.pm * BM + wr * 64 + fr, col0 = un.pn * BM + wc * 32 + 8 * fq;
        f32x4 bv[2][2];
#pragma unroll
        for (int bj = 0; bj < 2; ++bj) { bv[bj][0] = *(const f32x4*)(b2 + (size_t)un.e * D + col0 + bj * HALF); bv[bj][1] = *(const f32x4*)(b2 + (size_t)un.e * D + col0 + bj * HALF + 4); }
#pragma unroll
        for (int ai = 0; ai < 2; ++ai)
#pragma unroll
            for (int m = 0; m < 4; ++m) { unsigned char* rowp = ye + (size_t)(row0 + ai * HALF + m * 16) * D + col0;
#pragma unroll
                for (int bj = 0; bj < 2; ++bj) *(u32x2*)(rowp + bj * HALF) = pack8_fp8((acc[ai][bj][m][0] * W8_INV + bv[bj][0]) * YE_SCALE, (acc[ai][bj][m][1] * W8_INV + bv[bj][1]) * YE_SCALE); }
    }
};

template <class Epi, class Sched, bool ALIGN_EPI, bool GATHER, bool FP8 = false>
__device__ __forceinline__ void gemm_phase(PG8_LAS unsigned char* lds, const Gemm g, const Sched& S, const Epi& E, const PG8_LAS int* gtab) {
    int tid_ = (int)threadIdx.x; asm volatile("" : "+v"(tid_));
    const int tid = tid_, wid = __builtin_amdgcn_readfirstlane(tid >> 6), lane = tid & 63, wr = wid >> 2, wc = wid & 3, fr = lane & 15, fq = lane >> 4;
    const int K = g.K, nt = K / BK;
    unsigned voffB[2];
#pragma unroll
    for (int i = 0; i < 2; ++i) { int R, C; stage_rc(tid * 16 + i * 8192, R, C); const int Rb = Epi::PERM ? ((R & ~31) + perm32(R & 31)) : R; voffB[i] = (unsigned)(Rb * K + C) * 2u; }
    const size_t kstep = (size_t)(BK * 2);
    const size_t hstep = (size_t)HALF * K * 2;
    const size_t tstep = 2 * hstep;
    const unsigned ldsw = (unsigned)wid * 1024u;
    const int aoff = lds_byte(wr * 64 + fr, fq * 8), boff = lds_byte(wc * 32 + fr, fq * 8);
#define PG8_SA(b, h) (((b) * 2 + (h)) * HTB)
#define PG8_SB(b, h) ((4 + (b) * 2 + (h)) * HTB)
#define PG8_STAGE(bufoff, gbase, voff) do { _Pragma("unroll") for (int _i = 0; _i < 2; ++_i) \
        __builtin_amdgcn_global_load_lds((const unsigned*)((const char*)(gbase) + (voff)[_i]), (PG8_LAS unsigned*)(lds + (bufoff) + ldsw + _i * 8192), 16, 0, 0); } while (0)
#define PG8_LDA(dst, b, h) do { _Pragma("unroll") for (int m = 0; m < 4; ++m) _Pragma("unroll") for (int k = 0; k < 2; ++k) dst[m][k] = *(const PG8_LAS bf16x8*)(lds + PG8_SA(b, h) + aoff + m * 2048 + k * 1024); } while (0)
#define PG8_LDB(dst, b, h) do { _Pragma("unroll") for (int n = 0; n < 2; ++n) _Pragma("unroll") for (int k = 0; k < 2; ++k) dst[n][k] = *(const PG8_LAS bf16x8*)(lds + PG8_SB(b, h) + boff + n * 2048 + k * 1024); } while (0)
#define PG8_MMA(ai, bj, At, Bt) do { __builtin_amdgcn_s_setprio(1); if constexpr (FP8) { _Pragma("unroll") for (int m = 0; m < 4; ++m) _Pragma("unroll") for (int n = 0; n < 2; ++n) \
        mfma_fp8(acc[ai][bj][m][n], cat8(Bt[n][0], Bt[n][1]), cat8(At[m][0], At[m][1])); } else { \
        _Pragma("unroll") for (int m = 0; m < 4; ++m) _Pragma("unroll") for (int n = 0; n < 2; ++n) _Pragma("unroll") for (int k = 0; k < 2; ++k) \
        acc[ai][bj][m][n] = __builtin_amdgcn_mfma_f32_16x16x32_bf16(Bt[n][k], At[m][k], acc[ai][bj][m][n], 0, 0, 0); } __builtin_amdgcn_s_setprio(0); } while (0)
#define PG8_WAIT_V(n) asm volatile("s_waitcnt vmcnt(" #n ")" ::: "memory")
#define PG8_WAIT_L(n) asm volatile("s_waitcnt lgkmcnt(" #n ")" ::: "memory")
#define PG8_BAR __builtin_amdgcn_s_barrier()
#define PG8_SCHED __builtin_amdgcn_sched_barrier(0)
#define PG8_AOFF(dst, u, uidx) do { _Pragma("unroll") for (int _i = 0; _i < 2; ++_i) { int _R, _C; stage_rc(tid * 16 + _i * 8192, _R, _C); _Pragma("unroll") for (int _h = 0; _h < 2; ++_h) { \
        const int _row = GATHER ? gtab[(uidx) * 256 + _h * HALF + _R] : ((u).pm * BM + _h * HALF + _R); dst[_h][_i] = (unsigned)(_row * K + _C) * 2u; } } } while (0)
    Unit cur, nxt; int ui = 0;
    if (!S.next(0, cur)) return;
    f32x4 acc[2][2][4][2];
#pragma unroll
    for (int a = 0; a < 2; ++a)
#pragma unroll
        for (int b = 0; b < 2; ++b)
#pragma unroll
            for (int m = 0; m < 4; ++m)
#pragma unroll
                for (int n = 0; n < 2; ++n) acc[a][b][m][n] = (f32x4){0.f, 0.f, 0.f, 0.f};
    bf16x8 At[4][2], B0[2][2], B1[2][2];
    unsigned vAc[2][2], vAn[2][2];
    const char* const Ab = (const char*)g.A;
    const char* cB = (const char*)g.Bt + (size_t)cur.e * g.bstride + (size_t)cur.pn * tstep;
    PG8_AOFF(vAc, cur, 0);
    PG8_STAGE(PG8_SB(0, 0), cB, voffB); PG8_STAGE(PG8_SB(0, 1), cB + hstep, voffB); PG8_STAGE(PG8_SA(0, 0), Ab, vAc[0]); PG8_STAGE(PG8_SA(0, 1), Ab, vAc[1]);
    if (wr == 1) PG8_BAR;
    PG8_WAIT_V(2); PG8_BAR;
    PG8_STAGE(PG8_SB(1, 0), cB + kstep, voffB); PG8_STAGE(PG8_SA(1, 0), Ab + kstep, vAc[0]); PG8_STAGE(PG8_SB(1, 1), cB + hstep + kstep, voffB);
    PG8_WAIT_V(6); PG8_BAR;
    for (;;) {
        const bool has_next = S.next(ui + 1, nxt);
        const char* nB = has_next ? (const char*)g.Bt + (size_t)nxt.e * g.bstride + (size_t)nxt.pn * tstep : cB;
        if (has_next) { PG8_AOFF(vAn, nxt, ui + 1); }
        else {
#pragma unroll
            for (int h = 0; h < 2; ++h)
#pragma unroll
                for (int i = 0; i < 2; ++i) vAn[h][i] = vAc[h][i]; }
        _Pragma("nounroll") for (int t = 0; t < nt; t += 2) {
            const bool last = (t == nt - 2);
            const char* a1 = Ab + (size_t)(t + 1) * kstep;
            const char* a2 = last ? Ab : Ab + (size_t)(t + 2) * kstep; const char* b2 = last ? nB : cB + (size_t)(t + 2) * kstep;
            const char* a3 = a2 + kstep; const char* b3 = b2 + kstep;
            unsigned s0[2], s1[2];
#pragma unroll
            for (int i = 0; i < 2; ++i) { s0[i] = last ? vAn[0][i] : vAc[0][i]; s1[i] = last ? vAn[1][i] : vAc[1][i]; }
            PG8_LDB(B0, 0, 0); PG8_LDB(B1, 0, 1); PG8_SCHED; PG8_LDA(At, 0, 0); PG8_STAGE(PG8_SA(1, 1), a1, vAc[1]);
            PG8_WAIT_V(8); PG8_WAIT_L(0); PG8_BAR; PG8_MMA(0, 0, At, B0); PG8_MMA(0, 1, At, B1); PG8_BAR; PG8_SCHED;
            PG8_LDA(At, 0, 1); PG8_STAGE(PG8_SB(0, 0), b2, voffB); PG8_STAGE(PG8_SB(0, 1), b2 + hstep, voffB); PG8_STAGE(PG8_SA(0, 0), a2, s0);
            PG8_WAIT_V(8); PG8_WAIT_L(0); PG8_BAR; PG8_MMA(1, 0, At, B0); PG8_MMA(1, 1, At, B1); PG8_BAR; PG8_SCHED;
            PG8_LDB(B0, 1, 0); PG8_LDB(B1, 1, 1); PG8_SCHED; PG8_LDA(At, 1, 0); PG8_STAGE(PG8_SA(0, 1), a2, s1);
            PG8_WAIT_V(8); PG8_WAIT_L(0); PG8_BAR; PG8_MMA(0, 0, At, B0); PG8_MMA(0, 1, At, B1); PG8_BAR; PG8_SCHED;
            PG8_LDA(At, 1, 1); PG8_STAGE(PG8_SB(1, 0), b3, voffB); PG8_STAGE(PG8_SB(1, 1), b3 + hstep, voffB); PG8_STAGE(PG8_SA(1, 0), a3, s0);
            PG8_WAIT_V(8); PG8_WAIT_L(0); PG8_BAR; PG8_MMA(1, 0, At, B0); PG8_MMA(1, 1, At, B1); PG8_BAR; PG8_SCHED;
        }
        if constexpr (ALIGN_EPI) { if (wr == 0) PG8_BAR; }
        if constexpr (FP8) asm volatile("s_nop 15\n\ts_nop 15" ::: "memory");
        E(acc, cur, wr, wc, fr, fq);
        if (!has_next) break;
#pragma unroll
        for (int a = 0; a < 2; ++a)
#pragma unroll
            for (int b = 0; b < 2; ++b)
#pragma unroll
                for (int m = 0; m < 4; ++m)
#pragma unroll
                    for (int n = 0; n < 2; ++n) acc[a][b][m][n] = (f32x4){0.f, 0.f, 0.f, 0.f};
        cur = nxt; cB = nB; ++ui;
#pragma unroll
        for (int h = 0; h < 2; ++h)
#pragma unroll
            for (int i = 0; i < 2; ++i) vAc[h][i] = vAn[h][i];
        if constexpr (ALIGN_EPI) { if (wr == 1) PG8_BAR; }
    }
    PG8_WAIT_V(0);
    if constexpr (!ALIGN_EPI) { if (wr == 0) PG8_BAR; }
    PG8_BAR;
#undef PG8_SA
#undef PG8_SB
#undef PG8_STAGE
#undef PG8_LDA
#undef PG8_LDB
#undef PG8_MMA
#undef PG8_WAIT_V
#undef PG8_WAIT_L
#undef PG8_BAR
#undef PG8_SCHED
#undef PG8_AOFF
}
struct Gemm2 { const bf16_t* A0; const bf16_t* Bt0; const bf16_t* A1; const bf16_t* Bt1; int K0, K1; };
template <class Epi, class Sched>
__device__ __forceinline__ void gemm_chain2(PG8_LAS unsigned char* lds, const Gemm2 g, const Sched& S, const Epi& E) {
    constexpr bool ALIGN_EPI = true, GATHER = false, FP8 = false; const PG8_LAS int* gtab = nullptr; (void)gtab;
    int tid_ = (int)threadIdx.x; asm volatile("" : "+v"(tid_));
    const int tid = tid_, wid = __builtin_amdgcn_readfirstlane(tid >> 6), lane = tid & 63, wr = wid >> 2, wc = wid & 3, fr = lane & 15, fq = lane >> 4;
#define PG8_VOFFB(dst, Kx) do { _Pragma("unroll") for (int _i = 0; _i < 2; ++_i) { int _R, _C; stage_rc(tid * 16 + _i * 8192, _R, _C); const int _Rb = Epi::PERM ? ((_R & ~31) + perm32(_R & 31)) : _R; dst[_i] = (unsigned)(_Rb * (Kx) + _C) * 2u; } } while (0)
    int Kc = g.K0, Kn = g.K1, segc = 0;
    unsigned voffB[2], voffBn[2];
    PG8_VOFFB(voffB, Kc);
    const size_t kstep = (size_t)(BK * 2);
    size_t hstep = (size_t)HALF * Kc * 2, hstepn = hstep;
    const char* Ab = (const char*)g.A0; const char* Abn = Ab;
    const unsigned ldsw = (unsigned)wid * 1024u;
    const int aoff = lds_byte(wr * 64 + fr, fq * 8), boff = lds_byte(wc * 32 + fr, fq * 8);
#define PG8_SA(b, h) (((b) * 2 + (h)) * HTB)
#define PG8_SB(b, h) ((4 + (b) * 2 + (h)) * HTB)
#define PG8_STAGE(bufoff, gbase, voff) do { _Pragma("unroll") for (int _i = 0; _i < 2; ++_i) \
        __builtin_amdgcn_global_load_lds((const unsigned*)((const char*)(gbase) + (voff)[_i]), (PG8_LAS unsigned*)(lds + (bufoff) + ldsw + _i * 8192), 16, 0, 0); } while (0)
#define PG8_LDA(dst, b, h) do { _Pragma("unroll") for (int m = 0; m < 4; ++m) _Pragma("unroll") for (int k = 0; k < 2; ++k) dst[m][k] = *(const PG8_LAS bf16x8*)(lds + PG8_SA(b, h) + aoff + m * 2048 + k * 1024); } while (0)
#define PG8_LDB(dst, b, h) do { _Pragma("unroll") for (int n = 0; n < 2; ++n) _Pragma("unroll") for (int k = 0; k < 2; ++k) dst[n][k] = *(const PG8_LAS bf16x8*)(lds + PG8_SB(b, h) + boff + n * 2048 + k * 1024); } while (0)
#define PG8_MMA(ai, bj, At, Bt) do { __builtin_amdgcn_s_setprio(1); if constexpr (FP8) { _Pragma("unroll") for (int m = 0; m < 4; ++m) _Pragma("unroll") for (int n = 0; n < 2; ++n) \
        mfma_fp8(acc[ai][bj][m][n], cat8(Bt[n][0], Bt[n][1]), cat8(At[m][0], At[m][1])); } else { \
        _Pragma("unroll") for (int m = 0; m < 4; ++m) _Pragma("unroll") for (int n = 0; n < 2; ++n) _Pragma("unroll") for (int k = 0; k < 2; ++k) \
        acc[ai][bj][m][n] = __builtin_amdgcn_mfma_f32_16x16x32_bf16(Bt[n][k], At[m][k], acc[ai][bj][m][n], 0, 0, 0); } __builtin_amdgcn_s_setprio(0); } while (0)
#define PG8_WAIT_V(n) asm volatile("s_waitcnt vmcnt(" #n ")" ::: "memory")
#define PG8_WAIT_L(n) asm volatile("s_waitcnt lgkmcnt(" #n ")" ::: "memory")
#define PG8_BAR __builtin_amdgcn_s_barrier()
#define PG8_SCHED __builtin_amdgcn_sched_barrier(0)
#define PG8_AOFF(dst, u, uidx) do { _Pragma("unroll") for (int _i = 0; _i < 2; ++_i) { int _R, _C; stage_rc(tid * 16 + _i * 8192, _R, _C); _Pragma("unroll") for (int _h = 0; _h < 2; ++_h) { \
        const int _row = (u).pm * BM + _h * HALF + _R; dst[_h][_i] = (unsigned)(_row * (uidx) + _C) * 2u; } } } while (0)
    Unit cur, nxt; int ui = 0;
    if (!S.next(0, cur)) return;
    f32x4 acc[2][2][4][2];
#pragma unroll
    for (int a = 0; a < 2; ++a)
#pragma unroll
        for (int b = 0; b < 2; ++b)
#pragma unroll
            for (int m = 0; m < 4; ++m)
#pragma unroll
                for (int n = 0; n < 2; ++n) acc[a][b][m][n] = (f32x4){0.f, 0.f, 0.f, 0.f};
    bf16x8 At[4][2], B0[2][2], B1[2][2];
    unsigned vAc[2][2], vAn[2][2];
    const char* cB = (const char*)g.Bt0 + (size_t)cur.pn * 2 * hstep;
    PG8_AOFF(vAc, cur, Kc);
    PG8_STAGE(PG8_SB(0, 0), cB, voffB); PG8_STAGE(PG8_SB(0, 1), cB + hstep, voffB); PG8_STAGE(PG8_SA(0, 0), Ab, vAc[0]); PG8_STAGE(PG8_SA(0, 1), Ab, vAc[1]);
    if (wr == 1) PG8_BAR;
    PG8_WAIT_V(2); PG8_BAR;
    PG8_STAGE(PG8_SB(1, 0), cB + kstep, voffB); PG8_STAGE(PG8_SA(1, 0), Ab + kstep, vAc[0]); PG8_STAGE(PG8_SB(1, 1), cB + hstep + kstep, voffB);
    PG8_WAIT_V(6); PG8_BAR;
    for (;;) {
        bool has_next; const char* nB;
        if (segc == 0) { has_next = true; nxt = cur; Kn = g.K1; Abn = (const char*)g.A1; hstepn = (size_t)HALF * Kn * 2; nB = (const char*)g.Bt1 + (size_t)cur.pn * 2 * hstepn; PG8_VOFFB(voffBn, Kn); PG8_AOFF(vAn, cur, Kn); }
        else { has_next = S.next(ui + 1, nxt);
            if (has_next) { Kn = g.K0; Abn = (const char*)g.A0; hstepn = (size_t)HALF * Kn * 2; nB = (const char*)g.Bt0 + (size_t)nxt.pn * 2 * hstepn; PG8_VOFFB(voffBn, Kn); PG8_AOFF(vAn, nxt, Kn); }
            else { Kn = Kc; Abn = Ab; hstepn = hstep; nB = cB;
#pragma unroll
                for (int h = 0; h < 2; ++h)
#pragma unroll
                    for (int i = 0; i < 2; ++i) vAn[h][i] = vAc[h][i];
#pragma unroll
                for (int i = 0; i < 2; ++i) voffBn[i] = voffB[i]; } }
        const int nt = Kc / BK;
        _Pragma("nounroll") for (int t = 0; t < nt; t += 2) {
            const bool last = (t == nt - 2);
            const char* a1 = Ab + (size_t)(t + 1) * kstep;
            const char* a2 = last ? Abn : Ab + (size_t)(t + 2) * kstep; const char* b2 = last ? nB : cB + (size_t)(t + 2) * kstep;
            const size_t h2 = last ? hstepn : hstep; unsigned vB2[2];
#pragma unroll
            for (int i = 0; i < 2; ++i) vB2[i] = last ? voffBn[i] : voffB[i];
            const char* a3 = a2 + kstep; const char* b3 = b2 + kstep;
            unsigned s0[2], s1[2];
#pragma unroll
            for (int i = 0; i < 2; ++i) { s0[i] = last ? vAn[0][i] : vAc[0][i]; s1[i] = last ? vAn[1][i] : vAc[1][i]; }
            PG8_LDB(B0, 0, 0); PG8_LDB(B1, 0, 1); PG8_SCHED; PG8_LDA(At, 0, 0); PG8_STAGE(PG8_SA(1, 1), a1, vAc[1]);
            PG8_WAIT_V(8); PG8_WAIT_L(0); PG8_BAR; PG8_MMA(0, 0, At, B0); PG8_MMA(0, 1, At, B1); PG8_BAR; PG8_SCHED;
            PG8_LDA(At, 0, 1); PG8_STAGE(PG8_SB(0, 0), b2, vB2); PG8_STAGE(PG8_SB(0, 1), b2 + h2, vB2); PG8_STAGE(PG8_SA(0, 0), a2, s0);
            PG8_WAIT_V(8); PG8_WAIT_L(0); PG8_BAR; PG8_MMA(1, 0, At, B0); PG8_MMA(1, 1, At, B1); PG8_BAR; PG8_SCHED;
            PG8_LDB(B0, 1, 0); PG8_LDB(B1, 1, 1); PG8_SCHED; PG8_LDA(At, 1, 0); PG8_STAGE(PG8_SA(0, 1), a2, s1);
            PG8_WAIT_V(8); PG8_WAIT_L(0); PG8_BAR; PG8_MMA(0, 0, At, B0); PG8_MMA(0, 1, At, B1); PG8_BAR; PG8_SCHED;
            PG8_LDA(At, 1, 1); PG8_STAGE(PG8_SB(1, 0), b3, vB2); PG8_STAGE(PG8_SB(1, 1), b3 + h2, vB2); PG8_STAGE(PG8_SA(1, 0), a3, s0);
            PG8_WAIT_V(8); PG8_WAIT_L(0); PG8_BAR; PG8_MMA(1, 0, At, B0); PG8_MMA(1, 1, At, B1); PG8_BAR; PG8_SCHED;
        }
        if constexpr (ALIGN_EPI) { if (wr == 0) PG8_BAR; }
        if (segc == 1) { E(acc, cur, wr, wc, fr, fq); if (!has_next) break; }
        E.mid(acc, cur, wr, wc, fr, fq, segc == 1);
        if (segc == 1) { cur = nxt; ++ui; }
        segc ^= 1; Kc = Kn; Ab = Abn; hstep = hstepn; cB = nB;
#pragma unroll
        for (int i = 0; i < 2; ++i) voffB[i] = voffBn[i];
#pragma unroll
        for (int h = 0; h < 2; ++h)
#pragma unroll
            for (int i = 0; i < 2; ++i) vAc[h][i] = vAn[h][i];
        if constexpr (ALIGN_EPI) { if (wr == 1) PG8_BAR; }
    }
    PG8_WAIT_V(0);
    if constexpr (!ALIGN_EPI) { if (wr == 0) PG8_BAR; }
    PG8_BAR;
#undef PG8_SA
#undef PG8_SB
#undef PG8_STAGE
#undef PG8_LDA
#undef PG8_LDB
#undef PG8_MMA
#undef PG8_WAIT_V
#undef PG8_WAIT_L
#undef PG8_BAR
#undef PG8_SCHED
#undef PG8_AOFF
#undef PG8_VOFFB
}
}
#include <hip/hip_bf16.h>
#include <cmath>
namespace attn_body {
using bf16=__hip_bfloat16;
using bf16x8=__attribute__((ext_vector_type(8)))short;
using s16x4=__attribute__((ext_vector_type(4)))short;
using f32x16=__attribute__((ext_vector_type(16)))float;
using u32x4=__attribute__((ext_vector_type(4)))unsigned;
constexpr int BATCH=8,NHEAD=16,SEQ=2048,D=64,DM=NHEAD*D;
constexpr int NW=8,QBLK=32,QB=QBLK*NW,KVBLK=64,NQB=SEQ/QB;
constexpr int ATTN_PITCH=DM, ATTN_UNIT_ROWS=QB;
__device__ __forceinline__ int crow(int r,int hi){return (r&3)+8*(r>>2)+4*hi;}
#define SBAR() __builtin_amdgcn_sched_barrier(0)
__device__ __forceinline__ void cmask(f32x16&p0,f32x16&p1,int jb,int qrel,int hi){
  const float NEG=-INFINITY; int kb=64*jb+4*hi;
  #pragma unroll
  for(int r=0;r<16;++r){int kv=kb+(r&3)+8*(r>>2); if(kv>qrel)p0[r]=NEG; if(kv+32>qrel)p1[r]=NEG;}
}

constexpr int NSLOT=3, SLOTB=8192;
constexpr int LDS_K=0, LDS_V=NSLOT*SLOTB, LDS_WS=2*NSLOT*SLOTB, LDS_OST=LDS_WS+NW*64*4, LDS_BYTES=LDS_OST+NW*4096;
constexpr float C2=0.125f*1.4426950408889634f;
__device__ __forceinline__ void glds16(const void*gsrc,unsigned lds_dst){unsigned keep;
  asm volatile("s_mov_b32 %0, m0\n\ts_mov_b32 m0, %2\n\ts_nop 0\n\tglobal_load_lds_dwordx4 %1, off\n\ts_mov_b32 m0, %0":"=&s"(keep):"v"(gsrc),"s"(lds_dst):"memory");}
__device__ __forceinline__ float max3f(float a,float b,float c){float r;asm("v_max3_f32 %0, %1, %2, %3":"=v"(r):"v"(a),"v"(b),"v"(c));return r;}
__device__ __forceinline__ float max2f(float a,float b){float r;asm("v_max_f32_e32 %0, %1, %2":"=v"(r):"v"(a),"v"(b));return r;}
__device__ __forceinline__ float fadd_s(float a,float b){float r;asm("v_add_f32_e32 %0, %1, %2":"=v"(r):"v"(a),"v"(b));return r;}
__device__ __forceinline__ float fsub_s(float a,float b){float r;asm("v_sub_f32_e32 %0, %1, %2":"=v"(r):"v"(a),"v"(b));return r;}
typedef float f32x2_t __attribute__((ext_vector_type(2))); typedef __bf16 bf16x2_t __attribute__((ext_vector_type(2)));
__device__ __forceinline__ unsigned cvtpk_s(float lo,float hi){f32x2_t v={lo,hi};bf16x2_t b=__builtin_convertvector(v,bf16x2_t);return __builtin_bit_cast(unsigned,b);}
#define WAIT_BAR(N) asm volatile("s_waitcnt vmcnt(" #N ") lgkmcnt(0)\n\ts_barrier":::"memory")

__device__ __forceinline__ void qkt(f32x16&p0,f32x16&p1,const char*Kslot,const bf16x8*qr,const f32x16&negm,int r32,int hi){
  const char*kb=Kslot+hi*1024+r32*16;
  #pragma unroll
  for(int d0=0;d0<4;++d0){
    const bf16x8 b0=*reinterpret_cast<const bf16x8*>(kb+d0*2048);
    const bf16x8 b1=*reinterpret_cast<const bf16x8*>(kb+d0*2048+512);
    if(d0==0){p0=__builtin_amdgcn_mfma_f32_32x32x16_bf16(b0,qr[0],negm,0,0,0);p1=__builtin_amdgcn_mfma_f32_32x32x16_bf16(b1,qr[0],negm,0,0,0);}
    else{p0=__builtin_amdgcn_mfma_f32_32x32x16_bf16(b0,qr[d0],p0,0,0,0);p1=__builtin_amdgcn_mfma_f32_32x32x16_bf16(b1,qr[d0],p1,0,0,0);}}
}
typedef __attribute__((address_space(3))) const char* lds_cptr;
typedef short v4i16_t __attribute__((ext_vector_type(4)));
__device__ __forceinline__ void kload8(bf16x8*kf,lds_cptr kp){
  kf[0]=*(const __attribute__((address_space(3))) bf16x8*)(kp);      kf[1]=*(const __attribute__((address_space(3))) bf16x8*)(kp+512);
  kf[2]=*(const __attribute__((address_space(3))) bf16x8*)(kp+2048); kf[3]=*(const __attribute__((address_space(3))) bf16x8*)(kp+2560);
  kf[4]=*(const __attribute__((address_space(3))) bf16x8*)(kp+4096); kf[5]=*(const __attribute__((address_space(3))) bf16x8*)(kp+4608);
  kf[6]=*(const __attribute__((address_space(3))) bf16x8*)(kp+6144); kf[7]=*(const __attribute__((address_space(3))) bf16x8*)(kp+6656);
}
__device__ __forceinline__ void kload2(bf16x8*kf,lds_cptr kp,int j){ kf[2*j]=*(const __attribute__((address_space(3))) bf16x8*)(kp+j*2048); kf[2*j+1]=*(const __attribute__((address_space(3))) bf16x8*)(kp+j*2048+512); }
__device__ __forceinline__ s16x4 vtr(lds_cptr p){ return __builtin_bit_cast(s16x4,__builtin_amdgcn_ds_read_tr16_b64_v4i16((__attribute__((address_space(3))) v4i16_t*)p)); }
__device__ __forceinline__ float rowmax(const f32x16&p0,const f32x16&p1){
  float a=max3f(p0[0],p0[1],p1[0]),b=max3f(p0[2],p0[3],p1[1]);a=max3f(a,p1[2],p1[3]);
  #pragma unroll
  for(int r=4;r<16;r+=4){a=max3f(a,p0[r],p0[r+1]);b=max3f(b,p0[r+2],p0[r+3]);a=max3f(a,p1[r],p1[r+1]);b=max3f(b,p1[r+2],p1[r+3]);}
  const float m=max2f(a,b);
  auto rr=__builtin_amdgcn_permlane32_swap(__float_as_uint(m),__float_as_uint(m),false,false);
  return max2f(__uint_as_float(rr[0]),__uint_as_float(rr[1]));
}
__device__ __forceinline__ void pv(f32x16*o,int vb,bf16x8 pa0,bf16x8 pa1,bf16x8 pa2,bf16x8 pa3){
  #pragma unroll
  for(int d0=0;d0<2;++d0){s16x4 lo[4],hi[4];
    #pragma unroll
    for(int ks=0;ks<4;++ks){
      asm volatile("ds_read_b64_tr_b16 %0,%1 offset:%c2":"=&v"(lo[ks]):"v"(vb),"i"(d0*4096+ks*1024):"memory");
      asm volatile("ds_read_b64_tr_b16 %0,%1 offset:%c2":"=&v"(hi[ks]):"v"(vb),"i"(d0*4096+ks*1024+512):"memory");}
    asm volatile("s_waitcnt lgkmcnt(0)":::"memory");SBAR();
    #define PK(k) (bf16x8){lo[k][0],lo[k][1],lo[k][2],lo[k][3],hi[k][0],hi[k][1],hi[k][2],hi[k][3]}
    o[d0]=__builtin_amdgcn_mfma_f32_32x32x16_bf16(pa0,PK(0),o[d0],0,0,0);
    o[d0]=__builtin_amdgcn_mfma_f32_32x32x16_bf16(pa1,PK(1),o[d0],0,0,0);
    o[d0]=__builtin_amdgcn_mfma_f32_32x32x16_bf16(pa2,PK(2),o[d0],0,0,0);
    o[d0]=__builtin_amdgcn_mfma_f32_32x32x16_bf16(pa3,PK(3),o[d0],0,0,0);
    #undef PK
  }
}

#ifndef ATTN_STORE16
#define ATTN_STORE16(p,v) (*(u32x4*)(p)=(v))
#endif
template<int THRL> __device__ __forceinline__ void attn_unit(int b,int h,int hv,int qb,const bf16*Q,const bf16*__restrict__ K,const bf16*__restrict__ V,bf16*O,char*shm){
  int tid_=threadIdx.x; asm volatile("":"+v"(tid_));
  const int tid=tid_,lane=tid&63,r32=lane&31,hi=lane>>5; const int wid=__builtin_amdgcn_readfirstlane(tid>>6);
  const long rowbase=(long)b*SEQ; const int q0=qb*QB;
  const bf16*Qw=Q+(rowbase+q0+wid*QBLK)*DM+h*D;
  const bf16*Kh=K+rowbase*DM+h*D,*Vh=V+rowbase*DM+hv*D;
  const unsigned lds0=(unsigned)(uintptr_t)shm;
  float*wsf=(float*)(shm+LDS_WS)+wid*64;
  const bf16*ksrc=Kh+(long)lane*DM+wid*8;
  const bf16*vsrc=Vh+(long)(16*(wid&3)+(lane>>2))*DM+(wid>>2)*32+(lane&3)*8;
  const unsigned kdst=lds0+LDS_K+wid*1024, vdst=lds0+LDS_V+wid*1024;
  #define DMA_K(t,slot) glds16(ksrc+(long)(t)*KVBLK*DM,(unsigned)__builtin_amdgcn_readfirstlane(kdst+(slot)))
  #define DMA_V(t,slot) glds16(vsrc+(long)(t)*KVBLK*DM,(unsigned)__builtin_amdgcn_readfirstlane(vdst+(slot)))
  const int vb0=(int)(lds0+LDS_V)+((lane>>4)&1)*32+(lane&3)*8+(4*hi+((lane&15)>>2))*64;
  const char*Kbase=shm+LDS_K; bf16x8 kf[8];
  const lds_cptr shm3=(lds_cptr)shm; const lds_cptr kp0=shm3+LDS_K+hi*1024+r32*16; const lds_cptr vp0=shm3+LDS_V+((lane>>4)&1)*32+(lane&3)*8+(4*hi+((lane&15)>>2))*64;
  const int NT=(q0+QB)/KVBLK;
  DMA_K(0,0);DMA_V(0,0);DMA_K(1,SLOTB);
  bf16x8 qr[4];
  #pragma unroll
  for(int d0=0;d0<4;++d0)qr[d0]=*reinterpret_cast<const bf16x8*>(&Qw[(long)r32*DM+d0*16+hi*8]);
  float zz_=0.f; asm volatile("":"+v"(zz_));
  float mhat=0.f,l_reg=0.f;f32x16 o[2];
  #pragma unroll
  for(int r=0;r<16;++r){o[0][r]=zz_;o[1][r]=zz_;}
  f32x16 negm;
  #pragma unroll
  for(int r=0;r<16;++r)negm[r]=zz_;
  asm volatile("":"+v"(negm));
  const int qrel=wid*QBLK+r32;
  #define CMASK(P0,P1,t) do{int jb_=(t)-(NT-4); if(jb_>=0)cmask(P0,P1,jb_,qrel,hi);}while(0)
  bool resc=false;
  #define START(P0,P1) do{ const float rm=rowmax(P0,P1); resc=false; \
    { const float dl=rm; mhat=fadd_s(mhat,dl); \
      _Pragma("unroll") for(int r=0;r<16;++r){P0[r]=fsub_s(P0[r],dl);P1[r]=fsub_s(P1[r],dl);} \
      _Pragma("unroll") for(int r=0;r<16;++r)negm[r]=-mhat; asm volatile("":"+v"(negm)); } \
    _Pragma("unroll") for(int r=0;r<16;++r)P0[r]=__builtin_amdgcn_exp2f(P0[r]); }while(0)
  #define RESC() do{ if(resc){ asm volatile("s_waitcnt lgkmcnt(0)":::"memory"); \
      _Pragma("unroll") for(int d_=0;d_<2;++d_) _Pragma("unroll") for(int r=0;r<16;++r)o[d_][r]*=wsf[crow(r,hi)]; } }while(0)
  f32x16 pA0,pA1,pB0,pB1;
  int sl_prev=0,sl_cur=0,sl_next=SLOTB;
  #define ROT() do{sl_prev=sl_cur;sl_cur=sl_next;sl_next=(sl_next==(NSLOT-1)*SLOTB)?0:sl_next+SLOTB;}while(0)
  DMA_K(2,2*SLOTB);
  WAIT_BAR(3);
  qkt(pA0,pA1,Kbase,qr,negm,r32,hi);asm volatile("s_nop 15\n\ts_nop 7":"+v"(pA0),"+v"(pA1));CMASK(pA0,pA1,0);
  START(pA0,pA1);
  _Pragma("unroll") for(int r=0;r<16;++r)pA1[r]=__builtin_amdgcn_exp2f(pA1[r]);
  WAIT_BAR(0);
  DMA_K(3,0);DMA_V(1,SLOTB);
  ROT();
  kload8(kf,kp0+sl_cur);
  WAIT_BAR(2);
  s16x4 vlo[8],vhi[8]; u32x4 pw0,pw1,pw2,pw3;
  #define PKW(P,B) cvtpk_s(P[B],P[B+1])
  #define PAF(k) __builtin_bit_cast(bf16x8,pw##k)
  #define VFR(i) (bf16x8){vlo[i][0],vlo[i][1],vlo[i][2],vlo[i][3],vhi[i][0],vhi[i][1],vhi[i][2],vhi[i][3]}
  #define PIN(x) asm volatile("":"+v"(x))
  #define MX3(a,b,c) __builtin_fmaxf(__builtin_fmaxf((a),(b)),(c))
  #define GAPA(MF,A0,A1,A2,A3,W0,W1,PW) do{ MF; sacc+=A0; sacc+=A1; sacc+=A2; sacc+=A3; PIN(sacc); W0; W1; PIN(PW); SBAR(); }while(0)
  #define EX(v) __builtin_amdgcn_exp2f(v)
  #define GAPB(MF,X,B) do{ MF; X[B]=EX(X[B]); X[B+1]=EX(X[B+1]); X[B+2]=EX(X[B+2]); X[B+3]=EX(X[B+3]); PIN(X); SBAR(); }while(0)
  #define VRD(i) do{ vlo[i]=vtr(vp_+(((i)>>2)*4096+((i)&3)*1024)); vhi[i]=vtr(vp_+(((i)>>2)*4096+((i)&3)*1024+512)); }while(0)
  #define KRD(G,j) do{ if(G){ kload2(kf,kp0+sl_next,j); SBAR(); } }while(0)
  #define STEP(C0,C1,P0,P1,t,GK,GV,GL) do{ SBAR(); \
    const lds_cptr vp_=vp0+sl_prev; \
    VRD(0); SBAR(); float sacc=(P0[0]+P0[1]); \
    GAPA(C0=__builtin_amdgcn_mfma_f32_32x32x16_bf16(kf[0],qr[0],negm,0,0,0), P0[2],P0[3],P0[4],P0[5],     pw0[0]=PKW(P0,0), pw0[1]=PKW(P0,2), pw0); \
    VRD(4); SBAR(); GAPA(C1=__builtin_amdgcn_mfma_f32_32x32x16_bf16(kf[1],qr[0],negm,0,0,0), P0[6],P0[7],P0[8],P0[9],     pw0[2]=PKW(P0,4), pw0[3]=PKW(P0,6), pw0); \
    VRD(1); SBAR(); GAPA(C0=__builtin_amdgcn_mfma_f32_32x32x16_bf16(kf[2],qr[1],C0,0,0,0),   P0[10],P0[11],P0[12],P0[13], pw1[0]=PKW(P0,8), pw1[1]=PKW(P0,10), pw1); \
    VRD(5); SBAR(); GAPA(C1=__builtin_amdgcn_mfma_f32_32x32x16_bf16(kf[3],qr[1],C1,0,0,0),   P0[14],P0[15],P1[0],P1[1],   pw1[2]=PKW(P0,12),pw1[3]=PKW(P0,14), pw1); \
    VRD(2); SBAR(); GAPA(C0=__builtin_amdgcn_mfma_f32_32x32x16_bf16(kf[4],qr[2],C0,0,0,0),   P1[2],P1[3],P1[4],P1[5],     pw2[0]=PKW(P1,0), pw2[1]=PKW(P1,2), pw2); \
    VRD(6); SBAR(); GAPA(C1=__builtin_amdgcn_mfma_f32_32x32x16_bf16(kf[5],qr[2],C1,0,0,0),   P1[6],P1[7],P1[8],P1[9],     pw2[2]=PKW(P1,4), pw2[3]=PKW(P1,6), pw2); \
    VRD(3); SBAR(); GAPA(C0=__builtin_amdgcn_mfma_f32_32x32x16_bf16(kf[6],qr[3],C0,0,0,0),   P1[10],P1[11],P1[12],P1[13], pw3[0]=PKW(P1,8), pw3[1]=PKW(P1,10), pw3); \
    VRD(7); SBAR(); GAPA(C1=__builtin_amdgcn_mfma_f32_32x32x16_bf16(kf[7],qr[3],C1,0,0,0),   P1[14],P1[15],0.f,0.f,       pw3[2]=PKW(P1,12),pw3[3]=PKW(P1,14), pw3); \
    l_reg+=sacc; \
    if(GK){DMA_K((t)+3,sl_cur);} if(GV){DMA_V((t)+1,sl_next);} \
    CMASK(C0,C1,t); \
    { float a=MX3(C0[0],C0[1],C1[0]),b=MX3(C0[2],C0[3],C1[1]); a=MX3(a,C1[2],C1[3]); \
      _Pragma("unroll") for(int r=4;r<16;r+=4){a=MX3(a,C0[r],C0[r+1]);b=MX3(b,C0[r+2],C0[r+3]);a=MX3(a,C1[r],C1[r+1]);b=MX3(b,C1[r+2],C1[r+3]);} \
      float rm=__builtin_fmaxf(a,b); { auto rr=__builtin_amdgcn_permlane32_swap(__float_as_uint(rm),__float_as_uint(rm),false,false); rm=__builtin_fmaxf(__uint_as_float(rr[0]),__uint_as_float(rr[1])); } \
      resc=false; \
      if(__builtin_expect(__any(rm>(float)THRL),0)){ const float dl=__builtin_fmaxf(rm,0.f); mhat+=dl; \
        _Pragma("unroll") for(int r=0;r<16;++r){C0[r]-=dl;C1[r]-=dl;} \
        _Pragma("unroll") for(int r=0;r<16;++r)negm[r]=-mhat; asm volatile("":"+v"(negm)); \
        const float f=__builtin_amdgcn_exp2f(-dl); l_reg*=f; if(hi==0)wsf[r32]=f; resc=true; } } \
    SBAR(); \
    GAPB(o[0]=__builtin_amdgcn_mfma_f32_32x32x16_bf16(PAF(0),VFR(0),o[0],0,0,0), C0,0); \
    GAPB(o[1]=__builtin_amdgcn_mfma_f32_32x32x16_bf16(PAF(0),VFR(4),o[1],0,0,0), C0,4); \
    KRD(GL,0); GAPB(o[0]=__builtin_amdgcn_mfma_f32_32x32x16_bf16(PAF(1),VFR(1),o[0],0,0,0), C0,8); \
    KRD(GL,1); GAPB(o[1]=__builtin_amdgcn_mfma_f32_32x32x16_bf16(PAF(1),VFR(5),o[1],0,0,0), C0,12); \
    KRD(GL,2); GAPB(o[0]=__builtin_amdgcn_mfma_f32_32x32x16_bf16(PAF(2),VFR(2),o[0],0,0,0), C1,0); \
    KRD(GL,3); GAPB(o[1]=__builtin_amdgcn_mfma_f32_32x32x16_bf16(PAF(2),VFR(6),o[1],0,0,0), C1,4); \
    GAPB(o[0]=__builtin_amdgcn_mfma_f32_32x32x16_bf16(PAF(3),VFR(3),o[0],0,0,0), C1,8); \
    GAPB(o[1]=__builtin_amdgcn_mfma_f32_32x32x16_bf16(PAF(3),VFR(7),o[1],0,0,0), C1,12); \
    }while(0)
  int t=1;
  #undef CMASK
  #define CMASK(P0,P1,t) do{}while(0)
  for(;t+5<NT;t+=2){
    STEP(pB0,pB1,pA0,pA1,t,true,true,true);     WAIT_BAR(2); RESC(); ROT();
    STEP(pA0,pA1,pB0,pB1,t+1,true,true,true);   WAIT_BAR(2); RESC(); ROT();
  }
  #undef CMASK
  #define CMASK(P0,P1,t) do{int jb_=(t)-(NT-4); if(jb_>=0)cmask(P0,P1,jb_,qrel,hi);}while(0)
  #define ENDW(tt) do{ if((tt)+3<NT){WAIT_BAR(2);} else if((tt)+2<NT){WAIT_BAR(1);} else {WAIT_BAR(0);} }while(0)
  for(;t+1<NT;t+=2){
    STEP(pB0,pB1,pA0,pA1,t,(t+3<NT),(t+1<NT),(t+1<NT));       ENDW(t);   RESC(); ROT();
    STEP(pA0,pA1,pB0,pB1,t+1,(t+4<NT),(t+2<NT),(t+2<NT));     ENDW(t+1); RESC(); ROT();
  }
  STEP(pB0,pB1,pA0,pA1,NT-1,false,false,false); RESC();
  { float sacc=pB0[0]+pB0[1]; _Pragma("unroll") for(int r=2;r<16;++r)sacc+=pB0[r]; _Pragma("unroll") for(int r=0;r<16;++r)sacc+=pB1[r]; l_reg+=sacc;
    pw0=(u32x4){PKW(pB0,0),PKW(pB0,2),PKW(pB0,4),PKW(pB0,6)};pw1=(u32x4){PKW(pB0,8),PKW(pB0,10),PKW(pB0,12),PKW(pB0,14)};pw2=(u32x4){PKW(pB1,0),PKW(pB1,2),PKW(pB1,4),PKW(pB1,6)};pw3=(u32x4){PKW(pB1,8),PKW(pB1,10),PKW(pB1,12),PKW(pB1,14)};
    SBAR(); pv(o,vb0+sl_cur,PAF(0),PAF(1),PAF(2),PAF(3)); }
  #undef PKW
  #undef PAF
  #undef VFR
  #undef PIN
  #undef MX3
  #undef GAPA
  #undef GAPB
  #undef EX
  #undef VRD
  #undef KRD
  #undef STEP
  #undef ENDW
  {auto rr=__builtin_amdgcn_permlane32_swap(__float_as_uint(l_reg),__float_as_uint(l_reg),false,false);l_reg=__uint_as_float(rr[0])+__uint_as_float(rr[1]);}
  if(hi==0)wsf[32+r32]=l_reg;asm volatile("s_waitcnt lgkmcnt(0)":::"memory");
  float rli[16];
  #pragma unroll
  for(int r=0;r<16;++r)rli[r]=__builtin_amdgcn_rcpf(wsf[32+crow(r,hi)]);
  bf16*Ow=O+(rowbase+q0+wid*QBLK)*DM+hv*D;
  { bf16*stg=(bf16*)(shm+LDS_OST)+wid*2048;
    #pragma unroll
    for(int r=0;r<16;++r){const int orow=crow(r,hi);
      #pragma unroll
      for(int d0=0;d0<2;++d0)stg[orow*64+d0*32+r32]=__float2bfloat16(o[d0][r]*rli[r]);}
    asm volatile("s_waitcnt lgkmcnt(0)":::"memory");
    #pragma unroll
    for(int i=0;i<4;++i){const int row=i*8+(lane>>3),ch=lane&7; const u32x4 v=*(const u32x4*)(stg+row*64+ch*8); ATTN_STORE16(Ow+(long)row*DM+ch*8,v);} }
  asm volatile("s_waitcnt lgkmcnt(0)\n\ts_barrier":::"memory");
  #undef DMA_K
  #undef DMA_V
  #undef CMASK
  #undef START
  #undef RESC
  #undef ROT
}
constexpr int LDSW_K=0, LDSW_V=NSLOT*SLOTB, LDSW_WS=LDSW_V+NSLOT*2*SLOTB, LDSW_OST=LDSW_WS+NW*64*4, LDSW_BYTES=LDSW_OST+NW*4096;
struct Combine { bool on; const bf16* O0; bf16* oc; const float* g; float lam, eps, post; };
template<int THRL> __device__ __forceinline__ void attn_unit_w(int b,int h,int hh,int qb,const bf16*Q,const bf16*__restrict__ K,const bf16*__restrict__ V,bf16*O,char*shm,const Combine CB){
  int tid_=threadIdx.x; asm volatile("":"+v"(tid_));
  const int tid=tid_,lane=tid&63,r32=lane&31,hi=lane>>5; const int wid=__builtin_amdgcn_readfirstlane(tid>>6);
  const long rowbase=(long)b*SEQ; const int q0=qb*QB;
  const bf16*Qw=Q+(rowbase+q0+wid*QBLK)*DM+h*D;
  const bf16*Kh=K+rowbase*DM+h*D,*Vh=V+rowbase*DM+hh*128;
  const unsigned lds0=(unsigned)(uintptr_t)shm;
  float*wsf=(float*)(shm+LDSW_WS)+wid*64;
  const bf16*ksrc=Kh+(long)lane*DM+wid*8;
  const bf16*vsrc=Vh+(long)(16*(wid&3)+(lane>>2))*DM+(wid>>2)*32+(lane&3)*8;
  const unsigned kdst=lds0+LDSW_K+wid*1024, vdst=lds0+LDSW_V+wid*1024;
  #define DMA_K(t,slot) glds16(ksrc+(long)(t)*KVBLK*DM,(unsigned)__builtin_amdgcn_readfirstlane(kdst+(slot)))
  #define DMA_V(t,slot) do{ glds16(vsrc+(long)(t)*KVBLK*DM,(unsigned)__builtin_amdgcn_readfirstlane(vdst+2*(slot))); glds16(vsrc+(long)(t)*KVBLK*DM+64,(unsigned)__builtin_amdgcn_readfirstlane(vdst+2*(slot)+8192)); }while(0)
  const int vb0=(int)(lds0+LDSW_V)+((lane>>4)&1)*32+(lane&3)*8+(4*hi+((lane&15)>>2))*64;
  const char*Kbase=shm+LDSW_K; bf16x8 kf[8];
  const lds_cptr shm3=(lds_cptr)shm; const lds_cptr kp0=shm3+LDSW_K+hi*1024+r32*16; const lds_cptr vp0=shm3+LDSW_V+((lane>>4)&1)*32+(lane&3)*8+(4*hi+((lane&15)>>2))*64;
  const int NT=(q0+QB)/KVBLK;
  DMA_K(0,0);DMA_V(0,0);DMA_K(1,SLOTB);
  bf16x8 qr[4];
  #pragma unroll
  for(int d0=0;d0<4;++d0)qr[d0]=*reinterpret_cast<const bf16x8*>(&Qw[(long)r32*DM+d0*16+hi*8]);
  float zz_=0.f; asm volatile("":"+v"(zz_));
  float mhat=0.f,l_reg=0.f;f32x16 o[4];
  #pragma unroll
  for(int r=0;r<16;++r){o[0][r]=zz_;o[1][r]=zz_;o[2][r]=zz_;o[3][r]=zz_;}
  const f32x16 zero16={};
  const int qrel=wid*QBLK+r32;
  #define CMASK(P0,P1,t) do{int jb_=(t)-(NT-4); if(jb_>=0)cmask(P0,P1,jb_,qrel,hi);}while(0)
  bool resc=false;
  #define START(P0,P1) do{ const float rm=rowmax(P0,P1); resc=false; \
    { const float dl=(__builtin_fabsf(rm)>(float)THRL)?rm:0.f; mhat=fadd_s(mhat,dl);     \
      _Pragma("unroll") for(int r=0;r<16;++r){P0[r]=fsub_s(P0[r],dl);P1[r]=fsub_s(P1[r],dl);} } \
    _Pragma("unroll") for(int r=0;r<16;++r)P0[r]=__builtin_amdgcn_exp2f(P0[r]); }while(0)
  #define RESC() do{ if(resc){ asm volatile("s_waitcnt lgkmcnt(0)":::"memory"); \
      _Pragma("unroll") for(int d_=0;d_<4;++d_) _Pragma("unroll") for(int r=0;r<16;++r)o[d_][r]*=wsf[crow(r,hi)]; } }while(0)
  f32x16 pA0,pA1,pB0,pB1;
  int sl_prev=0,sl_cur=0,sl_next=SLOTB;
  #define ROT() do{sl_prev=sl_cur;sl_cur=sl_next;sl_next=(sl_next==(NSLOT-1)*SLOTB)?0:sl_next+SLOTB;}while(0)
  DMA_K(2,2*SLOTB);
  WAIT_BAR(4);
  qkt(pA0,pA1,Kbase,qr,zero16,r32,hi);asm volatile("s_nop 15\n\ts_nop 7":"+v"(pA0),"+v"(pA1));CMASK(pA0,pA1,0);
  START(pA0,pA1);
  _Pragma("unroll") for(int r=0;r<16;++r)pA1[r]=__builtin_amdgcn_exp2f(pA1[r]);
  WAIT_BAR(0);
  DMA_K(3,0);DMA_V(1,SLOTB);
  ROT();
  kload8(kf,kp0+sl_cur);
  WAIT_BAR(3);
  s16x4 vlo[4],vhi[4]; u32x4 pw0,pw1,pw2,pw3;
  #define GAPB2(MF,X,B) do{ MF; X[B]=EX(X[B]); X[B+1]=EX(X[B+1]); PIN(X); SBAR(); }while(0)
  #define PKW(P,B) cvtpk_s(P[B],P[B+1])
  #define PAF(k) __builtin_bit_cast(bf16x8,pw##k)
  #define VFR(i) (bf16x8){vlo[i][0],vlo[i][1],vlo[i][2],vlo[i][3],vhi[i][0],vhi[i][1],vhi[i][2],vhi[i][3]}
  #define PIN(x) asm volatile("":"+v"(x))
  #define MX3(a,b,c) __builtin_fmaxf(__builtin_fmaxf((a),(b)),(c))
  #define GAPA(MF,A0,A1,A2,A3,W0,W1,PW) do{ MF; sacc+=A0; sacc+=A1; sacc+=A2; sacc+=A3; PIN(sacc); W0; W1; PIN(PW); SBAR(); }while(0)
  #define EX(v) __builtin_amdgcn_exp2f(v)
  #define GAPB(MF,X,B) do{ MF; X[B]=EX(X[B]); X[B+1]=EX(X[B+1]); X[B+2]=EX(X[B+2]); X[B+3]=EX(X[B+3]); PIN(X); SBAR(); }while(0)
  #define VLD(sl,hf,i) do{ vlo[sl]=vtr(vp_+((hf)*8192+((i)>>2)*4096+((i)&3)*1024)); vhi[sl]=vtr(vp_+((hf)*8192+((i)>>2)*4096+((i)&3)*1024+512)); }while(0)
  #define KRD(G,j) do{ if(G){ kload2(kf,kp0+sl_next,j); SBAR(); } }while(0)
  #define STEP(C0,C1,P0,P1,t,GK,GV,GL) do{ SBAR(); \
    const lds_cptr vp_=vp0+2*sl_prev; \
    float sacc=(P0[0]+P0[1]); \
    GAPA(C0=__builtin_amdgcn_mfma_f32_32x32x16_bf16(kf[0],qr[0],zero16,0,0,0), P0[2],P0[3],P0[4],P0[5],     pw0[0]=PKW(P0,0), pw0[1]=PKW(P0,2), pw0); \
    GAPA(C1=__builtin_amdgcn_mfma_f32_32x32x16_bf16(kf[1],qr[0],zero16,0,0,0), P0[6],P0[7],P0[8],P0[9],     pw0[2]=PKW(P0,4), pw0[3]=PKW(P0,6), pw0); \
    GAPA(C0=__builtin_amdgcn_mfma_f32_32x32x16_bf16(kf[2],qr[1],C0,0,0,0),   P0[10],P0[11],P0[12],P0[13], pw1[0]=PKW(P0,8), pw1[1]=PKW(P0,10), pw1); \
    GAPA(C1=__builtin_amdgcn_mfma_f32_32x32x16_bf16(kf[3],qr[1],C1,0,0,0),   P0[14],P0[15],P1[0],P1[1],   pw1[2]=PKW(P0,12),pw1[3]=PKW(P0,14), pw1); \
    VLD(0,0,0); SBAR(); GAPA(C0=__builtin_amdgcn_mfma_f32_32x32x16_bf16(kf[4],qr[2],C0,0,0,0),   P1[2],P1[3],P1[4],P1[5],     pw2[0]=PKW(P1,0), pw2[1]=PKW(P1,2), pw2); \
    VLD(1,0,4); SBAR(); GAPA(C1=__builtin_amdgcn_mfma_f32_32x32x16_bf16(kf[5],qr[2],C1,0,0,0),   P1[6],P1[7],P1[8],P1[9],     pw2[2]=PKW(P1,4), pw2[3]=PKW(P1,6), pw2); \
    VLD(2,0,1); SBAR(); GAPA(C0=__builtin_amdgcn_mfma_f32_32x32x16_bf16(kf[6],qr[3],C0,0,0,0),   P1[10],P1[11],P1[12],P1[13], pw3[0]=PKW(P1,8), pw3[1]=PKW(P1,10), pw3); \
    VLD(3,0,5); SBAR(); GAPA(C1=__builtin_amdgcn_mfma_f32_32x32x16_bf16(kf[7],qr[3],C1,0,0,0),   P1[14],P1[15],0.f,0.f,       pw3[2]=PKW(P1,12),pw3[3]=PKW(P1,14), pw3); \
    l_reg+=sacc; \
    if(__any(mhat!=0.f)){ _Pragma("unroll") for(int r=0;r<16;++r){C0[r]-=mhat;C1[r]-=mhat;} } \
    if(GK){DMA_K((t)+3,sl_cur);} if(GV){DMA_V((t)+1,sl_next);} \
    CMASK(C0,C1,t); \
    { float a=MX3(C0[0],C0[1],C1[0]),b=MX3(C0[2],C0[3],C1[1]); a=MX3(a,C1[2],C1[3]); \
      _Pragma("unroll") for(int r=4;r<16;r+=4){a=MX3(a,C0[r],C0[r+1]);b=MX3(b,C0[r+2],C0[r+3]);a=MX3(a,C1[r],C1[r+1]);b=MX3(b,C1[r+2],C1[r+3]);} \
      float rm=__builtin_fmaxf(a,b); { auto rr=__builtin_amdgcn_permlane32_swap(__float_as_uint(rm),__float_as_uint(rm),false,false); rm=__builtin_fmaxf(__uint_as_float(rr[0]),__uint_as_float(rr[1])); } \
      resc=false; \
      if(__builtin_expect(__any(rm>(float)THRL),0)){ const float dl=__builtin_fmaxf(rm,0.f); mhat+=dl; \
        _Pragma("unroll") for(int r=0;r<16;++r){C0[r]-=dl;C1[r]-=dl;} \
        const float f=__builtin_amdgcn_exp2f(-dl); l_reg*=f; if(hi==0)wsf[r32]=f; resc=true; } } \
    SBAR(); \
    GAPB2(o[0]=__builtin_amdgcn_mfma_f32_32x32x16_bf16(PAF(0),VFR(0),o[0],0,0,0), C0,0); VLD(0,0,2); SBAR(); \
    GAPB2(o[1]=__builtin_amdgcn_mfma_f32_32x32x16_bf16(PAF(0),VFR(1),o[1],0,0,0), C0,2); VLD(1,0,6); SBAR(); \
    GAPB2(o[0]=__builtin_amdgcn_mfma_f32_32x32x16_bf16(PAF(1),VFR(2),o[0],0,0,0), C0,4); VLD(2,0,3); SBAR(); \
    GAPB2(o[1]=__builtin_amdgcn_mfma_f32_32x32x16_bf16(PAF(1),VFR(3),o[1],0,0,0), C0,6); VLD(3,0,7); SBAR(); \
    GAPB2(o[0]=__builtin_amdgcn_mfma_f32_32x32x16_bf16(PAF(2),VFR(0),o[0],0,0,0), C0,8); VLD(0,1,0); SBAR(); \
    GAPB2(o[1]=__builtin_amdgcn_mfma_f32_32x32x16_bf16(PAF(2),VFR(1),o[1],0,0,0), C0,10); VLD(1,1,4); SBAR(); \
    GAPB2(o[0]=__builtin_amdgcn_mfma_f32_32x32x16_bf16(PAF(3),VFR(2),o[0],0,0,0), C0,12); VLD(2,1,1); SBAR(); \
    GAPB2(o[1]=__builtin_amdgcn_mfma_f32_32x32x16_bf16(PAF(3),VFR(3),o[1],0,0,0), C0,14); VLD(3,1,5); SBAR(); \
    GAPB2(o[2]=__builtin_amdgcn_mfma_f32_32x32x16_bf16(PAF(0),VFR(0),o[2],0,0,0), C1,0); VLD(0,1,2); SBAR(); \
    GAPB2(o[3]=__builtin_amdgcn_mfma_f32_32x32x16_bf16(PAF(0),VFR(1),o[3],0,0,0), C1,2); VLD(1,1,6); SBAR(); \
    KRD(GL,0); GAPB2(o[2]=__builtin_amdgcn_mfma_f32_32x32x16_bf16(PAF(1),VFR(2),o[2],0,0,0), C1,4); VLD(2,1,3); SBAR(); \
    KRD(GL,1); GAPB2(o[3]=__builtin_amdgcn_mfma_f32_32x32x16_bf16(PAF(1),VFR(3),o[3],0,0,0), C1,6); VLD(3,1,7); SBAR(); \
    KRD(GL,2); GAPB2(o[2]=__builtin_amdgcn_mfma_f32_32x32x16_bf16(PAF(2),VFR(0),o[2],0,0,0), C1,8); \
    KRD(GL,3); GAPB2(o[3]=__builtin_amdgcn_mfma_f32_32x32x16_bf16(PAF(2),VFR(1),o[3],0,0,0), C1,10); \
    GAPB2(o[2]=__builtin_amdgcn_mfma_f32_32x32x16_bf16(PAF(3),VFR(2),o[2],0,0,0), C1,12); \
    GAPB2(o[3]=__builtin_amdgcn_mfma_f32_32x32x16_bf16(PAF(3),VFR(3),o[3],0,0,0), C1,14); \
    }while(0)
  int t=1;
  #undef CMASK
  #define CMASK(P0,P1,t) do{}while(0)
  for(;t+5<NT;t+=2){
    STEP(pB0,pB1,pA0,pA1,t,true,true,true);     WAIT_BAR(3); RESC(); ROT();
    STEP(pA0,pA1,pB0,pB1,t+1,true,true,true);   WAIT_BAR(3); RESC(); ROT();
  }
  #undef CMASK
  #define CMASK(P0,P1,t) do{int jb_=(t)-(NT-4); if(jb_>=0)cmask(P0,P1,jb_,qrel,hi);}while(0)
  #define ENDW(tt) do{ if((tt)+3<NT){WAIT_BAR(3);} else if((tt)+2<NT){WAIT_BAR(2);} else {WAIT_BAR(0);} }while(0)
  for(;t+1<NT;t+=2){
    STEP(pB0,pB1,pA0,pA1,t,(t+3<NT),(t+1<NT),(t+1<NT));       ENDW(t);   RESC(); ROT();
    STEP(pA0,pA1,pB0,pB1,t+1,(t+4<NT),(t+2<NT),(t+2<NT));     ENDW(t+1); RESC(); ROT();
  }
  STEP(pB0,pB1,pA0,pA1,NT-1,false,false,false); RESC();
  { float sacc=pB0[0]+pB0[1]; _Pragma("unroll") for(int r=2;r<16;++r)sacc+=pB0[r]; _Pragma("unroll") for(int r=0;r<16;++r)sacc+=pB1[r]; l_reg+=sacc;
    pw0=(u32x4){PKW(pB0,0),PKW(pB0,2),PKW(pB0,4),PKW(pB0,6)};pw1=(u32x4){PKW(pB0,8),PKW(pB0,10),PKW(pB0,12),PKW(pB0,14)};pw2=(u32x4){PKW(pB1,0),PKW(pB1,2),PKW(pB1,4),PKW(pB1,6)};pw3=(u32x4){PKW(pB1,8),PKW(pB1,10),PKW(pB1,12),PKW(pB1,14)};
    SBAR(); pv(o,vb0+2*sl_cur,PAF(0),PAF(1),PAF(2),PAF(3)); pv(o+2,vb0+2*sl_cur+8192,PAF(0),PAF(1),PAF(2),PAF(3)); }
  #undef PKW
  #undef PAF
  #undef VFR
  #undef PIN
  #undef MX3
  #undef GAPA
  #undef GAPB
  #undef GAPB2
  #undef EX
  #undef VLD
  #undef KRD
  #undef STEP
  #undef ENDW
  {auto rr=__builtin_amdgcn_permlane32_swap(__float_as_uint(l_reg),__float_as_uint(l_reg),false,false);l_reg=__uint_as_float(rr[0])+__uint_as_float(rr[1]);}
  if(hi==0)wsf[32+r32]=l_reg;asm volatile("s_waitcnt lgkmcnt(0)":::"memory");
  float rli[16];
  #pragma unroll
  for(int r=0;r<16;++r)rli[r]=__builtin_amdgcn_rcpf(wsf[32+crow(r,hi)]);
  bf16*Ow=O+(rowbase+q0+wid*QBLK)*DM+hh*128;
  bf16*stg=(bf16*)(shm+LDSW_OST)+wid*2048;
  if(!CB.on){
    #pragma unroll
    for(int hf=0;hf<2;++hf){
      #pragma unroll
      for(int r=0;r<16;++r){const int orow=crow(r,hi);
        #pragma unroll
        for(int d0=0;d0<2;++d0)stg[orow*64+d0*32+r32]=__float2bfloat16(o[2*hf+d0][r]*rli[r]);}
      asm volatile("s_waitcnt lgkmcnt(0)":::"memory");
      #pragma unroll
      for(int i=0;i<4;++i){const int row=i*8+(lane>>3),ch=lane&7; const u32x4 v=*(const u32x4*)(stg+row*64+ch*8); ATTN_STORE16(Ow+(long)row*DM+hf*64+ch*8,v);}
      asm volatile("s_waitcnt lgkmcnt(0)":::"memory"); }
  } else {
    const bf16*O0w=CB.O0+(rowbase+q0+wid*QBLK)*DM+hh*128; bf16*Cw=CB.oc+(rowbase+q0+wid*QBLK)*DM+hh*128;
    float av[2][4][8]; float ss[4]={0.f,0.f,0.f,0.f};
    #pragma unroll
    for(int hf=0;hf<2;++hf){
      #pragma unroll
      for(int r=0;r<16;++r){const int orow=crow(r,hi);
        #pragma unroll
        for(int d0=0;d0<2;++d0)stg[orow*64+d0*32+r32]=__float2bfloat16(o[2*hf+d0][r]*rli[r]);}
      asm volatile("s_waitcnt lgkmcnt(0)":::"memory");
      #pragma unroll
      for(int i=0;i<4;++i){const int row=i*8+(lane>>3),ch=lane&7; const u32x4 v1=*(const u32x4*)(stg+row*64+ch*8); const u32x4 v0=*(const u32x4*)(O0w+(long)row*DM+hf*64+ch*8);
        #pragma unroll
        for(int x=0;x<4;++x){ const float a0=__uint_as_float(v0[x]<<16)-CB.lam*__uint_as_float(v1[x]<<16), a1=__uint_as_float(v0[x]&0xffff0000u)-CB.lam*__uint_as_float(v1[x]&0xffff0000u);
          av[hf][i][2*x]=a0; av[hf][i][2*x+1]=a1; ss[i]+=a0*a0+a1*a1; } }
      asm volatile("s_waitcnt lgkmcnt(0)":::"memory"); }
    #pragma unroll
    for(int i=0;i<4;++i){ float t=ss[i];
      t+=__builtin_bit_cast(float,__builtin_amdgcn_update_dpp(0,__builtin_bit_cast(int,t),0xB1,0xf,0xf,false)); t+=__builtin_bit_cast(float,__builtin_amdgcn_update_dpp(0,__builtin_bit_cast(int,t),0x4E,0xf,0xf,false));
      t+=__builtin_bit_cast(float,__builtin_amdgcn_update_dpp(0,__builtin_bit_cast(int,t),0x141,0xf,0xf,false));
      const float rn=__builtin_amdgcn_rsqf(t*(1.f/128.f)+CB.eps)*CB.post; const int row=i*8+(lane>>3),ch=lane&7;
      #pragma unroll
      for(int hf=0;hf<2;++hf){ const float*gp=CB.g+hf*64+ch*8; u32x4 w;
        #pragma unroll
        for(int x=0;x<4;++x)w[x]=cvtpk_s(av[hf][i][2*x]*rn*gp[2*x],av[hf][i][2*x+1]*rn*gp[2*x+1]);
        ATTN_STORE16(Cw+(long)row*DM+hf*64+ch*8,w); } }
  }
  asm volatile("s_waitcnt lgkmcnt(0)\n\ts_barrier":::"memory");
  #undef DMA_K
  #undef DMA_V
  #undef CMASK
  #undef START
  #undef RESC
  #undef ROT
}
constexpr int ATTN_LDS_BYTES=LDS_BYTES;
struct AttnTensors { const bf16* Q; const bf16* K; const bf16* V; bf16* O0; Combine cb; };
template<int THRL=8,class Gap> __device__ __forceinline__ void attn_phase(char*lds,const AttnTensors&T,int vcu,int G,Gap gap){
  const int nbig=(512-vcu+G-1)/G; int i=0;
  if(__builtin_amdgcn_readfirstlane((int)threadIdx.x)>=256) __builtin_amdgcn_s_setprio(1);
  for(int L=vcu;L<512;L+=G){ const int rnd=L>>8,v=L&255,r=v&7,qb=rnd?r:(NQB-1-r); const int b=v>>5,h=rnd*4+((v&31)>>3);
    #pragma unroll 1
    for(int c=0;c<2;++c){ Combine cb=T.cb; cb.on=(c==1); attn_unit_w<THRL>(b,2*h+c,h,qb,T.Q,T.K,T.V,T.O0,lds,cb); gap(i,2*nbig); ++i; } }
}
#undef SBAR
#undef WAIT_BAR
}
#ifndef PROBE_DUP
#define PROBE_DUP (-1)
#endif
constexpr int NWAVES = 8;
constexpr int NPHASE = 11;
constexpr int RING_OFF = 0, RING_BYTES = 131072;
constexpr int LDSCTL_OFF = RING_BYTES, MISC_OFF = LDSCTL_OFF + 320;
constexpr int L_PTRS = LDSCTL_OFF;
constexpr int L_TSTART = 131584;
constexpr int L_CNT = 131744;
constexpr int L_TILEE = 131872;
constexpr int L_GTAB = 133120, MAXU = 12;
constexpr int L_ULIST = L_GTAB + MAXU * 1024;
constexpr int LDS_BYTES = 147456;
static_assert(MISC_OFF + 128 <= L_TSTART && L_TILEE + MT_MAX * 4 <= L_GTAB && L_ULIST + 16 + 16 * MAXU <= LDS_BYTES, "LDS map");

#define GAS __attribute__((address_space(1)))
#define LAS __attribute__((address_space(3)))
typedef unsigned short bf16;
typedef unsigned v4u __attribute__((ext_vector_type(4)));
typedef unsigned v2u __attribute__((ext_vector_type(2)));
typedef float f32x4 __attribute__((ext_vector_type(4)));
typedef GAS unsigned gu32;
#define RLX_AGENT __ATOMIC_RELAXED, __HIP_MEMORY_SCOPE_AGENT
#define LDS_WAIT() asm volatile("s_waitcnt lgkmcnt(0)" ::: "memory")
#define VM_WAIT() asm volatile("s_waitcnt vmcnt(0)" ::: "memory")
__device__ __forceinline__ unsigned pk2(float lo, float hi) { return pg8::cvt_pk_bf16(lo, hi); }
__device__ __forceinline__ float bflo(unsigned w) { return __uint_as_float(w << 16); }
__device__ __forceinline__ float bfhi(unsigned w) { return __uint_as_float(w & 0xffff0000u); }

#define XB_TMO      128
#define XB_XCNT(j)  (256  + 64 * (j))
#define XB_XSUB(j)  (1280 + 64 * (j))
#define XB_XGEN(j)  (2304 + 64 * (j))
#define XB_TOP      3328
#define XB_TOPGEN   3392
#define XCD_BAR_WORDS 3456
#define XB_LSUB(j)  (-1024 + 64 * (j))
#define XB_LGEN(j)  (-512 + 64 * (j))
#define XB_SPIN_CAP (1u << 18)
__device__ __forceinline__ unsigned xb_ld(unsigned* p)              { return __hip_atomic_load(p, __ATOMIC_RELAXED, __HIP_MEMORY_SCOPE_AGENT); }
__device__ __forceinline__ unsigned xb_add(unsigned* p, unsigned v) { return __hip_atomic_fetch_add(p, v, __ATOMIC_RELAXED, __HIP_MEMORY_SCOPE_AGENT); }
__device__ __forceinline__ unsigned xb_xcc_id() { return (unsigned)__builtin_amdgcn_s_getreg((3 << 11) | 20) & 0xFu; }
#define XB_SPIN(cond, bar) do { unsigned _sp = 0; while (cond) { __builtin_amdgcn_s_sleep(1); \
    if ((++_sp & 255u) == 0u) { if (xb_ld(&(bar)[XB_TMO])) break; if (_sp > XB_SPIN_CAP) { atomicAdd(&(bar)[XB_TMO], 1u); break; } } } } while (0)
struct XcdBarrier { unsigned* bar; unsigned x; volatile LAS unsigned* st; };
__device__ __forceinline__ XcdBarrier xcd_barrier_post(unsigned* bar, volatile LAS unsigned* st) {
    XcdBarrier b; b.bar = bar; b.x = xb_xcc_id(); b.st = st;
    if (threadIdx.x == 0) st[3] = xb_add(&bar[XB_XCNT(b.x)], 1u);
    return b;
}
__device__ __forceinline__ void xcd_barrier_complete(unsigned* bar, unsigned x, unsigned& nloc, unsigned& nx, unsigned& even) {
    const unsigned G = gridDim.x * gridDim.y * gridDim.z;
    unsigned sum, cnt, mine, sp = 0u;
    for (;;) {
        sum = 0u; cnt = 0u; mine = 0u; even = (G == 256u) ? 1u : 0u;
#pragma unroll
        for (unsigned j = 0; j < 16; ++j) { const unsigned c = xb_ld(&bar[XB_XCNT(j)]); sum += c; cnt += (c > 0u) ? 1u : 0u; mine = (j == x) ? c : mine; even = (c == (j < 8u ? 32u : 0u)) ? even : 0u; }
        if (sum == G) break;
        __builtin_amdgcn_s_sleep(1);
        if ((++sp & 255u) == 0u) { if (xb_ld(&bar[XB_TMO])) break; if (sp > XB_SPIN_CAP) { atomicAdd(&bar[XB_TMO], 1u); break; } }
    }
    nloc = mine > 0u ? mine : 1u; nx = cnt > 0u ? cnt : 1u;
}
__device__ __forceinline__ void xcd_barrier(const XcdBarrier& b) {
    asm volatile("s_waitcnt vmcnt(0)" ::: "memory");
    __syncthreads();
    if (threadIdx.x == 0) {
        unsigned* bar = b.bar;
        __builtin_amdgcn_s_waitcnt(0);
        unsigned nloc = b.st[0], nx = b.st[1];
        if (nloc == 0u) { unsigned even; xcd_barrier_complete(bar, b.x, nloc, nx, even); b.st[0] = nloc; b.st[1] = nx; b.st[2] = 1u + even; }
        const unsigned old = xb_add(&bar[XB_XSUB(b.x)], 1u);
        const unsigned gen = old / nloc;
        if (old + 1u == (gen + 1u) * nloc) {
            __builtin_amdgcn_fence(__ATOMIC_RELEASE, "agent");
            asm volatile("s_waitcnt vmcnt(0)" ::: "memory");
            const unsigned og = xb_add(&bar[XB_TOP], 1u);
            const unsigned tg = og / nx;
            if (og + 1u == (tg + 1u) * nx) xb_add(&bar[XB_TOPGEN], 1u);
            else XB_SPIN(xb_ld(&bar[XB_TOPGEN]) == tg, bar);
            __builtin_amdgcn_fence(__ATOMIC_ACQUIRE, "agent");
            xb_add(&bar[XB_XGEN(b.x)], 1u);
            asm volatile("s_waitcnt vmcnt(0)" ::: "memory");
        } else {
            XB_SPIN(xb_ld(&bar[XB_XGEN(b.x)]) == gen, bar);
            __builtin_amdgcn_fence(__ATOMIC_ACQUIRE, "agent");
            asm volatile("s_waitcnt vmcnt(0)" ::: "memory");
        }
    }
    __syncthreads();
}

__device__ __forceinline__ void xcc_local_barrier(const XcdBarrier& b) {
    asm volatile("s_waitcnt vmcnt(0)" ::: "memory");
    __syncthreads();
    if (threadIdx.x == 0) {
        unsigned* bar = b.bar;
        __builtin_amdgcn_s_waitcnt(0);
        const unsigned old = xb_add(&bar[XB_LSUB((int)b.x)], 1u);
        const unsigned gen = old >> 5;
        if (old + 1u == (gen + 1u) << 5) xb_add(&bar[XB_LGEN((int)b.x)], 1u);
        else XB_SPIN(xb_ld(&bar[XB_LGEN((int)b.x)]) == gen, bar);
        __builtin_amdgcn_fence(__ATOMIC_ACQUIRE, "agent");
        asm volatile("s_waitcnt vmcnt(0)" ::: "memory");
    }
    __syncthreads();
}

struct Frame {
    LAS unsigned char* lds;
    volatile LAS unsigned* MISC;
    gu32* ctl;
    int tid, lane, wave;
    int vcu, G, vb;
    unsigned char* ws;
};
__device__ __forceinline__ const void* inp(const Frame& F, int i) {
    const LAS unsigned* p = (const LAS unsigned*)(F.lds + L_PTRS) + 2 * i;
    const unsigned lo = __builtin_amdgcn_readfirstlane(p[0]), hi = __builtin_amdgcn_readfirstlane(p[1]);
    return (const void*)(const GAS char*)(((unsigned long long)hi << 32) | lo);
}
template <int CTRL> __device__ __forceinline__ float dpp_f(float v) { return __builtin_bit_cast(float, __builtin_amdgcn_update_dpp(0, __builtin_bit_cast(int, v), CTRL, 0xf, 0xf, false)); }
#define XSUM16(v) do { const auto r_ = __builtin_amdgcn_permlane16_swap(__float_as_uint(v), __float_as_uint(v), false, false); v = __uint_as_float(r_[0]) + __uint_as_float(r_[1]); } while (0)
#define XSUM32(v) do { const auto r_ = __builtin_amdgcn_permlane32_swap(__float_as_uint(v), __float_as_uint(v), false, false); v = __uint_as_float(r_[0]) + __uint_as_float(r_[1]); } while (0)
#define XMAX16(v) do { const auto r_ = __builtin_amdgcn_permlane16_swap(__float_as_uint(v), __float_as_uint(v), false, false); v = fmaxf(__uint_as_float(r_[0]), __uint_as_float(r_[1])); } while (0)
__device__ __forceinline__ float sum8(float v) { v += dpp_f<0xB1>(v); v += dpp_f<0x4E>(v); v += dpp_f<0x141>(v); return v; }
__device__ __forceinline__ float wave_sum(float v) {
    v = sum8(v); v += dpp_f<0x140>(v);
    XSUM16(v); XSUM32(v);
    return v;
}
__device__ __forceinline__ float max32(float v) {
    v = fmaxf(v, dpp_f<0xB1>(v)); v = fmaxf(v, dpp_f<0x4E>(v)); v = fmaxf(v, dpp_f<0x141>(v)); v = fmaxf(v, dpp_f<0x140>(v));
    XMAX16(v); return v;
}

template <class RowFn>
__device__ __forceinline__ void tr_item(const float* W, int ldw, int k0, int n0, bf16* dst, int ldk, int kd0, RowFn drow, LAS bf16* scr, int lane, bool zero) {
    const int c4 = lane & 15, kr = lane >> 4;
    if (!zero) {
        f32x4 v[16];
#pragma unroll
        for (int s = 0; s < 16; ++s) v[s] = *(const GAS f32x4*)(W + (size_t)(k0 + kr + 4 * s) * ldw + n0 + 4 * c4);
#pragma unroll
        for (int s = 0; s < 16; ++s) { const int kk = kr + 4 * s; const unsigned lo = pk2(v[s][0], v[s][1]), hi = pk2(v[s][2], v[s][3]);
            scr[(4 * c4 + 0) * 66 + kk] = (bf16)(lo & 0xffff); scr[(4 * c4 + 1) * 66 + kk] = (bf16)(lo >> 16); scr[(4 * c4 + 2) * 66 + kk] = (bf16)(hi & 0xffff); scr[(4 * c4 + 3) * 66 + kk] = (bf16)(hi >> 16); }
        LDS_WAIT(); asm volatile("" ::: "memory");
    }
    const int ch = lane & 7;
#pragma unroll
    for (int j = 0; j < 8; ++j) { const int nn = (lane >> 3) + 8 * j; v4u o = {0u, 0u, 0u, 0u};
        if (!zero) { const LAS unsigned* sp = (const LAS unsigned*)(scr + nn * 66 + 8 * ch); o.x = sp[0]; o.y = sp[1]; o.z = sp[2]; o.w = sp[3]; }
        *(GAS v4u*)(dst + (size_t)drow(nn) * ldk + kd0 + 8 * ch) = o; }
    LDS_WAIT(); asm volatile("" ::: "memory");
}

template <class RowFn>
__device__ __forceinline__ void tr_item_fp8(const float* W, int ldw, int k0, int n0, unsigned char* dst, int ldk, int kd0, RowFn drow, LAS unsigned char* scr, int lane) {
    const int c4 = lane & 15, kr = lane >> 4;
    f32x4 v[4][4];
#pragma unroll
    for (int s = 0; s < 4; ++s)
#pragma unroll
        for (int j = 0; j < 4; ++j) v[s][j] = *(const GAS f32x4*)(W + (size_t)(k0 + 16 * s + 4 * kr + j) * ldw + n0 + 4 * c4);
#pragma unroll
    for (int s = 0; s < 4; ++s)
#pragma unroll
        for (int x = 0; x < 4; ++x) { int w = 0; w = __builtin_amdgcn_cvt_pk_fp8_f32(v[s][0][x] * pg8::W8_SCALE, v[s][1][x] * pg8::W8_SCALE, w, false); w = __builtin_amdgcn_cvt_pk_fp8_f32(v[s][2][x] * pg8::W8_SCALE, v[s][3][x] * pg8::W8_SCALE, w, true);
            *(LAS unsigned*)(scr + (4 * c4 + x) * 68 + 16 * s + 4 * kr) = (unsigned)w; }
    LDS_WAIT(); asm volatile("" ::: "memory");
    const int ch = lane & 3;
#pragma unroll
    for (int j = 0; j < 4; ++j) { const int nn = (lane >> 2) + 16 * j; const LAS unsigned* sp = (const LAS unsigned*)(scr + nn * 68 + 16 * ch); v4u o; o.x = sp[0]; o.y = sp[1]; o.z = sp[2]; o.w = sp[3];
        *(GAS v4u*)(dst + (size_t)drow(nn) * ldk + kd0 + 16 * ch) = o; }
    LDS_WAIT(); asm volatile("" ::: "memory");
}

struct CItem { const float* src; unsigned char* dst; int ldw, ldk, base, mode; };
__device__ __forceinline__ CItem conv_item(const float* w_exp1, const float* w_exp2, unsigned char* ws, int r) {
    constexpr int I_2 = NE * 16 * 16;
    CItem it;
    if (r >= I_2) { r -= I_2; const int e = r / 512, rr = r % 512, kb = rr / 32, nb = rr % 32, n0 = nb * 64, j2 = n0 >> 1, pn = j2 >> 7, j = j2 & 127;
        it.src = w_exp1 + (size_t)e * D * 2 * FF + (size_t)(kb * 64) * (2 * FF) + n0; it.ldw = 2 * FF; it.dst = ws + WS_W1 + (size_t)e * 2 * FF * D + kb * 64; it.ldk = D; it.base = 256 * pn + j; it.mode = 1; }
    else { const int e = r / 256, rr = r % 256, kb = rr / 16, nb = rr % 16;
        it.src = w_exp2 + (size_t)e * FF * D + (size_t)(kb * 64) * D + nb * 64; it.ldw = D; it.dst = ws + WS_W2 + (size_t)e * D * FF + kb * 64; it.ldk = FF; it.base = nb * 64; it.mode = 0; }
    return it;
}
__device__ __forceinline__ void conv_load(const CItem& it, f32x4 (&v)[4][4], int lane) {
    const int c4 = lane & 15, kr = lane >> 4;
#pragma unroll
    for (int s = 0; s < 4; ++s)
#pragma unroll
        for (int j = 0; j < 4; ++j) v[s][j] = __builtin_nontemporal_load((const GAS f32x4*)(it.src + (size_t)(16 * s + 4 * kr + j) * it.ldw + 4 * c4));
}
__device__ __forceinline__ void conv_store(const CItem& it, const f32x4 (&v)[4][4], LAS unsigned char* scr, int lane) {
    const int c4 = lane & 15, kr = lane >> 4;
#pragma unroll
    for (int s = 0; s < 4; ++s)
#pragma unroll
        for (int x = 0; x < 4; ++x) { int w = 0; w = __builtin_amdgcn_cvt_pk_fp8_f32(v[s][0][x] * pg8::W8_SCALE, v[s][1][x] * pg8::W8_SCALE, w, false); w = __builtin_amdgcn_cvt_pk_fp8_f32(v[s][2][x] * pg8::W8_SCALE, v[s][3][x] * pg8::W8_SCALE, w, true);
            *(LAS unsigned*)(scr + (4 * c4 + x) * 68 + 16 * s + 4 * kr) = (unsigned)w; }
    LDS_WAIT(); asm volatile("" ::: "memory");
    const int ch = lane & 3;
#pragma unroll
    for (int j = 0; j < 4; ++j) { const int nn = (lane >> 2) + 16 * j; const LAS unsigned* sp = (const LAS unsigned*)(scr + nn * 68 + 16 * ch); v4u o; o.x = sp[0]; o.y = sp[1]; o.z = sp[2]; o.w = sp[3];
        const int row = it.mode ? it.base + 128 * (nn & 1) + (nn >> 1) : it.base + nn;
        *(GAS v4u*)(it.dst + (size_t)row * it.ldk + 16 * ch) = o; }
    LDS_WAIT(); asm volatile("" ::: "memory");
}
__device__ __forceinline__ void conv_expert_items(Frame& F, int first, int count, int k, int n, int part, int nparts, LAS unsigned char* scr) {
    const float* const w_exp1_ = (const float*)inp(F, 21); const float* const w_exp2_ = (const float*)inp(F, 23);
    const int ipw = (count + n - 1) / n, base = k * ipw, own = (ipw - F.wave + 7) / 8;
    const int j0 = own * part / nparts, j1 = own * (part + 1) / nparts;
    int lane = F.lane; asm volatile("" : "+v"(lane));
    int jj = j0;
    for (; jj + 1 < j1; jj += 2) {
        const int r0 = base + F.wave + 8 * jj, r1 = r0 + 8; if (r1 >= count) break;
        const CItem a = conv_item(w_exp1_, w_exp2_, F.ws, first + r0), b = conv_item(w_exp1_, w_exp2_, F.ws, first + r1);
        f32x4 va[4][4], vb[4][4]; conv_load(a, va, lane); conv_load(b, vb, lane); conv_store(a, va, scr, lane); conv_store(b, vb, scr, lane);
    }
    for (; jj < j1; ++jj) {
        const int r0 = base + F.wave + 8 * jj; if (r0 >= count) break;
        const CItem a = conv_item(w_exp1_, w_exp2_, F.ws, first + r0); f32x4 va[4][4]; conv_load(a, va, lane); conv_store(a, va, scr, lane);
    }
}
__device__ __forceinline__ void conv_in_idle_round(Frame& F, int nwg, int first, int count) {
    const int r = nwg % F.G, c = F.vb;
    if (r != 0 && c < r) return;
    conv_expert_items(F, first, count, r ? c - r : c, r ? F.G - r : F.G, 0, 1, F.lds + RING_OFF + F.wave * 4352);
}
constexpr int CONV_W2_IN_P2 = 5120, CONV_W2_ALL = NE * 16 * 16, CONV_ALL = NE * 16 * 16 + NE * 16 * 32;
__device__ __forceinline__ void p0_prologue(Frame& F) {
    const float* const c_ = (const float*)inp(F, 1); const float* const w_ada_ = (const float*)inp(F, 3); const float* const b_ada_ = (const float*)inp(F, 4); float* const mod_ = (float*)(F.ws + WS_MOD); const int* const positions_ = (const int*)inp(F, 2); float* const rope_ = (float*)(F.ws + WS_ROPE); const float* const lq1_ = (const float*)inp(F, 7); const float* const lk1_ = (const float*)inp(F, 8); const float* const lq2_ = (const float*)inp(F, 9); const float* const lk2_ = (const float*)inp(F, 10); float* const lam_ = (float*)(F.ws + WS_MOD + 256 * 1024); const float* const w_exp1_ = (const float*)inp(F, 21); bf16* const W1_t_ = (bf16*)(F.ws + WS_W1); const float* const w_exp2_ = (const float*)inp(F, 23); bf16* const W2_t_ = (bf16*)(F.ws + WS_W2); const float* const w_in_ = (const float*)inp(F, 6); bf16* const Win_t_ = (bf16*)(F.ws + WS_WIN); const float* const w_proj_a_ = (const float*)inp(F, 14); bf16* const Wa_t_ = (bf16*)(F.ws + WS_WA); const float* const w_proj_b_ = (const float*)inp(F, 15); bf16* const Wb_t_ = (bf16*)(F.ws + WS_WB); const float* const w_pool_ = (const float*)inp(F, 12); const float* const pool_scale_ = (const float*)inp(F, 13); bf16* const Wpool_t_ = (bf16*)(F.ws + WS_WPOOL); const float* const w_out_ = (const float*)inp(F, 16); bf16* const Wout_t_ = (bf16*)(F.ws + WS_WOUT);
    {
        LAS float* sc = (LAS float*)(F.lds + RING_OFF);
        LAS float* red = (LAS float*)(F.lds + RING_OFF + 32768);
        bool staged = false;
        for (int it = blockIdx.x; it < 96; it += F.G) {
            if (!staged) { for (int i = F.tid; i < NB * D; i += NWAVES * 64) { const int b = i >> 10, kk = i & 1023; const float v = c_[i]; sc[kk * 8 + b] = v / (1.f + __expf(-v)); } __syncthreads(); staged = true; }
            const int j0 = it * 64, cg = F.lane & 15, kq = F.lane >> 4;
            float acc[8][4];
#pragma unroll
            for (int b = 0; b < 8; ++b)
#pragma unroll
                for (int xx = 0; xx < 4; ++xx) acc[b][xx] = 0.f;
#pragma unroll 8
            for (int s = 0; s < 32; ++s) { const int kk = 32 * s + 4 * F.wave + kq;
                const f32x4 w = *(const GAS f32x4*)(w_ada_ + (size_t)kk * (NMOD * D) + j0 + 4 * cg);
                const f32x4 s0 = *(const LAS f32x4*)(sc + kk * 8), s1 = *(const LAS f32x4*)(sc + kk * 8 + 4);
#pragma unroll
                for (int xx = 0; xx < 4; ++xx) { acc[0][xx] += s0[0] * w[xx]; acc[1][xx] += s0[1] * w[xx]; acc[2][xx] += s0[2] * w[xx]; acc[3][xx] += s0[3] * w[xx];
                    acc[4][xx] += s1[0] * w[xx]; acc[5][xx] += s1[1] * w[xx]; acc[6][xx] += s1[2] * w[xx]; acc[7][xx] += s1[3] * w[xx]; } }
#pragma unroll
            for (int b = 0; b < 8; ++b)
#pragma unroll
                for (int xx = 0; xx < 4; ++xx) { float a = acc[b][xx]; a += __shfl_xor(a, 16); a += __shfl_xor(a, 32); if (kq == 0) red[(F.wave * 8 + b) * 64 + 4 * cg + xx] = a; }
            __syncthreads();
            { const int b = F.tid >> 6, col = F.tid & 63; float a = b_ada_[j0 + col];
#pragma unroll
              for (int w = 0; w < 8; ++w) a += red[(w * 8 + b) * 64 + col];
              mod_[b * (NMOD * D) + j0 + col] = a; }
            __syncthreads();
        }
        if (staged) __syncthreads();
    }
    for (int idx = F.vcu * (NWAVES * 64) + F.tid; idx < T * 8; idx += F.G * NWAVES * 64) { const int t = idx >> 3, i = idx & 7; float cs, sn; rope_cs(positions_[t], i, cs, sn); rope_[t * 16 + i] = cs; rope_[t * 16 + 8 + i] = sn; }
    if (blockIdx.x == 0 && F.wave == 0) { const float s1 = wave_sum(lq1_[F.lane] * lk1_[F.lane]), s2 = wave_sum(lq2_[F.lane] * lk2_[F.lane]); if (F.lane == 0) lam_[0] = expf(s1) - expf(s2) + LAM_INIT; }
    {
        LAS bf16* scr = (LAS bf16*)(F.lds + RING_OFF + F.wave * 8448);
        const int gw = F.vcu * NWAVES + F.wave, NGW = F.G * NWAVES;
        constexpr int I_IN = 16 * (INC / 64), I_A = 16 * 16, I_O = 16 * 16;
        constexpr int NITEMS = I_IN + I_A + I_O;
        for (int it = gw; it < NITEMS; it += NGW) {
            int r = it;
            if (r < I_IN) { const int kb = r / (INC / 64), nb = r % (INC / 64);
                tr_item(w_in_, INC, kb * 64, nb * 64, Win_t_, D, kb * 64, [=](int nn) { return nb * 64 + ((nb < 32 && nn < 16) ? ((nn & 7) * 2 + (nn >> 3)) : nn); }, scr, F.lane, false); continue; } r -= I_IN;
            if (r < I_A) { const int kb = r / 16, nb = r % 16;
                tr_item(w_proj_a_, D, kb * 64, nb * 64, Wa_t_, DW, kb * 64, [=](int nn) { return nb * 64 + nn; }, scr, F.lane, false); continue; } r -= I_A;
            { const int kb = r / 16, nb = r % 16;
                tr_item(w_out_, D, kb * 64, nb * 64, Wout_t_, D, kb * 64, [=](int nn) { return nb * 64 + nn; }, scr, F.lane, false); }
        }
        const int nfree = (F.G > 96) ? F.G - 96 : F.G, myfree = (F.G > 96) ? (int)blockIdx.x - 96 : (int)blockIdx.x;
        for (int it = myfree * NWAVES + F.wave; myfree >= 0 && it < 16 * 64; it += nfree * NWAVES) {
            const int n = (it & 15) * 64 + F.lane, kk0 = (it >> 4) * 8, g = kk0 >> 7, c0 = kk0 & 127;
            const float* wp = w_pool_ + (size_t)g * 128 * 128 + (size_t)c0 * 128; const float* sc = pool_scale_ + g * 128; const float* wb = w_proj_b_ + (size_t)(g * 128) * D + n;
            float wr0[8], wr1[8];
            { const float s0 = sc[F.lane], s1 = sc[64 + F.lane];
#pragma unroll
              for (int q = 0; q < 8; ++q) { wr0[q] = wp[q * 128 + F.lane] * s0; wr1[q] = wp[q * 128 + 64 + F.lane] * s1; } }
            float acc[8];
#pragma unroll
            for (int q = 0; q < 8; ++q) acc[q] = 0.f;
#pragma unroll 1
            for (int j0 = 0; j0 < 128; j0 += 32) {
                float b[32];
#pragma unroll
                for (int u = 0; u < 32; ++u) b[u] = wb[(size_t)(j0 + u) * D];
#pragma unroll
                for (int u = 0; u < 32; ++u) { const int jx = j0 + u;
#pragma unroll
                    for (int q = 0; q < 8; ++q) { const float w = __builtin_bit_cast(float, __builtin_amdgcn_readlane(__builtin_bit_cast(int, (j0 < 64) ? wr0[q] : wr1[q]), jx & 63)); acc[q] += w * b[u]; } }
            }
            *(GAS v4u*)(Wb_t_ + (size_t)n * PW + kk0) = (v4u){pk2(acc[0], acc[1]), pk2(acc[2], acc[3]), pk2(acc[4], acc[5]), pk2(acc[6], acc[7])};
        }
    }
}

__device__ __forceinline__ void p1_norm(Frame& F) {
    const float* const g_pre_mix_ = (const float*)inp(F, 5); const float* const x_ = (const float*)inp(F, 0); float* const mod_ = (float*)(F.ws + WS_MOD); bf16* const h_ = (bf16*)(F.ws + WS_H);
    const int gw = F.vcu * NWAVES + F.wave, NGW = F.G * NWAVES;
    f32x4 gv[4];
#pragma unroll
    for (int j = 0; j < 4; ++j) gv[j] = *((const GAS f32x4*)g_pre_mix_ + F.lane + 64 * j);
    f32x4 shv[4], scv[4]; int curb = -1;
#define P1_ROW(i) ((((i) & 2047) >> 8) * SEQ + ((i) >> 11) * 256 + ((i) & 255))
#define P1_LOAD(dst, i) do { const GAS f32x4* xr_ = (const GAS f32x4*)(x_ + (size_t)P1_ROW(i) * D) + F.lane; _Pragma("unroll") for (int j = 0; j < 4; ++j) dst[j] = xr_[64 * j]; } while (0)
    f32x4 v[4], vb[4], vc[4];
    if (gw < T) P1_LOAD(v, gw);
    if (gw + NGW < T) P1_LOAD(vb, gw + NGW);
    for (int mi_ = gw; mi_ < T; mi_ += NGW) {
        const int m = P1_ROW(mi_);
        const float* mb = mod_ + (m / SEQ) * (NMOD * D);
        if (mi_ + 2 * NGW < T) P1_LOAD(vc, mi_ + 2 * NGW);
        float s = 0.f;
        if (m / SEQ != curb) { curb = m / SEQ;
#pragma unroll
            for (int j = 0; j < 4; ++j) { shv[j] = *((const GAS f32x4*)mb + F.lane + 64 * j); scv[j] = *((const GAS f32x4*)(mb + D) + F.lane + 64 * j) + 1.f; } }
#pragma unroll
        for (int j = 0; j < 4; ++j) s += (v[j].x * v[j].x + v[j].y * v[j].y) + (v[j].z * v[j].z + v[j].w * v[j].w);
        const float r = rsqrtf(wave_sum(s) * (1.f / D) + NORM_EPS);
        GAS v2u* o8 = (GAS v2u*)(h_ + (size_t)m * D) + F.lane;
#pragma unroll
        for (int j = 0; j < 4; ++j) { const f32x4 o = v[j] * r * gv[j] * scv[j] + shv[j]; o8[64 * j] = (v2u){pk2(o.x, o.y), pk2(o.z, o.w)}; }
#pragma unroll
        for (int j = 0; j < 4; ++j) { v[j] = vb[j]; vb[j] = vc[j]; }
    }
#undef P1_ROW
#undef P1_LOAD
}
__device__ __forceinline__ void p3_poold(Frame& F) {
    bf16* const u_ = (bf16*)(F.ws + WS_U); bf16* const dd_ = (bf16*)(F.ws + WS_DD);
    LAS unsigned* col = (LAS unsigned*)(F.lds + RING_OFF + F.wave * 16384);
    const int gw = F.vcu * NWAVES + F.wave, NGW = F.G * NWAVES;
    for (int it = gw; it < (T / 32) * 4; it += NGW) {
        const int g = it & 3, blk = it >> 2, t0 = blk * 32, tin0 = t0 % SEQ, w = 2 << g;
        const bf16* up = u_ + (size_t)t0 * PW + g * 128 + 2 * F.lane;
        unsigned vals[48];
#pragma unroll
        for (int r = 0; r < 48; ++r) { vals[r] = 0u; if (tin0 - 16 + r >= 0) vals[r] = *(const GAS unsigned*)(up + (ptrdiff_t)(r - 16) * PW); }
#pragma unroll
        for (int r = 0; r < 48; ++r) col[r * 64 + F.lane] = vals[r];
        LDS_WAIT(); asm volatile("" ::: "memory");
        float s0 = 0.f, s1 = 0.f;
        for (int j = 1; j <= w; ++j) { const unsigned val = col[(16 - j) * 64 + F.lane]; s0 += bflo(val); s1 += bfhi(val); }
        bf16* dp = dd_ + (size_t)t0 * PW + g * 128 + 2 * F.lane;
        for (int r = 0; r < 32; ++r) { const unsigned cur = col[(16 + r) * 64 + F.lane], old = col[(16 + r - w) * 64 + F.lane];
            s0 += bflo(cur) - bflo(old); s1 += bfhi(cur) - bfhi(old);
            const float inv = 1.f / (float)min(tin0 + r + 1, w);
            *(GAS unsigned*)(dp + (size_t)r * PW) = pk2(s0 * inv - bflo(cur), s1 * inv - bfhi(cur)); }
        LDS_WAIT(); asm volatile("" ::: "memory");
    }
}
__device__ __forceinline__ void p3_combine(Frame& F, int b, int h, int qb) {
    const float* const g_subln_ = (const float*)inp(F, 11); const float* const lam_ = (const float*)(F.ws + WS_MOD + 256 * 1024);
    const bf16* const O0_ = (const bf16*)(F.ws + WS_O0); const bf16* const O1_ = (const bf16*)(F.ws + WS_O1); bf16* const oc_ = (bf16*)(F.ws + WS_OC);
    asm volatile("s_waitcnt vmcnt(0)" ::: "memory"); __syncthreads();
    const __amdgpu_buffer_rsrc_t r0 = __builtin_amdgcn_make_buffer_rsrc((void*)O0_, 0, T * DW * 2, 0x00020000), r1 = __builtin_amdgcn_make_buffer_rsrc((void*)O1_, 0, T * DW * 2, 0x00020000);
    int lane = F.lane; asm volatile("" : "+v"(lane));
    const float lam = lam_[0];
    float gs[16];
#pragma unroll
    for (int i = 0; i < 16; ++i) gs[i] = g_subln_[16 * (lane & 7) + i] * (1.f - LAM_INIT);
#pragma unroll 2
    for (int st = 0; st < 4; ++st) {
        const int row = b * SEQ + qb * 256 + F.wave * 32 + st * 8 + (lane >> 3);
        const size_t off = (size_t)row * DW + h * 128 + 16 * (lane & 7);
        const unsigned ob = (unsigned)(off * 2);
        const v4u a0 = __builtin_amdgcn_raw_buffer_load_b128(r0, ob, 0, 16), a1 = __builtin_amdgcn_raw_buffer_load_b128(r0, ob + 16, 0, 16), b0 = __builtin_amdgcn_raw_buffer_load_b128(r1, ob, 0, 16), b1 = __builtin_amdgcn_raw_buffer_load_b128(r1, ob + 16, 0, 16);
        float v[16];
#pragma unroll
        for (int i = 0; i < 4; ++i) { v[2 * i] = bflo(a0[i]) - lam * bflo(b0[i]); v[2 * i + 1] = bfhi(a0[i]) - lam * bfhi(b0[i]); v[8 + 2 * i] = bflo(a1[i]) - lam * bflo(b1[i]); v[8 + 2 * i + 1] = bfhi(a1[i]) - lam * bfhi(b1[i]); }
        float ss = 0.f;
#pragma unroll
        for (int i = 0; i < 16; ++i) ss += v[i] * v[i];
        ss = sum8(ss);
        const float r = rsqrtf(ss * (1.f / 128.f) + SUBLN_EPS);
        v4u o0, o1;
#pragma unroll
        for (int i = 0; i < 4; ++i) { o0[i] = pk2(v[2 * i] * r * gs[2 * i], v[2 * i + 1] * r * gs[2 * i + 1]); o1[i] = pk2(v[8 + 2 * i] * r * gs[8 + 2 * i], v[9 + 2 * i] * r * gs[9 + 2 * i]); }
        *(GAS v4u*)(oc_ + off) = o0; *(GAS v4u*)(oc_ + off + 8) = o1;
    }
}
__device__ __forceinline__ void p7_router(Frame& F, const int npass) {
    const float* const w_router_ = (const float*)inp(F, 19); const float* const b_router_ = (const float*)inp(F, 20); float* const mod_ = (float*)(F.ws + WS_MOD); float* const mx_ = (float*)(F.ws + WS_MX); const float* const x_ = (const float*)inp(F, 0); const float* const g_post_mix_ = (const float*)inp(F, 17); float* const out_ = (float*)inp(F, 26); const float* const g_pre_ffn_ = (const float*)inp(F, 18); bf16* const h2_ = (bf16*)(F.ws + WS_H2); int* const list_ = (int*)(F.ws + WS_LIST); unsigned* const tokslot_ = (unsigned*)(F.ws + WS_TOK); float* const tokw_ = (float*)(F.ws + WS_TOK + 256 * 1024);
    constexpr int HP = 2064;
    LAS unsigned char* hhi = F.lds + RING_OFF; LAS unsigned char* hlo = F.lds + RING_OFF + 16 * HP;
    LAS float* part = (LAS float*)(F.lds + RING_OFF + 66048);
    LAS unsigned* sel = (LAS unsigned*)(F.lds + RING_OFF + 98304);
    LAS float* selw = (LAS float*)(F.lds + RING_OFF + 98304 + 2048);
    LAS int* selt = (LAS int*)(F.lds + RING_OFF + 98304 + 4096);
    LAS unsigned* lcnt = (LAS unsigned*)(F.lds + RING_OFF + 98304 + 4608);
    LAS f32x4* cv = (LAS f32x4*)(F.lds + RING_OFF + 106496);
    int curb = -1;
    if (F.tid < 64) lcnt[F.tid] = 0u;
    const int e = F.lane & 31;
    pg8::bf16x8 bhi[4][2], blo[4][2];
#pragma unroll
    for (int ks = 0; ks < 4; ++ks)
#pragma unroll
        for (int nb2 = 0; nb2 < 2; ++nb2) { unsigned hh[4], ll[4];
#pragma unroll
            for (int jp = 0; jp < 4; ++jp) { const size_t k0 = (size_t)(128 * F.wave + 32 * ks + 8 * (F.lane >> 4) + 2 * jp); const float w0 = w_router_[k0 * NE + 16 * nb2 + (F.lane & 15)], w1 = w_router_[(k0 + 1) * NE + 16 * nb2 + (F.lane & 15)];
                hh[jp] = pk2(w0, w1); ll[jp] = pk2(w0 - bflo(hh[jp]), w1 - bfhi(hh[jp])); }
            bhi[ks][nb2] = __builtin_bit_cast(pg8::bf16x8, (v4u){hh[0], hh[1], hh[2], hh[3]}); blo[ks][nb2] = __builtin_bit_cast(pg8::bf16x8, (v4u){ll[0], ll[1], ll[2], ll[3]}); }
    const float bre = b_router_[e];
    __syncthreads();
    int nb = 0;
    for (int pass = 0; pass < npass; ++pass) {
    if (pass > 0) { __syncthreads(); if (F.tid < 64) lcnt[F.tid] = 0u; __syncthreads(); }
    nb = 0;
    for (int bi = F.vcu; bi < T / 16; bi += F.G, ++nb) {
        const int bt = ((bi & 255) >> 5) * (SEQ / 16) + (bi >> 8) * 32 + (bi & 31);
        if ((bt * 16) / SEQ != curb) { curb = (bt * 16) / SEQ; const float* mb = mod_ + curb * (NMOD * D);
            for (int i = F.tid; i < 5 * 256; i += NWAVES * 64) { const int v = i >> 8, c = i & 255;
                const GAS f32x4* src = (v == 0) ? (const GAS f32x4*)g_post_mix_ : (v == 1) ? (const GAS f32x4*)g_pre_ffn_ : (const GAS f32x4*)(mb + v * D);
                f32x4 val = src[c]; if (v == 4) val = val + 1.f; cv[i] = val; }
            __syncthreads(); }
        {
            const int t0 = bt * 16 + 2 * F.wave;
            f32x4 mv[2][4], xv[2][4];
#pragma unroll
            for (int rr = 0; rr < 2; ++rr)
#pragma unroll
                for (int j = 0; j < 4; ++j) { { const v2u mw = *((const GAS v2u*)((const bf16*)mx_ + (size_t)(t0 + rr) * D) + F.lane + 64 * j); mv[rr][j] = (f32x4){bflo(mw.x), bfhi(mw.x), bflo(mw.y), bfhi(mw.y)}; } xv[rr][j] = *((const GAS f32x4*)(x_ + (size_t)(t0 + rr) * D) + F.lane + 64 * j); }
#pragma unroll
            for (int rr = 0; rr < 2; ++rr) {
                const int r = 2 * F.wave + rr, t = t0 + rr; float s = 0.f;
#pragma unroll
                for (int j = 0; j < 4; ++j) s += (mv[rr][j].x * mv[rr][j].x + mv[rr][j].y * mv[rr][j].y) + (mv[rr][j].z * mv[rr][j].z + mv[rr][j].w * mv[rr][j].w);
                float rs = rsqrtf(wave_sum(s) * (1.f / D) + NORM_EPS); s = 0.f;
#pragma unroll
                for (int j = 0; j < 4; ++j) { const f32x4 gp = cv[F.lane + 64 * j], gt = cv[512 + F.lane + 64 * j];
                    xv[rr][j] = xv[rr][j] + gt * (mv[rr][j] * rs * gp); *((GAS v2u*)(F.ws + WS_X1 + (size_t)t * D * 2) + F.lane + 64 * j) = (v2u){pk2(xv[rr][j].x, xv[rr][j].y), pk2(xv[rr][j].z, xv[rr][j].w)};     s += (xv[rr][j].x * xv[rr][j].x + xv[rr][j].y * xv[rr][j].y) + (xv[rr][j].z * xv[rr][j].z + xv[rr][j].w * xv[rr][j].w); }
                rs = rsqrtf(wave_sum(s) * (1.f / D) + NORM_EPS);
#pragma unroll
                for (int j = 0; j < 4; ++j) { const f32x4 gq = cv[256 + F.lane + 64 * j], sh = cv[768 + F.lane + 64 * j], sc1 = cv[1024 + F.lane + 64 * j];
                    const f32x4 hv = xv[rr][j] * rs * gq * sc1 + sh;
                    if (!MK_SINGLE) *((GAS v2u*)(h2_ + (size_t)t * D) + F.lane + 64 * j) = (v2u){pk2(hv.x, hv.y), pk2(hv.z, hv.w)};
                    { int w8 = 0; w8 = __builtin_amdgcn_cvt_pk_fp8_f32(hv.x, hv.y, w8, false); w8 = __builtin_amdgcn_cvt_pk_fp8_f32(hv.z, hv.w, w8, true); *((GAS unsigned*)(F.ws + WS_H2F + (size_t)t * D) + F.lane + 64 * j) = (unsigned)w8; }
                    { const unsigned h0 = pk2(hv.x, hv.y), h1 = pk2(hv.z, hv.w); *(LAS v2u*)(hhi + r * HP + 8 * (F.lane + 64 * j)) = (v2u){h0, h1};
                      *(LAS v2u*)(hlo + r * HP + 8 * (F.lane + 64 * j)) = (v2u){pk2(hv.x - bflo(h0), hv.y - bfhi(h0)), pk2(hv.z - bflo(h1), hv.w - bfhi(h1))}; } }
            }
        }
        __syncthreads();
        { pg8::f32x4 acc2[2] = {{0.f, 0.f, 0.f, 0.f}, {0.f, 0.f, 0.f, 0.f}};
#pragma unroll
          for (int ks = 0; ks < 4; ++ks) { const int ao = (F.lane & 15) * HP + 2 * (128 * F.wave + 32 * ks + 8 * (F.lane >> 4));
              const pg8::bf16x8 ahi = *(const LAS pg8::bf16x8*)(hhi + ao), alo = *(const LAS pg8::bf16x8*)(hlo + ao);
#pragma unroll
              for (int nb2 = 0; nb2 < 2; ++nb2) { acc2[nb2] = __builtin_amdgcn_mfma_f32_16x16x32_bf16(ahi, bhi[ks][nb2], acc2[nb2], 0, 0, 0); acc2[nb2] = __builtin_amdgcn_mfma_f32_16x16x32_bf16(ahi, blo[ks][nb2], acc2[nb2], 0, 0, 0);
                  acc2[nb2] = __builtin_amdgcn_mfma_f32_16x16x32_bf16(alo, bhi[ks][nb2], acc2[nb2], 0, 0, 0); } }
#pragma unroll
          for (int nb2 = 0; nb2 < 2; ++nb2)
#pragma unroll
              for (int i2 = 0; i2 < 4; ++i2) part[(F.wave * 16 + 4 * (F.lane >> 4) + i2) * 32 + 16 * nb2 + (F.lane & 15)] = acc2[nb2][i2]; }
        __syncthreads();
        {
            const int r = 2 * F.wave + (F.lane >> 5), t = bt * 16 + r; float lg = bre;
#pragma unroll
            for (int w = 0; w < 8; ++w) lg += part[(w * 16 + r) * 32 + e];
            float val = lg, tv[4]; int ti[4];
#pragma unroll
            for (int kk = 0; kk < 4; ++kk) { const float m = max32(val);
                const unsigned long long bal = __ballot(val == m); const unsigned hb = (F.lane >> 5) ? (unsigned)(bal >> 32) : (unsigned)bal; const int idx = __builtin_ctz(hb);
                tv[kk] = m; ti[kk] = idx; if (e == idx) val = -INFINITY; }
            if (e == 0) { float pw[4], den = 0.f;
#pragma unroll
                for (int kk = 0; kk < 4; ++kk) { pw[kk] = __expf(tv[kk] - tv[0]); den += pw[kk]; }
                const float inv = 1.f / den; const int lr = nb * 16 + r; selt[lr] = t;
#pragma unroll
                for (int kk = 0; kk < 4; ++kk) { const unsigned lp = __hip_atomic_fetch_add(lcnt + ti[kk], 1u, __ATOMIC_RELAXED, __HIP_MEMORY_SCOPE_WORKGROUP); sel[lr * 4 + kk] = ((unsigned)ti[kk] << 16) | lp; selw[lr * 4 + kk] = pw[kk] * inv; } }
        }
    }
    }
    __syncthreads();
    if (PROBE_DUP == 77) { if (F.tid < NE) lcnt[32 + F.tid] = __hip_atomic_fetch_add((unsigned*)(F.ctl + CW_CNT + 64 * F.tid), 0u, RLX_AGENT); __syncthreads(); }
    if (F.tid < NE) lcnt[32 + F.tid] = __hip_atomic_fetch_add((unsigned*)(F.ctl + CW_CNT + 64 * F.tid), lcnt[F.tid], RLX_AGENT);
    __syncthreads();
    for (int s = F.tid; s < nb * 64; s += NWAVES * 64) { const unsigned sv = sel[s]; const int ee = sv >> 16; const unsigned pos = lcnt[32 + ee] + (sv & 0xffffu); const int t = selt[s >> 2];
        list_[ee * T + pos] = t; tokslot_[t * 4 + (s & 3)] = ((unsigned)ee << 16) | pos; tokw_[t * 4 + (s & 3)] = selw[s]; }
    __syncthreads();
}
__device__ __forceinline__ void moe_tables(Frame& F) {

    LAS int* tstart = (LAS int*)(F.lds + L_TSTART); LAS int* cntl = (LAS int*)(F.lds + L_CNT); LAS int* tile_e = (LAS int*)(F.lds + L_TILEE);
    if (F.tid < NE) cntl[F.tid] = (int)__hip_atomic_load((unsigned*)(F.ctl + CW_CNT + 64 * F.tid), RLX_AGENT);
    __syncthreads();
    if (F.tid == 0) { int s = 0; for (int e = 0; e < NE; ++e) { tstart[e] = s; s += (cntl[e] + 255) >> 8; } tstart[NE] = s; }
    __syncthreads();
    for (int pm = F.tid; pm < MT_MAX; pm += NWAVES * 64) { int e = 0;
#pragma unroll
        for (int j = 1; j < NE; ++j) e += (pm >= tstart[j]) ? 1 : 0;
        tile_e[pm] = e; }
    __syncthreads();
}
__device__ __forceinline__ void p10_final(Frame& F, const bool dry) {
    const float* const g_post_ffn_ = (const float*)inp(F, 25); const unsigned* const tokslot_ = (const unsigned*)(F.ws + WS_TOK); const float* const tokw_ = (const float*)(F.ws + WS_TOK + 256 * 1024);
    const unsigned char* const ye_ = (const unsigned char*)(F.ws + WS_YE); const float* const mod_ = (const float*)(F.ws + WS_MOD); float* const out_ = (float*)inp(F, 26);
    const LAS int* tstart = (const LAS int*)(F.lds + L_TSTART);
    LAS f32x4* gl = (LAS f32x4*)(F.lds + RING_OFF);
    for (int i = F.tid; i < NB * 256; i += NWAVES * 64) { const int b = i >> 8, c = i & 255; gl[i] = *((const GAS f32x4*)(mod_ + b * (NMOD * D) + 5 * D) + c) * *((const GAS f32x4*)g_post_ffn_ + c); }
    __syncthreads();
    const int gw = F.vcu * NWAVES + F.wave, NGW = F.G * NWAVES;
#define P10_SLOTS(sA, sB, wA, wB, t0_) do { const int ta_ = (t0_), tb_ = (ta_ + NGW < T) ? ta_ + NGW : ta_; if (ta_ < T) { sA = *(const GAS v4u*)(tokslot_ + ta_ * 4); sB = *(const GAS v4u*)(tokslot_ + tb_ * 4); wA = *(const GAS f32x4*)(tokw_ + ta_ * 4); wB = *(const GAS f32x4*)(tokw_ + tb_ * 4); } } while (0)
#define P10_ROWS(ya_, yb_, xa_, xb_, sA, sB, t0_) do { const int ta_ = (t0_), tb_ = (ta_ + NGW < T) ? ta_ + NGW : ta_; \
        _Pragma("unroll") for (int kk = 0; kk < 4; ++kk) { const GAS unsigned* ra = (const GAS unsigned*)(ye_ + (size_t)(256 * tstart[sA[kk] >> 16] + (sA[kk] & 0xffff)) * D); const GAS unsigned* rb = (const GAS unsigned*)(ye_ + (size_t)(256 * tstart[sB[kk] >> 16] + (sB[kk] & 0xffff)) * D); \
            _Pragma("unroll") for (int j = 0; j < 4; ++j) { ya_[kk][j] = ra[F.lane + 64 * j]; yb_[kk][j] = rb[F.lane + 64 * j]; } } \
        _Pragma("unroll") for (int j = 0; j < 4; ++j) { xa_[j] = *((const GAS v2u*)(F.ws + WS_X1 + (size_t)ta_ * D * 2) + F.lane + 64 * j); xb_[j] = *((const GAS v2u*)(F.ws + WS_X1 + (size_t)tb_ * D * 2) + F.lane + 64 * j); } } while (0)
    v4u s0A, s0B, s1A, s1B; f32x4 w0A, w0B, w1A, w1B;
    s0A = s0B = s1A = s1B = (v4u){0u, 0u, 0u, 0u}; w0A = w0B = w1A = w1B = (f32x4){0.f, 0.f, 0.f, 0.f};
    P10_SLOTS(s0A, s0B, w0A, w0B, gw); P10_SLOTS(s1A, s1B, w1A, w1B, gw + 2 * NGW);
    unsigned ya[4][4], yb[4][4], na[4][4], nb[4][4]; v2u xa[4], xb[4], nxa[4], nxb[4];
    if (gw < T) P10_ROWS(ya, yb, xa, xb, s0A, s0B, gw);
    for (int t0 = gw; t0 < T; t0 += 2 * NGW) {
        const int t1 = t0 + NGW; const bool two = t1 < T;
        const f32x4 twA0 = w0A, twB0 = w0B;
        if (t0 + 2 * NGW < T) P10_ROWS(na, nb, nxa, nxb, s1A, s1B, t0 + 2 * NGW);
        s0A = s1A; s0B = s1B; w0A = w1A; w0B = w1B;
        P10_SLOTS(s1A, s1B, w1A, w1B, t0 + 4 * NGW);
#pragma unroll
        for (int rr = 0; rr < 2; ++rr) {
            if (rr == 1 && !two) break;
            const int t = rr ? t1 : t0;
            float f[16];
#pragma unroll
            for (int i = 0; i < 16; ++i) f[i] = 0.f;
#pragma unroll
            for (int kk = 0; kk < 4; ++kk) { const float ws = (rr ? twB0[kk] : twA0[kk]) * pg8::YE_INV;
#pragma unroll
                for (int j = 0; j < 4; ++j) { const int a = (int)(rr ? yb[kk][j] : ya[kk][j]); const auto lo = __builtin_amdgcn_cvt_pk_f32_fp8(a, false), hi = __builtin_amdgcn_cvt_pk_f32_fp8(a, true);
                    f[4 * j] += ws * lo[0]; f[4 * j + 1] += ws * lo[1]; f[4 * j + 2] += ws * hi[0]; f[4 * j + 3] += ws * hi[1]; } }
            float ss = 0.f;
#pragma unroll
            for (int i = 0; i < 16; ++i) ss += f[i] * f[i];
            const float r = rsqrtf(wave_sum(ss) * (1.f / D) + NORM_EPS);
            const LAS f32x4* gtp = gl + (t / SEQ) * 256 + F.lane; GAS f32x4* op = (GAS f32x4*)(out_ + (size_t)t * D) + F.lane;
#pragma unroll
            for (int j = 0; j < 4; ++j) { const f32x4 gt = gtp[64 * j]; const v2u xw = rr ? xb[j] : xa[j]; const f32x4 x1 = {bflo(xw.x), bfhi(xw.x), bflo(xw.y), bfhi(xw.y)};
                const f32x4 fv = {f[4 * j], f[4 * j + 1], f[4 * j + 2], f[4 * j + 3]}; if (!dry) op[64 * j] = x1 + gt * (fv * r); }
        }
#pragma unroll
        for (int kk = 0; kk < 4; ++kk)
#pragma unroll
            for (int j = 0; j < 4; ++j) { ya[kk][j] = na[kk][j]; yb[kk][j] = nb[kk][j]; }
#pragma unroll
        for (int j = 0; j < 4; ++j) { xa[j] = nxa[j]; xb[j] = nxb[j]; }
    }
#undef P10_SLOTS
#undef P10_ROWS
}

struct Args { const void* in[26]; float* out; unsigned char* ws; int ph_lo, ph_hi; };
__global__ void __launch_bounds__(NWAVES * 64, 2) mega_fwd(Args args) {
    extern __shared__ __attribute__((aligned(16))) unsigned char lds[];
    Frame F;
    F.lds = (LAS unsigned char*)lds;
    F.MISC = (volatile LAS unsigned*)(F.lds + MISC_OFF);
    F.tid = threadIdx.x; F.lane = F.tid & 63; F.wave = __builtin_amdgcn_readfirstlane(F.tid >> 6);
    F.G = gridDim.x; { const int bx = blockIdx.x; F.vcu = (F.G % 8 == 0) ? (bx % 8) * (F.G / 8) + bx / 8 : bx; F.vb = bx; }
    F.ws = args.ws; F.ctl = (gu32*)(args.ws + WS_CTL);
    for (int u = F.tid; u < (LDS_BYTES - LDSCTL_OFF) / 4; u += NWAVES * 64) ((LAS unsigned*)(F.lds + LDSCTL_OFF))[u] = 0u;
    __syncthreads();
    if (F.tid == 0) { LAS unsigned long long* pt = (LAS unsigned long long*)(F.lds + L_PTRS);
#define PT(i) pt[i] = (unsigned long long)args.in[i];
        PT(0) PT(1) PT(2) PT(3) PT(4) PT(5) PT(6) PT(7) PT(8) PT(9) PT(10) PT(11) PT(12) PT(13) PT(14) PT(15) PT(16) PT(17) PT(18) PT(19) PT(20) PT(21) PT(22) PT(23) PT(24) PT(25)
#undef PT
        pt[26] = (unsigned long long)args.out; }
    __syncthreads();
    const int lo = args.ph_lo, hi = args.ph_hi;
    const bool single = (hi - lo) > 1;
    XcdBarrier bar; bar.bar = (unsigned*)(F.ctl + CW_BAR); bar.x = 0; bar.st = nullptr;
    if (single) bar = xcd_barrier_post((unsigned*)(F.ctl + CW_BAR), F.MISC + 8);
#define IN(k) (lo <= (k) && (k) < hi)
#define NREP(k) ((PROBE_DUP == (k) || (PROBE_DUP == 35 && (k) == 3)) ? 2 : 1)
#define SEAM(k) do { if (IN(k) && IN((k) + 1)) { xcd_barrier(bar); if (PROBE_DUP == 100 && (k) < 5) xcd_barrier(bar); } } while (0)
#define SEAML(k) do { if (IN(k) && IN((k) + 1)) { if (grp) xcc_local_barrier(bar); else xcd_barrier(bar); } } while (0)
    bool grp = false;
    const LAS int* gtab = (const LAS int*)(F.lds + L_GTAB);
#define REFRESH() do { int t_ = (int)threadIdx.x; asm volatile("" : "+v"(t_)); F.tid = t_; F.lane = t_ & 63; } while (0)

    _Pragma("unroll") for (int allrep_ = 0; allrep_ < ((PROBE_DUP == 200) ? 2 : 1); ++allrep_) {
    if (allrep_ > 0) { xcd_barrier(bar); if (blockIdx.x == 0 && F.tid < NE) __hip_atomic_store((unsigned*)(F.ctl + CW_CNT + 64 * F.tid), 0u, RLX_AGENT); xcd_barrier(bar); }
    if (IN(0)) _Pragma("unroll") for (int rep_ = 0; rep_ < NREP(0); ++rep_) { REFRESH(); p0_prologue(F); if (NREP(0) > 1) __syncthreads(); } SEAM(0);
    if (single && allrep_ == 0) { const unsigned md = __builtin_amdgcn_readfirstlane(F.MISC[10]), rk = __builtin_amdgcn_readfirstlane(F.MISC[11]);
        if (md == 2u && PROBE_DUP != 101) { grp = true; F.vcu = (int)bar.x * 32 + (int)rk; F.vb = (int)rk * 8 + (int)bar.x; } }
    if (IN(1)) _Pragma("unroll") for (int rep_ = 0; rep_ < NREP(1); ++rep_) { REFRESH(); p1_norm(F); } SEAML(1);
    if (IN(2)) _Pragma("unroll") for (int rep_ = 0; rep_ < NREP(2); ++rep_) { REFRESH();
        pg8::Gemm g{((bf16*)(F.ws + WS_H)), ((bf16*)(F.ws + WS_WIN)), D, 0, 0}; pg8::StaticOrder S; S.init(T, INC, F.G, F.vb);
        pg8::EpiZ E{((bf16*)(F.ws + WS_Q)), ((bf16*)(F.ws + WS_K)), ((bf16*)(F.ws + WS_V)), ((bf16*)(F.ws + WS_U)), ((bf16*)(F.ws + WS_GA)), ((bf16*)(F.ws + WS_GB)), ((float*)(F.ws + WS_ROPE))};
        pg8::gemm_phase<pg8::EpiZ, pg8::StaticOrder, true, false>(F.lds + RING_OFF, g, S, E, gtab);
        if (rep_ == NREP(2) - 1) conv_in_idle_round(F, (T / 256) * (INC / 256), 0, CONV_W2_IN_P2);
    } SEAML(2);
    if (IN(3)) _Pragma("unroll") for (int rep_ = 0; rep_ < NREP(3); ++rep_) { REFRESH();
        p3_poold(F);
        __syncthreads();
        const attn_body::Combine CB{false, (const attn_body::bf16*)(F.ws + WS_O0), (attn_body::bf16*)(F.ws + WS_OC), (const float*)inp(F, 11), ((const float*)(F.ws + WS_MOD + 256 * 1024))[0], SUBLN_EPS, 1.f - LAM_INIT};
        const attn_body::AttnTensors AT{(const attn_body::bf16*)(F.ws + WS_Q), (const attn_body::bf16*)(F.ws + WS_K), (const attn_body::bf16*)(F.ws + WS_V), (attn_body::bf16*)(F.ws + WS_O0), CB};
        attn_body::attn_phase<16>((char*)lds + RING_OFF, AT, F.vcu, F.G,
            [&](int i, int nun) { if (!((PROBE_DUP == 3 || PROBE_DUP == 35) && rep_ > 0)) { conv_expert_items(F, CONV_W2_ALL, CONV_ALL - CONV_W2_ALL, F.vcu, F.G, i, nun, F.lds + RING_OFF + F.wave * 4352);
                if (PROBE_DUP == 36) { const float* w1 = (const float*)inp(F, 21); int lane = F.lane; asm volatile("" : "+v"(lane));
                    for (int q = 0; q < 2; ++q) { CItem a; a.src = w1 + (size_t)(F.wave * 64) * (2 * FF); a.ldw = 2 * FF; a.dst = F.ws + WS_Y + (size_t)(blockIdx.x * 8 + F.wave) * 65536; a.ldk = D; a.base = 0; a.mode = 0; f32x4 va[4][4]; conv_load(a, va, lane); conv_store(a, va, F.lds + RING_OFF + F.wave * 4352, lane); } }
                asm volatile("s_waitcnt lgkmcnt(0)\n\ts_barrier" ::: "memory"); } });
        __builtin_amdgcn_s_setprio(0);
    } SEAML(3);
    if (IN(5)) _Pragma("unroll") for (int rep_ = 0; rep_ < NREP(5); ++rep_) { REFRESH();
        pg8::Gemm2 g{((bf16*)(F.ws + WS_DD)), ((bf16*)(F.ws + WS_WB)), ((bf16*)(F.ws + WS_OC)), ((bf16*)(F.ws + WS_WA)), PW, DW};
        pg8::StaticOrder S; S.init(T, D, F.G, F.vb);
        pg8::EpiChain E{((const bf16*)(F.ws + WS_GA)), ((const bf16*)(F.ws + WS_GB)), ((bf16*)(F.ws + WS_MI))};
        pg8::gemm_chain2<pg8::EpiChain, pg8::StaticOrder>(F.lds + RING_OFF, g, S, E);
    } SEAML(5);
    if (IN(6)) _Pragma("unroll") for (int rep_ = 0; rep_ < NREP(6); ++rep_) { REFRESH();
        pg8::Gemm g{((bf16*)(F.ws + WS_MI)), ((bf16*)(F.ws + WS_WOUT)), D, 0, 0}; pg8::StaticOrder S; S.init(T, D, F.G, F.vb);
        pg8::EpiBf16Plain E{((bf16*)(F.ws + WS_MX))};
        pg8::gemm_phase<pg8::EpiBf16Plain, pg8::StaticOrder, true, false>(F.lds + RING_OFF, g, S, E, gtab);
    } SEAML(6);
    if (IN(7)) { REFRESH(); p7_router(F, NREP(7)); } SEAM(7);
    if (IN(8) || IN(9) || IN(10)) { REFRESH(); moe_tables(F); }
    if (IN(8)) _Pragma("unroll") for (int rep_ = 0; rep_ < NREP(8); ++rep_) { REFRESH();
        const LAS int* tstart = (const LAS int*)(F.lds + L_TSTART); const LAS int* cntl = (const LAS int*)(F.lds + L_CNT);
        { pg8::MoeOrder S0; S0.init(tstart[NE], 2 * FF, F.G, F.vb, (const LAS int*)(F.lds + L_TILEE));
          pg8::Unit un; LAS int* gt = (LAS int*)(F.lds + L_GTAB); LAS int* ul = (LAS int*)(F.lds + L_ULIST); int n = 0;
          _Pragma("unroll 1") for (int i = 0; i < MAXU && S0.next(i, un); ++i, ++n) if (F.tid == 0) { ul[4 + 4 * i] = un.pm; ul[5 + 4 * i] = un.pn; ul[6 + 4 * i] = un.e; }
          if (F.tid == 0) ul[0] = n;
          __syncthreads();
          int tokv[MAXU / 2];
#pragma unroll
          for (int j = 0; j < MAXU / 2; ++j) { const int x = F.tid + 512 * j, i = x >> 8, r = x & 255; tokv[j] = 0;
              if (i < n) { const int pm = ul[4 + 4 * i], e = ul[6 + 4 * i], pos = (pm - tstart[e]) * 256 + r; if (pos < cntl[e]) tokv[j] = ((const int*)(F.ws + WS_LIST))[e * T + pos]; } }
#pragma unroll
          for (int j = 0; j < MAXU / 2; ++j) { const int x = F.tid + 512 * j; if ((x >> 8) < n) gt[x] = tokv[j]; }
          __syncthreads(); }
        const pg8::ListOrder S{(const LAS int*)(F.lds + L_ULIST)};
        pg8::Gemm g{((bf16*)(F.ws + WS_H2F)), ((bf16*)(F.ws + WS_W1)), D / 2, 0, (size_t)2 * FF * D};
        pg8::EpiSwiglu E{(unsigned char*)(F.ws + WS_A), ((const float*)inp(F, 22))};
        pg8::gemm_phase<pg8::EpiSwiglu, pg8::ListOrder, true, true, true>(F.lds + RING_OFF, g, S, E, gtab);
        if (rep_ == NREP(8) - 1) conv_in_idle_round(F, tstart[NE] * (2 * FF / 256), CONV_W2_IN_P2, CONV_W2_ALL - CONV_W2_IN_P2);
    } SEAM(8);
    if (IN(9)) _Pragma("unroll") for (int rep_ = 0; rep_ < NREP(9); ++rep_) { REFRESH();
        const LAS int* tstart = (const LAS int*)(F.lds + L_TSTART);
        { pg8::MoeOrder S0; S0.init(tstart[NE], D, F.G, F.vb, (const LAS int*)(F.lds + L_TILEE));
          pg8::Unit un; LAS int* ul = (LAS int*)(F.lds + L_ULIST); int n = 0;
          __syncthreads();
          _Pragma("unroll 1") for (int i = 0; i < MAXU && S0.next(i, un); ++i, ++n) if (F.tid == 0) { ul[4 + 4 * i] = un.pm; ul[5 + 4 * i] = un.pn; ul[6 + 4 * i] = un.e; }
          if (F.tid == 0) ul[0] = n;
          __syncthreads(); }
        const pg8::ListOrder S{(const LAS int*)(F.lds + L_ULIST)};
        pg8::Gemm g{((bf16*)(F.ws + WS_A)), ((bf16*)(F.ws + WS_W2)), FF / 2, 0, (size_t)D * FF};
        pg8::EpiYe E{(unsigned char*)(F.ws + WS_YE), ((const float*)inp(F, 24))};
        pg8::gemm_phase<pg8::EpiYe, pg8::ListOrder, true, false, true>(F.lds + RING_OFF, g, S, E, gtab);
    } SEAM(9);
    if (IN(10)) { REFRESH(); if (NREP(10) > 1) p10_final(F, true); p10_final(F, false); }
    }
#undef IN
#undef SEAM
#undef SEAML
}
#ifndef MK_SINGLE
#define MK_SINGLE 1
#endif
#ifndef OPT_MASK
#define OPT_MASK 0x7ff
#endif
extern "C" void kernel_launch(void* const* d_in, const int* in_sizes, int n_in, void* d_out, int out_size, void* d_ws, size_t ws_size, hipStream_t stream) {
    static int grid = 0;
    if (grid == 0) {
        if (n_in != 26 || in_sizes[0] != T * D || out_size != T * D || ws_size < WS_END) { fprintf(stderr, "kernel_launch: unexpected shapes (n_in %d, in0 %d, out %d, ws %zu); nothing launched\n", n_in, n_in > 0 ? in_sizes[0] : -1, out_size, ws_size); grid = -1; return; }
        int dev = 0, cus = 0, per_cu = 0;
        if (hipGetDevice(&dev) != hipSuccess || hipDeviceGetAttribute(&cus, hipDeviceAttributeMultiprocessorCount, dev) != hipSuccess) { fprintf(stderr, "kernel_launch: device query failed\n"); grid = -1; return; }
        if (hipFuncSetAttribute((const void*)mega_fwd, hipFuncAttributeMaxDynamicSharedMemorySize, LDS_BYTES) != hipSuccess) { fprintf(stderr, "kernel_launch: hipFuncSetAttribute failed\n"); grid = -1; return; }
        if (hipOccupancyMaxActiveBlocksPerMultiprocessor(&per_cu, (const void*)mega_fwd, NWAVES * 64, LDS_BYTES) != hipSuccess || per_cu < 1) fprintf(stderr, "kernel_launch: note: occupancy query reports %d workgroups per CU\n", per_cu);
        (void)hipGetLastError();
        grid = cus;
    }
    if (grid < 0) return;
    unsigned char* ws = (unsigned char*)d_ws;
    (void)hipMemsetAsync(ws + WS_CTL, 0, CTL_ZERO_BYTES, stream);
    Args a{};
    for (int i = 0; i < 26; ++i) a.in[i] = d_in[i];
    a.out = (float*)d_out; a.ws = ws;
#if MK_SINGLE
    a.ph_lo = 0; a.ph_hi = NPHASE;
    hipLaunchKernelGGL(mega_fwd, dim3(grid), dim3(NWAVES * 64), LDS_BYTES, stream, a);
#else
    const float* x = (const float*)d_in[0]; const float* c = (const float*)d_in[1]; const int* positions = (const int*)d_in[2];
    const float* w_ada = (const float*)d_in[3]; const float* b_ada = (const float*)d_in[4]; const float* g_pre_mix = (const float*)d_in[5]; const float* w_in = (const float*)d_in[6];
    const float* lq1 = (const float*)d_in[7]; const float* lk1 = (const float*)d_in[8]; const float* lq2 = (const float*)d_in[9]; const float* lk2 = (const float*)d_in[10];
    const float* g_subln = (const float*)d_in[11]; const float* w_pool = (const float*)d_in[12]; const float* pool_scale = (const float*)d_in[13];
    const float* w_proj_a = (const float*)d_in[14]; const float* w_proj_b = (const float*)d_in[15]; const float* w_out = (const float*)d_in[16];
    const float* g_post_mix = (const float*)d_in[17]; const float* g_pre_ffn = (const float*)d_in[18]; const float* w_router = (const float*)d_in[19]; const float* b_router = (const float*)d_in[20];
    const float* w_exp1 = (const float*)d_in[21]; const float* b_exp1 = (const float*)d_in[22]; const float* w_exp2 = (const float*)d_in[23]; const float* b_exp2 = (const float*)d_in[24];
    const float* g_post_ffn = (const float*)d_in[25];
    float* out = (float*)d_out;
    using nv::bf;
    unsigned* ctl = (unsigned*)(ws + WS_CTL); unsigned* cnt = ctl + CW_CNT;
    float* mod = (float*)(ws + WS_MOD); float* lam = (float*)(ws + WS_MOD + 256 * 1024); int* tstart = (int*)(ws + WS_MOD + 260 * 1024);
    float* rope = (float*)(ws + WS_ROPE); int* list = (int*)(ws + WS_LIST); unsigned* tokslot = (unsigned*)(ws + WS_TOK); float* tokw = (float*)(ws + WS_TOK + 256 * 1024);
    bf* h = (bf*)(ws + WS_H); bf* q = (bf*)(ws + WS_Q); bf* k = (bf*)(ws + WS_K); bf* v = (bf*)(ws + WS_V); bf* u = (bf*)(ws + WS_U); bf* ga = (bf*)(ws + WS_GA); bf* gb = (bf*)(ws + WS_GB);
    bf* dd = (bf*)(ws + WS_DD); bf* O0 = (bf*)(ws + WS_O0); bf* O1 = (bf*)(ws + WS_O1); bf* oc = (bf*)(ws + WS_OC); bf* pp = (bf*)(ws + WS_PP); float* Y = (float*)(ws + WS_Y);
    bf* mi = (bf*)(ws + WS_MI); float* mx = (float*)(ws + WS_MX); bf* h2 = (bf*)(ws + WS_H2); bf* abuf = (bf*)(ws + WS_A); bf* ye = (bf*)(ws + WS_YE);
#define OPT(kk) ((OPT_MASK >> (kk)) & 1)
#define LAUNCH_OPT(kk) do { a.ph_lo = (kk); a.ph_hi = (kk) + 1; hipLaunchKernelGGL(mega_fwd, dim3(grid), dim3(NWAVES * 64), LDS_BYTES, stream, a); } while (0)
    if (OPT_MASK != 0) LAUNCH_OPT(0);
    if (!OPT(0)) { nv::k_mod<<<NB * NMOD * D / 256, 256, 0, stream>>>(c, w_ada, b_ada, lq1, lk1, lq2, lk2, mod, lam); nv::k_rope<<<T * 8 / 256, 256, 0, stream>>>(positions, rope); }
    if (OPT(1)) LAUNCH_OPT(1); else nv::k_norm1<<<T, 256, 0, stream>>>(x, g_pre_mix, mod, 0, D, h);
    if (OPT(2)) LAUNCH_OPT(2); else { nv::k_gemm<<<dim3(INC / 64, T / 64), 256, 0, stream>>>(nv::RmPlain{h, w_in, D, INC}, nv::EpZ{q, k, v, u, ga, gb}, D); nv::k_rope_apply<<<T * 1024 / 256, 256, 0, stream>>>(q, k, rope); }
    if (OPT(3)) LAUNCH_OPT(3); else { nv::k_attn<<<NB * 16 * SEQ / 4, 256, 0, stream>>>(q, k, v, O0, O1); nv::k_poold<<<T * PW / 256, 256, 0, stream>>>(u, dd); }
    if (OPT(4)) LAUNCH_OPT(4); else { nv::k_combine<<<T * NH / 4, 256, 0, stream>>>(O0, O1, lam, g_subln, oc);
        for (int g = 0; g < 4; ++g) nv::k_gemm<<<dim3(128 / 64, T / 64), 256, 0, stream>>>(nv::RmPlain{dd + g * 128, w_pool + g * 128 * 128, PW, 128}, nv::EpPool{pp, pool_scale, g, 0}, 128); }
    if (OPT(5)) LAUNCH_OPT(5); else { nv::k_gemm<<<dim3(D / 64, T / 64), 256, 0, stream>>>(nv::RmPlain{oc, w_proj_a, D, D}, nv::EpGateY{Y, ga}, DW);
        nv::k_gemm<<<dim3(D / 64, T / 64), 256, 0, stream>>>(nv::RmPlain{pp, w_proj_b, PW, D}, nv::EpGateAdd{Y, gb, mi}, PW); }
    if (OPT(6)) LAUNCH_OPT(6); else nv::k_gemm<<<dim3(D / 64, T / 64), 256, 0, stream>>>(nv::RmPlain{mi, w_out, D, D}, nv::EpF32{mx}, D);
    if (OPT(7)) LAUNCH_OPT(7); else nv::k_router<<<T / 4, 256, 0, stream>>>(x, mx, mod, g_post_mix, g_pre_ffn, w_router, b_router, out, h2, cnt, list, tokslot, tokw);
    nv::k_tstart<<<1, 64, 0, stream>>>(cnt, tstart);
    if (OPT(8)) LAUNCH_OPT(8); else nv::k_moe1<<<dim3(2 * FF / 64, MPAD / 64), 256, 0, stream>>>(nv::RmMoe{h2, tstart, cnt, list, w_exp1, (size_t)D * 2 * FF, 2 * FF, 1}, b_exp1, abuf);
    if (OPT(9)) LAUNCH_OPT(9); else nv::k_gemm<<<dim3(D / 64, MPAD / 64), 256, 0, stream>>>(nv::RmMoe{abuf, tstart, cnt, list, w_exp2, (size_t)FF * D, D, 0}, nv::EpYe{ye, b_exp2}, FF);
    if (OPT(10)) LAUNCH_OPT(10); else nv::k_final<<<T / 4, 256, 0, stream>>>(ye, tstart, tokslot, tokw, mod, g_post_ffn, out);
#endif
}
```
